# Optimizing an MI355X kernel written in HIP

```python
import math
import jax, jax.numpy as jnp
from jax import lax
import numpy as np

D_MODEL = 1024
BATCH = 8
SEQ = 2048
DEPTH = 2
DEC_BATCH = 128
DEC_SEQ = 4
PAST_LEN = 16384
PAGE_SIZE = 128

N_MIXERS = 2
N_GLA_LAYERS = (DEPTH + 1) // 2
N_S5_LAYERS = DEPTH // 2
N_SANDWICH_NORMS = 6
D_FF = ((8 * D_MODEL // 3 + 127) // 128) * 128
GLA_HEADS = 4
GLA_DK = D_MODEL // 2 // GLA_HEADS
GLA_DV = D_MODEL // GLA_HEADS
GLA_KEY_DIM = GLA_HEADS * GLA_DK
GLA_VAL_DIM = GLA_HEADS * GLA_DV
GATE_RANK = 16
GATE_TAU = 16.0
GLA_CHUNK = 64
S5_GROUP = 16
S5_GROUPS = D_MODEL // S5_GROUP
S5_STATE = 64
DT_MIN = 1e-3
DT_MAX = 1e-1
EPS = 1e-6

kernel_name = 'hybrid_gla_s5_macaron_step'


def rmsnorm(x, g):
    xf = x.astype(jnp.float32)
    y = xf * lax.rsqrt(jnp.mean(xf * xf, axis=-1, keepdims=True) + EPS)
    return (y * g.astype(jnp.float32)).astype(x.dtype)


def swiglu(x, w_gu, w_down):
    gate, up = jnp.split(x @ w_gu, 2, axis=-1)
    return (jax.nn.silu(gate) * up) @ w_down


def gla_recurrence(q, k, v, logf, s0):
    B, T, H = q.shape[:3]
    c = min(GLA_CHUNK, T)
    n = -(-T // c)
    pad = n * c - T
    f32 = jnp.float32
    q, k, v, logf = (a.astype(f32) for a in (q, k, v, logf))
    if pad:
        pw = ((0, 0), (0, pad), (0, 0), (0, 0))
        q, k, v, logf = (jnp.pad(a, pw) for a in (q, k, v, logf))

    def to_chunks(a):
        return a.reshape(B, n, c, H, a.shape[-1]).transpose(1, 0, 3, 2, 4)

    causal = jnp.tril(jnp.ones((c, c), dtype=bool))

    def step(S, inp):
        qc, kc, vc, gc = inp
        b = jnp.cumsum(gc, axis=2)
        diff = b[:, :, :, None, :] - b[:, :, None, :, :]
        decay = jnp.exp(jnp.where(causal[:, :, None], diff, -jnp.inf))
        att = jnp.einsum('bhtd,bhsd,bhtsd->bhts', qc, kc, decay)
        o = (jnp.einsum('bhts,bhsv->bhtv', att, vc)
             + jnp.einsum('bhtd,bhdv->bhtv', qc * jnp.exp(b), S))
        b_end = b[:, :, -1:, :]
        S_new = (jnp.exp(b_end[:, :, 0, :])[..., None] * S
                 + jnp.einsum('bhsd,bhsv->bhdv', kc * jnp.exp(b_end - b), vc))
        return S_new, o

    S, o = lax.scan(step, s0.astype(f32), (to_chunks(q), to_chunks(k), to_chunks(v), to_chunks(logf)))
    o = o.transpose(1, 0, 3, 2, 4).reshape(B, n * c, H, v.shape[-1])[:, :T]
    return o, S.astype(s0.dtype)


def gla_mixer(x, s0, w_in, w_g2, b_g, g_onorm, w_out):
    B, T, _ = x.shape
    proj = x @ w_in
    q, k, v, r, glr = jnp.split(
        proj, [GLA_KEY_DIM, 2 * GLA_KEY_DIM, 2 * GLA_KEY_DIM + GLA_VAL_DIM,
               2 * GLA_KEY_DIM + 2 * GLA_VAL_DIM], axis=-1)
    logf = jax.nn.log_sigmoid((glr @ w_g2 + b_g).astype(jnp.float32)) / GATE_TAU
    q = q.reshape(B, T, GLA_HEADS, GLA_DK) * (GLA_DK ** -0.5)
    k = k.reshape(B, T, GLA_HEADS, GLA_DK)
    v = v.reshape(B, T, GLA_HEADS, GLA_DV)
    logf = logf.reshape(B, T, GLA_HEADS, GLA_DK)
    o, S = gla_recurrence(q, k, v, logf, s0)
    o = rmsnorm(o.astype(x.dtype), g_onorm).reshape(B, T, GLA_VAL_DIM)
    o = o * jax.nn.silu(r)
    return o @ w_out, S


def s5_discretize(lam_re, lam_im, log_dt, b_re, b_im):
    f32 = jnp.float32
    lam_re, lam_im, b_re, b_im = (a.astype(f32) for a in (lam_re, lam_im, b_re, b_im))
    dt = jnp.exp(log_dt.astype(f32))[:, None]
    mag = jnp.exp(lam_re * dt)
    ang = lam_im * dt
    a_re, a_im = mag * jnp.cos(ang), mag * jnp.sin(ang)
    nr, ni = a_re - 1.0, a_im
    den = lam_re * lam_re + lam_im * lam_im
    f_re = (nr * lam_re + ni * lam_im) / den
    f_im = (ni * lam_re - nr * lam_im) / den
    bb_re = f_re[..., None] * b_re - f_im[..., None] * b_im
    bb_im = f_re[..., None] * b_im + f_im[..., None] * b_re
    return a_re, a_im, bb_re, bb_im


def s5_mixer(x, h0_re, h0_im, lam_re, lam_im, log_dt, b_re, b_im, c_re, c_im, d_skip, w_glu, b_glu):
    B, T, _ = x.shape
    f32 = jnp.float32
    xf = x.astype(f32)
    u = xf.reshape(B, T, S5_GROUPS, S5_GROUP)
    a_re, a_im, bb_re, bb_im = s5_discretize(lam_re, lam_im, log_dt, b_re, b_im)
    bu_re = jnp.einsum('btgc,gpc->btgp', u, bb_re)
    bu_im = jnp.einsum('btgc,gpc->btgp', u, bb_im)
    hr, hi = h0_re.astype(f32), h0_im.astype(f32)
    bu_re = bu_re.at[:, 0].add(a_re * hr - a_im * hi)
    bu_im = bu_im.at[:, 0].add(a_re * hi + a_im * hr)
    A_re = jnp.broadcast_to(a_re[None, None], (1, T, S5_GROUPS, S5_STATE))
    A_im = jnp.broadcast_to(a_im[None, None], (1, T, S5_GROUPS, S5_STATE))

    def combine(e1, e2):
        ar1, ai1, br1, bi1 = e1
        ar2, ai2, br2, bi2 = e2
        return (ar1 * ar2 - ai1 * ai2,
                ar1 * ai2 + ai1 * ar2,
                ar2 * br1 - ai2 * bi1 + br2,
                ar2 * bi1 + ai2 * br1 + bi2)

    _, _, h_re, h_im = lax.associative_scan(combine, (A_re, A_im, bu_re, bu_im), axis=1)
    y = (jnp.einsum('btgp,gcp->btgc', h_re, c_re.astype(f32))
         - jnp.einsum('btgp,gcp->btgc', h_im, c_im.astype(f32)))
    z = (y.reshape(B, T, D_MODEL) + d_skip.astype(f32) * xf).astype(x.dtype)
    val, gate = jnp.split(z @ w_glu + b_glu, 2, axis=-1)
    out = val * jax.nn.sigmoid(gate)
    return out, h_re[:, -1].astype(h0_re.dtype), h_im[:, -1].astype(h0_im.dtype)


def setup_inputs(seed: int = 0) -> dict:
    key = jax.random.key(seed)
    ks = jax.random.split(key, 24)
    f32 = jnp.float32

    def nrm(k, shape, scale):
        return scale * jax.random.normal(k, shape, f32)

    s5_shape = (N_S5_LAYERS, S5_GROUPS, S5_STATE)
    n_idx = jnp.arange(S5_STATE, dtype=f32)
    return {
        'x_prompt': nrm(ks[0], (BATCH, SEQ, D_MODEL), 1.0),
        'x_sample': nrm(ks[1], (DEC_BATCH, DEC_SEQ, D_MODEL), 1.0),
        'state_gla': nrm(ks[2], (N_GLA_LAYERS, DEC_BATCH, GLA_HEADS, GLA_DK, GLA_DV), 0.5),
        'state_s5_re': nrm(ks[3], (N_S5_LAYERS, DEC_BATCH, S5_GROUPS, S5_STATE), 0.1),
        'state_s5_im': nrm(ks[4], (N_S5_LAYERS, DEC_BATCH, S5_GROUPS, S5_STATE), 0.1),
        'norm_g': 1.0 + nrm(ks[5], (DEPTH, N_SANDWICH_NORMS, D_MODEL), 0.05),
        'w_ffn_gu': nrm(ks[6], (DEPTH, 2, D_MODEL, 2 * D_FF), D_MODEL ** -0.5),
        'w_ffn_down': nrm(ks[7], (DEPTH, 2, D_FF, D_MODEL), D_FF ** -0.5),
        'gla_w_in': nrm(ks[8], (N_GLA_LAYERS, D_MODEL, 2 * GLA_KEY_DIM + 2 * GLA_VAL_DIM + GATE_RANK), D_MODEL ** -0.5),
        'gla_w_g2': nrm(ks[9], (N_GLA_LAYERS, GATE_RANK, GLA_KEY_DIM), GATE_RANK ** -0.5),
        'gla_b_g': nrm(ks[10], (N_GLA_LAYERS, GLA_KEY_DIM), 0.1),
        'gla_g_onorm': 1.0 + nrm(ks[11], (N_GLA_LAYERS, GLA_DV), 0.05),
        'gla_w_out': nrm(ks[12], (N_GLA_LAYERS, GLA_VAL_DIM, D_MODEL), GLA_VAL_DIM ** -0.5),
        's5_lam_re': -0.5 * jnp.exp(nrm(ks[13], s5_shape, 0.02)),
        's5_lam_im': math.pi * n_idx + nrm(ks[14], s5_shape, 0.01),
        's5_log_dt': jax.random.uniform(ks[15], (N_S5_LAYERS, S5_GROUPS), f32, math.log(DT_MIN), math.log(DT_MAX)),
        's5_b_re': nrm(ks[16], (N_S5_LAYERS, S5_GROUPS, S5_STATE, S5_GROUP), (2 * S5_GROUP) ** -0.5),
        's5_b_im': nrm(ks[17], (N_S5_LAYERS, S5_GROUPS, S5_STATE, S5_GROUP), (2 * S5_GROUP) ** -0.5),
        's5_c_re': nrm(ks[18], (N_S5_LAYERS, S5_GROUPS, S5_GROUP, S5_STATE), S5_STATE ** -0.5),
        's5_c_im': nrm(ks[19], (N_S5_LAYERS, S5_GROUPS, S5_GROUP, S5_STATE), S5_STATE ** -0.5),
        's5_d': nrm(ks[20], (N_S5_LAYERS, D_MODEL), 1.0),
        's5_w_glu': nrm(ks[21], (N_S5_LAYERS, D_MODEL, 2 * D_MODEL), D_MODEL ** -0.5),
        's5_b_glu': nrm(ks[22], (N_S5_LAYERS, 2 * D_MODEL), 0.01),
    }


def reference(x_prompt, x_sample, state_gla, state_s5_re, state_s5_im, norm_g, w_ffn_gu, w_ffn_down,
              gla_w_in, gla_w_g2, gla_b_g, gla_g_onorm, gla_w_out,
              s5_lam_re, s5_lam_im, s5_log_dt, s5_b_re, s5_b_im, s5_c_re, s5_c_im, s5_d, s5_w_glu, s5_b_glu):

    def run(x, gla_s0, s5_h0_re, s5_h0_im):
        new_gla, new_re, new_im = [], [], []
        for i in range(DEPTH):
            g = norm_g[i]
            x = x + 0.5 * rmsnorm(swiglu(rmsnorm(x, g[0]), w_ffn_gu[i, 0], w_ffn_down[i, 0]), g[1])
            h = rmsnorm(x, g[2])
            j = i // N_MIXERS
            if i % N_MIXERS == 0:
                m, s = gla_mixer(h, gla_s0[j], gla_w_in[j], gla_w_g2[j], gla_b_g[j], gla_g_onorm[j], gla_w_out[j])
                new_gla.append(s)
            else:
                m, hr, hi = s5_mixer(h, s5_h0_re[j], s5_h0_im[j], s5_lam_re[j], s5_lam_im[j], s5_log_dt[j],
                                     s5_b_re[j], s5_b_im[j], s5_c_re[j], s5_c_im[j], s5_d[j],
                                     s5_w_glu[j], s5_b_glu[j])
                new_re.append(hr)
                new_im.append(hi)
            x = x + rmsnorm(m, g[3])
            x = x + 0.5 * rmsnorm(swiglu(rmsnorm(x, g[4]), w_ffn_gu[i, 1], w_ffn_down[i, 1]), g[5])
        return x, jnp.stack(new_gla), jnp.stack(new_re), jnp.stack(new_im)

    zero_gla = jnp.zeros((N_GLA_LAYERS, x_prompt.shape[0], GLA_HEADS, GLA_DK, GLA_DV), x_prompt.dtype)
    zero_s5 = jnp.zeros((N_S5_LAYERS, x_prompt.shape[0], S5_GROUPS, S5_STATE), x_prompt.dtype)
    y_prompt, gla_p, s5re_p, s5im_p = run(x_prompt, zero_gla, zero_s5, zero_s5)
    y_sample, gla_s, s5re_s, s5im_s = run(x_sample, state_gla, state_s5_re, state_s5_im)
    return (y_prompt, y_sample, gla_p, s5re_p, s5im_p, gla_s, s5re_s, s5im_s)
```

```cpp
#include <hip/hip_runtime.h>
#include <hip/hip_cooperative_groups.h>
#include <cstdio>
namespace cg = cooperative_groups;

#ifndef MULTI_LAUNCH
#define MULTI_LAUNCH 0
#endif

#ifndef DBG_NPH
#define DBG_NPH 0
#endif
#define LAS __attribute__((address_space(3)))
typedef unsigned short bf16_t;
typedef short bf16x8 __attribute__((ext_vector_type(8)));
typedef float f32x4 __attribute__((ext_vector_type(4)));
typedef unsigned u32x4 __attribute__((ext_vector_type(4)));
typedef unsigned u32x2 __attribute__((ext_vector_type(2)));

constexpr int D = 1024, FF = 2816, NGU = 5632, MP = 16384, MS = 512, M = MP + MS;
constexpr int NIN = 3584;
constexpr int LDIN = 3088;
constexpr float EPS = 1e-6f;
constexpr int NPH = 24;

constexpr size_t O_X = 0, O_GP = 17301504, O_RP = 18350080, O_IP = 18382848, O_GS = 18415616, O_RS = 35192832, O_IS = 35717120;

constexpr size_t MiB = 1u << 20;
constexpr size_t WS_WGU = 1 * MiB;
constexpr size_t WS_WDN = WS_WGU + 44 * MiB;
constexpr size_t WS_WIN = WS_WDN + 22 * MiB;
constexpr size_t WS_WOUT = WS_WIN + 7 * MiB;
constexpr size_t WS_WGLU = WS_WOUT + 2 * MiB;
constexpr size_t WS_S5M = WS_WGLU + 4 * MiB;
constexpr size_t WS_SMALL = WS_S5M + 16 * MiB;
constexpr size_t WS_H = WS_SMALL + 1 * MiB;
constexpr size_t WS_BIG = WS_H + 33 * MiB;
constexpr size_t WS_ACT = WS_BIG;
constexpr size_t WS_Y = WS_BIG + 92 * MiB;
constexpr size_t WS_QKV = WS_BIG;
constexpr size_t WS_KC = WS_BIG + 116 * MiB;
constexpr size_t WS_BEND = WS_BIG + 180 * MiB;
constexpr size_t WS_HS5 = WS_BIG;
constexpr size_t WS_HLOC = WS_BIG + 48 * MiB;
constexpr size_t WS_Z = WS_BIG + 128 * MiB;
constexpr size_t WS_END = WS_BIG + 181 * MiB;
constexpr size_t S5M_G = 262144;
constexpr int SM_ARE = 0, SM_AIM = 4096, SM_FRE = 8192, SM_FIM = 12288, SM_A16R = 16384, SM_A16I = 20480;

constexpr int LDS_BYTES = 147456;

typedef __bf16 bf16x2_t __attribute__((ext_vector_type(2)));
typedef float f32x2_t __attribute__((ext_vector_type(2)));
__device__ __forceinline__ unsigned cvt_pk_bf16(float lo, float hi) { const f32x2_t v = {lo, hi}; const bf16x2_t b = __builtin_convertvector(v, bf16x2_t); return __builtin_bit_cast(unsigned, b); }
__device__ __forceinline__ float bflo(unsigned w) { return __uint_as_float(w << 16); }
__device__ __forceinline__ float bfhi(unsigned w) { return __uint_as_float(w & 0xffff0000u); }
__device__ __forceinline__ float bf2f(bf16_t b) { return __uint_as_float(((unsigned)b) << 16); }
__device__ __forceinline__ bf16_t f2bf(float f) { return (bf16_t)(cvt_pk_bf16(f, 0.f) & 0xffffu); }
__device__ __forceinline__ float wave_sum(float v) {
#pragma unroll
    for (int o = 1; o < 64; o <<= 1) v += __shfl_xor(v, o);
    return v;
}
__device__ __forceinline__ int otid() { int t = threadIdx.x; asm volatile("" : "+v"(t)); return t; }
__device__ __forceinline__ float sigmoidf_(float a) { return __builtin_amdgcn_rcpf(1.0f + __expf(-a)); }
__device__ __forceinline__ float siluf_(float a) { return a * sigmoidf_(a); }

constexpr int BM = 256, BK = 64, HALF = 128, HTB = HALF * BK * 2;
__device__ __forceinline__ int lds_byte(int r, int c) { const int st = (r >> 4) * 2 + (c >> 5), rr = r & 15, cc = c & 31, ob = rr * 64 + cc * 2; return st * 1024 + (ob ^ (((ob >> 9) & 1) << 5)); }
__device__ __forceinline__ void stage_rc(int b, int& R, int& C) { const int st = b / 1024, sb = b % 1024, swz = sb ^ (((sb >> 9) & 1) << 5); R = (st >> 1) * 16 + swz / 64; C = (st & 1) * 32 + (swz % 64) / 2; }
__device__ __forceinline__ int perm32(int rho) { const int n = rho >> 4, i = rho & 15; return 8 * (i >> 2) + 4 * n + (i & 3); }

struct Unit { const char* A; const char* B; int pm, pn; };

struct TileOrder {
    int nM, nN, nwg, G, c; const char* A0; const char* B0; size_t at, bt;
    __device__ __forceinline__ bool next(int i, Unit& u) const {
        const long L = (long)i * G + c; if (L >= nwg) return false;
        int wgid = (int)L; { const int q = nwg / 8, r = nwg % 8, xcd = wgid % 8, off = wgid / 8; wgid = (xcd < r ? xcd * (q + 1) : r * (q + 1) + (xcd - r) * q) + off; }
        const int nig = 8 * nN, gid = wgid / nig, fm = gid * 8, gsz = (nM - fm) < 8 ? (nM - fm) : 8;
        u.pm = fm + ((wgid % nig) % gsz); u.pn = (wgid % nig) / gsz;
        u.A = A0 + (size_t)u.pm * at; u.B = B0 + (size_t)u.pn * bt; return true;
    }
};
struct S5Order {
    int G, c; const char* A0; const char* B0;
    __device__ __forceinline__ bool next(int i, Unit& u) const {
        const int L = i * G + c; if (L >= 256) return false;
        u.pn = L >> 2; u.pm = L & 3; u.A = A0 + (size_t)u.pn * (1024 * 384 * 2) + (size_t)u.pm * (BM * 384 * 2); u.B = B0 + (size_t)u.pn * 262144; return true;
    }
};

template <class Epi, class Sched>
__device__ __forceinline__ void gemm_phase(LAS unsigned char* lds, const int K, const int lda, const int ldb, const Sched& S, const Epi& E) {
    int tid_ = threadIdx.x; asm volatile("" : "+v"(tid_));
    const int tid = tid_, wid = __builtin_amdgcn_readfirstlane(tid >> 6), lane = tid & 63, wr = wid >> 2, wc = wid & 3, fr = lane & 15, fq = lane >> 4;
    const int nt = K / BK;
    unsigned voffA[2], voffB[2];
#pragma unroll
    for (int i = 0; i < 2; ++i) { int R, C; stage_rc(tid * 16 + i * 8192, R, C); const int Rb = (R & ~31) + perm32(R & 31);
        voffA[i] = (unsigned)(R * lda + C) * 2u; voffB[i] = (unsigned)(Rb * ldb + C) * 2u; }
    const size_t kstep = (size_t)(BK * 2);
    const size_t hstepA = (size_t)HALF * lda * 2, hstepB = (size_t)HALF * ldb * 2;
    const unsigned ldsw = (unsigned)wid * 1024u;
    const int aoff = lds_byte(wr * 64 + fr, fq * 8), boff = lds_byte(wc * 32 + fr, fq * 8);
#define PG8_SA(b, h) (((b) * 2 + (h)) * HTB)
#define PG8_SB(b, h) ((4 + (b) * 2 + (h)) * HTB)
#define PG8_STAGE(bufoff, gbase, voff) do { _Pragma("unroll") for (int _i = 0; _i < 2; ++_i) \
        __builtin_amdgcn_global_load_lds((const unsigned*)((const char*)(gbase) + (voff)[_i]), (LAS unsigned*)(lds + (bufoff) + ldsw + _i * 8192), 16, 0, 0); } while (0)
#define PG8_LDA(dst, b, h) do { _Pragma("unroll") for (int m = 0; m < 4; ++m) _Pragma("unroll") for (int k = 0; k < 2; ++k) dst[m][k] = *(const LAS bf16x8*)(lds + PG8_SA(b, h) + aoff + m * 2048 + k * 1024); } while (0)
#define PG8_LDB(dst, b, h) do { _Pragma("unroll") for (int n = 0; n < 2; ++n) _Pragma("unroll") for (int k = 0; k < 2; ++k) dst[n][k] = *(const LAS bf16x8*)(lds + PG8_SB(b, h) + boff + n * 2048 + k * 1024); } while (0)
#define PG8_MMA(ai, bj, At, Bt) do { __builtin_amdgcn_s_setprio(1); _Pragma("unroll") for (int m = 0; m < 4; ++m) _Pragma("unroll") for (int n = 0; n < 2; ++n) _Pragma("unroll") for (int k = 0; k < 2; ++k) \
        acc[ai][bj][m][n] = __builtin_amdgcn_mfma_f32_16x16x32_bf16(Bt[n][k], At[m][k], acc[ai][bj][m][n], 0, 0, 0); __builtin_amdgcn_s_setprio(0); } while (0)
#define PG8_WAIT_V(n) asm volatile("s_waitcnt vmcnt(" #n ")" ::: "memory")
#define PG8_WAIT_L(n) asm volatile("s_waitcnt lgkmcnt(" #n ")" ::: "memory")
#define PG8_BAR __builtin_amdgcn_s_barrier()
#define PG8_SCHED __builtin_amdgcn_sched_barrier(0)
    Unit cur, nxt; int ui = 0;
    if (!S.next(0, cur)) return;
    f32x4 acc[2][2][4][2];
#pragma unroll
    for (int a = 0; a < 2; ++a)
#pragma unroll
        for (int b = 0; b < 2; ++b)
#pragma unroll
            for (int m = 0; m < 4; ++m)
#pragma unroll
                for (int n = 0; n < 2; ++n) acc[a][b][m][n] = (f32x4){0.f, 0.f, 0.f, 0.f};
    bf16x8 At[4][2], B0[2][2], B1[2][2];
    const char* cA = cur.A; const char* cB = cur.B;
    PG8_STAGE(PG8_SB(0, 0), cB, voffB); PG8_STAGE(PG8_SA(0, 0), cA, voffA); PG8_STAGE(PG8_SB(0, 1), cB + hstepB, voffB); PG8_STAGE(PG8_SA(0, 1), cA + hstepA, voffA);
    if (wr == 1) PG8_BAR;
    PG8_WAIT_V(4); PG8_BAR;
    PG8_STAGE(PG8_SB(1, 0), cB + kstep, voffB); PG8_STAGE(PG8_SA(1, 0), cA + kstep, voffA); PG8_STAGE(PG8_SB(1, 1), cB + hstepB + kstep, voffB);
    PG8_WAIT_V(6); PG8_BAR;
    for (;;) {
        const bool has_next = S.next(ui + 1, nxt);
        const char* nA = has_next ? nxt.A : cA; const char* nB = has_next ? nxt.B : cB;
        for (int t = 0; t < nt; t += 2) {
            const bool last = (t == nt - 2);
            const char* a1 = cA + (size_t)(t + 1) * kstep;
            const char* a2 = last ? nA : cA + (size_t)(t + 2) * kstep; const char* b2 = last ? nB : cB + (size_t)(t + 2) * kstep;
            const char* a3 = a2 + kstep; const char* b3 = b2 + kstep;
            PG8_LDB(B0, 0, 0); PG8_SCHED; PG8_LDA(At, 0, 0); PG8_STAGE(PG8_SA(1, 1), a1 + hstepA, voffA);
            PG8_WAIT_L(8); PG8_BAR; PG8_WAIT_L(0); PG8_MMA(0, 0, At, B0); PG8_BAR; PG8_SCHED;
            PG8_LDB(B1, 0, 1); PG8_STAGE(PG8_SB(0, 0), b2, voffB);
            PG8_BAR; PG8_WAIT_L(0); PG8_MMA(0, 1, At, B1); PG8_BAR;
            PG8_LDA(At, 0, 1); PG8_STAGE(PG8_SA(0, 0), a2, voffA);
            PG8_BAR; PG8_WAIT_L(0); PG8_MMA(1, 0, At, B0); PG8_BAR; PG8_SCHED;
            PG8_STAGE(PG8_SB(0, 1), b2 + hstepB, voffB);
            PG8_WAIT_V(6); PG8_BAR; PG8_MMA(1, 1, At, B1); PG8_BAR;
            PG8_LDB(B0, 1, 0); PG8_SCHED; PG8_LDA(At, 1, 0); PG8_STAGE(PG8_SA(0, 1), a2 + hstepA, voffA);
            PG8_WAIT_L(8); PG8_BAR; PG8_WAIT_L(0); PG8_MMA(0, 0, At, B0); PG8_BAR; PG8_SCHED;
            PG8_LDB(B1, 1, 1); PG8_STAGE(PG8_SB(1, 0), b3, voffB);
            PG8_BAR; PG8_WAIT_L(0); PG8_MMA(0, 1, At, B1); PG8_BAR;
            PG8_LDA(At, 1, 1); PG8_STAGE(PG8_SA(1, 0), a3, voffA);
            PG8_BAR; PG8_WAIT_L(0); PG8_MMA(1, 0, At, B0); PG8_BAR; PG8_SCHED;
            PG8_STAGE(PG8_SB(1, 1), b3 + hstepB, voffB);
            PG8_WAIT_V(6); PG8_BAR; PG8_MMA(1, 1, At, B1); PG8_BAR;
        }
        E(acc, cur, wr, wc, fr, fq);
        if (!has_next) break;
#pragma unroll
        for (int a = 0; a < 2; ++a)
#pragma unroll
            for (int b = 0; b < 2; ++b)
#pragma unroll
                for (int m = 0; m < 4; ++m)
#pragma unroll
                    for (int n = 0; n < 2; ++n) acc[a][b][m][n] = (f32x4){0.f, 0.f, 0.f, 0.f};
        cur = nxt; cA = nA; cB = nB; ++ui;
    }
    PG8_WAIT_V(0);
    if (wr == 0) PG8_BAR;
    PG8_BAR;
#undef PG8_SA
#undef PG8_SB
#undef PG8_STAGE
#undef PG8_LDA
#undef PG8_LDB
#undef PG8_MMA
#undef PG8_WAIT_V
#undef PG8_WAIT_L
#undef PG8_BAR
#undef PG8_SCHED
}

template <int MODE>
struct EpiGated {
    bf16_t* O; int ldc; const float* bias;
    __device__ __forceinline__ void operator()(const f32x4 (&acc)[2][2][4][2], const Unit& u, int wr, int wc, int fr, int fq) const {
        const int row0 = u.pm * BM + wr * 64 + fr, col0 = u.pn * 128 + wc * 32 + 8 * fq;
        f32x4 b0[2], b1[2];
#pragma unroll
        for (int n = 0; n < 2; ++n) { b0[n] = (f32x4){0.f, 0.f, 0.f, 0.f}; b1[n] = b0[n];
            if (MODE == 1) { b0[n] = *(const f32x4*)(bias + col0 + 4 * n); b1[n] = *(const f32x4*)(bias + ldc + col0 + 4 * n); } }
#pragma unroll
        for (int ai = 0; ai < 2; ++ai)
#pragma unroll
            for (int m = 0; m < 4; ++m) {
                float v[8];
#pragma unroll
                for (int n = 0; n < 2; ++n)
#pragma unroll
                    for (int j = 0; j < 4; ++j) { const float a = acc[ai][0][m][n][j] + b0[n][j], b = acc[ai][1][m][n][j] + b1[n][j];
                        v[4 * n + j] = (MODE == 0) ? siluf_(a) * b : a * sigmoidf_(b); }
                u32x4 w; w.x = cvt_pk_bf16(v[0], v[1]); w.y = cvt_pk_bf16(v[2], v[3]); w.z = cvt_pk_bf16(v[4], v[5]); w.w = cvt_pk_bf16(v[6], v[7]);
                *(u32x4*)(O + (size_t)(row0 + ai * HALF + m * 16) * ldc + col0) = w;
            }
    }
};
template <int GLA>
struct EpiPlain {
    bf16_t* O; int ldc; const float* bg;
    __device__ __forceinline__ void operator()(const f32x4 (&acc)[2][2][4][2], const Unit& u, int wr, int wc, int fr, int fq) const {
        const int row0 = u.pm * BM + wr * 64 + fr, col0 = u.pn * BM + wc * 32 + 8 * fq;
        const bool lf = GLA && (u.pn >= 12);
#pragma unroll
        for (int bj = 0; bj < 2; ++bj) {
            f32x4 bb[2];
#pragma unroll
            for (int n = 0; n < 2; ++n) bb[n] = lf ? *(const f32x4*)(bg + (col0 - 3072) + bj * HALF + 4 * n) : (f32x4){0.f, 0.f, 0.f, 0.f};
#pragma unroll
            for (int ai = 0; ai < 2; ++ai)
#pragma unroll
                for (int m = 0; m < 4; ++m) {
                    float v[8];
#pragma unroll
                    for (int n = 0; n < 2; ++n)
#pragma unroll
                        for (int j = 0; j < 4; ++j) { float a = acc[ai][bj][m][n][j];
                            if (lf) { const float z = a + bb[n][j]; a = (fminf(z, 0.f) - __logf(1.0f + __expf(-fabsf(z)))) * 0.0625f; }
                            v[4 * n + j] = a; }
                    u32x4 w; w.x = cvt_pk_bf16(v[0], v[1]); w.y = cvt_pk_bf16(v[2], v[3]); w.z = cvt_pk_bf16(v[4], v[5]); w.w = cvt_pk_bf16(v[6], v[7]);
                    *(u32x4*)(O + (size_t)(row0 + ai * HALF + m * 16) * ldc + col0 + bj * HALF) = w;
                }
        }
    }
};
struct EpiS5A {
    float* HL;
    __device__ __forceinline__ void operator()(const f32x4 (&acc)[2][2][4][2], const Unit& u, int wr, int wc, int fr, int fq) const {
        const int row0 = u.pm * BM + wr * 64 + fr, col0 = wc * 32 + 8 * fq;
#pragma unroll
        for (int ai = 0; ai < 2; ++ai)
#pragma unroll
            for (int m = 0; m < 4; ++m) { float* p = HL + ((size_t)u.pn * 1024 + row0 + ai * HALF + m * 16) * 128 + col0;
                *(f32x4*)p = acc[ai][0][m][0]; *(f32x4*)(p + 4) = acc[ai][0][m][1]; }
    }
};
struct EpiS5B {
    unsigned char* ws; const float* dsk;
    __device__ __forceinline__ void operator()(const f32x4 (&acc)[2][2][4][2], const Unit& u, int wr, int wc, int fr, int fq) const {
        bf16_t* Z = (bf16_t*)(ws + WS_Z); const bf16_t* Hh = (const bf16_t*)(ws + WS_H);
        asm volatile("" : "+v"(fq));
        const int g = u.pn, c0 = (8 * fq) & 15;
        const f32x4 d0 = *(const f32x4*)(dsk + g * 16 + c0), d1 = *(const f32x4*)(dsk + g * 16 + c0 + 4);
#pragma unroll
        for (int bj = 0; bj < 2; ++bj) { const int t = 8 * bj + 2 * wc + (fq >> 1);
#pragma unroll
            for (int ai = 0; ai < 2; ++ai)
#pragma unroll
                for (int m = 0; m < 4; ++m) { const int colr = u.pm * BM + ai * HALF + wr * 64 + m * 16 + fr; const size_t off = (size_t)(colr * 16 + t) * D + g * 16 + c0;
                    const u32x4 uu = *(const u32x4*)(Hh + off); const f32x4 a0 = acc[ai][bj][m][0], a1 = acc[ai][bj][m][1];
                    u32x4 w; w.x = cvt_pk_bf16(a0[0] + d0[0] * bflo(uu.x), a0[1] + d0[1] * bfhi(uu.x)); w.y = cvt_pk_bf16(a0[2] + d0[2] * bflo(uu.y), a0[3] + d0[3] * bfhi(uu.y));
                    w.z = cvt_pk_bf16(a1[0] + d1[0] * bflo(uu.z), a1[1] + d1[1] * bfhi(uu.z)); w.w = cvt_pk_bf16(a1[2] + d1[2] * bflo(uu.w), a1[3] + d1[3] * bfhi(uu.w));
                    *(u32x4*)(Z + off) = w; }
        }
    }
};

struct Params { const float* in[23]; float* out; unsigned char* ws; int ph_lo, ph_hi; };

__device__ __forceinline__ void row_pass(const float* xin_p, const float* xin_s, const bf16_t* Y, const float* g_post, float scale, float* xout,
                                         const float* g_pre, bf16_t* Hh, bf16_t* HS5) {
    const int tid = otid(); const int lane = tid & 63, gw = blockIdx.x * 8 + (tid >> 6), NGW = gridDim.x * 8;
    for (int m = gw; m < M; m += NGW) {
        const float* xr = (m < MP) ? xin_p + (size_t)m * D : xin_s + (size_t)(m - MP) * D;
        f32x4 v[4];
#pragma unroll
        for (int j = 0; j < 4; ++j) v[j] = *(const f32x4*)(xr + 256 * j + 4 * lane);
        if (Y) {
            f32x4 yv[4]; float ss = 0.f;
#pragma unroll
            for (int j = 0; j < 4; ++j) { const u32x2 w = *(const u32x2*)(Y + (size_t)m * D + 256 * j + 4 * lane); yv[j] = (f32x4){bflo(w.x), bfhi(w.x), bflo(w.y), bfhi(w.y)};
                ss += (yv[j].x * yv[j].x + yv[j].y * yv[j].y) + (yv[j].z * yv[j].z + yv[j].w * yv[j].w); }
            const float r = rsqrtf(wave_sum(ss) * (1.0f / D) + EPS) * scale;
#pragma unroll
            for (int j = 0; j < 4; ++j) { const f32x4 g = *(const f32x4*)(g_post + 256 * j + 4 * lane); v[j] = v[j] + yv[j] * g * r;
                *(f32x4*)(xout + (size_t)m * D + 256 * j + 4 * lane) = v[j]; }
        }
        if (g_pre) {
            float ss = 0.f;
#pragma unroll
            for (int j = 0; j < 4; ++j) ss += (v[j].x * v[j].x + v[j].y * v[j].y) + (v[j].z * v[j].z + v[j].w * v[j].w);
            const float r = rsqrtf(wave_sum(ss) * (1.0f / D) + EPS);
#pragma unroll
            for (int j = 0; j < 4; ++j) { const f32x4 g = *(const f32x4*)(g_pre + 256 * j + 4 * lane); const f32x4 h = v[j] * g * r;
                u32x2 w; w.x = cvt_pk_bf16(h.x, h.y); w.y = cvt_pk_bf16(h.z, h.w);
                *(u32x2*)(Hh + (size_t)m * D + 256 * j + 4 * lane) = w;
                if (HS5 && m < MP) { const int gi = j * 16 + (lane >> 2), c = (lane & 3) * 4;
                    *(u32x2*)(HS5 + ((size_t)gi * 1024 + (m >> 4)) * 384 + (m & 15) * 16 + c) = w; } }
        }
    }
}

__device__ __forceinline__ void transpose_item(const float* W, int ldw, int K, int scol0, bf16_t* Bt, int drow0, int k0, float scale, LAS float* scr, int lane) {
#pragma unroll 8
    for (int i = 0; i < 32; ++i) { const int kk = 2 * i + (lane >> 5); scr[kk * 33 + (lane & 31)] = W[(size_t)(k0 + kk) * ldw + scol0 + (lane & 31)]; }
    asm volatile("s_waitcnt lgkmcnt(0)" ::: "memory");
    const int c = lane & 7;
#pragma unroll
    for (int j = 0; j < 4; ++j) { const int n = (lane >> 3) + 8 * j; const LAS float* s = scr + (8 * c) * 33 + n;
        u32x4 o; o.x = cvt_pk_bf16(s[0 * 33] * scale, s[1 * 33] * scale); o.y = cvt_pk_bf16(s[2 * 33] * scale, s[3 * 33] * scale);
        o.z = cvt_pk_bf16(s[4 * 33] * scale, s[5 * 33] * scale); o.w = cvt_pk_bf16(s[6 * 33] * scale, s[7 * 33] * scale);
        *(u32x4*)(Bt + (size_t)(drow0 + n) * K + k0 + 8 * c) = o; }
    asm volatile("s_waitcnt lgkmcnt(0)" ::: "memory");
}

__device__ __forceinline__ void s5_prep_group(const Params& P, LAS unsigned char* lds, int g) {
    LAS float* apr = (LAS float*)lds;
    LAS float* api = apr + 17 * 64;
    LAS float* bbr = api + 17 * 64;
    LAS float* bbi = bbr + 1024;
    LAS float* cre = bbi + 1024;
    LAS float* cim = cre + 1024;
    LAS float* fre = cim + 1024;
    LAS float* fim = fre + 64;
    LAS float* kmat = fim + 64;
    const int tid = otid();
    float* sm = (float*)(P.ws + WS_SMALL);
    bf16_t* Wm = (bf16_t*)(P.ws + WS_S5M + (size_t)g * S5M_G);
    bf16_t* TE = Wm + 128 * 256;
    if (tid < 64) {
        const int p = tid; const float lr = P.in[13][g * 64 + p], li = P.in[14][g * 64 + p]; const float dt = expf(P.in[15][g]);
        float a1r = 0.f, a1i = 0.f;
        for (int tau = 0; tau <= 16; ++tau) {
            const float mag = expf(lr * dt * (float)tau);
            double rev = (double)li * (double)dt * (double)tau * 0.15915494309189535; rev -= __builtin_rint(rev);
            const float rr = (float)rev; const float s = __builtin_amdgcn_sinf(rr), c = __builtin_amdgcn_cosf(rr);
            apr[tau * 64 + p] = mag * c; api[tau * 64 + p] = mag * s;
            if (tau == 1) { a1r = mag * c; a1i = mag * s; }
            if (tau == 16) { sm[SM_A16R + g * 64 + p] = mag * c; sm[SM_A16I + g * 64 + p] = mag * s; }
        }
        const float nr = a1r - 1.0f, ni = a1i, den = lr * lr + li * li;
        const float fr_ = (nr * lr + ni * li) / den, fi_ = (ni * lr - nr * li) / den;
        fre[p] = fr_; fim[p] = fi_;
        sm[SM_ARE + g * 64 + p] = a1r; sm[SM_AIM + g * 64 + p] = a1i; sm[SM_FRE + g * 64 + p] = fr_; sm[SM_FIM + g * 64 + p] = fi_;
    }
    __syncthreads();
    for (int idx = tid; idx < 1024; idx += 512) { const int p = idx >> 4; const float br = P.in[16][g * 1024 + idx], bi = P.in[17][g * 1024 + idx];
        bbr[idx] = fre[p] * br - fim[p] * bi; bbi[idx] = fre[p] * bi + fim[p] * br;
        cre[idx] = P.in[18][g * 1024 + idx]; cim[idx] = P.in[19][g * 1024 + idx]; }
    __syncthreads();
    for (int idx = tid; idx < 32768; idx += 512) { const int row = idx >> 8, col = idx & 255, s = col >> 4, c = col & 15, p = row & 63, im = row >> 6;
        const float ar = apr[(15 - s) * 64 + p], ai = api[(15 - s) * 64 + p], br = bbr[p * 16 + c], bi = bbi[p * 16 + c];
        Wm[idx] = f2bf(im ? (ar * bi + ai * br) : (ar * br - ai * bi)); }
    for (int idx = tid; idx < 4096; idx += 512) { const int tau = idx >> 8, cp = (idx >> 4) & 15, c = idx & 15; float sum = 0.f;
        for (int p = 0; p < 64; ++p) { const float cr = cre[cp * 64 + p], ci = cim[cp * 64 + p], ar = apr[tau * 64 + p], ai = api[tau * 64 + p];
            const float car = cr * ar - ci * ai, cai = cr * ai + ci * ar; sum += car * bbr[p * 16 + c] - cai * bbi[p * 16 + c]; }
        kmat[idx] = sum; }
    __syncthreads();
    for (int idx = tid; idx < 256 * 384; idx += 512) { const int row = idx / 384, col = idx - row * 384, t = row >> 4, cp = row & 15; float v;
        if (col < 256) { const int s = col >> 4, c = col & 15; v = (s <= t) ? kmat[((t - s) << 8) + (cp << 4) + c] : 0.f; }
        else { const int pp = col - 256, p = pp & 63, im = pp >> 6; const float cr = cre[cp * 64 + p], ci = cim[cp * 64 + p], ar = apr[(t + 1) * 64 + p], ai = api[(t + 1) * 64 + p];
            v = im ? -(cr * ai + ci * ar) : (cr * ar - ci * ai); }
        TE[idx] = f2bf(v); }
    __syncthreads();
}

__device__ __forceinline__ void phase0(const Params& P, LAS unsigned char* lds) {
    const int tid = otid(), lane = tid & 63, wave = tid >> 6;
    const int gw = blockIdx.x * 8 + wave, NGW = gridDim.x * 8;
    LAS float* scr = (LAS float*)(lds + wave * 16384);
    bf16_t* WGU = (bf16_t*)(P.ws + WS_WGU); bf16_t* WDN = (bf16_t*)(P.ws + WS_WDN); bf16_t* WIN = (bf16_t*)(P.ws + WS_WIN);
    bf16_t* WOUT = (bf16_t*)(P.ws + WS_WOUT); bf16_t* WGLU = (bf16_t*)(P.ws + WS_WGLU);
    constexpr int I_GU = 4 * 16 * 176, I_DN = 4 * 44 * 32, I_IN = 16 * 96, I_OUT = 16 * 32, I_GLU = 16 * 64;
    for (int it = gw; it < I_GU + I_DN + I_IN + I_OUT + I_GLU; it += NGW) {
        int r = it;
        if (r < I_GU) { const int lf = r / 2816, rr = r % 2816, kb = rr / 176, nb = rr % 176, n0 = nb * 32, pn = n0 >> 8, bj = (n0 >> 7) & 1, i = n0 & 127;
            transpose_item(P.in[6] + (size_t)lf * D * NGU, NGU, D, bj * FF + pn * 128 + i, WGU + (size_t)lf * NGU * D, n0, kb * 64, 1.0f, scr, lane); continue; }
        r -= I_GU;
        if (r < I_DN) { const int lf = r / 1408, rr = r % 1408, kb = rr / 32, nb = rr % 32;
            transpose_item(P.in[7] + (size_t)lf * FF * D, D, FF, nb * 32, WDN + (size_t)lf * D * FF, nb * 32, kb * 64, 1.0f, scr, lane); continue; }
        r -= I_DN;
        if (r < I_IN) { const int kb = r / 96, nb = r % 96, n0 = nb * 32;
            transpose_item(P.in[8], LDIN, D, n0, WIN, n0, kb * 64, n0 < 512 ? 0.08838834764831845f : 1.0f, scr, lane); continue; }
        r -= I_IN;
        if (r < I_OUT) { const int kb = r / 32, nb = r % 32; transpose_item(P.in[12], D, D, nb * 32, WOUT, nb * 32, kb * 64, 1.0f, scr, lane); continue; }
        r -= I_OUT;
        { const int kb = r / 64, nb = r % 64, n0 = nb * 32, pn = n0 >> 8, bj = (n0 >> 7) & 1, i = n0 & 127;
            transpose_item(P.in[21], 2 * D, D, bj * D + pn * 128 + i, WGLU, n0, kb * 64, 1.0f, scr, lane); }
    }
    for (int idx = blockIdx.x * 512 + tid; idx < 512 * 1024; idx += gridDim.x * 512) { const int j = idx >> 10, k = idx & 1023; float s = 0.f;
#pragma unroll
        for (int r = 0; r < 16; ++r) s += P.in[8][(size_t)k * LDIN + 3072 + r] * P.in[9][r * 512 + j];
        WIN[(size_t)(3072 + j) * D + k] = f2bf(s); }
    __syncthreads();
    for (int g = blockIdx.x; g < 64; g += gridDim.x) s5_prep_group(P, lds, g);
    row_pass(P.in[0], P.in[1], nullptr, nullptr, 0.f, nullptr, P.in[5], (bf16_t*)(P.ws + WS_H), nullptr);
}

__device__ __forceinline__ void gla_cumsum(LAS float* BC, LAS float* TOT, const bf16_t* lf, int tid) {
#pragma unroll
    for (int i = 0; i < 2; ++i) { const int e = tid + 512 * i, t = e >> 4, d0 = (e & 15) * 8; const u32x4 w = *(const u32x4*)(lf + (size_t)t * NIN + d0);
        LAS float* b = BC + t * 128 + d0; b[0] = bflo(w.x); b[1] = bfhi(w.x); b[2] = bflo(w.y); b[3] = bfhi(w.y); b[4] = bflo(w.z); b[5] = bfhi(w.z); b[6] = bflo(w.w); b[7] = bfhi(w.w); }
    __syncthreads();
    const int dk = tid & 127, seg = tid >> 7; float run = 0.f;
#pragma unroll
    for (int i = 0; i < 16; ++i) { const int t = seg * 16 + i; run += BC[t * 128 + dk]; BC[t * 128 + dk] = run; }
    TOT[seg * 128 + dk] = run;
    __syncthreads();
    float off = 0.f;
    for (int s = 0; s < seg; ++s) off += TOT[s * 128 + dk];
#pragma unroll
    for (int i = 0; i < 16; ++i) BC[(seg * 16 + i) * 128 + dk] += off;
    __syncthreads();
}
__device__ __forceinline__ void gla_load_vt(LAS bf16_t* VT, const bf16_t* v, int tid) {
#pragma unroll
    for (int i = 0; i < 4; ++i) { const int e = tid + 512 * i, t = e >> 5, d0 = (e & 31) * 8; const u32x4 w = *(const u32x4*)(v + (size_t)t * NIN + d0);
        LAS bf16_t* p = VT + d0 * 72 + t;
        p[0] = (bf16_t)(w.x & 0xffff); p[72] = (bf16_t)(w.x >> 16); p[144] = (bf16_t)(w.y & 0xffff); p[216] = (bf16_t)(w.y >> 16);
        p[288] = (bf16_t)(w.z & 0xffff); p[360] = (bf16_t)(w.z >> 16); p[432] = (bf16_t)(w.w & 0xffff); p[504] = (bf16_t)(w.w >> 16); }
}

__device__ __forceinline__ void gla_phase_a(const Params& P, LAS unsigned char* lds) {
    const int tid = otid(), lane = tid & 63, w = tid >> 6, l16 = lane & 15, q = lane >> 4;
    LAS float* BC = (LAS float*)lds; LAS float* TOT = (LAS float*)(lds + 32768);
    LAS bf16_t* KT = (LAS bf16_t*)(lds + 34816); LAS bf16_t* VT = (LAS bf16_t*)(lds + 53248);
    const bf16_t* QKV = (const bf16_t*)(P.ws + WS_QKV); bf16_t* KC = (bf16_t*)(P.ws + WS_KC); float* BEND = (float*)(P.ws + WS_BEND);
    for (int item = blockIdx.x; item < 1024; item += gridDim.x) {
        const int b = item >> 7, h = (item >> 5) & 3, c = item & 31; const size_t tok0 = (size_t)b * 2048 + c * 64;
        const bf16_t* base = QKV + tok0 * NIN;
        gla_cumsum(BC, TOT, base + 3072 + h * 128, tid);
        if (tid < 128) BEND[item * 128 + tid] = BC[63 * 128 + tid];
#pragma unroll
        for (int i = 0; i < 2; ++i) { const int e = tid + 512 * i, t = e >> 4, d0 = (e & 15) * 8; const u32x4 wv = *(const u32x4*)(base + (size_t)t * NIN + 512 + h * 128 + d0);
            float kv[8] = {bflo(wv.x), bfhi(wv.x), bflo(wv.y), bfhi(wv.y), bflo(wv.z), bfhi(wv.z), bflo(wv.w), bfhi(wv.w)};
#pragma unroll
            for (int j = 0; j < 8; ++j) KT[(d0 + j) * 72 + t] = f2bf(kv[j] * __expf(BC[63 * 128 + d0 + j] - BC[t * 128 + d0 + j])); }
        gla_load_vt(VT, base + 1024 + h * 256, tid);
        __syncthreads();
        f32x4 acc[8][2];
#pragma unroll
        for (int a = 0; a < 8; ++a) { acc[a][0] = (f32x4){0.f, 0.f, 0.f, 0.f}; acc[a][1] = acc[a][0]; }
#pragma unroll
        for (int kk = 0; kk < 2; ++kk) {
            bf16x8 vb[2];
#pragma unroll
            for (int d = 0; d < 2; ++d) vb[d] = *(const LAS bf16x8*)(VT + (16 * (2 * w + d) + l16) * 72 + kk * 32 + q * 8);
#pragma unroll
            for (int a = 0; a < 8; ++a) { const bf16x8 ka = *(const LAS bf16x8*)(KT + (16 * a + l16) * 72 + kk * 32 + q * 8);
#pragma unroll
                for (int d = 0; d < 2; ++d) acc[a][d] = __builtin_amdgcn_mfma_f32_16x16x32_bf16(ka, vb[d], acc[a][d], 0, 0, 0); }
        }
#pragma unroll
        for (int a = 0; a < 8; ++a)
#pragma unroll
            for (int d = 0; d < 2; ++d) { u32x2 o; o.x = cvt_pk_bf16(acc[a][d][0], acc[a][d][1]); o.y = cvt_pk_bf16(acc[a][d][2], acc[a][d][3]);
                *(u32x2*)(KC + ((size_t)item * 256 + 16 * (2 * w + d) + l16) * 128 + 16 * a + 4 * q) = o; }
        __syncthreads();
    }
}
__device__ __forceinline__ void gla_phase_b(const Params& P) {
    bf16_t* KC = (bf16_t*)(P.ws + WS_KC); const float* BEND = (const float*)(P.ws + WS_BEND);
    const int tidb = otid();
    for (int idx = blockIdx.x * 512 + tidb; idx < 32 * 4096; idx += gridDim.x * 512) {
        const int bh = idx >> 12, e = idx & 4095, dv = e >> 4, dk0 = (e & 15) * 8;
        float S[8];
#pragma unroll
        for (int j = 0; j < 8; ++j) S[j] = 0.f;
#pragma unroll 4
        for (int c = 0; c < 32; ++c) { const int item = bh * 32 + c;
            u32x4* p = (u32x4*)(KC + ((size_t)item * 256 + dv) * 128 + dk0); const u32x4 kc = *p;
            const f32x4 e0 = *(const f32x4*)(BEND + item * 128 + dk0), e1 = *(const f32x4*)(BEND + item * 128 + dk0 + 4);
            u32x4 o; o.x = cvt_pk_bf16(S[0], S[1]); o.y = cvt_pk_bf16(S[2], S[3]); o.z = cvt_pk_bf16(S[4], S[5]); o.w = cvt_pk_bf16(S[6], S[7]); *p = o;
            S[0] = __expf(e0.x) * S[0] + bflo(kc.x); S[1] = __expf(e0.y) * S[1] + bfhi(kc.x); S[2] = __expf(e0.z) * S[2] + bflo(kc.y); S[3] = __expf(e0.w) * S[3] + bfhi(kc.y);
            S[4] = __expf(e1.x) * S[4] + bflo(kc.z); S[5] = __expf(e1.y) * S[5] + bfhi(kc.z); S[6] = __expf(e1.z) * S[6] + bflo(kc.w); S[7] = __expf(e1.w) * S[7] + bfhi(kc.w); }
        float* o = P.out + O_GP + (size_t)bh * 32768;
#pragma unroll
        for (int j = 0; j < 8; ++j) o[(dk0 + j) * 256 + dv] = S[j];
    }
}
__device__ __forceinline__ void gla_phase_c(const Params& P, LAS unsigned char* lds) {
    const int tid = otid(), lane = tid & 63, w = tid >> 6, l16 = lane & 15, q = lane >> 4;
    LAS float* BC = (LAS float*)lds; LAS float* TOT = (LAS float*)(lds + 32768); LAS float* PART = (LAS float*)(lds + 34816);
    LAS bf16_t* QT = (LAS bf16_t*)(lds + 36864); LAS bf16_t* KT = (LAS bf16_t*)(lds + 54272);
    LAS bf16_t* VT = (LAS bf16_t*)(lds + 71680); LAS bf16_t* ATT = (LAS bf16_t*)(lds + 108544);
    const bf16_t* QKV = (const bf16_t*)(P.ws + WS_QKV); const bf16_t* KC = (const bf16_t*)(P.ws + WS_KC); bf16_t* Oo = (bf16_t*)(P.ws + WS_H);
    const float* gon = P.in[11];
    for (int item = blockIdx.x; item < 1024; item += gridDim.x) {
        const int b = item >> 7, h = (item >> 5) & 3, c = item & 31; const size_t tok0 = (size_t)b * 2048 + c * 64;
        const bf16_t* base = QKV + tok0 * NIN;
        gla_cumsum(BC, TOT, base + 3072 + h * 128, tid);
#pragma unroll
        for (int i = 0; i < 2; ++i) { const int e = tid + 512 * i, t = e >> 4, d0 = (e & 15) * 8;
            const u32x4 wq = *(const u32x4*)(base + (size_t)t * NIN + h * 128 + d0), wk = *(const u32x4*)(base + (size_t)t * NIN + 512 + h * 128 + d0);
            float qv[8] = {bflo(wq.x), bfhi(wq.x), bflo(wq.y), bfhi(wq.y), bflo(wq.z), bfhi(wq.z), bflo(wq.w), bfhi(wq.w)};
            float kv[8] = {bflo(wk.x), bfhi(wk.x), bflo(wk.y), bfhi(wk.y), bflo(wk.z), bfhi(wk.z), bflo(wk.w), bfhi(wk.w)};
            float eb[8];
#pragma unroll
            for (int j = 0; j < 8; ++j) { eb[j] = BC[t * 128 + d0 + j]; qv[j] *= __expf(eb[j]); kv[j] *= __expf(-eb[j]); }
            u32x4 oq, ok; oq.x = cvt_pk_bf16(qv[0], qv[1]); oq.y = cvt_pk_bf16(qv[2], qv[3]); oq.z = cvt_pk_bf16(qv[4], qv[5]); oq.w = cvt_pk_bf16(qv[6], qv[7]);
            ok.x = cvt_pk_bf16(kv[0], kv[1]); ok.y = cvt_pk_bf16(kv[2], kv[3]); ok.z = cvt_pk_bf16(kv[4], kv[5]); ok.w = cvt_pk_bf16(kv[6], kv[7]);
            *(LAS u32x4*)(QT + t * 136 + d0) = oq; *(LAS u32x4*)(KT + t * 136 + d0) = ok; }
        gla_load_vt(VT, base + 1024 + h * 256, tid);
        __syncthreads();
        {
            const int tm = w >> 1;
#pragma unroll
            for (int d = 0; d < 2; ++d) { const int sn = 2 * (w & 1) + d; f32x4 a = (f32x4){0.f, 0.f, 0.f, 0.f};
                if (sn <= tm) {
#pragma unroll
                    for (int kk = 0; kk < 4; ++kk) { const bf16x8 kf = *(const LAS bf16x8*)(KT + (16 * sn + l16) * 136 + kk * 32 + q * 8);
                        const bf16x8 qf = *(const LAS bf16x8*)(QT + (16 * tm + l16) * 136 + kk * 32 + q * 8);
                        a = __builtin_amdgcn_mfma_f32_16x16x32_bf16(kf, qf, a, 0, 0, 0); }
                }
                const int t = 16 * tm + l16, s0 = 16 * sn + 4 * q;
#pragma unroll
                for (int i = 0; i < 4; ++i) if (s0 + i > t) a[i] = 0.f;
                u32x2 o; o.x = cvt_pk_bf16(a[0], a[1]); o.y = cvt_pk_bf16(a[2], a[3]);
                *(LAS u32x2*)(ATT + t * 72 + s0) = o; }
        }
        __syncthreads();
        f32x4 acc[2][4];
#pragma unroll
        for (int d = 0; d < 2; ++d)
#pragma unroll
            for (int tm = 0; tm < 4; ++tm) acc[d][tm] = (f32x4){0.f, 0.f, 0.f, 0.f};
#pragma unroll
        for (int kk = 0; kk < 2; ++kk) {
            bf16x8 vf[2], af[4];
#pragma unroll
            for (int d = 0; d < 2; ++d) vf[d] = *(const LAS bf16x8*)(VT + (16 * (2 * w + d) + l16) * 72 + kk * 32 + q * 8);
#pragma unroll
            for (int tm = 0; tm < 4; ++tm) af[tm] = *(const LAS bf16x8*)(ATT + (16 * tm + l16) * 72 + kk * 32 + q * 8);
#pragma unroll
            for (int d = 0; d < 2; ++d)
#pragma unroll
                for (int tm = 0; tm < 4; ++tm) acc[d][tm] = __builtin_amdgcn_mfma_f32_16x16x32_bf16(vf[d], af[tm], acc[d][tm], 0, 0, 0);
        }
#pragma unroll
        for (int kk = 0; kk < 4; ++kk) {
            bf16x8 sf[2], qf[4];
#pragma unroll
            for (int d = 0; d < 2; ++d) sf[d] = *(const bf16x8*)(KC + ((size_t)item * 256 + 16 * (2 * w + d) + l16) * 128 + kk * 32 + q * 8);
#pragma unroll
            for (int tm = 0; tm < 4; ++tm) qf[tm] = *(const LAS bf16x8*)(QT + (16 * tm + l16) * 136 + kk * 32 + q * 8);
#pragma unroll
            for (int d = 0; d < 2; ++d)
#pragma unroll
                for (int tm = 0; tm < 4; ++tm) acc[d][tm] = __builtin_amdgcn_mfma_f32_16x16x32_bf16(sf[d], qf[tm], acc[d][tm], 0, 0, 0);
        }
#pragma unroll
        for (int tm = 0; tm < 4; ++tm) { float ss = 0.f;
#pragma unroll
            for (int d = 0; d < 2; ++d) ss += (acc[d][tm][0] * acc[d][tm][0] + acc[d][tm][1] * acc[d][tm][1]) + (acc[d][tm][2] * acc[d][tm][2] + acc[d][tm][3] * acc[d][tm][3]);
            ss += __shfl_xor(ss, 16); ss += __shfl_xor(ss, 32);
            if (q == 0) PART[w * 64 + 16 * tm + l16] = ss; }
        __syncthreads();
#pragma unroll
        for (int tm = 0; tm < 4; ++tm) { float tot = 0.f;
#pragma unroll
            for (int ww = 0; ww < 8; ++ww) tot += PART[ww * 64 + 16 * tm + l16];
            const float rs = rsqrtf(tot * (1.0f / 256.0f) + EPS); const size_t tok = tok0 + 16 * tm + l16;
#pragma unroll
            for (int d = 0; d < 2; ++d) { const int dv0 = 16 * (2 * w + d) + 4 * q; const f32x4 g = *(const f32x4*)(gon + dv0);
                const u32x2 rr = *(const u32x2*)(QKV + tok * NIN + 2048 + h * 256 + dv0);
                u32x2 o; o.x = cvt_pk_bf16(acc[d][tm][0] * rs * g.x * siluf_(bflo(rr.x)), acc[d][tm][1] * rs * g.y * siluf_(bfhi(rr.x)));
                o.y = cvt_pk_bf16(acc[d][tm][2] * rs * g.z * siluf_(bflo(rr.y)), acc[d][tm][3] * rs * g.w * siluf_(bfhi(rr.y)));
                *(u32x2*)(Oo + tok * D + h * 256 + dv0) = o; } }
        __syncthreads();
    }
    LAS float* SQ = (LAS float*)lds; LAS float* SK = SQ + 512; LAS float* SE = SK + 512; LAS float* OS = SE + 512;   LAS float* WP = OS + 2048;
    for (int item = blockIdx.x; item < 512; item += gridDim.x) {
        const int b = item >> 2, h = item & 3; const size_t row0 = (size_t)MP + b * 4;
        { const int t = tid >> 7, dk = tid & 127; const bf16_t* r = QKV + (row0 + t) * NIN;
            SQ[tid] = bf2f(r[h * 128 + dk]); SK[tid] = bf2f(r[512 + h * 128 + dk]); SE[tid] = __expf(bf2f(r[3072 + h * 128 + dk])); }
        __syncthreads();
        const int dv = tid & 255, half = tid >> 8;
        const float* s0 = P.in[2] + ((size_t)item * 128 + half * 64) * 256 + dv;
        float S[64];
#pragma unroll
        for (int i = 0; i < 64; ++i) S[i] = s0[i * 256];
        float vv[4];
#pragma unroll
        for (int t = 0; t < 4; ++t) vv[t] = bf2f(QKV[(row0 + t) * NIN + 1024 + h * 256 + dv]);
#pragma unroll
        for (int t = 0; t < 4; ++t) { float op = 0.f;
#pragma unroll
            for (int i = 0; i < 64; ++i) { const int dk = half * 64 + i; S[i] = SE[t * 128 + dk] * S[i] + SK[t * 128 + dk] * vv[t]; op += SQ[t * 128 + dk] * S[i]; }
            OS[(half * 4 + t) * 256 + dv] = op; }
        float* so = P.out + O_GS + ((size_t)item * 128 + half * 64) * 256 + dv;
#pragma unroll
        for (int i = 0; i < 64; ++i) so[i * 256] = S[i];
        __syncthreads();
        float o4[4];
#pragma unroll
        for (int t = 0; t < 4; ++t) { o4[t] = OS[t * 256 + dv] + OS[(4 + t) * 256 + dv]; const float s = wave_sum(o4[t] * o4[t]); if (tid < 256 && lane == 0) WP[w * 4 + t] = s; }
        __syncthreads();
        if (tid < 256) {
#pragma unroll
            for (int t = 0; t < 4; ++t) { const float tot = WP[t] + WP[4 + t] + WP[8 + t] + WP[12 + t]; const float rs = rsqrtf(tot * (1.0f / 256.0f) + EPS);
                const float r = bf2f(QKV[(row0 + t) * NIN + 2048 + h * 256 + dv]);
                Oo[(row0 + t) * D + h * 256 + dv] = f2bf(o4[t] * rs * gon[dv] * siluf_(r)); }
        }
        __syncthreads();
    }
}

__device__ __forceinline__ void s5_prefix_and_sample(const Params& P) {
    const int tid = otid(); const int lane = tid & 63, gw = blockIdx.x * 8 + (tid >> 6), NGW = gridDim.x * 8;
    const float* sm = (const float*)(P.ws + WS_SMALL); const float* HL = (const float*)(P.ws + WS_HLOC); bf16_t* HS5 = (bf16_t*)(P.ws + WS_HS5);
    for (int pr = gw; pr < 512; pr += NGW) {
        const int g = pr >> 3, b = pr & 7; const float ar = sm[SM_A16R + g * 64 + lane], ai = sm[SM_A16I + g * 64 + lane];
        float hr = 0.f, hi = 0.f;
#pragma unroll 8
        for (int c = 0; c < 128; ++c) { const size_t col = (size_t)g * 1024 + b * 128 + c;
            const float lr = HL[col * 128 + lane], li = HL[col * 128 + 64 + lane];
            HS5[col * 384 + 256 + lane] = f2bf(hr); HS5[col * 384 + 320 + lane] = f2bf(hi);
            const float nr = ar * hr - ai * hi + lr, ni = ar * hi + ai * hr + li; hr = nr; hi = ni; }
        P.out[O_RP + (size_t)b * 4096 + g * 64 + lane] = hr; P.out[O_IP + (size_t)b * 4096 + g * 64 + lane] = hi;
    }
    const bf16_t* Hh = (const bf16_t*)(P.ws + WS_H); bf16_t* Z = (bf16_t*)(P.ws + WS_Z);
    for (int it = gw; it < 128 * 64; it += NGW) {
        const int b = it >> 6, g = it & 63, p = lane;
        const float ar = sm[SM_ARE + g * 64 + p], ai = sm[SM_AIM + g * 64 + p], fr = sm[SM_FRE + g * 64 + p], fi = sm[SM_FIM + g * 64 + p];
        float bbr[16], bbi[16];
#pragma unroll
        for (int c4 = 0; c4 < 4; ++c4) { const f32x4 br = *(const f32x4*)(P.in[16] + ((size_t)g * 64 + p) * 16 + 4 * c4), bi = *(const f32x4*)(P.in[17] + ((size_t)g * 64 + p) * 16 + 4 * c4);
#pragma unroll
            for (int j = 0; j < 4; ++j) { bbr[4 * c4 + j] = fr * br[j] - fi * bi[j]; bbi[4 * c4 + j] = fr * bi[j] + fi * br[j]; } }
        float hr = P.in[3][(size_t)b * 4096 + g * 64 + p], hi = P.in[4][(size_t)b * 4096 + g * 64 + p];
        const float dsk = P.in[20][g * 16 + (lane & 15)];
#pragma unroll 1
        for (int t = 0; t < 4; ++t) { const size_t row = (size_t)MP + b * 4 + t;
            const u32x4 u0 = *(const u32x4*)(Hh + row * D + g * 16), u1 = *(const u32x4*)(Hh + row * D + g * 16 + 8);
            const float u[16] = {bflo(u0.x), bfhi(u0.x), bflo(u0.y), bfhi(u0.y), bflo(u0.z), bfhi(u0.z), bflo(u0.w), bfhi(u0.w),
                                 bflo(u1.x), bfhi(u1.x), bflo(u1.y), bfhi(u1.y), bflo(u1.z), bfhi(u1.z), bflo(u1.w), bfhi(u1.w)};
            float br = 0.f, bi = 0.f;
#pragma unroll
            for (int c = 0; c < 16; ++c) { br += bbr[c] * u[c]; bi += bbi[c] * u[c]; }
            const float nr = ar * hr - ai * hi + br, ni = ar * hi + ai * hr + bi; hr = nr; hi = ni;
            float ymine = 0.f;
#pragma unroll
            for (int c = 0; c < 16; ++c) { const float cr = P.in[18][((size_t)g * 16 + c) * 64 + p], ci = P.in[19][((size_t)g * 16 + c) * 64 + p];
                const float y = wave_sum(cr * hr - ci * hi); if ((lane & 15) == c) ymine = y; }
            float um = 0.f;
#pragma unroll
            for (int c = 0; c < 16; ++c) if ((lane & 15) == c) um = u[c];
            if (lane < 16) Z[row * D + g * 16 + lane] = f2bf(ymine + dsk * um);
        }
        P.out[O_RS + (size_t)b * 4096 + g * 64 + p] = hr; P.out[O_IS + (size_t)b * 4096 + g * 64 + p] = hi;
    }
}

__global__ void __launch_bounds__(512, 2) fwd_kernel(Params P) {
    extern __shared__ __attribute__((aligned(16))) unsigned char lds_raw[];
    LAS unsigned char* lds = (LAS unsigned char*)lds_raw;
    cg::grid_group grid = cg::this_grid();
    const int lo = P.ph_lo, hi = P.ph_hi; int ph = 0;
    const int G = gridDim.x, cb = blockIdx.x;
    unsigned char* ws = P.ws;
    bf16_t* Hh = (bf16_t*)(ws + WS_H); bf16_t* ACT = (bf16_t*)(ws + WS_ACT); bf16_t* Y = (bf16_t*)(ws + WS_Y);
    float* X = P.out + O_X;
#define PH_BEGIN if (lo <= ph && ph < hi) {
#define PH_END } ++ph; if (lo < ph && ph < hi) grid.sync();

    PH_BEGIN phase0(P, lds); PH_END

#define MIXER_GLA \
    PH_BEGIN { TileOrder S{M / BM, NIN / BM, (M / BM) * (NIN / BM), G, cb, (const char*)Hh, (const char*)(ws + WS_WIN), (size_t)BM * D * 2, (size_t)BM * D * 2}; \
        EpiPlain<1> E{(bf16_t*)(ws + WS_QKV), NIN, P.in[10]}; gemm_phase(lds, D, D, D, S, E); } PH_END \
    PH_BEGIN gla_phase_a(P, lds); PH_END \
    PH_BEGIN gla_phase_b(P); PH_END \
    PH_BEGIN gla_phase_c(P, lds); PH_END \
    PH_BEGIN { TileOrder S{M / BM, D / BM, (M / BM) * (D / BM), G, cb, (const char*)Hh, (const char*)(ws + WS_WOUT), (size_t)BM * D * 2, (size_t)BM * D * 2}; \
        EpiPlain<0> E{Y, D, nullptr}; gemm_phase(lds, D, D, D, S, E); } PH_END
#define MIXER_S5 \
    PH_BEGIN { S5Order S{G, cb, (const char*)(ws + WS_HS5), (const char*)(ws + WS_S5M)}; \
        EpiS5A E{(float*)(ws + WS_HLOC)}; gemm_phase(lds, 256, 384, 256, S, E); } PH_END \
    PH_BEGIN s5_prefix_and_sample(P); PH_END \
    PH_BEGIN { S5Order S{G, cb, (const char*)(ws + WS_HS5), (const char*)(ws + WS_S5M + 65536)}; \
        EpiS5B E{ws, P.in[20]}; gemm_phase(lds, 384, 384, 384, S, E); } PH_END \
    PH_BEGIN { TileOrder S{M / BM, 2 * D / BM, (M / BM) * (2 * D / BM), G, cb, (const char*)(ws + WS_Z), (const char*)(ws + WS_WGLU), (size_t)BM * D * 2, (size_t)BM * D * 2}; \
        EpiGated<1> E{Y, D, P.in[22]}; gemm_phase(lds, D, D, D, S, E); } PH_END
#define FFN_GEMMS(l, f) \
    PH_BEGIN { TileOrder S{M / BM, NGU / BM, (M / BM) * (NGU / BM), G, cb, (const char*)Hh, (const char*)(ws + WS_WGU + (size_t)((l) * 2 + (f)) * NGU * D * 2), (size_t)BM * D * 2, (size_t)BM * D * 2}; \
        EpiGated<0> E{ACT, FF, nullptr}; gemm_phase(lds, D, D, D, S, E); } PH_END \
    PH_BEGIN { TileOrder S{M / BM, D / BM, (M / BM) * (D / BM), G, cb, (const char*)ACT, (const char*)(ws + WS_WDN + (size_t)((l) * 2 + (f)) * D * FF * 2), (size_t)BM * FF * 2, (size_t)BM * FF * 2}; \
        EpiPlain<0> E{Y, D, nullptr}; gemm_phase(lds, FF, FF, FF, S, E); } PH_END
    const float* ng0 = P.in[5]; const float* ng1 = P.in[5] + 6 * D;
    FFN_GEMMS(0, 0)
    PH_BEGIN row_pass(P.in[0], P.in[1], Y, ng0 + 1 * D, 0.5f, X, ng0 + 2 * D, Hh, nullptr); PH_END
    MIXER_GLA
    PH_BEGIN row_pass(X, X + (size_t)MP * D, Y, ng0 + 3 * D, 1.0f, X, ng0 + 4 * D, Hh, nullptr); PH_END
    FFN_GEMMS(0, 1)
    PH_BEGIN row_pass(X, X + (size_t)MP * D, Y, ng0 + 5 * D, 0.5f, X, ng1, Hh, nullptr); PH_END
    FFN_GEMMS(1, 0)
    PH_BEGIN row_pass(X, X + (size_t)MP * D, Y, ng1 + 1 * D, 0.5f, X, ng1 + 2 * D, Hh, (bf16_t*)(ws + WS_HS5)); PH_END
    MIXER_S5
    PH_BEGIN row_pass(X, X + (size_t)MP * D, Y, ng1 + 3 * D, 1.0f, X, ng1 + 4 * D, Hh, nullptr); PH_END
    FFN_GEMMS(1, 1)
    PH_BEGIN row_pass(X, X + (size_t)MP * D, Y, ng1 + 5 * D, 0.5f, X, nullptr, Hh, nullptr); PH_END
#undef PH_BEGIN
#undef PH_END
}

__global__ void dbg_checksum(const unsigned* w, size_t nwords, float* out, size_t nout) {
    for (size_t i = (size_t)blockIdx.x * blockDim.x + threadIdx.x; i < nout; i += (size_t)gridDim.x * blockDim.x) {
        unsigned h = 0; for (int j = 0; j < 3; ++j) { const size_t k = 3 * i + j; if (k < nwords) h = h * 0x9E3779B1u + w[k]; }
        out[i] = (float)(h & 0xffffu);
    }
}
extern "C" void kernel_launch(void* const* d_in, const int* in_sizes, int n_in, void* d_out, int out_size, void* d_ws, size_t ws_size, hipStream_t stream) {
    static int grid = 0;
    if (grid == 0) {
        if (n_in != 23 || ws_size < WS_END) { fprintf(stderr, "kernel_launch: unexpected n_in %d or ws_size %zu (< %zu)\n", n_in, ws_size, (size_t)WS_END); grid = -1; return; }
        int dev = 0, cus = 0, per_cu = 0;
        hipGetDevice(&dev); hipDeviceGetAttribute(&cus, hipDeviceAttributeMultiprocessorCount, dev);
        if (hipFuncSetAttribute((const void*)fwd_kernel, hipFuncAttributeMaxDynamicSharedMemorySize, LDS_BYTES) != hipSuccess) { fprintf(stderr, "kernel_launch: hipFuncSetAttribute failed\n"); grid = -1; return; }
        if (hipOccupancyMaxActiveBlocksPerMultiprocessor(&per_cu, (const void*)fwd_kernel, 512, LDS_BYTES) != hipSuccess || per_cu < 1) { fprintf(stderr, "kernel_launch: occupancy query failed (%d)\n", per_cu); grid = -1; return; }
        grid = cus * per_cu;
    }
    if (grid < 0) return;
    Params p{};
    for (int i = 0; i < 23; ++i) p.in[i] = (const float*)d_in[i];
    p.out = (float*)d_out; p.ws = (unsigned char*)d_ws;
#if MULTI_LAUNCH
    for (int k = 0; k < (DBG_NPH ? DBG_NPH : NPH); ++k) { p.ph_lo = k; p.ph_hi = k + 1; hipLaunchKernelGGL(fwd_kernel, dim3(grid), dim3(512), LDS_BYTES, stream, p); }
#if DBG_NPH
    hipLaunchKernelGGL(dbg_checksum, dim3(2048), dim3(256), 0, stream, (const unsigned*)d_ws, (size_t)(WS_END / 4), (float*)d_out, (size_t)out_size);
#endif
#else
    p.ph_lo = 0; p.ph_hi = NPH;
    void* args[] = {&p};
    hipError_t e = hipLaunchCooperativeKernel((const void*)fwd_kernel, dim3(grid), dim3(512), args, LDS_BYTES, stream);
    if (e != hipSuccess) fprintf(stderr, "cooperative launch failed: %s (grid %d)\n", hipGetErrorString(e), grid);
#endif
}
```

```cpp
#include <hip/hip_runtime.h>
#include <hip/hip_cooperative_groups.h>
#include <cstdio>
namespace cg = cooperative_groups;

#ifndef MULTI_LAUNCH
#define MULTI_LAUNCH 0
#endif

#ifndef DBG_NPH
#define DBG_NPH 0
#endif
#define LAS __attribute__((address_space(3)))
typedef unsigned short bf16_t;
typedef short bf16x8 __attribute__((ext_vector_type(8)));
typedef float f32x4 __attribute__((ext_vector_type(4)));
typedef unsigned u32x4 __attribute__((ext_vector_type(4)));
typedef unsigned u32x2 __attribute__((ext_vector_type(2)));

constexpr int D = 1024, FF = 2816, NGU = 5632, MP = 16384, MS = 512, M = MP + MS;
constexpr int NIN = 3584;
constexpr int LDIN = 3088;
constexpr float EPS = 1e-6f;
constexpr int NPH = 24;

constexpr size_t O_X = 0, O_GP = 17301504, O_RP = 18350080, O_IP = 18382848, O_GS = 18415616, O_RS = 35192832, O_IS = 35717120;

constexpr size_t MiB = 1u << 20;
constexpr size_t WS_WGU = 1 * MiB;
constexpr size_t WS_WDN = WS_WGU + 44 * MiB;
constexpr size_t WS_WIN = WS_WDN + 22 * MiB;
constexpr size_t WS_WOUT = WS_WIN + 7 * MiB;
constexpr size_t WS_WGLU = WS_WOUT + 2 * MiB;
constexpr size_t WS_S5M = WS_WGLU + 4 * MiB;
constexpr size_t WS_SMALL = WS_S5M + 16 * MiB;
constexpr size_t WS_H = WS_SMALL + 1 * MiB;
constexpr size_t WS_BIG = WS_H + 33 * MiB;
constexpr size_t WS_ACT = WS_BIG;
constexpr size_t WS_Y = WS_BIG + 92 * MiB;
constexpr size_t WS_QKV = WS_BIG;
constexpr size_t WS_KC = WS_BIG + 116 * MiB;
constexpr size_t WS_BEND = WS_BIG + 180 * MiB;
constexpr size_t WS_HS5 = WS_BIG;
constexpr size_t WS_HLOC = WS_BIG + 48 * MiB;
constexpr size_t WS_Z = WS_BIG + 128 * MiB;
constexpr size_t WS_PART = WS_BIG + 128 * MiB;
constexpr size_t WS_END = WS_BIG + 181 * MiB;
constexpr size_t S5M_G = 262144;
constexpr int SM_ARE = 0, SM_AIM = 4096, SM_FRE = 8192, SM_FIM = 12288, SM_A16R = 16384, SM_A16I = 20480;

constexpr int LDS_BYTES = 147456;

typedef __bf16 bf16x2_t __attribute__((ext_vector_type(2)));
typedef float f32x2_t __attribute__((ext_vector_type(2)));
__device__ __forceinline__ unsigned cvt_pk_bf16(float lo, float hi) { const f32x2_t v = {lo, hi}; const bf16x2_t b = __builtin_convertvector(v, bf16x2_t); return __builtin_bit_cast(unsigned, b); }
__device__ __forceinline__ float bflo(unsigned w) { return __uint_as_float(w << 16); }
__device__ __forceinline__ float bfhi(unsigned w) { return __uint_as_float(w & 0xffff0000u); }
__device__ __forceinline__ float bf2f(bf16_t b) { return __uint_as_float(((unsigned)b) << 16); }
__device__ __forceinline__ bf16_t f2bf(float f) { return (bf16_t)(cvt_pk_bf16(f, 0.f) & 0xffffu); }
__device__ __forceinline__ float wave_sum(float v) {
#pragma unroll
    for (int o = 1; o < 64; o <<= 1) v += __shfl_xor(v, o);
    return v;
}
__device__ __forceinline__ int otid() { int t = threadIdx.x; asm volatile("" : "+v"(t)); return t; }
__device__ __forceinline__ float sigmoidf_(float a) { return __builtin_amdgcn_rcpf(1.0f + __expf(-a)); }
__device__ __forceinline__ float siluf_(float a) { return a * sigmoidf_(a); }

constexpr int BM = 256, BK = 64, HALF = 128, HTB = HALF * BK * 2;
__device__ __forceinline__ int lds_byte(int r, int c) { const int st = (r >> 4) * 2 + (c >> 5), rr = r & 15, cc = c & 31, ob = rr * 64 + cc * 2; return st * 1024 + (ob ^ (((ob >> 9) & 1) << 5)); }
__device__ __forceinline__ void stage_rc(int b, int& R, int& C) { const int st = b / 1024, sb = b % 1024, swz = sb ^ (((sb >> 9) & 1) << 5); R = (st >> 1) * 16 + swz / 64; C = (st & 1) * 32 + (swz % 64) / 2; }
__device__ __forceinline__ int perm32(int rho) { const int n = rho >> 4, i = rho & 15; return 8 * (i >> 2) + 4 * n + (i & 3); }

struct Unit { const char* A; const char* B; int pm, pn, nt, ks; };

struct TileOrder {
    int nM, nN, nwg, G, c; const char* A0; const char* B0; size_t at, bt; int ntk;
    __device__ __forceinline__ bool next(int i, Unit& u) const {
        const long L = (long)i * G + c; if (L >= nwg) return false;
        u.nt = ntk; u.ks = -1;
        int wgid = (int)L; { const int q = nwg / 8, r = nwg % 8, xcd = wgid % 8, off = wgid / 8; wgid = (xcd < r ? xcd * (q + 1) : r * (q + 1) + (xcd - r) * q) + off; }
        const int nig = 8 * nN, gid = wgid / nig, fm = gid * 8, gsz = (nM - fm) < 8 ? (nM - fm) : 8;
        u.pm = fm + ((wgid % nig) % gsz); u.pn = (wgid % nig) / gsz;
        u.A = A0 + (size_t)u.pm * at; u.B = B0 + (size_t)u.pn * bt; return true;
    }
};
struct SplitOrder {
    TileOrder T; int nks;
    __device__ __forceinline__ bool next(int i, Unit& u) const {
        const int L = i * T.G + T.c;
        if (L < T.nwg) return T.next(i, u);
        const int j = L - T.nwg; if (j >= 8 * nks) return false;
        const int st = j & 7, ks = j >> 3; u.pm = 64 + (st >> 2); u.pn = st & 3; u.nt = 4; u.ks = ks;
        u.A = T.A0 + (size_t)u.pm * T.at + (size_t)ks * 512; u.B = T.B0 + (size_t)u.pn * T.bt + (size_t)ks * 512; return true;
    }
};
struct S5Order {
    int G, c; const char* A0; const char* B0; int ntk;
    __device__ __forceinline__ bool next(int i, Unit& u) const {
        const int L = i * G + c; if (L >= 256) return false;
        u.nt = ntk; u.ks = -1;
        u.pn = L >> 2; u.pm = L & 3; u.A = A0 + (size_t)u.pn * (1024 * 384 * 2) + (size_t)u.pm * (BM * 384 * 2); u.B = B0 + (size_t)u.pn * 262144; return true;
    }
};

template <class Epi, class Sched>
__device__ __forceinline__ void gemm_phase(LAS unsigned char* lds, const int lda, const int ldb, const Sched& S, const Epi& E) {
    int tid_ = threadIdx.x; asm volatile("" : "+v"(tid_));
    const int tid = tid_, wid = __builtin_amdgcn_readfirstlane(tid >> 6), lane = tid & 63, wr = wid >> 2, wc = wid & 3, fr = lane & 15, fq = lane >> 4;
    unsigned voffA[2], voffB[2];
#pragma unroll
    for (int i = 0; i < 2; ++i) { int R, C; stage_rc(tid * 16 + i * 8192, R, C); const int Rb = (R & ~31) + perm32(R & 31);
        voffA[i] = (unsigned)(R * lda + C) * 2u; voffB[i] = (unsigned)(Rb * ldb + C) * 2u; }
    const size_t kstep = (size_t)(BK * 2);
    const size_t hstepA = (size_t)HALF * lda * 2, hstepB = (size_t)HALF * ldb * 2;
    const unsigned ldsw = (unsigned)wid * 1024u;
    const int aoff = lds_byte(wr * 64 + fr, fq * 8), boff = lds_byte(wc * 32 + fr, fq * 8);
#define PG8_SA(b, h) (((b) * 2 + (h)) * HTB)
#define PG8_SB(b, h) ((4 + (b) * 2 + (h)) * HTB)
#define PG8_STAGE(bufoff, gbase, voff) do { _Pragma("unroll") for (int _i = 0; _i < 2; ++_i) \
        __builtin_amdgcn_global_load_lds((const unsigned*)((const char*)(gbase) + (voff)[_i]), (LAS unsigned*)(lds + (bufoff) + ldsw + _i * 8192), 16, 0, 0); } while (0)
#define PG8_LDA(dst, b, h) do { _Pragma("unroll") for (int m = 0; m < 4; ++m) _Pragma("unroll") for (int k = 0; k < 2; ++k) dst[m][k] = *(const LAS bf16x8*)(lds + PG8_SA(b, h) + aoff + m * 2048 + k * 1024); } while (0)
#define PG8_LDB(dst, b, h) do { _Pragma("unroll") for (int n = 0; n < 2; ++n) _Pragma("unroll") for (int k = 0; k < 2; ++k) dst[n][k] = *(const LAS bf16x8*)(lds + PG8_SB(b, h) + boff + n * 2048 + k * 1024); } while (0)
#define PG8_MMA(ai, bj, At, Bt) do { __builtin_amdgcn_s_setprio(1); _Pragma("unroll") for (int m = 0; m < 4; ++m) _Pragma("unroll") for (int n = 0; n < 2; ++n) _Pragma("unroll") for (int k = 0; k < 2; ++k) \
        acc[ai][bj][m][n] = __builtin_amdgcn_mfma_f32_16x16x32_bf16(Bt[n][k], At[m][k], acc[ai][bj][m][n], 0, 0, 0); __builtin_amdgcn_s_setprio(0); } while (0)
#define PG8_WAIT_V(n) asm volatile("s_waitcnt vmcnt(" #n ")" ::: "memory")
#define PG8_WAIT_L(n) asm volatile("s_waitcnt lgkmcnt(" #n ")" ::: "memory")
#define PG8_BAR __builtin_amdgcn_s_barrier()
#define PG8_SCHED __builtin_amdgcn_sched_barrier(0)
    Unit cur, nxt; int ui = 0;
    if (!S.next(0, cur)) return;
    f32x4 acc[2][2][4][2];
#pragma unroll
    for (int a = 0; a < 2; ++a)
#pragma unroll
        for (int b = 0; b < 2; ++b)
#pragma unroll
            for (int m = 0; m < 4; ++m)
#pragma unroll
                for (int n = 0; n < 2; ++n) acc[a][b][m][n] = (f32x4){0.f, 0.f, 0.f, 0.f};
    bf16x8 At[4][2], B0[2][2], B1[2][2];
    const char* cA = cur.A; const char* cB = cur.B;
    PG8_STAGE(PG8_SB(0, 0), cB, voffB); PG8_STAGE(PG8_SA(0, 0), cA, voffA); PG8_STAGE(PG8_SB(0, 1), cB + hstepB, voffB); PG8_STAGE(PG8_SA(0, 1), cA + hstepA, voffA);
    if (wr == 1) PG8_BAR;
    PG8_WAIT_V(4); PG8_BAR;
    PG8_STAGE(PG8_SB(1, 0), cB + kstep, voffB); PG8_STAGE(PG8_SA(1, 0), cA + kstep, voffA); PG8_STAGE(PG8_SB(1, 1), cB + hstepB + kstep, voffB);
    PG8_WAIT_V(6); PG8_BAR;
    for (;;) {
        const bool has_next = S.next(ui + 1, nxt);
        const char* nA = has_next ? nxt.A : cA; const char* nB = has_next ? nxt.B : cB;
        const int nt = cur.nt;
        for (int t = 0; t < nt; t += 2) {
            const bool last = (t == nt - 2);
            const char* a1 = cA + (size_t)(t + 1) * kstep;
            const char* a2 = last ? nA : cA + (size_t)(t + 2) * kstep; const char* b2 = last ? nB : cB + (size_t)(t + 2) * kstep;
            const char* a3 = a2 + kstep; const char* b3 = b2 + kstep;
            PG8_LDB(B0, 0, 0); PG8_SCHED; PG8_LDA(At, 0, 0); PG8_STAGE(PG8_SA(1, 1), a1 + hstepA, voffA);
            PG8_WAIT_L(8); PG8_BAR; PG8_WAIT_L(0); PG8_MMA(0, 0, At, B0); PG8_BAR; PG8_SCHED;
            PG8_LDB(B1, 0, 1); PG8_STAGE(PG8_SB(0, 0), b2, voffB);
            PG8_BAR; PG8_WAIT_L(0); PG8_MMA(0, 1, At, B1); PG8_BAR;
            PG8_LDA(At, 0, 1); PG8_STAGE(PG8_SA(0, 0), a2, voffA);
            PG8_BAR; PG8_WAIT_L(0); PG8_MMA(1, 0, At, B0); PG8_BAR; PG8_SCHED;
            PG8_STAGE(PG8_SB(0, 1), b2 + hstepB, voffB);
            PG8_WAIT_V(6); PG8_BAR; PG8_MMA(1, 1, At, B1); PG8_BAR;
            PG8_LDB(B0, 1, 0); PG8_SCHED; PG8_LDA(At, 1, 0); PG8_STAGE(PG8_SA(0, 1), a2 + hstepA, voffA);
            PG8_WAIT_L(8); PG8_BAR; PG8_WAIT_L(0); PG8_MMA(0, 0, At, B0); PG8_BAR; PG8_SCHED;
            PG8_LDB(B1, 1, 1); PG8_STAGE(PG8_SB(1, 0), b3, voffB);
            PG8_BAR; PG8_WAIT_L(0); PG8_MMA(0, 1, At, B1); PG8_BAR;
            PG8_LDA(At, 1, 1); PG8_STAGE(PG8_SA(1, 0), a3, voffA);
            PG8_BAR; PG8_WAIT_L(0); PG8_MMA(1, 0, At, B0); PG8_BAR; PG8_SCHED;
            PG8_STAGE(PG8_SB(1, 1), b3 + hstepB, voffB);
            PG8_WAIT_V(6); PG8_BAR; PG8_MMA(1, 1, At, B1); PG8_BAR;
        }
        E(acc, cur, wr, wc, fr, fq);
        if (!has_next) break;
#pragma unroll
        for (int a = 0; a < 2; ++a)
#pragma unroll
            for (int b = 0; b < 2; ++b)
#pragma unroll
                for (int m = 0; m < 4; ++m)
#pragma unroll
                    for (int n = 0; n < 2; ++n) acc[a][b][m][n] = (f32x4){0.f, 0.f, 0.f, 0.f};
        cur = nxt; cA = nA; cB = nB; ++ui;
    }
    PG8_WAIT_V(0);
    if (wr == 0) PG8_BAR;
    PG8_BAR;
#undef PG8_SA
#undef PG8_SB
#undef PG8_STAGE
#undef PG8_LDA
#undef PG8_LDB
#undef PG8_MMA
#undef PG8_WAIT_V
#undef PG8_WAIT_L
#undef PG8_BAR
#undef PG8_SCHED
}

template <int MODE>
struct EpiGated {
    bf16_t* O; int ldc; const float* bias;
    __device__ __forceinline__ void operator()(const f32x4 (&acc)[2][2][4][2], const Unit& u, int wr, int wc, int fr, int fq) const {
        const int row0 = u.pm * BM + wr * 64 + fr, col0 = u.pn * 128 + wc * 32 + 8 * fq;
        f32x4 b0[2], b1[2];
#pragma unroll
        for (int n = 0; n < 2; ++n) { b0[n] = (f32x4){0.f, 0.f, 0.f, 0.f}; b1[n] = b0[n];
            if (MODE == 1) { b0[n] = *(const f32x4*)(bias + col0 + 4 * n); b1[n] = *(const f32x4*)(bias + ldc + col0 + 4 * n); } }
#pragma unroll
        for (int ai = 0; ai < 2; ++ai)
#pragma unroll
            for (int m = 0; m < 4; ++m) {
                float v[8];
#pragma unroll
                for (int n = 0; n < 2; ++n)
#pragma unroll
                    for (int j = 0; j < 4; ++j) { const float a = acc[ai][0][m][n][j] + b0[n][j], b = acc[ai][1][m][n][j] + b1[n][j];
                        v[4 * n + j] = (MODE == 0) ? siluf_(a) * b : a * sigmoidf_(b); }
                u32x4 w; w.x = cvt_pk_bf16(v[0], v[1]); w.y = cvt_pk_bf16(v[2], v[3]); w.z = cvt_pk_bf16(v[4], v[5]); w.w = cvt_pk_bf16(v[6], v[7]);
                *(u32x4*)(O + (size_t)(row0 + ai * HALF + m * 16) * ldc + col0) = w;
            }
    }
};
template <int GLA>
struct EpiPlain {
    bf16_t* O; int ldc; const float* bg; float* part;
    __device__ __forceinline__ void operator()(const f32x4 (&acc)[2][2][4][2], const Unit& u, int wr, int wc, int fr, int fq) const {
        const int row0 = u.pm * BM + wr * 64 + fr, col0 = u.pn * BM + wc * 32 + 8 * fq;
        if (!GLA && u.ks >= 0) {
#pragma unroll
            for (int bj = 0; bj < 2; ++bj)
#pragma unroll
                for (int ai = 0; ai < 2; ++ai)
#pragma unroll
                    for (int m = 0; m < 4; ++m) { float* p = part + ((size_t)u.ks * MS + (row0 + ai * HALF + m * 16 - MP)) * D + col0 + bj * HALF;
                        *(f32x4*)p = acc[ai][bj][m][0]; *(f32x4*)(p + 4) = acc[ai][bj][m][1]; }
            return;
        }
        const bool lf = GLA && (u.pn >= 12);
#pragma unroll
        for (int bj = 0; bj < 2; ++bj) {
            f32x4 bb[2];
#pragma unroll
            for (int n = 0; n < 2; ++n) bb[n] = lf ? *(const f32x4*)(bg + (col0 - 3072) + bj * HALF + 4 * n) : (f32x4){0.f, 0.f, 0.f, 0.f};
#pragma unroll
            for (int ai = 0; ai < 2; ++ai)
#pragma unroll
                for (int m = 0; m < 4; ++m) {
                    float v[8];
#pragma unroll
                    for (int n = 0; n < 2; ++n)
#pragma unroll
                        for (int j = 0; j < 4; ++j) { float a = acc[ai][bj][m][n][j];
                            if (lf) { const float z = a + bb[n][j]; a = (fminf(z, 0.f) - __logf(1.0f + __expf(-fabsf(z)))) * 0.0625f; }
                            v[4 * n + j] = a; }
                    u32x4 w; w.x = cvt_pk_bf16(v[0], v[1]); w.y = cvt_pk_bf16(v[2], v[3]); w.z = cvt_pk_bf16(v[4], v[5]); w.w = cvt_pk_bf16(v[6], v[7]);
                    *(u32x4*)(O + (size_t)(row0 + ai * HALF + m * 16) * ldc + col0 + bj * HALF) = w;
                }
        }
    }
};
struct EpiS5A {
    float* HL;
    __device__ __forceinline__ void operator()(const f32x4 (&acc)[2][2][4][2], const Unit& u, int wr, int wc, int fr, int fq) const {
        const int row0 = u.pm * BM + wr * 64 + fr, col0 = wc * 32 + 8 * fq;
#pragma unroll
        for (int ai = 0; ai < 2; ++ai)
#pragma unroll
            for (int m = 0; m < 4; ++m) { float* p = HL + ((size_t)u.pn * 1024 + row0 + ai * HALF + m * 16) * 128 + col0;
                *(f32x4*)p = acc[ai][0][m][0]; *(f32x4*)(p + 4) = acc[ai][0][m][1]; }
    }
};
struct EpiS5B {
    unsigned char* ws; const float* dsk;
    __device__ __forceinline__ void operator()(const f32x4 (&acc)[2][2][4][2], const Unit& u, int wr, int wc, int fr, int fq) const {
        bf16_t* Z = (bf16_t*)(ws + WS_Z); const bf16_t* Hh = (const bf16_t*)(ws + WS_H);
        asm volatile("" : "+v"(fq));
        const int g = u.pn, c0 = (8 * fq) & 15;
        const f32x4 d0 = *(const f32x4*)(dsk + g * 16 + c0), d1 = *(const f32x4*)(dsk + g * 16 + c0 + 4);
#pragma unroll
        for (int bj = 0; bj < 2; ++bj) { const int t = 8 * bj + 2 * wc + (fq >> 1);
#pragma unroll
            for (int ai = 0; ai < 2; ++ai)
#pragma unroll
                for (int m = 0; m < 4; ++m) { const int colr = u.pm * BM + ai * HALF + wr * 64 + m * 16 + fr; const size_t off = (size_t)(colr * 16 + t) * D + g * 16 + c0;
                    const u32x4 uu = *(const u32x4*)(Hh + off); const f32x4 a0 = acc[ai][bj][m][0], a1 = acc[ai][bj][m][1];
                    u32x4 w; w.x = cvt_pk_bf16(a0[0] + d0[0] * bflo(uu.x), a0[1] + d0[1] * bfhi(uu.x)); w.y = cvt_pk_bf16(a0[2] + d0[2] * bflo(uu.y), a0[3] + d0[3] * bfhi(uu.y));
                    w.z = cvt_pk_bf16(a1[0] + d1[0] * bflo(uu.z), a1[1] + d1[1] * bfhi(uu.z)); w.w = cvt_pk_bf16(a1[2] + d1[2] * bflo(uu.w), a1[3] + d1[3] * bfhi(uu.w));
                    *(u32x4*)(Z + off) = w; }
        }
    }
};

struct Params { const float* in[23]; float* out; unsigned char* ws; int ph_lo, ph_hi; };

__device__ __forceinline__ void row_pass(const float* xin_p, const float* xin_s, const bf16_t* Y, const float* g_post, float scale, float* xout,
                                         const float* g_pre, bf16_t* Hh, bf16_t* HS5, const float* part, int nks) {
    const int tid = otid(); const int lane = tid & 63, gw = blockIdx.x * 8 + (tid >> 6), NGW = gridDim.x * 8;
    for (int m = gw; m < M; m += NGW) {
        const float* xr = (m < MP) ? xin_p + (size_t)m * D : xin_s + (size_t)(m - MP) * D;
        f32x4 v[4];
#pragma unroll
        for (int j = 0; j < 4; ++j) v[j] = *(const f32x4*)(xr + 256 * j + 4 * lane);
        if (Y) {
            f32x4 yv[4]; float ss = 0.f;
#pragma unroll
            for (int j = 0; j < 4; ++j) {
                if (part && m >= MP) { f32x4 s = (f32x4){0.f, 0.f, 0.f, 0.f};
                    for (int ks = 0; ks < nks; ++ks) s += *(const f32x4*)(part + ((size_t)ks * MS + (m - MP)) * D + 256 * j + 4 * lane);
                    yv[j] = s; }
                else { const u32x2 w = *(const u32x2*)(Y + (size_t)m * D + 256 * j + 4 * lane); yv[j] = (f32x4){bflo(w.x), bfhi(w.x), bflo(w.y), bfhi(w.y)}; }
                ss += (yv[j].x * yv[j].x + yv[j].y * yv[j].y) + (yv[j].z * yv[j].z + yv[j].w * yv[j].w); }
            const float r = rsqrtf(wave_sum(ss) * (1.0f / D) + EPS) * scale;
#pragma unroll
            for (int j = 0; j < 4; ++j) { const f32x4 g = *(const f32x4*)(g_post + 256 * j + 4 * lane); v[j] = v[j] + yv[j] * g * r;
                *(f32x4*)(xout + (size_t)m * D + 256 * j + 4 * lane) = v[j]; }
        }
        if (g_pre) {
            float ss = 0.f;
#pragma unroll
            for (int j = 0; j < 4; ++j) ss += (v[j].x * v[j].x + v[j].y * v[j].y) + (v[j].z * v[j].z + v[j].w * v[j].w);
            const float r = rsqrtf(wave_sum(ss) * (1.0f / D) + EPS);
#pragma unroll
            for (int j = 0; j < 4; ++j) { const f32x4 g = *(const f32x4*)(g_pre + 256 * j + 4 * lane); const f32x4 h = v[j] * g * r;
                u32x2 w; w.x = cvt_pk_bf16(h.x, h.y); w.y = cvt_pk_bf16(h.z, h.w);
                *(u32x2*)(Hh + (size_t)m * D + 256 * j + 4 * lane) = w;
                if (HS5 && m < MP) { const int gi = j * 16 + (lane >> 2), c = (lane & 3) * 4;
                    *(u32x2*)(HS5 + ((size_t)gi * 1024 + (m >> 4)) * 384 + (m & 15) * 16 + c) = w; } }
        }
    }
}

__device__ __forceinline__ void transpose_item(const float* W, int ldw, int K, int scol0, bf16_t* Bt, int drow0, int k0, float scale, LAS float* scr, int lane) {
#pragma unroll 8
    for (int i = 0; i < 32; ++i) { const int kk = 2 * i + (lane >> 5); scr[kk * 33 + (lane & 31)] = W[(size_t)(k0 + kk) * ldw + scol0 + (lane & 31)]; }
    asm volatile("s_waitcnt lgkmcnt(0)" ::: "memory");
    const int c = lane & 7;
#pragma unroll
    for (int j = 0; j < 4; ++j) { const int n = (lane >> 3) + 8 * j; const LAS float* s = scr + (8 * c) * 33 + n;
        u32x4 o; o.x = cvt_pk_bf16(s[0 * 33] * scale, s[1 * 33] * scale); o.y = cvt_pk_bf16(s[2 * 33] * scale, s[3 * 33] * scale);
        o.z = cvt_pk_bf16(s[4 * 33] * scale, s[5 * 33] * scale); o.w = cvt_pk_bf16(s[6 * 33] * scale, s[7 * 33] * scale);
        *(u32x4*)(Bt + (size_t)(drow0 + n) * K + k0 + 8 * c) = o; }
    asm volatile("s_waitcnt lgkmcnt(0)" ::: "memory");
}

__device__ __forceinline__ void s5_prep_group(const Params& P, LAS unsigned char* lds, int g) {
    LAS float* apr = (LAS float*)lds;
    LAS float* api = apr + 17 * 64;
    LAS float* bbr = api + 17 * 64;
    LAS float* bbi = bbr + 1024;
    LAS float* cre = bbi + 1024;
    LAS float* cim = cre + 1024;
    LAS float* fre = cim + 1024;
    LAS float* fim = fre + 64;
    LAS float* kmat = fim + 64;
    const int tid = otid();
    float* sm = (float*)(P.ws + WS_SMALL);
    bf16_t* Wm = (bf16_t*)(P.ws + WS_S5M + (size_t)g * S5M_G);
    bf16_t* TE = Wm + 128 * 256;
    if (tid < 64) {
        const int p = tid; const float lr = P.in[13][g * 64 + p], li = P.in[14][g * 64 + p]; const float dt = expf(P.in[15][g]);
        float a1r = 0.f, a1i = 0.f;
        for (int tau = 0; tau <= 16; ++tau) {
            const float mag = expf(lr * dt * (float)tau);
            double rev = (double)li * (double)dt * (double)tau * 0.15915494309189535; rev -= __builtin_rint(rev);
            const float rr = (float)rev; const float s = __builtin_amdgcn_sinf(rr), c = __builtin_amdgcn_cosf(rr);
            apr[tau * 64 + p] = mag * c; api[tau * 64 + p] = mag * s;
            if (tau == 1) { a1r = mag * c; a1i = mag * s; }
            if (tau == 16) { sm[SM_A16R + g * 64 + p] = mag * c; sm[SM_A16I + g * 64 + p] = mag * s; }
        }
        const float nr = a1r - 1.0f, ni = a1i, den = lr * lr + li * li;
        const float fr_ = (nr * lr + ni * li) / den, fi_ = (ni * lr - nr * li) / den;
        fre[p] = fr_; fim[p] = fi_;
        sm[SM_ARE + g * 64 + p] = a1r; sm[SM_AIM + g * 64 + p] = a1i; sm[SM_FRE + g * 64 + p] = fr_; sm[SM_FIM + g * 64 + p] = fi_;
    }
    __syncthreads();
    for (int idx = tid; idx < 1024; idx += 512) { const int p = idx >> 4; const float br = P.in[16][g * 1024 + idx], bi = P.in[17][g * 1024 + idx];
        bbr[idx] = fre[p] * br - fim[p] * bi; bbi[idx] = fre[p] * bi + fim[p] * br;
        cre[idx] = P.in[18][g * 1024 + idx]; cim[idx] = P.in[19][g * 1024 + idx]; }
    __syncthreads();
    for (int idx = tid; idx < 32768; idx += 512) { const int row = idx >> 8, col = idx & 255, s = col >> 4, c = col & 15, p = row & 63, im = row >> 6;
        const float ar = apr[(15 - s) * 64 + p], ai = api[(15 - s) * 64 + p], br = bbr[p * 16 + c], bi = bbi[p * 16 + c];
        Wm[idx] = f2bf(im ? (ar * bi + ai * br) : (ar * br - ai * bi)); }
    for (int idx = tid; idx < 4096; idx += 512) { const int tau = idx >> 8, cp = (idx >> 4) & 15, c = idx & 15; float sum = 0.f;
        for (int p = 0; p < 64; ++p) { const float cr = cre[cp * 64 + p], ci = cim[cp * 64 + p], ar = apr[tau * 64 + p], ai = api[tau * 64 + p];
            const float car = cr * ar - ci * ai, cai = cr * ai + ci * ar; sum += car * bbr[p * 16 + c] - cai * bbi[p * 16 + c]; }
        kmat[idx] = sum; }
    __syncthreads();
    for (int idx = tid; idx < 256 * 384; idx += 512) { const int row = idx / 384, col = idx - row * 384, t = row >> 4, cp = row & 15; float v;
        if (col < 256) { const int s = col >> 4, c = col & 15; v = (s <= t) ? kmat[((t - s) << 8) + (cp << 4) + c] : 0.f; }
        else { const int pp = col - 256, p = pp & 63, im = pp >> 6; const float cr = cre[cp * 64 + p], ci = cim[cp * 64 + p], ar = apr[(t + 1) * 64 + p], ai = api[(t + 1) * 64 + p];
            v = im ? -(cr * ai + ci * ar) : (cr * ar - ci * ai); }
        TE[idx] = f2bf(v); }
    __syncthreads();
}

__device__ __forceinline__ void phase0(const Params& P, LAS unsigned char* lds) {
    const int tid = otid(), lane = tid & 63, wave = tid >> 6;
    const int gw = blockIdx.x * 8 + wave, NGW = gridDim.x * 8;
    LAS float* scr = (LAS float*)(lds + wave * 16384);
    bf16_t* WGU = (bf16_t*)(P.ws + WS_WGU); bf16_t* WDN = (bf16_t*)(P.ws + WS_WDN); bf16_t* WIN = (bf16_t*)(P.ws + WS_WIN);
    bf16_t* WOUT = (bf16_t*)(P.ws + WS_WOUT); bf16_t* WGLU = (bf16_t*)(P.ws + WS_WGLU);
    constexpr int I_GU = 4 * 16 * 176, I_DN = 4 * 44 * 32, I_IN = 16 * 96, I_OUT = 16 * 32, I_GLU = 16 * 64;
    for (int it = gw; it < I_GU + I_DN + I_IN + I_OUT + I_GLU; it += NGW) {
        int r = it;
        if (r < I_GU) { const int lf = r / 2816, rr = r % 2816, kb = rr / 176, nb = rr % 176, n0 = nb * 32, pn = n0 >> 8, bj = (n0 >> 7) & 1, i = n0 & 127;
            transpose_item(P.in[6] + (size_t)lf * D * NGU, NGU, D, bj * FF + pn * 128 + i, WGU + (size_t)lf * NGU * D, n0, kb * 64, 1.0f, scr, lane); continue; }
        r -= I_GU;
        if (r < I_DN) { const int lf = r / 1408, rr = r % 1408, kb = rr / 32, nb = rr % 32;
            transpose_item(P.in[7] + (size_t)lf * FF * D, D, FF, nb * 32, WDN + (size_t)lf * D * FF, nb * 32, kb * 64, 1.0f, scr, lane); continue; }
        r -= I_DN;
        if (r < I_IN) { const int kb = r / 96, nb = r % 96, n0 = nb * 32;
            transpose_item(P.in[8], LDIN, D, n0, WIN, n0, kb * 64, n0 < 512 ? 0.08838834764831845f : 1.0f, scr, lane); continue; }
        r -= I_IN;
        if (r < I_OUT) { const int kb = r / 32, nb = r % 32; transpose_item(P.in[12], D, D, nb * 32, WOUT, nb * 32, kb * 64, 1.0f, scr, lane); continue; }
        r -= I_OUT;
        { const int kb = r / 64, nb = r % 64, n0 = nb * 32, pn = n0 >> 8, bj = (n0 >> 7) & 1, i = n0 & 127;
            transpose_item(P.in[21], 2 * D, D, bj * D + pn * 128 + i, WGLU, n0, kb * 64, 1.0f, scr, lane); }
    }
    for (int idx = blockIdx.x * 512 + tid; idx < 512 * 1024; idx += gridDim.x * 512) { const int j = idx >> 10, k = idx & 1023; float s = 0.f;
#pragma unroll
        for (int r = 0; r < 16; ++r) s += P.in[8][(size_t)k * LDIN + 3072 + r] * P.in[9][r * 512 + j];
        WIN[(size_t)(3072 + j) * D + k] = f2bf(s); }
    __syncthreads();
    for (int g = blockIdx.x; g < 64; g += gridDim.x) s5_prep_group(P, lds, g);
    row_pass(P.in[0], P.in[1], nullptr, nullptr, 0.f, nullptr, P.in[5], (bf16_t*)(P.ws + WS_H), nullptr, nullptr, 0);
}

__device__ __forceinline__ void gla_cumsum(LAS float* BC, LAS float* TOT, const bf16_t* lf, int tid) {
#pragma unroll
    for (int i = 0; i < 2; ++i) { const int e = tid + 512 * i, t = e >> 4, d0 = (e & 15) * 8; const u32x4 w = *(const u32x4*)(lf + (size_t)t * NIN + d0);
        LAS float* b = BC + t * 128 + d0; b[0] = bflo(w.x); b[1] = bfhi(w.x); b[2] = bflo(w.y); b[3] = bfhi(w.y); b[4] = bflo(w.z); b[5] = bfhi(w.z); b[6] = bflo(w.w); b[7] = bfhi(w.w); }
    __syncthreads();
    const int dk = tid & 127, seg = tid >> 7; float run = 0.f;
#pragma unroll
    for (int i = 0; i < 16; ++i) { const int t = seg * 16 + i; run += BC[t * 128 + dk]; BC[t * 128 + dk] = run; }
    TOT[seg * 128 + dk] = run;
    __syncthreads();
    float off = 0.f;
    for (int s = 0; s < seg; ++s) off += TOT[s * 128 + dk];
#pragma unroll
    for (int i = 0; i < 16; ++i) BC[(seg * 16 + i) * 128 + dk] += off;
    __syncthreads();
}
__device__ __forceinline__ void gla_load_vt(LAS bf16_t* VT, const bf16_t* v, int tid) {
#pragma unroll
    for (int i = 0; i < 4; ++i) { const int e = tid + 512 * i, t = e >> 5, d0 = (e & 31) * 8; const u32x4 w = *(const u32x4*)(v + (size_t)t * NIN + d0);
        LAS bf16_t* p = VT + d0 * 72 + t;
        p[0] = (bf16_t)(w.x & 0xffff); p[72] = (bf16_t)(w.x >> 16); p[144] = (bf16_t)(w.y & 0xffff); p[216] = (bf16_t)(w.y >> 16);
        p[288] = (bf16_t)(w.z & 0xffff); p[360] = (bf16_t)(w.z >> 16); p[432] = (bf16_t)(w.w & 0xffff); p[504] = (bf16_t)(w.w >> 16); }
}

__device__ __forceinline__ void gla_phase_a(const Params& P, LAS unsigned char* lds) {
    const int tid = otid(), lane = tid & 63, w = tid >> 6, l16 = lane & 15, q = lane >> 4;
    LAS float* BC = (LAS float*)lds; LAS float* TOT = (LAS float*)(lds + 32768);
    LAS bf16_t* KT = (LAS bf16_t*)(lds + 34816); LAS bf16_t* VT = (LAS bf16_t*)(lds + 53248);
    const bf16_t* QKV = (const bf16_t*)(P.ws + WS_QKV); bf16_t* KC = (bf16_t*)(P.ws + WS_KC); float* BEND = (float*)(P.ws + WS_BEND);
    for (int item = blockIdx.x; item < 1024; item += gridDim.x) {
        const int b = item >> 7, h = (item >> 5) & 3, c = item & 31; const size_t tok0 = (size_t)b * 2048 + c * 64;
        const bf16_t* base = QKV + tok0 * NIN;
        gla_cumsum(BC, TOT, base + 3072 + h * 128, tid);
        if (tid < 128) BEND[item * 128 + tid] = BC[63 * 128 + tid];
#pragma unroll
        for (int i = 0; i < 2; ++i) { const int e = tid + 512 * i, t = e >> 4, d0 = (e & 15) * 8; const u32x4 wv = *(const u32x4*)(base + (size_t)t * NIN + 512 + h * 128 + d0);
            float kv[8] = {bflo(wv.x), bfhi(wv.x), bflo(wv.y), bfhi(wv.y), bflo(wv.z), bfhi(wv.z), bflo(wv.w), bfhi(wv.w)};
#pragma unroll
            for (int j = 0; j < 8; ++j) KT[(d0 + j) * 72 + t] = f2bf(kv[j] * __expf(BC[63 * 128 + d0 + j] - BC[t * 128 + d0 + j])); }
        gla_load_vt(VT, base + 1024 + h * 256, tid);
        __syncthreads();
        f32x4 acc[8][2];
#pragma unroll
        for (int a = 0; a < 8; ++a) { acc[a][0] = (f32x4){0.f, 0.f, 0.f, 0.f}; acc[a][1] = acc[a][0]; }
#pragma unroll
        for (int kk = 0; kk < 2; ++kk) {
            bf16x8 vb[2];
#pragma unroll
            for (int d = 0; d < 2; ++d) vb[d] = *(const LAS bf16x8*)(VT + (16 * (2 * w + d) + l16) * 72 + kk * 32 + q * 8);
#pragma unroll
            for (int a = 0; a < 8; ++a) { const bf16x8 ka = *(const LAS bf16x8*)(KT + (16 * a + l16) * 72 + kk * 32 + q * 8);
#pragma unroll
                for (int d = 0; d < 2; ++d) acc[a][d] = __builtin_amdgcn_mfma_f32_16x16x32_bf16(ka, vb[d], acc[a][d], 0, 0, 0); }
        }
#pragma unroll
        for (int a = 0; a < 8; ++a)
#pragma unroll
            for (int d = 0; d < 2; ++d) { u32x2 o; o.x = cvt_pk_bf16(acc[a][d][0], acc[a][d][1]); o.y = cvt_pk_bf16(acc[a][d][2], acc[a][d][3]);
                *(u32x2*)(KC + ((size_t)item * 256 + 16 * (2 * w + d) + l16) * 128 + 16 * a + 4 * q) = o; }
        __syncthreads();
    }
}
__device__ __forceinline__ void gla_phase_b(const Params& P) {
    bf16_t* KC = (bf16_t*)(P.ws + WS_KC); const float* BEND = (const float*)(P.ws + WS_BEND);
    const int tidb = otid();
    for (int idx = blockIdx.x * 512 + tidb; idx < 32 * 4096; idx += gridDim.x * 512) {
        const int bh = idx >> 12, e = idx & 4095, dv = e >> 4, dk0 = (e & 15) * 8;
        float S[8];
#pragma unroll
        for (int j = 0; j < 8; ++j) S[j] = 0.f;
#pragma unroll 4
        for (int c = 0; c < 32; ++c) { const int item = bh * 32 + c;
            u32x4* p = (u32x4*)(KC + ((size_t)item * 256 + dv) * 128 + dk0); const u32x4 kc = *p;
            const f32x4 e0 = *(const f32x4*)(BEND + item * 128 + dk0), e1 = *(const f32x4*)(BEND + item * 128 + dk0 + 4);
            u32x4 o; o.x = cvt_pk_bf16(S[0], S[1]); o.y = cvt_pk_bf16(S[2], S[3]); o.z = cvt_pk_bf16(S[4], S[5]); o.w = cvt_pk_bf16(S[6], S[7]); *p = o;
            S[0] = __expf(e0.x) * S[0] + bflo(kc.x); S[1] = __expf(e0.y) * S[1] + bfhi(kc.x); S[2] = __expf(e0.z) * S[2] + bflo(kc.y); S[3] = __expf(e0.w) * S[3] + bfhi(kc.y);
            S[4] = __expf(e1.x) * S[4] + bflo(kc.z); S[5] = __expf(e1.y) * S[5] + bfhi(kc.z); S[6] = __expf(e1.z) * S[6] + bflo(kc.w); S[7] = __expf(e1.w) * S[7] + bfhi(kc.w); }
        float* o = P.out + O_GP + (size_t)bh * 32768;
#pragma unroll
        for (int j = 0; j < 8; ++j) o[(dk0 + j) * 256 + dv] = S[j];
    }
}
__device__ __forceinline__ void gla_phase_c(const Params& P, LAS unsigned char* lds) {
    const int tid = otid(), lane = tid & 63, w = tid >> 6, l16 = lane & 15, q = lane >> 4;
    LAS float* BC = (LAS float*)lds; LAS float* TOT = (LAS float*)(lds + 32768); LAS float* PART = (LAS float*)(lds + 34816);
    LAS bf16_t* QT = (LAS bf16_t*)(lds + 36864); LAS bf16_t* KT = (LAS bf16_t*)(lds + 54272);
    LAS bf16_t* VT = (LAS bf16_t*)(lds + 71680); LAS bf16_t* ATT = (LAS bf16_t*)(lds + 108544);
    const bf16_t* QKV = (const bf16_t*)(P.ws + WS_QKV); const bf16_t* KC = (const bf16_t*)(P.ws + WS_KC); bf16_t* Oo = (bf16_t*)(P.ws + WS_H);
    const float* gon = P.in[11];
    for (int item = blockIdx.x; item < 1024; item += gridDim.x) {
        const int b = item >> 7, h = (item >> 5) & 3, c = item & 31; const size_t tok0 = (size_t)b * 2048 + c * 64;
        const bf16_t* base = QKV + tok0 * NIN;
        gla_cumsum(BC, TOT, base + 3072 + h * 128, tid);
#pragma unroll
        for (int i = 0; i < 2; ++i) { const int e = tid + 512 * i, t = e >> 4, d0 = (e & 15) * 8;
            const u32x4 wq = *(const u32x4*)(base + (size_t)t * NIN + h * 128 + d0), wk = *(const u32x4*)(base + (size_t)t * NIN + 512 + h * 128 + d0);
            float qv[8] = {bflo(wq.x), bfhi(wq.x), bflo(wq.y), bfhi(wq.y), bflo(wq.z), bfhi(wq.z), bflo(wq.w), bfhi(wq.w)};
            float kv[8] = {bflo(wk.x), bfhi(wk.x), bflo(wk.y), bfhi(wk.y), bflo(wk.z), bfhi(wk.z), bflo(wk.w), bfhi(wk.w)};
            float eb[8];
#pragma unroll
            for (int j = 0; j < 8; ++j) { eb[j] = BC[t * 128 + d0 + j]; qv[j] *= __expf(eb[j]); kv[j] *= __expf(-eb[j]); }
            u32x4 oq, ok; oq.x = cvt_pk_bf16(qv[0], qv[1]); oq.y = cvt_pk_bf16(qv[2], qv[3]); oq.z = cvt_pk_bf16(qv[4], qv[5]); oq.w = cvt_pk_bf16(qv[6], qv[7]);
            ok.x = cvt_pk_bf16(kv[0], kv[1]); ok.y = cvt_pk_bf16(kv[2], kv[3]); ok.z = cvt_pk_bf16(kv[4], kv[5]); ok.w = cvt_pk_bf16(kv[6], kv[7]);
            *(LAS u32x4*)(QT + t * 136 + d0) = oq; *(LAS u32x4*)(KT + t * 136 + d0) = ok; }
        gla_load_vt(VT, base + 1024 + h * 256, tid);
        __syncthreads();
        {
            const int tm = w >> 1;
#pragma unroll
            for (int d = 0; d < 2; ++d) { const int sn = 2 * (w & 1) + d; f32x4 a = (f32x4){0.f, 0.f, 0.f, 0.f};
                if (sn <= tm) {
#pragma unroll
                    for (int kk = 0; kk < 4; ++kk) { const bf16x8 kf = *(const LAS bf16x8*)(KT + (16 * sn + l16) * 136 + kk * 32 + q * 8);
                        const bf16x8 qf = *(const LAS bf16x8*)(QT + (16 * tm + l16) * 136 + kk * 32 + q * 8);
                        a = __builtin_amdgcn_mfma_f32_16x16x32_bf16(kf, qf, a, 0, 0, 0); }
                }
                const int t = 16 * tm + l16, s0 = 16 * sn + 4 * q;
#pragma unroll
                for (int i = 0; i < 4; ++i) if (s0 + i > t) a[i] = 0.f;
                u32x2 o; o.x = cvt_pk_bf16(a[0], a[1]); o.y = cvt_pk_bf16(a[2], a[3]);
                *(LAS u32x2*)(ATT + t * 72 + s0) = o; }
        }
        __syncthreads();
        f32x4 acc[2][4];
#pragma unroll
        for (int d = 0; d < 2; ++d)
#pragma unroll
            for (int tm = 0; tm < 4; ++tm) acc[d][tm] = (f32x4){0.f, 0.f, 0.f, 0.f};
#pragma unroll
        for (int kk = 0; kk < 2; ++kk) {
            bf16x8 vf[2], af[4];
#pragma unroll
            for (int d = 0; d < 2; ++d) vf[d] = *(const LAS bf16x8*)(VT + (16 * (2 * w + d) + l16) * 72 + kk * 32 + q * 8);
#pragma unroll
            for (int tm = 0; tm < 4; ++tm) af[tm] = *(const LAS bf16x8*)(ATT + (16 * tm + l16) * 72 + kk * 32 + q * 8);
#pragma unroll
            for (int d = 0; d < 2; ++d)
#pragma unroll
                for (int tm = 0; tm < 4; ++tm) acc[d][tm] = __builtin_amdgcn_mfma_f32_16x16x32_bf16(vf[d], af[tm], acc[d][tm], 0, 0, 0);
        }
#pragma unroll
        for (int kk = 0; kk < 4; ++kk) {
            bf16x8 sf[2], qf[4];
#pragma unroll
            for (int d = 0; d < 2; ++d) sf[d] = *(const bf16x8*)(KC + ((size_t)item * 256 + 16 * (2 * w + d) + l16) * 128 + kk * 32 + q * 8);
#pragma unroll
            for (int tm = 0; tm < 4; ++tm) qf[tm] = *(const LAS bf16x8*)(QT + (16 * tm + l16) * 136 + kk * 32 + q * 8);
#pragma unroll
            for (int d = 0; d < 2; ++d)
#pragma unroll
                for (int tm = 0; tm < 4; ++tm) acc[d][tm] = __builtin_amdgcn_mfma_f32_16x16x32_bf16(sf[d], qf[tm], acc[d][tm], 0, 0, 0);
        }
#pragma unroll
        for (int tm = 0; tm < 4; ++tm) { float ss = 0.f;
#pragma unroll
            for (int d = 0; d < 2; ++d) ss += (acc[d][tm][0] * acc[d][tm][0] + acc[d][tm][1] * acc[d][tm][1]) + (acc[d][tm][2] * acc[d][tm][2] + acc[d][tm][3] * acc[d][tm][3]);
            ss += __shfl_xor(ss, 16); ss += __shfl_xor(ss, 32);
            if (q == 0) PART[w * 64 + 16 * tm + l16] = ss; }
        __syncthreads();
#pragma unroll
        for (int tm = 0; tm < 4; ++tm) { float tot = 0.f;
#pragma unroll
            for (int ww = 0; ww < 8; ++ww) tot += PART[ww * 64 + 16 * tm + l16];
            const float rs = rsqrtf(tot * (1.0f / 256.0f) + EPS); const size_t tok = tok0 + 16 * tm + l16;
#pragma unroll
            for (int d = 0; d < 2; ++d) { const int dv0 = 16 * (2 * w + d) + 4 * q; const f32x4 g = *(const f32x4*)(gon + dv0);
                const u32x2 rr = *(const u32x2*)(QKV + tok * NIN + 2048 + h * 256 + dv0);
                u32x2 o; o.x = cvt_pk_bf16(acc[d][tm][0] * rs * g.x * siluf_(bflo(rr.x)), acc[d][tm][1] * rs * g.y * siluf_(bfhi(rr.x)));
                o.y = cvt_pk_bf16(acc[d][tm][2] * rs * g.z * siluf_(bflo(rr.y)), acc[d][tm][3] * rs * g.w * siluf_(bfhi(rr.y)));
                *(u32x2*)(Oo + tok * D + h * 256 + dv0) = o; } }
        __syncthreads();
    }
    LAS float* SQ = (LAS float*)lds; LAS float* SK = SQ + 512; LAS float* SE = SK + 512; LAS float* OS = SE + 512;   LAS float* WP = OS + 2048;
    for (int item = blockIdx.x; item < 512; item += gridDim.x) {
        const int b = item >> 2, h = item & 3; const size_t row0 = (size_t)MP + b * 4;
        { const int t = tid >> 7, dk = tid & 127; const bf16_t* r = QKV + (row0 + t) * NIN;
            SQ[tid] = bf2f(r[h * 128 + dk]); SK[tid] = bf2f(r[512 + h * 128 + dk]); SE[tid] = __expf(bf2f(r[3072 + h * 128 + dk])); }
        __syncthreads();
        const int dv = tid & 255, half = tid >> 8;
        const float* s0 = P.in[2] + ((size_t)item * 128 + half * 64) * 256 + dv;
        float S[64];
#pragma unroll
        for (int i = 0; i < 64; ++i) S[i] = s0[i * 256];
        float vv[4];
#pragma unroll
        for (int t = 0; t < 4; ++t) vv[t] = bf2f(QKV[(row0 + t) * NIN + 1024 + h * 256 + dv]);
#pragma unroll
        for (int t = 0; t < 4; ++t) { float op = 0.f;
#pragma unroll
            for (int i = 0; i < 64; ++i) { const int dk = half * 64 + i; S[i] = SE[t * 128 + dk] * S[i] + SK[t * 128 + dk] * vv[t]; op += SQ[t * 128 + dk] * S[i]; }
            OS[(half * 4 + t) * 256 + dv] = op; }
        float* so = P.out + O_GS + ((size_t)item * 128 + half * 64) * 256 + dv;
#pragma unroll
        for (int i = 0; i < 64; ++i) so[i * 256] = S[i];
        __syncthreads();
        float o4[4];
#pragma unroll
        for (int t = 0; t < 4; ++t) { o4[t] = OS[t * 256 + dv] + OS[(4 + t) * 256 + dv]; const float s = wave_sum(o4[t] * o4[t]); if (tid < 256 && lane == 0) WP[w * 4 + t] = s; }
        __syncthreads();
        if (tid < 256) {
#pragma unroll
            for (int t = 0; t < 4; ++t) { const float tot = WP[t] + WP[4 + t] + WP[8 + t] + WP[12 + t]; const float rs = rsqrtf(tot * (1.0f / 256.0f) + EPS);
                const float r = bf2f(QKV[(row0 + t) * NIN + 2048 + h * 256 + dv]);
                Oo[(row0 + t) * D + h * 256 + dv] = f2bf(o4[t] * rs * gon[dv] * siluf_(r)); }
        }
        __syncthreads();
    }
}

__device__ __forceinline__ void s5_prefix_and_sample(const Params& P) {
    const int tid = otid(); const int lane = tid & 63, gw = blockIdx.x * 8 + (tid >> 6), NGW = gridDim.x * 8;
    const float* sm = (const float*)(P.ws + WS_SMALL); const float* HL = (const float*)(P.ws + WS_HLOC); bf16_t* HS5 = (bf16_t*)(P.ws + WS_HS5);
    for (int pr = gw; pr < 512; pr += NGW) {
        const int g = pr >> 3, b = pr & 7; const float ar = sm[SM_A16R + g * 64 + lane], ai = sm[SM_A16I + g * 64 + lane];
        float hr = 0.f, hi = 0.f;
#pragma unroll 8
        for (int c = 0; c < 128; ++c) { const size_t col = (size_t)g * 1024 + b * 128 + c;
            const float lr = HL[col * 128 + lane], li = HL[col * 128 + 64 + lane];
            HS5[col * 384 + 256 + lane] = f2bf(hr); HS5[col * 384 + 320 + lane] = f2bf(hi);
            const float nr = ar * hr - ai * hi + lr, ni = ar * hi + ai * hr + li; hr = nr; hi = ni; }
        P.out[O_RP + (size_t)b * 4096 + g * 64 + lane] = hr; P.out[O_IP + (size_t)b * 4096 + g * 64 + lane] = hi;
    }
    const bf16_t* Hh = (const bf16_t*)(P.ws + WS_H); bf16_t* Z = (bf16_t*)(P.ws + WS_Z);
    for (int it = gw; it < 128 * 64; it += NGW) {
        const int b = it >> 6, g = it & 63, p = lane;
        const float ar = sm[SM_ARE + g * 64 + p], ai = sm[SM_AIM + g * 64 + p], fr = sm[SM_FRE + g * 64 + p], fi = sm[SM_FIM + g * 64 + p];
        float bbr[16], bbi[16];
#pragma unroll
        for (int c4 = 0; c4 < 4; ++c4) { const f32x4 br = *(const f32x4*)(P.in[16] + ((size_t)g * 64 + p) * 16 + 4 * c4), bi = *(const f32x4*)(P.in[17] + ((size_t)g * 64 + p) * 16 + 4 * c4);
#pragma unroll
            for (int j = 0; j < 4; ++j) { bbr[4 * c4 + j] = fr * br[j] - fi * bi[j]; bbi[4 * c4 + j] = fr * bi[j] + fi * br[j]; } }
        float hr = P.in[3][(size_t)b * 4096 + g * 64 + p], hi = P.in[4][(size_t)b * 4096 + g * 64 + p];
        const float dsk = P.in[20][g * 16 + (lane & 15)];
#pragma unroll 1
        for (int t = 0; t < 4; ++t) { const size_t row = (size_t)MP + b * 4 + t;
            const u32x4 u0 = *(const u32x4*)(Hh + row * D + g * 16), u1 = *(const u32x4*)(Hh + row * D + g * 16 + 8);
            const float u[16] = {bflo(u0.x), bfhi(u0.x), bflo(u0.y), bfhi(u0.y), bflo(u0.z), bfhi(u0.z), bflo(u0.w), bfhi(u0.w),
                                 bflo(u1.x), bfhi(u1.x), bflo(u1.y), bfhi(u1.y), bflo(u1.z), bfhi(u1.z), bflo(u1.w), bfhi(u1.w)};
            float br = 0.f, bi = 0.f;
#pragma unroll
            for (int c = 0; c < 16; ++c) { br += bbr[c] * u[c]; bi += bbi[c] * u[c]; }
            const float nr = ar * hr - ai * hi + br, ni = ar * hi + ai * hr + bi; hr = nr; hi = ni;
            float ymine = 0.f;
#pragma unroll
            for (int c = 0; c < 16; ++c) { const float cr = P.in[18][((size_t)g * 16 + c) * 64 + p], ci = P.in[19][((size_t)g * 16 + c) * 64 + p];
                const float y = wave_sum(cr * hr - ci * hi); if ((lane & 15) == c) ymine = y; }
            float um = 0.f;
#pragma unroll
            for (int c = 0; c < 16; ++c) if ((lane & 15) == c) um = u[c];
            if (lane < 16) Z[row * D + g * 16 + lane] = f2bf(ymine + dsk * um);
        }
        P.out[O_RS + (size_t)b * 4096 + g * 64 + p] = hr; P.out[O_IS + (size_t)b * 4096 + g * 64 + p] = hi;
    }
}

#define XB_TMO      128
#define XB_XCNT(j)  (256  + 64 * (j))
#define XB_XSUB(j)  (1280 + 64 * (j))
#define XB_XGEN(j)  (2304 + 64 * (j))
#define XB_TOP      3328
#define XB_TOPGEN   3392
#define XCD_BAR_WORDS 3456
#define XB_SPIN_CAP (1u << 22)
__device__ __forceinline__ unsigned xb_ld(unsigned* p)              { return __hip_atomic_load(p, __ATOMIC_RELAXED, __HIP_MEMORY_SCOPE_AGENT); }
__device__ __forceinline__ unsigned xb_add(unsigned* p, unsigned v) { return __hip_atomic_fetch_add(p, v, __ATOMIC_RELAXED, __HIP_MEMORY_SCOPE_AGENT); }
__device__ __forceinline__ unsigned xb_xcc_id() { return (unsigned)__builtin_amdgcn_s_getreg((3 << 11) | 20) & 0xFu; }
#define XB_SPIN(cond, bar) do { unsigned _sp = 0; while (cond) { __builtin_amdgcn_s_sleep(1); \
    if ((++_sp & 255u) == 0u) { if (xb_ld(&(bar)[XB_TMO])) break; if (_sp > XB_SPIN_CAP) { atomicAdd(&(bar)[XB_TMO], 1u); break; } } } } while (0)
struct XcdBarrier { unsigned* bar; unsigned x; volatile LAS unsigned* st; };
__device__ __forceinline__ XcdBarrier xcd_barrier_post(unsigned* bar, volatile LAS unsigned* st) {
    XcdBarrier b; b.bar = bar; b.x = xb_xcc_id(); b.st = st;
    if (threadIdx.x == 0) (void)xb_add(&bar[XB_XCNT(b.x)], 1u);
    return b;
}
__device__ __forceinline__ void xcd_barrier_complete(unsigned* bar, unsigned x, unsigned& nloc, unsigned& nx) {
    const unsigned G = gridDim.x * gridDim.y * gridDim.z;
    unsigned sum, cnt, mine, sp = 0u;
    for (;;) {
        sum = 0u; cnt = 0u; mine = 0u;
#pragma unroll
        for (unsigned j = 0; j < 16; ++j) { const unsigned c = xb_ld(&bar[XB_XCNT(j)]); sum += c; cnt += (c > 0u) ? 1u : 0u; mine = (j == x) ? c : mine; }
        if (sum == G) break;
        __builtin_amdgcn_s_sleep(1);
        if ((++sp & 255u) == 0u) { if (xb_ld(&bar[XB_TMO])) break; if (sp > XB_SPIN_CAP) { atomicAdd(&bar[XB_TMO], 1u); break; } }
    }
    nloc = mine > 0u ? mine : 1u; nx = cnt > 0u ? cnt : 1u;
}
__device__ __forceinline__ void xcd_barrier(const XcdBarrier& b) {
    asm volatile("s_waitcnt vmcnt(0)" ::: "memory");
    __syncthreads();
    if (threadIdx.x == 0) {
        unsigned* bar = b.bar;
        __builtin_amdgcn_s_waitcnt(0);
        unsigned nloc = b.st[0], nx = b.st[1];
        if (nloc == 0u) { xcd_barrier_complete(bar, b.x, nloc, nx); b.st[0] = nloc; b.st[1] = nx; }
        const unsigned old = xb_add(&bar[XB_XSUB(b.x)], 1u);
        const unsigned gen = old / nloc;
        if (old + 1u == (gen + 1u) * nloc) {
            __builtin_amdgcn_fence(__ATOMIC_RELEASE, "agent");
            asm volatile("s_waitcnt vmcnt(0)" ::: "memory");
            const unsigned og = xb_add(&bar[XB_TOP], 1u);
            const unsigned tg = og / nx;
            if (og + 1u == (tg + 1u) * nx) xb_add(&bar[XB_TOPGEN], 1u);
            else XB_SPIN(xb_ld(&bar[XB_TOPGEN]) == tg, bar);
            __builtin_amdgcn_fence(__ATOMIC_ACQUIRE, "agent");
            xb_add(&bar[XB_XGEN(b.x)], 1u);
            asm volatile("s_waitcnt vmcnt(0)" ::: "memory");
        } else {
            XB_SPIN(xb_ld(&bar[XB_XGEN(b.x)]) == gen, bar);
            __builtin_amdgcn_fence(__ATOMIC_ACQUIRE, "agent");
            asm volatile("s_waitcnt vmcnt(0)" ::: "memory");
        }
    }
    __syncthreads();
}

__global__ void __launch_bounds__(512, 2) fwd_kernel(Params P) {
    extern __shared__ __attribute__((aligned(16))) unsigned char lds_raw[];
    LAS unsigned char* lds = (LAS unsigned char*)lds_raw;
    cg::grid_group grid = cg::this_grid();
    const int lo = P.ph_lo, hi = P.ph_hi; int ph = 0;
    const int G = gridDim.x, cb = blockIdx.x;
    unsigned char* ws = P.ws;
    bf16_t* Hh = (bf16_t*)(ws + WS_H); bf16_t* ACT = (bf16_t*)(ws + WS_ACT); bf16_t* Y = (bf16_t*)(ws + WS_Y);
    float* X = P.out + O_X;
#define PH_BEGIN if (lo <= ph && ph < hi) {
#define PH_END } ++ph; if (lo < ph && ph < hi) { if (ph == 1) grid.sync(); else xcd_barrier(xbar); }
    volatile LAS unsigned* xst = (volatile LAS unsigned*)(lds + LDS_BYTES - 64);
    if (threadIdx.x < 2) xst[threadIdx.x] = 0u;
    __syncthreads();
    XcdBarrier xbar; xbar.bar = (unsigned*)ws; xbar.x = 0; xbar.st = xst;
    if (hi - lo > 1) xbar = xcd_barrier_post((unsigned*)ws, xst);

    PH_BEGIN phase0(P, lds); PH_END

#define MIXER_GLA \
    PH_BEGIN { TileOrder S{M / BM, NIN / BM, (M / BM) * (NIN / BM), G, cb, (const char*)Hh, (const char*)(ws + WS_WIN), (size_t)BM * D * 2, (size_t)BM * D * 2, D / BK}; \
        EpiPlain<1> E{(bf16_t*)(ws + WS_QKV), NIN, P.in[10], nullptr}; gemm_phase(lds, D, D, S, E); } PH_END \
    PH_BEGIN gla_phase_a(P, lds); PH_END \
    PH_BEGIN gla_phase_b(P); PH_END \
    PH_BEGIN gla_phase_c(P, lds); PH_END \
    PH_BEGIN { SplitOrder S{{MP / BM, D / BM, (MP / BM) * (D / BM), G, cb, (const char*)Hh, (const char*)(ws + WS_WOUT), (size_t)BM * D * 2, (size_t)BM * D * 2, D / BK}, D / 256}; \
        EpiPlain<0> E{Y, D, nullptr, PART}; gemm_phase(lds, D, D, S, E); } PH_END
#define MIXER_S5 \
    PH_BEGIN { S5Order S{G, cb, (const char*)(ws + WS_HS5), (const char*)(ws + WS_S5M), 4}; \
        EpiS5A E{(float*)(ws + WS_HLOC)}; gemm_phase(lds, 384, 256, S, E); } PH_END \
    PH_BEGIN s5_prefix_and_sample(P); PH_END \
    PH_BEGIN { S5Order S{G, cb, (const char*)(ws + WS_HS5), (const char*)(ws + WS_S5M + 65536), 6}; \
        EpiS5B E{ws, P.in[20]}; gemm_phase(lds, 384, 384, S, E); } PH_END \
    PH_BEGIN { TileOrder S{M / BM, 2 * D / BM, (M / BM) * (2 * D / BM), G, cb, (const char*)(ws + WS_Z), (const char*)(ws + WS_WGLU), (size_t)BM * D * 2, (size_t)BM * D * 2, D / BK}; \
        EpiGated<1> E{Y, D, P.in[22]}; gemm_phase(lds, D, D, S, E); } PH_END
#define FFN_GEMMS(l, f) \
    PH_BEGIN { TileOrder S{M / BM, NGU / BM, (M / BM) * (NGU / BM), G, cb, (const char*)Hh, (const char*)(ws + WS_WGU + (size_t)((l) * 2 + (f)) * NGU * D * 2), (size_t)BM * D * 2, (size_t)BM * D * 2, D / BK}; \
        EpiGated<0> E{ACT, FF, nullptr}; gemm_phase(lds, D, D, S, E); } PH_END \
    PH_BEGIN { SplitOrder S{{MP / BM, D / BM, (MP / BM) * (D / BM), G, cb, (const char*)ACT, (const char*)(ws + WS_WDN + (size_t)((l) * 2 + (f)) * D * FF * 2), (size_t)BM * FF * 2, (size_t)BM * FF * 2, FF / BK}, FF / 256}; \
        EpiPlain<0> E{Y, D, nullptr, PART}; gemm_phase(lds, FF, FF, S, E); } PH_END
    const float* ng0 = P.in[5]; const float* ng1 = P.in[5] + 6 * D;
    float* PART = (float*)(ws + WS_PART);
    FFN_GEMMS(0, 0)
    PH_BEGIN row_pass(P.in[0], P.in[1], Y, ng0 + 1 * D, 0.5f, X, ng0 + 2 * D, Hh, nullptr, PART, FF / 256); PH_END
    MIXER_GLA
    PH_BEGIN row_pass(X, X + (size_t)MP * D, Y, ng0 + 3 * D, 1.0f, X, ng0 + 4 * D, Hh, nullptr, PART, D / 256); PH_END
    FFN_GEMMS(0, 1)
    PH_BEGIN row_pass(X, X + (size_t)MP * D, Y, ng0 + 5 * D, 0.5f, X, ng1, Hh, nullptr, PART, FF / 256); PH_END
    FFN_GEMMS(1, 0)
    PH_BEGIN row_pass(X, X + (size_t)MP * D, Y, ng1 + 1 * D, 0.5f, X, ng1 + 2 * D, Hh, (bf16_t*)(ws + WS_HS5), PART, FF / 256); PH_END
    MIXER_S5
    PH_BEGIN row_pass(X, X + (size_t)MP * D, Y, ng1 + 3 * D, 1.0f, X, ng1 + 4 * D, Hh, nullptr, nullptr, 0); PH_END
    FFN_GEMMS(1, 1)
    PH_BEGIN row_pass(X, X + (size_t)MP * D, Y, ng1 + 5 * D, 0.5f, X, nullptr, Hh, nullptr, PART, FF / 256); PH_END
#undef PH_BEGIN
#undef PH_END
}

__global__ void dbg_checksum(const unsigned* w, size_t nwords, float* out, size_t nout) {
    for (size_t i = (size_t)blockIdx.x * blockDim.x + threadIdx.x; i < nout; i += (size_t)gridDim.x * blockDim.x) {
        unsigned h = 0; for (int j = 0; j < 3; ++j) { const size_t k = 3 * i + j; if (k < nwords) h = h * 0x9E3779B1u + w[k]; }
        out[i] = (float)(h & 0xffffu);
    }
}
extern "C" void kernel_launch(void* const* d_in, const int* in_sizes, int n_in, void* d_out, int out_size, void* d_ws, size_t ws_size, hipStream_t stream) {
    static int grid = 0;
    if (grid == 0) {
        if (n_in != 23 || ws_size < WS_END) { fprintf(stderr, "kernel_launch: unexpected n_in %d or ws_size %zu (< %zu)\n", n_in, ws_size, (size_t)WS_END); grid = -1; return; }
        int dev = 0, cus = 0, per_cu = 0;
        hipGetDevice(&dev); hipDeviceGetAttribute(&cus, hipDeviceAttributeMultiprocessorCount, dev);
        if (hipFuncSetAttribute((const void*)fwd_kernel, hipFuncAttributeMaxDynamicSharedMemorySize, LDS_BYTES) != hipSuccess) { fprintf(stderr, "kernel_launch: hipFuncSetAttribute failed\n"); grid = -1; return; }
        if (hipOccupancyMaxActiveBlocksPerMultiprocessor(&per_cu, (const void*)fwd_kernel, 512, LDS_BYTES) != hipSuccess || per_cu < 1) { fprintf(stderr, "kernel_launch: occupancy query failed (%d)\n", per_cu); grid = -1; return; }
        grid = cus * per_cu;
    }
    if (grid < 0) return;
    if (hipMemsetAsync(d_ws, 0, 16384, stream) != hipSuccess) { fprintf(stderr, "kernel_launch: memset failed\n"); return; }
    Params p{};
    for (int i = 0; i < 23; ++i) p.in[i] = (const float*)d_in[i];
    p.out = (float*)d_out; p.ws = (unsigned char*)d_ws;
#if MULTI_LAUNCH
    for (int k = 0; k < (DBG_NPH ? DBG_NPH : NPH); ++k) { p.ph_lo = k; p.ph_hi = k + 1; hipLaunchKernelGGL(fwd_kernel, dim3(grid), dim3(512), LDS_BYTES, stream, p); }
#if DBG_NPH
    hipLaunchKernelGGL(dbg_checksum, dim3(2048), dim3(256), 0, stream, (const unsigned*)d_ws, (size_t)(WS_END / 4), (float*)d_out, (size_t)out_size);
#endif
#else
    p.ph_lo = 0; p.ph_hi = NPH;
    void* args[] = {&p};
    hipError_t e = hipLaunchCooperativeKernel((const void*)fwd_kernel, dim3(grid), dim3(512), args, LDS_BYTES, stream);
    if (e != hipSuccess) fprintf(stderr, "cooperative launch failed: %s (grid %d)\n", hipGetErrorString(e), grid);
#endif
}
```

```cpp
#include <hip/hip_runtime.h>
#include <hip/hip_cooperative_groups.h>
#include <cstdio>
namespace cg = cooperative_groups;

#ifndef MULTI_LAUNCH
#define MULTI_LAUNCH 0
#endif

#ifndef PROBE_MASK
#define PROBE_MASK 0u
#endif
#ifndef DBG_NPH
#define DBG_NPH 0
#endif
#define LAS __attribute__((address_space(3)))
typedef unsigned short bf16_t;
typedef short bf16x8 __attribute__((ext_vector_type(8)));
typedef float f32x4 __attribute__((ext_vector_type(4)));
typedef unsigned u32x4 __attribute__((ext_vector_type(4)));
typedef unsigned u32x2 __attribute__((ext_vector_type(2)));

constexpr int D = 1024, FF = 2816, NGU = 5632, MP = 16384, MS = 512, M = MP + MS;
constexpr int NIN = 3584;
constexpr int LDIN = 3088;
constexpr float EPS = 1e-6f;
constexpr int NPH = 22;

constexpr size_t O_X = 0, O_GP = 17301504, O_RP = 18350080, O_IP = 18382848, O_GS = 18415616, O_RS = 35192832, O_IS = 35717120;

constexpr size_t MiB = 1u << 20;
constexpr size_t WS_WGU = 1 * MiB;
constexpr size_t WS_WDN = WS_WGU + 44 * MiB;
constexpr size_t WS_WIN = WS_WDN + 22 * MiB;
constexpr size_t WS_WOUT = WS_WIN + 7 * MiB;
constexpr size_t WS_WGLU = WS_WOUT + 2 * MiB;
constexpr size_t WS_S5M = WS_WGLU + 4 * MiB;
constexpr size_t WS_SMALL = WS_S5M + 16 * MiB;
constexpr size_t WS_HSMP = WS_SMALL + 1 * MiB;
constexpr size_t WS_H = WS_SMALL + 2 * MiB;
constexpr size_t WS_BIG = WS_H + 33 * MiB;
constexpr size_t WS_ACT = WS_BIG;
constexpr size_t WS_Y = WS_BIG + 92 * MiB;
constexpr size_t WS_QKV = WS_BIG;
constexpr size_t WS_KC = WS_BIG + 116 * MiB;
constexpr size_t WS_BEND = WS_BIG + 180 * MiB;
constexpr size_t WS_HS5 = WS_BIG;
constexpr size_t WS_HLOC = WS_BIG + 48 * MiB;
constexpr size_t WS_Z = WS_BIG + 128 * MiB;
constexpr size_t WS_PART = WS_BIG + 128 * MiB;
constexpr size_t WS_O = WS_BIG + 181 * MiB;
constexpr size_t WS_END = WS_BIG + 214 * MiB;
constexpr size_t S5M_G = 262144;
constexpr int SM_R2 = 32768;
constexpr int SM_ARE = 0, SM_AIM = 4096, SM_FRE = 8192, SM_FIM = 12288, SM_A16R = 16384, SM_A16I = 20480;

constexpr int LDS_BYTES = 147456;

typedef __bf16 bf16x2_t __attribute__((ext_vector_type(2)));
typedef float f32x2_t __attribute__((ext_vector_type(2)));
__device__ __forceinline__ unsigned cvt_pk_bf16(float lo, float hi) { const f32x2_t v = {lo, hi}; const bf16x2_t b = __builtin_convertvector(v, bf16x2_t); return __builtin_bit_cast(unsigned, b); }
__device__ __forceinline__ float bflo(unsigned w) { return __uint_as_float(w << 16); }
__device__ __forceinline__ float bfhi(unsigned w) { return __uint_as_float(w & 0xffff0000u); }
__device__ __forceinline__ float bf2f(bf16_t b) { return __uint_as_float(((unsigned)b) << 16); }
__device__ __forceinline__ bf16_t f2bf(float f) { return (bf16_t)(cvt_pk_bf16(f, 0.f) & 0xffffu); }
__device__ __forceinline__ float wave_sum(float v) {
#pragma unroll
    for (int o = 1; o < 64; o <<= 1) v += __shfl_xor(v, o);
    return v;
}
__device__ __forceinline__ int otid() { int t = threadIdx.x; asm volatile("" : "+v"(t)); return t; }
__device__ __forceinline__ float sigmoidf_(float a) { return __builtin_amdgcn_rcpf(1.0f + __expf(-a)); }
__device__ __forceinline__ float siluf_(float a) { return a * sigmoidf_(a); }
__device__ __forceinline__ float logf_gate(float z) { return (fminf(z, 0.f) - __logf(1.0f + __expf(-fabsf(z)))) * 0.0625f; }

constexpr int BM = 256, BK = 64, HALF = 128, HTB = HALF * BK * 2;
__device__ __forceinline__ int lds_byte(int r, int c) { const int st = (r >> 4) * 2 + (c >> 5), rr = r & 15, cc = c & 31, ob = rr * 64 + cc * 2; return st * 1024 + (ob ^ (((ob >> 9) & 1) << 5)); }
__device__ __forceinline__ void stage_rc(int b, int& R, int& C) { const int st = b / 1024, sb = b % 1024, swz = sb ^ (((sb >> 9) & 1) << 5); R = (st >> 1) * 16 + swz / 64; C = (st & 1) * 32 + (swz % 64) / 2; }
__device__ __forceinline__ int perm32(int rho) { const int n = rho >> 4, i = rho & 15; return 8 * (i >> 2) + 4 * n + (i & 3); }

struct Unit { const char* A; const char* B; int pm, pn, nt, ks; };

struct TileOrder {
    int nM, nN, nwg, G, c; const char* A0; const char* B0; size_t at, bt; int ntk;
    __device__ __forceinline__ bool next(int i, Unit& u) const {
        const long L = (long)i * G + c; if (L >= nwg) return false;
        u.nt = ntk; u.ks = -1;
        int wgid = (int)L; { const int q = nwg / 8, r = nwg % 8, xcd = wgid % 8, off = wgid / 8; wgid = (xcd < r ? xcd * (q + 1) : r * (q + 1) + (xcd - r) * q) + off; }
        const int nig = 8 * nN, gid = wgid / nig, fm = gid * 8, gsz = (nM - fm) < 8 ? (nM - fm) : 8;
        u.pm = fm + ((wgid % nig) % gsz); u.pn = (wgid % nig) / gsz;
        u.A = A0 + (size_t)u.pm * at; u.B = B0 + (size_t)u.pn * bt; return true;
    }
};
struct SplitOrder {
    TileOrder T; int nks;
    __device__ __forceinline__ bool next(int i, Unit& u) const {
        const int L = i * T.G + T.c;
        if (L < T.nwg) return T.next(i, u);
        const int j = L - T.nwg, ns = 2 * T.nN; if (j >= ns * nks) return false;
        const int st = j % ns, ks = j / ns; u.pm = 64 + st / T.nN; u.pn = st % T.nN; u.nt = 4; u.ks = ks;
        u.A = T.A0 + (size_t)u.pm * T.at + (size_t)ks * 512; u.B = T.B0 + (size_t)u.pn * T.bt + (size_t)ks * 512; return true;
    }
};
struct OneUnit { Unit u; __device__ __forceinline__ bool next(int i, Unit& o) const { if (i) return false; o = u; return true; } };
struct S5Order {
    int G, c; const char* A0; const char* B0; int ntk;
    __device__ __forceinline__ bool next(int i, Unit& u) const {
        const int L = i * G + c; if (L >= 256) return false;
        u.nt = ntk; u.ks = -1;
        { const int xcd = L & 7, idx = L >> 3, combo = xcd * 8 + (idx >> 2); u.pn = (combo >> 2) * 4 + (idx & 3); u.pm = combo & 3; }
        u.A = A0 + (size_t)u.pn * (1024 * 384 * 2) + (size_t)u.pm * (BM * 384 * 2); u.B = B0 + (size_t)u.pn * 262144; return true;
    }
};

template <class Epi, class Sched>
__device__ __forceinline__ void gemm_phase(LAS unsigned char* lds, const int lda, const int ldb, const Sched& S, const Epi& E) {
    int tid_ = threadIdx.x; asm volatile("" : "+v"(tid_));
    const int tid = tid_, wid = __builtin_amdgcn_readfirstlane(tid >> 6), lane = tid & 63, wr = wid >> 2, wc = wid & 3, fr = lane & 15, fq = lane >> 4;
    unsigned voffA[2], voffB[2];
#pragma unroll
    for (int i = 0; i < 2; ++i) { int R, C; stage_rc(tid * 16 + i * 8192, R, C); const int Rb = (R & ~31) + perm32(R & 31);
        voffA[i] = (unsigned)(R * lda + C) * 2u; voffB[i] = (unsigned)(Rb * ldb + C) * 2u; }
    const size_t kstep = (size_t)(BK * 2);
    const size_t hstepA = (size_t)HALF * lda * 2, hstepB = (size_t)HALF * ldb * 2;
    const unsigned ldsw = (unsigned)wid * 1024u;
    const int aoff = lds_byte(wr * 64 + fr, fq * 8), boff = lds_byte(wc * 32 + fr, fq * 8);
#define PG8_SA(b, h) (((b) * 2 + (h)) * HTB)
#define PG8_SB(b, h) ((4 + (b) * 2 + (h)) * HTB)
#define PG8_STAGE(bufoff, gbase, voff) do { _Pragma("unroll") for (int _i = 0; _i < 2; ++_i) \
        __builtin_amdgcn_global_load_lds((const unsigned*)((const char*)(gbase) + (voff)[_i]), (LAS unsigned*)(lds + (bufoff) + ldsw + _i * 8192), 16, 0, 0); } while (0)
#define PG8_LDA(dst, b, h) do { _Pragma("unroll") for (int m = 0; m < 4; ++m) _Pragma("unroll") for (int k = 0; k < 2; ++k) dst[m][k] = *(const LAS bf16x8*)(lds + PG8_SA(b, h) + aoff + m * 2048 + k * 1024); } while (0)
#define PG8_LDB(dst, b, h) do { _Pragma("unroll") for (int n = 0; n < 2; ++n) _Pragma("unroll") for (int k = 0; k < 2; ++k) dst[n][k] = *(const LAS bf16x8*)(lds + PG8_SB(b, h) + boff + n * 2048 + k * 1024); } while (0)
#define PG8_MMA(ai, bj, At, Bt) do { __builtin_amdgcn_s_setprio(1); _Pragma("unroll") for (int m = 0; m < 4; ++m) _Pragma("unroll") for (int n = 0; n < 2; ++n) _Pragma("unroll") for (int k = 0; k < 2; ++k) \
        acc[ai][bj][m][n] = __builtin_amdgcn_mfma_f32_16x16x32_bf16(Bt[n][k], At[m][k], acc[ai][bj][m][n], 0, 0, 0); __builtin_amdgcn_s_setprio(0); } while (0)
#define PG8_WAIT_V(n) asm volatile("s_waitcnt vmcnt(" #n ")" ::: "memory")
#define PG8_WAIT_L(n) asm volatile("s_waitcnt lgkmcnt(" #n ")" ::: "memory")
#define PG8_BAR __builtin_amdgcn_s_barrier()
#define PG8_SCHED __builtin_amdgcn_sched_barrier(0)
    Unit cur, nxt; int ui = 0;
    if (!S.next(0, cur)) return;
    f32x4 acc[2][2][4][2];
#pragma unroll
    for (int a = 0; a < 2; ++a)
#pragma unroll
        for (int b = 0; b < 2; ++b)
#pragma unroll
            for (int m = 0; m < 4; ++m)
#pragma unroll
                for (int n = 0; n < 2; ++n) acc[a][b][m][n] = (f32x4){0.f, 0.f, 0.f, 0.f};
    bf16x8 At[4][2], B0[2][2], B1[2][2];
    const char* cA = cur.A; const char* cB = cur.B;
    PG8_STAGE(PG8_SB(0, 0), cB, voffB); PG8_STAGE(PG8_SA(0, 0), cA, voffA); PG8_STAGE(PG8_SB(0, 1), cB + hstepB, voffB); PG8_STAGE(PG8_SA(0, 1), cA + hstepA, voffA);
    if (wr == 1) PG8_BAR;
    PG8_WAIT_V(4); PG8_BAR;
    PG8_STAGE(PG8_SB(1, 0), cB + kstep, voffB); PG8_STAGE(PG8_SA(1, 0), cA + kstep, voffA); PG8_STAGE(PG8_SB(1, 1), cB + hstepB + kstep, voffB);
    PG8_WAIT_V(6); PG8_BAR;
    for (;;) {
        const bool has_next = S.next(ui + 1, nxt);
        const char* nA = has_next ? nxt.A : cA; const char* nB = has_next ? nxt.B : cB;
        const int nt = cur.nt;
        for (int t = 0; t < nt; t += 2) {
            const bool last = (t == nt - 2);
            const char* a1 = cA + (size_t)(t + 1) * kstep;
            const char* a2 = last ? nA : cA + (size_t)(t + 2) * kstep; const char* b2 = last ? nB : cB + (size_t)(t + 2) * kstep;
            const char* a3 = a2 + kstep; const char* b3 = b2 + kstep;
            PG8_LDB(B0, 0, 0); PG8_SCHED; PG8_LDA(At, 0, 0); PG8_STAGE(PG8_SA(1, 1), a1 + hstepA, voffA);
            PG8_WAIT_L(8); PG8_BAR; PG8_WAIT_L(0); PG8_MMA(0, 0, At, B0); PG8_BAR; PG8_SCHED;
            PG8_LDB(B1, 0, 1); PG8_STAGE(PG8_SB(0, 0), b2, voffB);
            PG8_BAR; PG8_WAIT_L(0); PG8_MMA(0, 1, At, B1); PG8_BAR;
            PG8_LDA(At, 0, 1); PG8_STAGE(PG8_SA(0, 0), a2, voffA);
            PG8_BAR; PG8_WAIT_L(0); PG8_MMA(1, 0, At, B0); PG8_BAR; PG8_SCHED;
            PG8_STAGE(PG8_SB(0, 1), b2 + hstepB, voffB);
            PG8_WAIT_V(6); PG8_BAR; PG8_MMA(1, 1, At, B1); PG8_BAR;
            PG8_LDB(B0, 1, 0); PG8_SCHED; PG8_LDA(At, 1, 0); PG8_STAGE(PG8_SA(0, 1), a2 + hstepA, voffA);
            PG8_WAIT_L(8); PG8_BAR; PG8_WAIT_L(0); PG8_MMA(0, 0, At, B0); PG8_BAR; PG8_SCHED;
            PG8_LDB(B1, 1, 1); PG8_STAGE(PG8_SB(1, 0), b3, voffB);
            PG8_BAR; PG8_WAIT_L(0); PG8_MMA(0, 1, At, B1); PG8_BAR;
            PG8_LDA(At, 1, 1); PG8_STAGE(PG8_SA(1, 0), a3, voffA);
            PG8_BAR; PG8_WAIT_L(0); PG8_MMA(1, 0, At, B0); PG8_BAR; PG8_SCHED;
            PG8_STAGE(PG8_SB(1, 1), b3 + hstepB, voffB);
            PG8_WAIT_V(6); PG8_BAR; PG8_MMA(1, 1, At, B1); PG8_BAR;
        }
        E(acc, cur, wr, wc, fr, fq);
        if (!has_next) break;
#pragma unroll
        for (int a = 0; a < 2; ++a)
#pragma unroll
            for (int b = 0; b < 2; ++b)
#pragma unroll
                for (int m = 0; m < 4; ++m)
#pragma unroll
                    for (int n = 0; n < 2; ++n) acc[a][b][m][n] = (f32x4){0.f, 0.f, 0.f, 0.f};
        cur = nxt; cA = nA; cB = nB; ++ui;
    }
    PG8_WAIT_V(0);
    if (wr == 0) PG8_BAR;
    PG8_BAR;
#undef PG8_SA
#undef PG8_SB
#undef PG8_STAGE
#undef PG8_LDA
#undef PG8_LDB
#undef PG8_MMA
#undef PG8_WAIT_V
#undef PG8_WAIT_L
#undef PG8_BAR
#undef PG8_SCHED
}

template <int MODE>
struct EpiGated {
    bf16_t* O; int ldc; const float* bias; float* part;
    __device__ __forceinline__ void operator()(const f32x4 (&acc)[2][2][4][2], const Unit& u, int wr, int wc, int fr, int fq) const {
        const int row0 = u.pm * BM + wr * 64 + fr, col0 = u.pn * 128 + wc * 32 + 8 * fq;
        if (MODE == 1 && u.ks >= 0) {
#pragma unroll
            for (int bj = 0; bj < 2; ++bj)
#pragma unroll
                for (int ai = 0; ai < 2; ++ai)
#pragma unroll
                    for (int m = 0; m < 4; ++m) { float* p = part + ((size_t)u.ks * MS + (row0 + ai * HALF + m * 16 - MP)) * (2 * ldc) + u.pn * BM + bj * HALF + wc * 32 + 8 * fq;
                        *(f32x4*)p = acc[ai][bj][m][0]; *(f32x4*)(p + 4) = acc[ai][bj][m][1]; }
            return;
        }
        f32x4 b0[2], b1[2];
#pragma unroll
        for (int n = 0; n < 2; ++n) { b0[n] = (f32x4){0.f, 0.f, 0.f, 0.f}; b1[n] = b0[n];
            if (MODE == 1) { b0[n] = *(const f32x4*)(bias + col0 + 4 * n); b1[n] = *(const f32x4*)(bias + ldc + col0 + 4 * n); } }
#pragma unroll
        for (int ai = 0; ai < 2; ++ai)
#pragma unroll
            for (int m = 0; m < 4; ++m) {
                float v[8]; const float rs = 1.0f;
#pragma unroll
                for (int n = 0; n < 2; ++n)
#pragma unroll
                    for (int j = 0; j < 4; ++j) { const float a = acc[ai][0][m][n][j] * rs + b0[n][j], b = acc[ai][1][m][n][j] * rs + b1[n][j];
                        v[4 * n + j] = (MODE == 0) ? siluf_(a) * b : a * sigmoidf_(b); }
                u32x4 w; w.x = cvt_pk_bf16(v[0], v[1]); w.y = cvt_pk_bf16(v[2], v[3]); w.z = cvt_pk_bf16(v[4], v[5]); w.w = cvt_pk_bf16(v[6], v[7]);
                *(u32x4*)(O + (size_t)(row0 + ai * HALF + m * 16) * ldc + col0) = w;
            }
    }
};
template <int GLA>
struct EpiPlain {
    bf16_t* O; int ldc; const float* bg; float* part; const float* r2;
    __device__ __forceinline__ void operator()(const f32x4 (&acc)[2][2][4][2], const Unit& u, int wr, int wc, int fr, int fq) const {
        const int row0 = u.pm * BM + wr * 64 + fr, col0 = u.pn * BM + wc * 32 + 8 * fq;
        if (!GLA && u.ks >= 0) {
#pragma unroll
            for (int bj = 0; bj < 2; ++bj)
#pragma unroll
                for (int ai = 0; ai < 2; ++ai)
#pragma unroll
                    for (int m = 0; m < 4; ++m) { float* p = part + ((size_t)u.ks * MS + (row0 + ai * HALF + m * 16 - MP)) * D + col0 + bj * HALF;
                        *(f32x4*)p = acc[ai][bj][m][0]; *(f32x4*)(p + 4) = acc[ai][bj][m][1]; }
            return;
        }
        const bool lf = GLA && (u.pn >= 12);
#pragma unroll
        for (int bj = 0; bj < 2; ++bj) {
            f32x4 bb[2];
#pragma unroll
            for (int n = 0; n < 2; ++n) bb[n] = lf ? *(const f32x4*)(bg + (col0 - 3072) + bj * HALF + 4 * n) : (f32x4){0.f, 0.f, 0.f, 0.f};
#pragma unroll
            for (int ai = 0; ai < 2; ++ai)
#pragma unroll
                for (int m = 0; m < 4; ++m) {
                    float v[8]; const float rs = 1.0f;
#pragma unroll
                    for (int n = 0; n < 2; ++n)
#pragma unroll
                        for (int j = 0; j < 4; ++j) { float a = acc[ai][bj][m][n][j] * rs;
                            if (lf) a += bb[n][j];
                            v[4 * n + j] = a; }
                    u32x4 w; w.x = cvt_pk_bf16(v[0], v[1]); w.y = cvt_pk_bf16(v[2], v[3]); w.z = cvt_pk_bf16(v[4], v[5]); w.w = cvt_pk_bf16(v[6], v[7]);
                    *(u32x4*)(O + (size_t)(row0 + ai * HALF + m * 16) * ldc + col0 + bj * HALF) = w;
                }
        }
    }
};
struct EpiS5A {
    float* HL;
    __device__ __forceinline__ void operator()(const f32x4 (&acc)[2][2][4][2], const Unit& u, int wr, int wc, int fr, int fq) const {
        const int row0 = u.pm * BM + wr * 64 + fr, col0 = wc * 32 + 8 * fq;
#pragma unroll
        for (int ai = 0; ai < 2; ++ai)
#pragma unroll
            for (int m = 0; m < 4; ++m) { float* p = HL + ((size_t)u.pn * 1024 + row0 + ai * HALF + m * 16) * 128 + col0;
                *(f32x4*)p = acc[ai][0][m][0]; *(f32x4*)(p + 4) = acc[ai][0][m][1]; }
    }
};
struct EpiS5B {
    unsigned char* ws; const float* dsk;
    __device__ __forceinline__ void operator()(const f32x4 (&acc)[2][2][4][2], const Unit& u, int wr, int wc, int fr, int fq) const {
        bf16_t* Z = (bf16_t*)(ws + WS_Z); const bf16_t* HS5 = (const bf16_t*)(ws + WS_HS5);
        asm volatile("" : "+v"(fq));
        const int g = u.pn, c0 = (8 * fq) & 15;
        const f32x4 d0 = *(const f32x4*)(dsk + g * 16 + c0), d1 = *(const f32x4*)(dsk + g * 16 + c0 + 4);
#pragma unroll
        for (int bj = 0; bj < 2; ++bj) { const int t = 8 * bj + 2 * wc + (fq >> 1);
#pragma unroll
            for (int ai = 0; ai < 2; ++ai)
#pragma unroll
                for (int m = 0; m < 4; ++m) { const int colr = u.pm * BM + ai * HALF + wr * 64 + m * 16 + fr; const size_t off = (size_t)(colr * 16 + t) * D + g * 16 + c0;
                    const u32x4 uu = *(const u32x4*)(HS5 + ((size_t)g * 1024 + colr) * 384 + t * 16 + c0); const f32x4 a0 = acc[ai][bj][m][0], a1 = acc[ai][bj][m][1];
                    u32x4 w; w.x = cvt_pk_bf16(a0[0] + d0[0] * bflo(uu.x), a0[1] + d0[1] * bfhi(uu.x)); w.y = cvt_pk_bf16(a0[2] + d0[2] * bflo(uu.y), a0[3] + d0[3] * bfhi(uu.y));
                    w.z = cvt_pk_bf16(a1[0] + d1[0] * bflo(uu.z), a1[1] + d1[1] * bfhi(uu.z)); w.w = cvt_pk_bf16(a1[2] + d1[2] * bflo(uu.w), a1[3] + d1[3] * bfhi(uu.w));
                    *(u32x4*)(Z + off) = w; }
        }
    }
};

struct Params { const float* in[23]; float* out; unsigned char* ws; int ph_lo, ph_hi; };

template <int R, int NKS>
__device__ __forceinline__ void row_pass(const float* xf_p, const float* xf_s, bf16_t* XB, float* R2, const bf16_t* Y, const float* g_post, float scale,
                                         const float* part, float* outf, const float* g_pre, bf16_t* HS5, bf16_t* HSMP, const float* glu_bias = nullptr) {
    const int tid = otid(); const int lane = tid & 63, gw = blockIdx.x * 8 + (tid >> 6), NGW = gridDim.x * 8;
    const int KMAX = (M + NGW - 1) / NGW;
    for (int k0 = 0; k0 < KMAX; k0 += R) {
        f32x4 v[R][4], yv[R][4];
#pragma unroll
        for (int r = 0; r < R; ++r) { const int kk = (k0 + r + KMAX - 1) % KMAX, mr = gw + kk * NGW, m = (k0 + r < KMAX && mr < M) ? mr : gw;
            if (xf_p) { const float* xr = (m < MP) ? xf_p + (size_t)m * D : xf_s + (size_t)(m - MP) * D;
#pragma unroll
                for (int j = 0; j < 4; ++j) v[r][j] = *(const f32x4*)(xr + 256 * j + 4 * lane);
            } else {
                const float ir = 1.0f / R2[m];
#pragma unroll
                for (int j = 0; j < 4; ++j) { const u32x2 w = *(const u32x2*)(XB + (size_t)m * D + 256 * j + 4 * lane); v[r][j] = (f32x4){bflo(w.x), bfhi(w.x), bflo(w.y), bfhi(w.y)} * ir; }
            }
            if (Y) {
                if (glu_bias && m >= MP) {
#pragma unroll
                    for (int j = 0; j < 4; ++j) { const int nc = 256 * (2 * j + (lane >> 5)) + 4 * (lane & 31);
                        f32x4 sv = *(const f32x4*)(glu_bias + 256 * j + 4 * lane), sg = *(const f32x4*)(glu_bias + D + 256 * j + 4 * lane);
                        f32x4 tv[NKS], tg[NKS];
#pragma unroll
                        for (int ks = 0; ks < NKS; ++ks) { const float* pp = part + ((size_t)ks * MS + (m - MP)) * (2 * D) + nc; tv[ks] = *(const f32x4*)pp; tg[ks] = *(const f32x4*)(pp + 128); }
#pragma unroll
                        for (int ks = 0; ks < NKS; ++ks) { sv += tv[ks]; sg += tg[ks]; }
                        yv[r][j] = (f32x4){sv.x * sigmoidf_(sg.x), sv.y * sigmoidf_(sg.y), sv.z * sigmoidf_(sg.z), sv.w * sigmoidf_(sg.w)}; }
                } else if (part && m >= MP) {
#pragma unroll
                    for (int j = 0; j < 4; ++j) { f32x4 t[NKS];
#pragma unroll
                        for (int ks = 0; ks < NKS; ++ks) t[ks] = *(const f32x4*)(part + ((size_t)ks * MS + (m - MP)) * D + 256 * j + 4 * lane);
                        f32x4 s = t[0];
#pragma unroll
                        for (int ks = 1; ks < NKS; ++ks) s += t[ks];
                        yv[r][j] = s; }
                } else {
#pragma unroll
                    for (int j = 0; j < 4; ++j) { const u32x2 w = *(const u32x2*)(Y + (size_t)m * D + 256 * j + 4 * lane); yv[r][j] = (f32x4){bflo(w.x), bfhi(w.x), bflo(w.y), bfhi(w.y)}; }
                }
            }
        }
#pragma unroll
        for (int r = 0; r < R; ++r) { const int kk = (k0 + r + KMAX - 1) % KMAX, m = gw + kk * NGW; if (k0 + r >= KMAX || m >= M) continue;
            if (Y) {
                float ss = 0.f;
#pragma unroll
                for (int j = 0; j < 4; ++j) ss += (yv[r][j].x * yv[r][j].x + yv[r][j].y * yv[r][j].y) + (yv[r][j].z * yv[r][j].z + yv[r][j].w * yv[r][j].w);
                const float rr = rsqrtf(wave_sum(ss) * (1.0f / D) + EPS) * scale;
#pragma unroll
                for (int j = 0; j < 4; ++j) { const f32x4 g = *(const f32x4*)(g_post + 256 * j + 4 * lane); v[r][j] = v[r][j] + yv[r][j] * g * rr; }
            }
            if (outf) {
#pragma unroll
                for (int j = 0; j < 4; ++j) *(f32x4*)(outf + (size_t)m * D + 256 * j + 4 * lane) = v[r][j];
            } else {
                float ss = 0.f;
#pragma unroll
                for (int j = 0; j < 4; ++j) ss += (v[r][j].x * v[r][j].x + v[r][j].y * v[r][j].y) + (v[r][j].z * v[r][j].z + v[r][j].w * v[r][j].w);
                const float rr = rsqrtf(wave_sum(ss) * (1.0f / D) + EPS);
#pragma unroll
                for (int j = 0; j < 4; ++j) { u32x2 w; w.x = cvt_pk_bf16(v[r][j].x * rr, v[r][j].y * rr); w.y = cvt_pk_bf16(v[r][j].z * rr, v[r][j].w * rr);
                    *(u32x2*)(XB + (size_t)m * D + 256 * j + 4 * lane) = w; }
                if (lane == 0) R2[m] = rr;
                if (g_pre) {
#pragma unroll
                    for (int j = 0; j < 4; ++j) { const f32x4 g = *(const f32x4*)(g_pre + 256 * j + 4 * lane); const f32x4 h = v[r][j] * g * rr;
                        u32x2 w; w.x = cvt_pk_bf16(h.x, h.y); w.y = cvt_pk_bf16(h.z, h.w);
                        if (m < MP) { const int gi = j * 16 + (lane >> 2), c = (lane & 3) * 4;
                            *(u32x2*)(HS5 + ((size_t)gi * 1024 + (m >> 4)) * 384 + (m & 15) * 16 + c) = w; }
                        else *(u32x2*)(HSMP + (size_t)(m - MP) * D + 256 * j + 4 * lane) = w; }
                }
            }
        }
    }
}

__device__ __forceinline__ void transpose_item(const float* W, int ldw, int K, int scol0, bf16_t* Bt, int drow0, int k0, float scale, const float* gk, LAS bf16_t* scr, int lane) {
    const float* src = W + (size_t)(k0 + (lane >> 5)) * ldw + scol0 + 4 * (lane & 31);
#pragma unroll 16
    for (int i = 0; i < 32; ++i) { const f32x4 w = __builtin_nontemporal_load((const f32x4*)(src + (size_t)(2 * i) * ldw));
        const float sc = gk ? gk[k0 + 2 * i + (lane >> 5)] * scale : scale;
        u32x2 o; o.x = cvt_pk_bf16(w.x * sc, w.y * sc); o.y = cvt_pk_bf16(w.z * sc, w.w * sc);
        *(LAS u32x2*)(scr + (2 * i + (lane >> 5)) * 136 + 4 * (lane & 31)) = o; }
    asm volatile("s_waitcnt lgkmcnt(0)" ::: "memory");
#pragma unroll 4
    for (int t = 0; t < 16; ++t) { const int task = t * 64 + lane, n = task >> 3, kc = task & 7; const LAS bf16_t* s = scr + (kc * 8) * 136 + n;
        u32x4 o; o.x = (unsigned)s[0] | ((unsigned)s[136] << 16); o.y = (unsigned)s[272] | ((unsigned)s[408] << 16);
        o.z = (unsigned)s[544] | ((unsigned)s[680] << 16); o.w = (unsigned)s[816] | ((unsigned)s[952] << 16);
        *(u32x4*)(Bt + (size_t)(drow0 + n) * K + k0 + 8 * kc) = o; }
    asm volatile("s_waitcnt lgkmcnt(0)" ::: "memory");
}

__device__ __forceinline__ void s5_prep_group(const Params& P, LAS unsigned char* lds, int g, int qt) {
    LAS float* apr = (LAS float*)lds;
    LAS float* api = apr + 17 * 64;
    LAS float* bbr = api + 17 * 64;
    LAS float* bbi = bbr + 1024;
    LAS float* cre = bbi + 1024;
    LAS float* cim = cre + 1024;
    LAS float* fre = cim + 1024;
    LAS float* fim = fre + 64;
    LAS float* kmat = fim + 64;
    const int tid = otid();
    float* sm = (float*)(P.ws + WS_SMALL);
    bf16_t* Wm = (bf16_t*)(P.ws + WS_S5M + (size_t)g * S5M_G);
    bf16_t* TE = Wm + 128 * 256;
    if (tid < 64) {
        const int p = tid; const float lr = P.in[13][g * 64 + p], li = P.in[14][g * 64 + p]; const float dt = expf(P.in[15][g]);
        float a1r = 0.f, a1i = 0.f;
        for (int tau = 0; tau <= 16; ++tau) {
            const float mag = expf(lr * dt * (float)tau);
            double rev = (double)li * (double)dt * (double)tau * 0.15915494309189535; rev -= __builtin_rint(rev);
            const float rr = (float)rev; const float s = __builtin_amdgcn_sinf(rr), c = __builtin_amdgcn_cosf(rr);
            apr[tau * 64 + p] = mag * c; api[tau * 64 + p] = mag * s;
            if (tau == 1) { a1r = mag * c; a1i = mag * s; }
            if (tau == 16 && qt == 0) { sm[SM_A16R + g * 64 + p] = mag * c; sm[SM_A16I + g * 64 + p] = mag * s; }
        }
        const float nr = a1r - 1.0f, ni = a1i, den = lr * lr + li * li;
        const float fr_ = (nr * lr + ni * li) / den, fi_ = (ni * lr - nr * li) / den;
        fre[p] = fr_; fim[p] = fi_;
        if (qt == 0) { sm[SM_ARE + g * 64 + p] = a1r; sm[SM_AIM + g * 64 + p] = a1i; sm[SM_FRE + g * 64 + p] = fr_; sm[SM_FIM + g * 64 + p] = fi_; }
    }
    __syncthreads();
    for (int idx = tid; idx < 1024; idx += 512) { const int p = idx >> 4; const float br = P.in[16][g * 1024 + idx], bi = P.in[17][g * 1024 + idx];
        bbr[idx] = fre[p] * br - fim[p] * bi; bbi[idx] = fre[p] * bi + fim[p] * br;
        cre[idx] = P.in[18][g * 1024 + idx]; cim[idx] = P.in[19][g * 1024 + idx]; }
    __syncthreads();
    for (int idx = qt * 8192 + tid; idx < (qt + 1) * 8192; idx += 512) { const int row = idx >> 8, col = idx & 255, s = col >> 4, c = col & 15, p = row & 63, im = row >> 6;
        const float ar = apr[(15 - s) * 64 + p], ai = api[(15 - s) * 64 + p], br = bbr[p * 16 + c], bi = bbi[p * 16 + c];
        Wm[idx] = f2bf(im ? (ar * bi + ai * br) : (ar * br - ai * bi)); }
    for (int i2 = tid; i2 < 1024; i2 += 512) { const int tau = i2 >> 6, cp = 4 * qt + ((i2 >> 4) & 3), c = i2 & 15, idx = (tau << 8) + (cp << 4) + c; float sum = 0.f;
        for (int p = 0; p < 64; ++p) { const float cr = cre[cp * 64 + p], ci = cim[cp * 64 + p], ar = apr[tau * 64 + p], ai = api[tau * 64 + p];
            const float car = cr * ar - ci * ai, cai = cr * ai + ci * ar; sum += car * bbr[p * 16 + c] - cai * bbi[p * 16 + c]; }
        kmat[idx] = sum; }
    __syncthreads();
    for (int i2 = tid; i2 < 64 * 384; i2 += 512) { const int r2 = i2 / 384, col = i2 - r2 * 384, t = r2 >> 2, cp = 4 * qt + (r2 & 3), row = t * 16 + cp, idx = row * 384 + col; float v;
        if (col < 256) { const int s = col >> 4, c = col & 15; v = (s <= t) ? kmat[((t - s) << 8) + (cp << 4) + c] : 0.f; }
        else { const int pp = col - 256, p = pp & 63, im = pp >> 6; const float cr = cre[cp * 64 + p], ci = cim[cp * 64 + p], ar = apr[(t + 1) * 64 + p], ai = api[(t + 1) * 64 + p];
            v = im ? -(cr * ai + ci * ar) : (cr * ar - ci * ai); }
        TE[idx] = f2bf(v); }
    __syncthreads();
}

__device__ __forceinline__ void s5_idle_prep(const Params& P, LAS unsigned char* lds, int slot) {
    const int G = gridDim.x, nfull = ((M / BM) * (NGU / BM)) % G, cb = blockIdx.x;
    if (nfull == 0 || cb < nfull) return;
    const int wi = slot * (G - nfull) + (cb - nfull);
    if (wi < 256) s5_prep_group(P, lds, wi >> 2, wi & 3);
}
__device__ __forceinline__ void s5_idle_prep_inproj(const Params& P, LAS unsigned char* lds) {
    const int G = gridDim.x, nf1 = ((M / BM) * (NGU / BM)) % G, nf2 = ((M / BM) * (NIN / BM)) % G, cb = blockIdx.x;
    if (nf1 == 0 || nf2 == 0 || cb < nf2) return;
    const int wi = 3 * (G - nf1) + (cb - nf2);
    if (wi < 256) s5_prep_group(P, lds, wi >> 2, wi & 3);
}
__device__ __forceinline__ void phase0(const Params& P, LAS unsigned char* lds) {
    const int tid = otid(), lane = tid & 63, wave = tid >> 6;
    const int gw = blockIdx.x * 8 + wave, NGW = gridDim.x * 8;
    LAS bf16_t* scr = (LAS bf16_t*)(lds + wave * 17408);
    bf16_t* WGU = (bf16_t*)(P.ws + WS_WGU); bf16_t* WDN = (bf16_t*)(P.ws + WS_WDN); bf16_t* WIN = (bf16_t*)(P.ws + WS_WIN);
    bf16_t* WOUT = (bf16_t*)(P.ws + WS_WOUT); bf16_t* WGLU = (bf16_t*)(P.ws + WS_WGLU);
    constexpr int I_GU = 4 * 16 * 44, I_DN = 4 * 44 * 8, I_IN = 16 * 24, I_OUT = 16 * 8, I_GLU = 16 * 16;
#pragma unroll 1
    for (int step = 0; step < 2; ++step) {
    if (((blockIdx.x & 1) != 0) == (step == 0)) {
        { const int G_ = gridDim.x, nf1_ = ((M / BM) * (NGU / BM)) % G_, nf2_ = ((M / BM) * (NIN / BM)) % G_;
          const int first_ = (nf1_ && nf2_) ? 3 * (G_ - nf1_) + (G_ - nf2_) : (nf1_ ? 3 * (G_ - nf1_) : 0);
          for (int wi = first_ + blockIdx.x; wi < 256; wi += gridDim.x) s5_prep_group(P, lds, wi >> 2, wi & 3); }
    } else {
    for (int it = gw; it < I_GU + I_DN + I_IN + I_OUT + I_GLU; it += NGW) {
        int r = it;
        if (r < I_GU) { const int lf = r / 704, rr = r % 704, kb = rr / 44, nb = rr % 44, n0 = nb * 128, pn = n0 >> 8, bj = (n0 >> 7) & 1;
            transpose_item(P.in[6] + (size_t)lf * D * NGU, NGU, D, bj * FF + pn * 128, WGU + (size_t)lf * NGU * D, n0, kb * 64, 1.0f, P.in[5] + (size_t)((lf >> 1) * 6 + (lf & 1) * 4) * D, scr, lane); continue; }
        r -= I_GU;
        if (r < I_DN) { const int lf = r / 352, rr = r % 352, kb = rr / 8, nb = rr % 8;
            transpose_item(P.in[7] + (size_t)lf * FF * D, D, FF, nb * 128, WDN + (size_t)lf * D * FF, nb * 128, kb * 64, 1.0f, nullptr, scr, lane); continue; }
        r -= I_DN;
        if (r < I_IN) { const int kb = r / 24, nb = r % 24, n0 = nb * 128;
            transpose_item(P.in[8], LDIN, D, n0, WIN, n0, kb * 64, n0 < 512 ? 0.08838834764831845f : 1.0f, P.in[5] + 2 * D, scr, lane); continue; }
        r -= I_IN;
        if (r < I_OUT) { const int kb = r / 8, nb = r % 8; transpose_item(P.in[12], D, D, nb * 128, WOUT, nb * 128, kb * 64, 1.0f, nullptr, scr, lane); continue; }
        r -= I_OUT;
        { const int kb = r / 16, nb = r % 16, n0 = nb * 128, pn = n0 >> 8, bj = (n0 >> 7) & 1;
            transpose_item(P.in[21], 2 * D, D, bj * D + pn * 128, WGLU, n0, kb * 64, 1.0f, nullptr, scr, lane); }
    }
    for (int idx = blockIdx.x * 512 + tid; idx < 64 * 1024; idx += gridDim.x * 512) { const int jb = idx >> 10, k = idx & 1023;
        const float* wr = P.in[8] + (size_t)k * LDIN + 3072; const f32x4 a0 = *(const f32x4*)wr, a1 = *(const f32x4*)(wr + 4), a2 = *(const f32x4*)(wr + 8), a3 = *(const f32x4*)(wr + 12);
        const float a[16] = {a0.x, a0.y, a0.z, a0.w, a1.x, a1.y, a1.z, a1.w, a2.x, a2.y, a2.z, a2.w, a3.x, a3.y, a3.z, a3.w}; const float gk = P.in[5][2 * D + k];
#pragma unroll
        for (int jj = 0; jj < 8; ++jj) { const int j = jb * 8 + jj; float s = 0.f;
#pragma unroll
            for (int r = 0; r < 16; ++r) s += a[r] * P.in[9][r * 512 + j];
            WIN[(size_t)(3072 + j) * D + k] = f2bf(s * gk); } }
    }
    __syncthreads();
    }
    row_pass<3, 1>(P.in[0], P.in[1], (bf16_t*)(P.ws + WS_H), (float*)(P.ws + WS_SMALL) + SM_R2, nullptr, nullptr, 0.f, nullptr, nullptr, nullptr, nullptr, nullptr);
}

__device__ __forceinline__ void gla_cumsum(LAS float* BC, LAS float* TOT, const u32x4 (&lw)[2], int tid) {
#pragma unroll
    for (int i = 0; i < 2; ++i) { const int e = tid + 512 * i, t = e >> 4, d0 = (e & 15) * 8; const u32x4 w = lw[i];
        LAS float* b = BC + t * 128 + d0; b[0] = logf_gate(bflo(w.x)); b[1] = logf_gate(bfhi(w.x)); b[2] = logf_gate(bflo(w.y)); b[3] = logf_gate(bfhi(w.y));
        b[4] = logf_gate(bflo(w.z)); b[5] = logf_gate(bfhi(w.z)); b[6] = logf_gate(bflo(w.w)); b[7] = logf_gate(bfhi(w.w)); }
    __syncthreads();
    const int dk = tid & 127, seg = tid >> 7; float run = 0.f;
#pragma unroll
    for (int i = 0; i < 16; ++i) { const int t = seg * 16 + i; run += BC[t * 128 + dk]; BC[t * 128 + dk] = run; }
    TOT[seg * 128 + dk] = run;
    __syncthreads();
    float off = 0.f;
    for (int s = 0; s < seg; ++s) off += TOT[s * 128 + dk];
#pragma unroll
    for (int i = 0; i < 16; ++i) BC[(seg * 16 + i) * 128 + dk] += off;
    __syncthreads();
}
__device__ __forceinline__ void gla_load_vt(LAS bf16_t* VT, const u32x4 (&vw)[4], int tid) {
#pragma unroll
    for (int i = 0; i < 4; ++i) { const int e = tid + 512 * i, t = e >> 5, d0 = (e & 31) * 8; const u32x4 w = vw[i];
        LAS bf16_t* p = VT + d0 * 72 + ((((t >> 3) ^ ((d0 >> 3) & 7)) << 3) | (t & 7));
        p[0] = (bf16_t)(w.x & 0xffff); p[72] = (bf16_t)(w.x >> 16); p[144] = (bf16_t)(w.y & 0xffff); p[216] = (bf16_t)(w.y >> 16);
        p[288] = (bf16_t)(w.z & 0xffff); p[360] = (bf16_t)(w.z >> 16); p[432] = (bf16_t)(w.w & 0xffff); p[504] = (bf16_t)(w.w >> 16); }
}

__device__ __forceinline__ void gla_phase_a(const Params& P, LAS unsigned char* lds) {
    const int tid = otid(), lane = tid & 63, w = tid >> 6, l16 = lane & 15, q = lane >> 4;
    LAS float* BC = (LAS float*)lds; LAS float* TOT = (LAS float*)(lds + 32768);
    LAS bf16_t* KT = (LAS bf16_t*)(lds + 34816); LAS bf16_t* VT = (LAS bf16_t*)(lds + 53248);
    const bf16_t* QKV = (const bf16_t*)(P.ws + WS_QKV); bf16_t* KC = (bf16_t*)(P.ws + WS_KC); float* BEND = (float*)(P.ws + WS_BEND);
    for (int item = blockIdx.x; item < 1024; item += gridDim.x) {
        const int b = item >> 7, h = (item >> 5) & 3, c = item & 31; const size_t tok0 = (size_t)b * 2048 + c * 64;
        const bf16_t* base = QKV + tok0 * NIN;
        u32x4 lw[2], kw[2], vw[4];
#pragma unroll
        for (int i = 0; i < 2; ++i) { const int e = tid + 512 * i, t = e >> 4, d0 = (e & 15) * 8; lw[i] = *(const u32x4*)(base + (size_t)t * NIN + 3072 + h * 128 + d0); kw[i] = *(const u32x4*)(base + (size_t)t * NIN + 512 + h * 128 + d0); }
#pragma unroll
        for (int i = 0; i < 4; ++i) { const int e = tid + 512 * i, t = e >> 5, d0 = (e & 31) * 8; vw[i] = *(const u32x4*)(base + (size_t)t * NIN + 1024 + h * 256 + d0); }
        gla_cumsum(BC, TOT, lw, tid);
        if (tid < 128) BEND[item * 128 + tid] = BC[63 * 128 + tid];
#pragma unroll
        for (int i = 0; i < 2; ++i) { const int e = tid + 512 * i, t = e >> 4, d0 = (e & 15) * 8; const u32x4 wv = kw[i];
            float kv[8] = {bflo(wv.x), bfhi(wv.x), bflo(wv.y), bfhi(wv.y), bflo(wv.z), bfhi(wv.z), bflo(wv.w), bfhi(wv.w)};
#pragma unroll
            for (int j = 0; j < 8; ++j) KT[(d0 + j) * 72 + ((((t >> 3) ^ ((d0 >> 3) & 7)) << 3) | (t & 7))] = f2bf(kv[j] * __expf(BC[63 * 128 + d0 + j] - BC[t * 128 + d0 + j])); }
        gla_load_vt(VT, vw, tid);
        __syncthreads();
        f32x4 acc[8][2];
#pragma unroll
        for (int a = 0; a < 8; ++a) { acc[a][0] = (f32x4){0.f, 0.f, 0.f, 0.f}; acc[a][1] = acc[a][0]; }
#pragma unroll
        for (int kk = 0; kk < 2; ++kk) {
            bf16x8 vb[2];
#pragma unroll
            for (int d = 0; d < 2; ++d) vb[d] = *(const LAS bf16x8*)(VT + (16 * (2 * w + d) + l16) * 72 + (((kk * 4 + q) ^ ((2 * (2 * w + d) + (l16 >> 3)) & 7)) << 3));
#pragma unroll
            for (int a = 0; a < 8; ++a) { const bf16x8 ka = *(const LAS bf16x8*)(KT + (16 * a + l16) * 72 + (((kk * 4 + q) ^ ((2 * a + (l16 >> 3)) & 7)) << 3));
#pragma unroll
                for (int d = 0; d < 2; ++d) acc[a][d] = __builtin_amdgcn_mfma_f32_16x16x32_bf16(ka, vb[d], acc[a][d], 0, 0, 0); }
        }
#pragma unroll
        for (int a = 0; a < 8; ++a)
#pragma unroll
            for (int d = 0; d < 2; ++d) { u32x2 o; o.x = cvt_pk_bf16(acc[a][d][0], acc[a][d][1]); o.y = cvt_pk_bf16(acc[a][d][2], acc[a][d][3]);
                *(u32x2*)(KC + ((size_t)item * 256 + 16 * (2 * w + d) + l16) * 128 + 16 * a + 4 * q) = o; }
        __syncthreads();
    }
}
__device__ __forceinline__ void gla_phase_b(const Params& P) {
    bf16_t* KC = (bf16_t*)(P.ws + WS_KC); const float* BEND = (const float*)(P.ws + WS_BEND);
    const int tidb = otid();
    for (int idx = blockIdx.x * 512 + tidb; idx < 32 * 4096; idx += gridDim.x * 512) {
        const int bh = idx >> 12, e = idx & 4095, dv = e >> 4, dk0 = (e & 15) * 8;
        float S[8];
#pragma unroll
        for (int j = 0; j < 8; ++j) S[j] = 0.f;
#pragma unroll 8
        for (int c = 0; c < 32; ++c) { const int item = bh * 32 + c;
            u32x4* p = (u32x4*)(KC + ((size_t)item * 256 + dv) * 128 + dk0); const u32x4 kc = *p;
            const f32x4 e0 = *(const f32x4*)(BEND + item * 128 + dk0), e1 = *(const f32x4*)(BEND + item * 128 + dk0 + 4);
            u32x4 o; o.x = cvt_pk_bf16(S[0], S[1]); o.y = cvt_pk_bf16(S[2], S[3]); o.z = cvt_pk_bf16(S[4], S[5]); o.w = cvt_pk_bf16(S[6], S[7]); *p = o;
            S[0] = __expf(e0.x) * S[0] + bflo(kc.x); S[1] = __expf(e0.y) * S[1] + bfhi(kc.x); S[2] = __expf(e0.z) * S[2] + bflo(kc.y); S[3] = __expf(e0.w) * S[3] + bfhi(kc.y);
            S[4] = __expf(e1.x) * S[4] + bflo(kc.z); S[5] = __expf(e1.y) * S[5] + bfhi(kc.z); S[6] = __expf(e1.z) * S[6] + bflo(kc.w); S[7] = __expf(e1.w) * S[7] + bfhi(kc.w); }
        float* o = P.out + O_GP + (size_t)bh * 32768;
#pragma unroll
        for (int j = 0; j < 8; ++j) o[(dk0 + j) * 256 + dv] = S[j];
    }
}
__device__ __forceinline__ void gla_phase_c(const Params& P, LAS unsigned char* lds) {
    const int tid = otid(), lane = tid & 63, w = tid >> 6, l16 = lane & 15, q = lane >> 4;
    LAS float* BC = (LAS float*)lds; LAS float* TOT = (LAS float*)(lds + 32768); LAS float* PART = (LAS float*)(lds + 34816);
    LAS bf16_t* QT = (LAS bf16_t*)(lds + 36864); LAS bf16_t* KT = (LAS bf16_t*)(lds + 54272);
    LAS bf16_t* VT = (LAS bf16_t*)(lds + 71680); LAS bf16_t* ATT = (LAS bf16_t*)(lds + 108544);
    const bf16_t* QKV = (const bf16_t*)(P.ws + WS_QKV); const bf16_t* KC = (const bf16_t*)(P.ws + WS_KC); bf16_t* Oo = (bf16_t*)(P.ws + WS_O);
    const float* gon = P.in[11];
    for (int item = blockIdx.x; item < 1024; item += gridDim.x) {
        const int b = item >> 7, h = (item >> 5) & 3, c = item & 31; const size_t tok0 = (size_t)b * 2048 + c * 64;
        const bf16_t* base = QKV + tok0 * NIN;
        u32x4 lw[2], qw[2], kw[2], vw[4]; bf16x8 sfr[4][2]; u32x2 rw[4][2];
#pragma unroll
        for (int i = 0; i < 2; ++i) { const int e = tid + 512 * i, t = e >> 4, d0 = (e & 15) * 8; lw[i] = *(const u32x4*)(base + (size_t)t * NIN + 3072 + h * 128 + d0);
            qw[i] = *(const u32x4*)(base + (size_t)t * NIN + h * 128 + d0); kw[i] = *(const u32x4*)(base + (size_t)t * NIN + 512 + h * 128 + d0); }
#pragma unroll
        for (int i = 0; i < 4; ++i) { const int e = tid + 512 * i, t = e >> 5, d0 = (e & 31) * 8; vw[i] = *(const u32x4*)(base + (size_t)t * NIN + 1024 + h * 256 + d0); }
#pragma unroll
        for (int kk = 0; kk < 4; ++kk)
#pragma unroll
            for (int d = 0; d < 2; ++d) sfr[kk][d] = *(const bf16x8*)(KC + ((size_t)item * 256 + 16 * (2 * w + d) + l16) * 128 + kk * 32 + q * 8);
#pragma unroll
        for (int tm = 0; tm < 4; ++tm)
#pragma unroll
            for (int d = 0; d < 2; ++d) rw[tm][d] = *(const u32x2*)(QKV + (tok0 + 16 * tm + l16) * NIN + 2048 + h * 256 + 16 * (2 * w + d) + 4 * q);
        gla_cumsum(BC, TOT, lw, tid);
#pragma unroll
        for (int i = 0; i < 2; ++i) { const int e = tid + 512 * i, t = e >> 4, d0 = (e & 15) * 8;
            const u32x4 wq = qw[i], wk = kw[i];
            float qv[8] = {bflo(wq.x), bfhi(wq.x), bflo(wq.y), bfhi(wq.y), bflo(wq.z), bfhi(wq.z), bflo(wq.w), bfhi(wq.w)};
            float kv[8] = {bflo(wk.x), bfhi(wk.x), bflo(wk.y), bfhi(wk.y), bflo(wk.z), bfhi(wk.z), bflo(wk.w), bfhi(wk.w)};
            float eb[8];
#pragma unroll
            for (int j = 0; j < 8; ++j) { eb[j] = BC[t * 128 + d0 + j]; qv[j] *= __expf(eb[j]); kv[j] *= __expf(-eb[j]); }
            u32x4 oq, ok; oq.x = cvt_pk_bf16(qv[0], qv[1]); oq.y = cvt_pk_bf16(qv[2], qv[3]); oq.z = cvt_pk_bf16(qv[4], qv[5]); oq.w = cvt_pk_bf16(qv[6], qv[7]);
            ok.x = cvt_pk_bf16(kv[0], kv[1]); ok.y = cvt_pk_bf16(kv[2], kv[3]); ok.z = cvt_pk_bf16(kv[4], kv[5]); ok.w = cvt_pk_bf16(kv[6], kv[7]);
            *(LAS u32x4*)(QT + t * 136 + d0) = oq; *(LAS u32x4*)(KT + t * 136 + d0) = ok; }
        gla_load_vt(VT, vw, tid);
        __syncthreads();
        {
            const int tm = w >> 1;
#pragma unroll
            for (int d = 0; d < 2; ++d) { const int sn = 2 * (w & 1) + d; f32x4 a = (f32x4){0.f, 0.f, 0.f, 0.f};
                if (sn <= tm) {
#pragma unroll
                    for (int kk = 0; kk < 4; ++kk) { const bf16x8 kf = *(const LAS bf16x8*)(KT + (16 * sn + l16) * 136 + kk * 32 + q * 8);
                        const bf16x8 qf = *(const LAS bf16x8*)(QT + (16 * tm + l16) * 136 + kk * 32 + q * 8);
                        a = __builtin_amdgcn_mfma_f32_16x16x32_bf16(kf, qf, a, 0, 0, 0); }
                }
                const int t = 16 * tm + l16, s0 = 16 * sn + 4 * q;
#pragma unroll
                for (int i = 0; i < 4; ++i) if (s0 + i > t) a[i] = 0.f;
                u32x2 o; o.x = cvt_pk_bf16(a[0], a[1]); o.y = cvt_pk_bf16(a[2], a[3]);
                *(LAS u32x2*)(ATT + t * 72 + s0) = o; }
        }
        __syncthreads();
        f32x4 acc[2][4];
#pragma unroll
        for (int d = 0; d < 2; ++d)
#pragma unroll
            for (int tm = 0; tm < 4; ++tm) acc[d][tm] = (f32x4){0.f, 0.f, 0.f, 0.f};
#pragma unroll
        for (int kk = 0; kk < 2; ++kk) {
            bf16x8 vf[2], af[4];
#pragma unroll
            for (int d = 0; d < 2; ++d) vf[d] = *(const LAS bf16x8*)(VT + (16 * (2 * w + d) + l16) * 72 + (((kk * 4 + q) ^ ((2 * (2 * w + d) + (l16 >> 3)) & 7)) << 3));
#pragma unroll
            for (int tm = 0; tm < 4; ++tm) af[tm] = *(const LAS bf16x8*)(ATT + (16 * tm + l16) * 72 + kk * 32 + q * 8);
#pragma unroll
            for (int d = 0; d < 2; ++d)
#pragma unroll
                for (int tm = 0; tm < 4; ++tm) acc[d][tm] = __builtin_amdgcn_mfma_f32_16x16x32_bf16(vf[d], af[tm], acc[d][tm], 0, 0, 0);
        }
#pragma unroll
        for (int kk = 0; kk < 4; ++kk) {
            bf16x8 sf[2], qf[4];
#pragma unroll
            for (int d = 0; d < 2; ++d) sf[d] = sfr[kk][d];
#pragma unroll
            for (int tm = 0; tm < 4; ++tm) qf[tm] = *(const LAS bf16x8*)(QT + (16 * tm + l16) * 136 + kk * 32 + q * 8);
#pragma unroll
            for (int d = 0; d < 2; ++d)
#pragma unroll
                for (int tm = 0; tm < 4; ++tm) acc[d][tm] = __builtin_amdgcn_mfma_f32_16x16x32_bf16(sf[d], qf[tm], acc[d][tm], 0, 0, 0);
        }
#pragma unroll
        for (int tm = 0; tm < 4; ++tm) { float ss = 0.f;
#pragma unroll
            for (int d = 0; d < 2; ++d) ss += (acc[d][tm][0] * acc[d][tm][0] + acc[d][tm][1] * acc[d][tm][1]) + (acc[d][tm][2] * acc[d][tm][2] + acc[d][tm][3] * acc[d][tm][3]);
            ss += __shfl_xor(ss, 16); ss += __shfl_xor(ss, 32);
            if (q == 0) PART[w * 64 + 16 * tm + l16] = ss; }
        __syncthreads();
#pragma unroll
        for (int tm = 0; tm < 4; ++tm) { float tot = 0.f;
#pragma unroll
            for (int ww = 0; ww < 8; ++ww) tot += PART[ww * 64 + 16 * tm + l16];
            const float rs = rsqrtf(tot * (1.0f / 256.0f) + EPS); const size_t tok = tok0 + 16 * tm + l16;
#pragma unroll
            for (int d = 0; d < 2; ++d) { const int dv0 = 16 * (2 * w + d) + 4 * q; const f32x4 g = *(const f32x4*)(gon + dv0);
                const u32x2 rr = rw[tm][d];
                u32x2 o; o.x = cvt_pk_bf16(acc[d][tm][0] * rs * g.x * siluf_(bflo(rr.x)), acc[d][tm][1] * rs * g.y * siluf_(bfhi(rr.x)));
                o.y = cvt_pk_bf16(acc[d][tm][2] * rs * g.z * siluf_(bflo(rr.y)), acc[d][tm][3] * rs * g.w * siluf_(bfhi(rr.y)));
                *(u32x2*)(Oo + tok * D + h * 256 + dv0) = o; } }
        __syncthreads();
    }
    LAS float* SQ = (LAS float*)lds; LAS float* SK = SQ + 512; LAS float* SE = SK + 512; LAS float* OS = SE + 512;   LAS float* WP = OS + 2048;
    for (int item = blockIdx.x; item < 512; item += gridDim.x) {
        const int b = item >> 2, h = item & 3; const size_t row0 = (size_t)MP + b * 4;
        { const int t = tid >> 7, dk = tid & 127; const bf16_t* r = QKV + (row0 + t) * NIN;
            SQ[tid] = bf2f(r[h * 128 + dk]); SK[tid] = bf2f(r[512 + h * 128 + dk]); SE[tid] = __expf(logf_gate(bf2f(r[3072 + h * 128 + dk]))); }
        __syncthreads();
        const int dv = tid & 255, half = tid >> 8;
        const float* s0 = P.in[2] + ((size_t)item * 128 + half * 64) * 256 + dv;
        float S[64];
#pragma unroll
        for (int i = 0; i < 64; ++i) S[i] = s0[i * 256];
        float vv[4];
#pragma unroll
        for (int t = 0; t < 4; ++t) vv[t] = bf2f(QKV[(row0 + t) * NIN + 1024 + h * 256 + dv]);
#pragma unroll
        for (int t = 0; t < 4; ++t) { float op = 0.f;
#pragma unroll
            for (int i = 0; i < 64; ++i) { const int dk = half * 64 + i; S[i] = SE[t * 128 + dk] * S[i] + SK[t * 128 + dk] * vv[t]; op += SQ[t * 128 + dk] * S[i]; }
            OS[(half * 4 + t) * 256 + dv] = op; }
        float* so = P.out + O_GS + ((size_t)item * 128 + half * 64) * 256 + dv;
#pragma unroll
        for (int i = 0; i < 64; ++i) so[i * 256] = S[i];
        __syncthreads();
        float o4[4];
#pragma unroll
        for (int t = 0; t < 4; ++t) { o4[t] = OS[t * 256 + dv] + OS[(4 + t) * 256 + dv]; const float s = wave_sum(o4[t] * o4[t]); if (tid < 256 && lane == 0) WP[w * 4 + t] = s; }
        __syncthreads();
        if (tid < 256) {
#pragma unroll
            for (int t = 0; t < 4; ++t) { const float tot = WP[t] + WP[4 + t] + WP[8 + t] + WP[12 + t]; const float rs = rsqrtf(tot * (1.0f / 256.0f) + EPS);
                const float r = bf2f(QKV[(row0 + t) * NIN + 2048 + h * 256 + dv]);
                Oo[(row0 + t) * D + h * 256 + dv] = f2bf(o4[t] * rs * gon[dv] * siluf_(r)); }
        }
        __syncthreads();
    }
}

__device__ __forceinline__ void s5_prefix_and_sample(const Params& P, LAS unsigned char* lds) {
    const int tid = otid(); const int lane = tid & 63, w = tid >> 6, gw = blockIdx.x * 8 + w, NGW = gridDim.x * 8;
    const float* sm = (const float*)(P.ws + WS_SMALL); const float* HL = (const float*)(P.ws + WS_HLOC); bf16_t* HS5 = (bf16_t*)(P.ws + WS_HS5);
    LAS float* TOT = (LAS float*)lds;
    for (int L = blockIdx.x; L < 256; L += gridDim.x) {
        int g, mt; { const int xcd = L & 7, idx = L >> 3, combo = xcd * 8 + (idx >> 2); g = (combo >> 2) * 4 + (idx & 3); mt = combo & 3; }
        const char* Aop = (const char*)(P.ws + WS_HS5) + (size_t)g * (1024 * 384 * 2) + (size_t)mt * (BM * 384 * 2);
        { OneUnit S1{{Aop, (const char*)(P.ws + WS_S5M) + (size_t)g * 262144, mt, g, 4, -1}}; EpiS5A E1{(float*)(P.ws + WS_HLOC)}; gemm_phase(lds, 384, 256, S1, E1); }
        asm volatile("s_waitcnt vmcnt(0)" ::: "memory"); __syncthreads();
        {
        const int seg = w & 3, b = 2 * mt + (w >> 2);
        const float ar = sm[SM_A16R + g * 64 + lane], ai = sm[SM_A16I + g * 64 + lane];
        const size_t col0 = (size_t)g * 1024 + b * 128 + seg * 32;
        float lr[32], li[32];
#pragma unroll
        for (int c = 0; c < 32; ++c) { lr[c] = HL[(col0 + c) * 128 + lane]; li[c] = HL[(col0 + c) * 128 + 64 + lane]; }
        float hr = 0.f, hi = 0.f;
#pragma unroll
        for (int c = 0; c < 32; ++c) { const float tr = lr[c], ti = li[c]; lr[c] = hr; li[c] = hi; const float nr = ar * hr - ai * hi + tr, ni = ar * hi + ai * hr + ti; hr = nr; hi = ni; }
        TOT[(w * 2 + 0) * 64 + lane] = hr; TOT[(w * 2 + 1) * 64 + lane] = hi;
        __syncthreads();
        float a32r = ar, a32i = ai;
#pragma unroll
        for (int k = 0; k < 5; ++k) { const float nr = a32r * a32r - a32i * a32i, ni = 2.f * a32r * a32i; a32r = nr; a32i = ni; }
        float cr = 0.f, ci = 0.f;
        for (int s = 0; s < seg; ++s) { const int ws_ = (w & 4) + s; const float tr = TOT[(ws_ * 2 + 0) * 64 + lane], ti = TOT[(ws_ * 2 + 1) * 64 + lane];
            const float nr = a32r * cr - a32i * ci + tr, ni = a32r * ci + a32i * cr + ti; cr = nr; ci = ni; }
        float pr_ = cr, pi_ = ci;
#pragma unroll
        for (int c = 0; c < 32; ++c) { HS5[(col0 + c) * 384 + 256 + lane] = f2bf(lr[c] + pr_); HS5[(col0 + c) * 384 + 320 + lane] = f2bf(li[c] + pi_);
            const float nr = ar * pr_ - ai * pi_, ni = ar * pi_ + ai * pr_; pr_ = nr; pi_ = ni; }
        if (seg == 3) { P.out[O_RP + (size_t)b * 4096 + g * 64 + lane] = hr + pr_; P.out[O_IP + (size_t)b * 4096 + g * 64 + lane] = hi + pi_; }
        }
        asm volatile("s_waitcnt vmcnt(0)" ::: "memory"); __syncthreads();
        { OneUnit S2{{Aop, (const char*)(P.ws + WS_S5M + 65536) + (size_t)g * 262144, mt, g, 6, -1}}; EpiS5B E2{P.ws, P.in[20]}; gemm_phase(lds, 384, 384, S2, E2); }
        __syncthreads();
    }
    const bf16_t* HSMP = (const bf16_t*)(P.ws + WS_HSMP); bf16_t* Z = (bf16_t*)(P.ws + WS_Z);
    LAS float* cb_ = (LAS float*)(lds + 4096 + w * 10752);
    LAS float* hb = cb_ + 2 * 16 * 68;
    for (int wv = gw; wv < 64 * 32; wv += NGW) {
        const int g = wv & 63, b0 = (wv >> 6) * 4, p = lane;
        const float ar = sm[SM_ARE + g * 64 + p], ai = sm[SM_AIM + g * 64 + p], fr = sm[SM_FRE + g * 64 + p], fi = sm[SM_FIM + g * 64 + p];
        f32x4 brv[4], biv[4], crv[4], civ[4];
#pragma unroll
        for (int c4 = 0; c4 < 4; ++c4) { brv[c4] = *(const f32x4*)(P.in[16] + ((size_t)g * 64 + p) * 16 + 4 * c4); biv[c4] = *(const f32x4*)(P.in[17] + ((size_t)g * 64 + p) * 16 + 4 * c4);
            crv[c4] = *(const f32x4*)(P.in[18] + (size_t)g * 1024 + (lane + 64 * c4) * 4); civ[c4] = *(const f32x4*)(P.in[19] + (size_t)g * 1024 + (lane + 64 * c4) * 4); }
        const int t = lane >> 4, cp = lane & 15; const float dsk = P.in[20][g * 16 + cp];
        float bbr[16], bbi[16];
#pragma unroll
        for (int c4 = 0; c4 < 4; ++c4) {
#pragma unroll
            for (int j = 0; j < 4; ++j) { bbr[4 * c4 + j] = fr * brv[c4][j] - fi * biv[c4][j]; bbi[4 * c4 + j] = fr * biv[c4][j] + fi * brv[c4][j]; }
            const int f = lane + 64 * c4, row = f >> 4, col = (f & 15) * 4;
            *(LAS f32x4*)(cb_ + row * 68 + col) = crv[c4]; *(LAS f32x4*)(cb_ + 16 * 68 + row * 68 + col) = civ[c4]; }
#pragma unroll 1
        for (int bb = 0; bb < 4; ++bb) { const int b = b0 + bb;
            u32x4 ua[4], ub[4];
#pragma unroll
            for (int tt = 0; tt < 4; ++tt) { ua[tt] = *(const u32x4*)(HSMP + (size_t)(b * 4 + tt) * D + g * 16); ub[tt] = *(const u32x4*)(HSMP + (size_t)(b * 4 + tt) * D + g * 16 + 8); }
            float hr = P.in[3][(size_t)b * 4096 + g * 64 + p], hi = P.in[4][(size_t)b * 4096 + g * 64 + p];
            const size_t row = (size_t)b * 4 + t; const float uu = bf2f(HSMP[row * D + g * 16 + cp]);
#pragma unroll
            for (int tt = 0; tt < 4; ++tt) { const u32x4 u0 = ua[tt], u1 = ub[tt];
                const float u[16] = {bflo(u0.x), bfhi(u0.x), bflo(u0.y), bfhi(u0.y), bflo(u0.z), bfhi(u0.z), bflo(u0.w), bfhi(u0.w),
                                     bflo(u1.x), bfhi(u1.x), bflo(u1.y), bfhi(u1.y), bflo(u1.z), bfhi(u1.z), bflo(u1.w), bfhi(u1.w)};
                float br = 0.f, bi = 0.f;
#pragma unroll
                for (int c = 0; c < 16; ++c) { br += bbr[c] * u[c]; bi += bbi[c] * u[c]; }
                const float nr = ar * hr - ai * hi + br, ni = ar * hi + ai * hr + bi; hr = nr; hi = ni;
                hb[(tt * 2 + 0) * 64 + p] = hr; hb[(tt * 2 + 1) * 64 + p] = hi; }
            P.out[O_RS + (size_t)b * 4096 + g * 64 + p] = hr; P.out[O_IS + (size_t)b * 4096 + g * 64 + p] = hi;
            asm volatile("s_waitcnt lgkmcnt(0)" ::: "memory");
            float y = 0.f;
#pragma unroll
            for (int i = 0; i < 16; ++i) { const f32x4 c4r = *(const LAS f32x4*)(cb_ + cp * 68 + 4 * i), c4i = *(const LAS f32x4*)(cb_ + 16 * 68 + cp * 68 + 4 * i);
                const f32x4 h4r = *(const LAS f32x4*)(hb + (t * 2 + 0) * 64 + 4 * i), h4i = *(const LAS f32x4*)(hb + (t * 2 + 1) * 64 + 4 * i);
                y += (c4r.x * h4r.x - c4i.x * h4i.x) + (c4r.y * h4r.y - c4i.y * h4i.y) + (c4r.z * h4r.z - c4i.z * h4i.z) + (c4r.w * h4r.w - c4i.w * h4i.w); }
            Z[((size_t)MP + row) * D + g * 16 + cp] = f2bf(y + dsk * uu);
            asm volatile("s_waitcnt lgkmcnt(0)" ::: "memory");
        }
    }
}

#define XB_TMO      128
#define XB_XCNT(j)  (256  + 64 * (j))
#define XB_XSUB(j)  (1280 + 64 * (j))
#define XB_XGEN(j)  (2304 + 64 * (j))
#define XB_TOP      3328
#define XB_TOPGEN   3392
#define XCD_BAR_WORDS 3456
#define XB_SPIN_CAP (1u << 22)
__device__ __forceinline__ unsigned xb_ld(unsigned* p)              { return __hip_atomic_load(p, __ATOMIC_RELAXED, __HIP_MEMORY_SCOPE_AGENT); }
__device__ __forceinline__ unsigned xb_add(unsigned* p, unsigned v) { return __hip_atomic_fetch_add(p, v, __ATOMIC_RELAXED, __HIP_MEMORY_SCOPE_AGENT); }
__device__ __forceinline__ unsigned xb_xcc_id() { return (unsigned)__builtin_amdgcn_s_getreg((3 << 11) | 20) & 0xFu; }
#define XB_SPIN(cond, bar) do { unsigned _sp = 0; while (cond) { __builtin_amdgcn_s_sleep(1); \
    if ((++_sp & 255u) == 0u) { if (xb_ld(&(bar)[XB_TMO])) break; if (_sp > XB_SPIN_CAP) { atomicAdd(&(bar)[XB_TMO], 1u); break; } } } } while (0)
struct XcdBarrier { unsigned* bar; unsigned x; volatile LAS unsigned* st; };
__device__ __forceinline__ XcdBarrier xcd_barrier_post(unsigned* bar, volatile LAS unsigned* st) {
    XcdBarrier b; b.bar = bar; b.x = xb_xcc_id(); b.st = st;
    if (threadIdx.x == 0) (void)xb_add(&bar[XB_XCNT(b.x)], 1u);
    return b;
}
__device__ __forceinline__ void xcd_barrier_complete(unsigned* bar, unsigned x, unsigned& nloc, unsigned& nx) {
    const unsigned G = gridDim.x * gridDim.y * gridDim.z;
    unsigned sum, cnt, mine, sp = 0u;
    for (;;) {
        sum = 0u; cnt = 0u; mine = 0u;
#pragma unroll
        for (unsigned j = 0; j < 16; ++j) { const unsigned c = xb_ld(&bar[XB_XCNT(j)]); sum += c; cnt += (c > 0u) ? 1u : 0u; mine = (j == x) ? c : mine; }
        if (sum == G) break;
        __builtin_amdgcn_s_sleep(1);
        if ((++sp & 255u) == 0u) { if (xb_ld(&bar[XB_TMO])) break; if (sp > XB_SPIN_CAP) { atomicAdd(&bar[XB_TMO], 1u); break; } }
    }
    nloc = mine > 0u ? mine : 1u; nx = cnt > 0u ? cnt : 1u;
}
__device__ __forceinline__ void xcd_barrier(const XcdBarrier& b) {
    asm volatile("s_waitcnt vmcnt(0)" ::: "memory");
    __syncthreads();
    if (threadIdx.x == 0) {
        unsigned* bar = b.bar;
        __builtin_amdgcn_s_waitcnt(0);
        unsigned nloc = b.st[0], nx = b.st[1];
        if (nloc == 0u) { xcd_barrier_complete(bar, b.x, nloc, nx); b.st[0] = nloc; b.st[1] = nx; }
        const unsigned old = xb_add(&bar[XB_XSUB(b.x)], 1u);
        const unsigned gen = old / nloc;
        if (old + 1u == (gen + 1u) * nloc) {
            __builtin_amdgcn_fence(__ATOMIC_RELEASE, "agent");
            asm volatile("s_waitcnt vmcnt(0)" ::: "memory");
            const unsigned og = xb_add(&bar[XB_TOP], 1u);
            const unsigned tg = og / nx;
            if (og + 1u == (tg + 1u) * nx) xb_add(&bar[XB_TOPGEN], 1u);
            else XB_SPIN(xb_ld(&bar[XB_TOPGEN]) == tg, bar);
            __builtin_amdgcn_fence(__ATOMIC_ACQUIRE, "agent");
            xb_add(&bar[XB_XGEN(b.x)], 1u);
            asm volatile("s_waitcnt vmcnt(0)" ::: "memory");
        } else {
            XB_SPIN(xb_ld(&bar[XB_XGEN(b.x)]) == gen, bar);
            __builtin_amdgcn_fence(__ATOMIC_ACQUIRE, "agent");
            asm volatile("s_waitcnt vmcnt(0)" ::: "memory");
        }
    }
    __syncthreads();
}

__global__ void __launch_bounds__(512, 2) fwd_kernel(Params P) {
    extern __shared__ __attribute__((aligned(16))) unsigned char lds_raw[];
    LAS unsigned char* lds = (LAS unsigned char*)lds_raw;
    cg::grid_group grid = cg::this_grid();
    const int lo = P.ph_lo, hi = P.ph_hi; int ph = 0;
    const int G = gridDim.x, cb = blockIdx.x;
    unsigned char* ws = P.ws;
    bf16_t* XB = (bf16_t*)(ws + WS_H); bf16_t* ACT = (bf16_t*)(ws + WS_ACT); bf16_t* Y = (bf16_t*)(ws + WS_Y);
    float* R2 = (float*)(ws + WS_SMALL) + SM_R2;
    unsigned long long pr_acc = 0ull, pr_t0 = 0ull;
#define PH_BEGIN if (PROBE_MASK) pr_t0 = __builtin_amdgcn_s_memrealtime(); if (lo <= ph && ph < hi) {
#define PH_END } ++ph; if (lo < ph && ph < hi) xcd_barrier(xbar); \
    if (PROBE_MASK && ((PROBE_MASK >> (ph - 1)) & 1u)) pr_acc += __builtin_amdgcn_s_memrealtime() - pr_t0;
    volatile LAS unsigned* xst = (volatile LAS unsigned*)(lds + LDS_BYTES - 64);
    if (threadIdx.x < 2) xst[threadIdx.x] = 0u;
    __syncthreads();
    if (ws == nullptr) grid.sync();
    XcdBarrier xbar; xbar.bar = (unsigned*)ws; xbar.x = 0; xbar.st = xst;
    if (hi - lo > 1) xbar = xcd_barrier_post((unsigned*)ws, xst);

    PH_BEGIN phase0(P, lds); PH_END

#define MIXER_GLA \
    PH_BEGIN { TileOrder S{M / BM, NIN / BM, (M / BM) * (NIN / BM), G, cb, (const char*)XB, (const char*)(ws + WS_WIN), (size_t)BM * D * 2, (size_t)BM * D * 2, D / BK}; \
        EpiPlain<1> E{(bf16_t*)(ws + WS_QKV), NIN, P.in[10], nullptr, R2}; gemm_phase(lds, D, D, S, E); } s5_idle_prep_inproj(P, lds); PH_END \
    PH_BEGIN gla_phase_a(P, lds); PH_END \
    PH_BEGIN gla_phase_b(P); PH_END \
    PH_BEGIN gla_phase_c(P, lds); PH_END \
    PH_BEGIN { SplitOrder S{{MP / BM, D / BM, (MP / BM) * (D / BM), G, cb, (const char*)(ws + WS_O), (const char*)(ws + WS_WOUT), (size_t)BM * D * 2, (size_t)BM * D * 2, D / BK}, D / 256}; \
        EpiPlain<0> E{Y, D, nullptr, PART, nullptr}; gemm_phase(lds, D, D, S, E); } PH_END
#define MIXER_S5 \
    PH_BEGIN s5_prefix_and_sample(P, lds); PH_END \
    PH_BEGIN { SplitOrder S{{MP / BM, 2 * D / BM, (MP / BM) * (2 * D / BM), G, cb, (const char*)(ws + WS_Z), (const char*)(ws + WS_WGLU), (size_t)BM * D * 2, (size_t)BM * D * 2, D / BK}, D / 256}; \
        EpiGated<1> E{Y, D, P.in[22], (float*)(ws + WS_HLOC)}; gemm_phase(lds, D, D, S, E); } PH_END
#define FFN_GEMMS(l, f, HOOK) \
    PH_BEGIN { TileOrder S{M / BM, NGU / BM, (M / BM) * (NGU / BM), G, cb, (const char*)XB, (const char*)(ws + WS_WGU + (size_t)((l) * 2 + (f)) * NGU * D * 2), (size_t)BM * D * 2, (size_t)BM * D * 2, D / BK}; \
        EpiGated<0> E{ACT, FF, nullptr, nullptr}; gemm_phase(lds, D, D, S, E); } HOOK PH_END \
    PH_BEGIN { SplitOrder S{{MP / BM, D / BM, (MP / BM) * (D / BM), G, cb, (const char*)ACT, (const char*)(ws + WS_WDN + (size_t)((l) * 2 + (f)) * D * FF * 2), (size_t)BM * FF * 2, (size_t)BM * FF * 2, FF / BK}, FF / 256}; \
        EpiPlain<0> E{Y, D, nullptr, PART, nullptr}; gemm_phase(lds, FF, FF, S, E); } PH_END
    const float* ng0 = P.in[5]; const float* ng1 = P.in[5] + 6 * D;
    float* PART = (float*)(ws + WS_PART);
    FFN_GEMMS(0, 0, s5_idle_prep(P, lds, 0);)
    PH_BEGIN row_pass<3, FF / 256>(P.in[0], P.in[1], XB, R2, Y, ng0 + 1 * D, 0.5f, PART, nullptr, nullptr, nullptr, nullptr); PH_END
    MIXER_GLA
    PH_BEGIN row_pass<3, D / 256>(nullptr, nullptr, XB, R2, Y, ng0 + 3 * D, 1.0f, PART, nullptr, nullptr, nullptr, nullptr); PH_END
    FFN_GEMMS(0, 1, s5_idle_prep(P, lds, 1);)
    PH_BEGIN row_pass<3, FF / 256>(nullptr, nullptr, XB, R2, Y, ng0 + 5 * D, 0.5f, PART, nullptr, nullptr, nullptr, nullptr); PH_END
    FFN_GEMMS(1, 0, s5_idle_prep(P, lds, 2);)
    PH_BEGIN row_pass<3, FF / 256>(nullptr, nullptr, XB, R2, Y, ng1 + 1 * D, 0.5f, PART, nullptr, ng1 + 2 * D, (bf16_t*)(ws + WS_HS5), (bf16_t*)(ws + WS_HSMP)); PH_END
    MIXER_S5
    PH_BEGIN row_pass<3, D / 256>(nullptr, nullptr, XB, R2, Y, ng1 + 3 * D, 1.0f, (const float*)(ws + WS_HLOC), nullptr, nullptr, nullptr, nullptr, P.in[22]); PH_END
    FFN_GEMMS(1, 1, )
    PH_BEGIN row_pass<2, FF / 256>(nullptr, nullptr, XB, R2, Y, ng1 + 5 * D, 0.5f, PART, P.out + O_X, nullptr, nullptr, nullptr); PH_END
    if (PROBE_MASK && blockIdx.x == 0 && threadIdx.x == 0) { const unsigned long long t1 = __builtin_amdgcn_s_memrealtime(); while (__builtin_amdgcn_s_memrealtime() - t1 < pr_acc) __builtin_amdgcn_s_sleep(8); }
#undef PH_BEGIN
#undef PH_END
}

__global__ void dbg_checksum(const unsigned* w, size_t nwords, float* out, size_t nout) {
    for (size_t i = (size_t)blockIdx.x * blockDim.x + threadIdx.x; i < nout; i += (size_t)gridDim.x * blockDim.x) {
        unsigned h = 0; for (int j = 0; j < 3; ++j) { const size_t k = 3 * i + j; if (k < nwords) h = h * 0x9E3779B1u + w[k]; }
        out[i] = (float)(h & 0xffffu);
    }
}
extern "C" void kernel_launch(void* const* d_in, const int* in_sizes, int n_in, void* d_out, int out_size, void* d_ws, size_t ws_size, hipStream_t stream) {
    static int grid = 0;
    if (grid == 0) {
        if (n_in != 23 || ws_size < WS_END) { fprintf(stderr, "kernel_launch: unexpected n_in %d or ws_size %zu (< %zu)\n", n_in, ws_size, (size_t)WS_END); grid = -1; return; }
        int dev = 0, cus = 0, per_cu = 0;
        hipGetDevice(&dev); hipDeviceGetAttribute(&cus, hipDeviceAttributeMultiprocessorCount, dev);
        if (hipFuncSetAttribute((const void*)fwd_kernel, hipFuncAttributeMaxDynamicSharedMemorySize, LDS_BYTES) != hipSuccess) { fprintf(stderr, "kernel_launch: hipFuncSetAttribute failed\n"); grid = -1; return; }
        if (hipOccupancyMaxActiveBlocksPerMultiprocessor(&per_cu, (const void*)fwd_kernel, 512, LDS_BYTES) != hipSuccess || per_cu < 1) { fprintf(stderr, "kernel_launch: occupancy query failed (%d)\n", per_cu); grid = -1; return; }
        grid = cus * per_cu;
    }
    if (grid < 0) return;
    if (hipMemsetAsync(d_ws, 0, 16384, stream) != hipSuccess) { fprintf(stderr, "kernel_launch: memset failed\n"); return; }
    Params p{};
    for (int i = 0; i < 23; ++i) p.in[i] = (const float*)d_in[i];
    p.out = (float*)d_out; p.ws = (unsigned char*)d_ws;
#if MULTI_LAUNCH
    for (int k = 0; k < (DBG_NPH ? DBG_NPH : NPH); ++k) { p.ph_lo = k; p.ph_hi = k + 1; hipLaunchKernelGGL(fwd_kernel, dim3(grid), dim3(512), LDS_BYTES, stream, p); }
#if DBG_NPH
    hipLaunchKernelGGL(dbg_checksum, dim3(2048), dim3(256), 0, stream, (const unsigned*)d_ws, (size_t)(WS_END / 4), (float*)d_out, (size_t)out_size);
#endif
#else
    p.ph_lo = 0; p.ph_hi = NPH;
    void* args[] = {&p};
    hipError_t e = hipLaunchCooperativeKernel((const void*)fwd_kernel, dim3(grid), dim3(512), args, LDS_BYTES, stream);
    if (e != hipSuccess) fprintf(stderr, "cooperative launch failed: %s (grid %d)\n", hipGetErrorString(e), grid);
#endif
}
```

```cpp
#include <hip/hip_runtime.h>
#include <hip/hip_cooperative_groups.h>
#include <cstdio>
namespace cg = cooperative_groups;

#ifndef MULTI_LAUNCH
#define MULTI_LAUNCH 0
#endif

#ifndef PROBE_MASK
#define PROBE_MASK 0u
#endif
#ifndef DBG_NPH
#define DBG_NPH 0
#endif
#define LAS __attribute__((address_space(3)))
typedef unsigned short bf16_t;
typedef short bf16x8 __attribute__((ext_vector_type(8)));
typedef float f32x4 __attribute__((ext_vector_type(4)));
typedef unsigned u32x4 __attribute__((ext_vector_type(4)));
typedef unsigned u32x2 __attribute__((ext_vector_type(2)));

constexpr int D = 1024, FF = 2816, NGU = 5632, MP = 16384, MS = 512, M = MP + MS;
constexpr int NIN = 3584;
constexpr int LDIN = 3088;
constexpr float EPS = 1e-6f;
constexpr int NPH = 22;

constexpr size_t O_X = 0, O_GP = 17301504, O_RP = 18350080, O_IP = 18382848, O_GS = 18415616, O_RS = 35192832, O_IS = 35717120;

constexpr size_t MiB = 1u << 20;
constexpr size_t WS_WGU = 1 * MiB;
constexpr size_t WS_WDN = WS_WGU + 44 * MiB;
constexpr size_t WS_WIN = WS_WDN + 22 * MiB;
constexpr size_t WS_WOUT = WS_WIN + 7 * MiB;
constexpr size_t WS_WGLU = WS_WOUT + 2 * MiB;
constexpr size_t WS_S5M = WS_WGLU + 4 * MiB;
constexpr size_t WS_SMALL = WS_S5M + 16 * MiB;
constexpr size_t WS_HSMP = WS_SMALL + 1 * MiB;
constexpr size_t WS_H = WS_SMALL + 2 * MiB;
constexpr size_t WS_BIG = WS_H + 33 * MiB;
constexpr size_t WS_ACT = WS_BIG;
constexpr size_t WS_Y = WS_BIG + 92 * MiB;
constexpr size_t WS_QKV = WS_BIG;
constexpr size_t WS_KC = WS_BIG + 116 * MiB;
constexpr size_t WS_BEND = WS_BIG + 180 * MiB;
constexpr size_t WS_HS5 = WS_BIG;
constexpr size_t WS_HLOC = WS_BIG + 48 * MiB;
constexpr size_t WS_Z = WS_BIG + 128 * MiB;
constexpr size_t WS_PART = WS_BIG + 128 * MiB;
constexpr size_t WS_O = WS_BIG + 181 * MiB;
constexpr size_t WS_END = WS_BIG + 214 * MiB;
constexpr size_t S5M_G = 262144;
constexpr int SM_R2 = 32768;
constexpr int SM_ARE = 0, SM_AIM = 4096, SM_FRE = 8192, SM_FIM = 12288, SM_A16R = 16384, SM_A16I = 20480;

constexpr int LDS_BYTES = 147456;

typedef __bf16 bf16x2_t __attribute__((ext_vector_type(2)));
typedef float f32x2_t __attribute__((ext_vector_type(2)));
__device__ __forceinline__ unsigned cvt_pk_bf16(float lo, float hi) { const f32x2_t v = {lo, hi}; const bf16x2_t b = __builtin_convertvector(v, bf16x2_t); return __builtin_bit_cast(unsigned, b); }
__device__ __forceinline__ float bflo(unsigned w) { return __uint_as_float(w << 16); }
__device__ __forceinline__ float bfhi(unsigned w) { return __uint_as_float(w & 0xffff0000u); }
__device__ __forceinline__ float bf2f(bf16_t b) { return __uint_as_float(((unsigned)b) << 16); }
__device__ __forceinline__ bf16_t f2bf(float f) { return (bf16_t)(cvt_pk_bf16(f, 0.f) & 0xffffu); }
__device__ __forceinline__ float wave_sum(float v) {
#pragma unroll
    for (int o = 1; o < 64; o <<= 1) v += __shfl_xor(v, o);
    return v;
}
__device__ __forceinline__ int otid() { int t = threadIdx.x; asm volatile("" : "+v"(t)); return t; }
__device__ __forceinline__ float sigmoidf_(float a) { return __builtin_amdgcn_rcpf(1.0f + __expf(-a)); }
__device__ __forceinline__ float siluf_(float a) { return a * sigmoidf_(a); }
__device__ __forceinline__ float logf_gate(float z) { return (fminf(z, 0.f) - __logf(1.0f + __expf(-fabsf(z)))) * 0.0625f; }

constexpr int BM = 256, BK = 64, HALF = 128, HTB = HALF * BK * 2;
__device__ __forceinline__ int lds_byte(int r, int c) { const int st = (r >> 4) * 2 + (c >> 5), rr = r & 15, cc = c & 31, ob = rr * 64 + cc * 2; return st * 1024 + (ob ^ (((ob >> 9) & 1) << 5)); }
__device__ __forceinline__ void stage_rc(int b, int& R, int& C) { const int st = b / 1024, sb = b % 1024, swz = sb ^ (((sb >> 9) & 1) << 5); R = (st >> 1) * 16 + swz / 64; C = (st & 1) * 32 + (swz % 64) / 2; }
__device__ __forceinline__ int perm32(int rho) { const int n = rho >> 4, i = rho & 15; return 8 * (i >> 2) + 4 * n + (i & 3); }

struct Unit { const char* A; const char* B; int pm, pn, nt, ks; };

struct TileOrder {
    int nM, nN, nwg, G, c; const char* A0; const char* B0; size_t at, bt; int ntk;
    __device__ __forceinline__ bool next(int i, Unit& u) const {
        const long L = (long)i * G + c; if (L >= nwg) return false;
        u.nt = ntk; u.ks = -1;
        int wgid = (int)L; { const int q = nwg / 8, r = nwg % 8, xcd = wgid % 8, off = wgid / 8; wgid = (xcd < r ? xcd * (q + 1) : r * (q + 1) + (xcd - r) * q) + off; }
        const int nig = 8 * nN, gid = wgid / nig, fm = gid * 8, gsz = (nM - fm) < 8 ? (nM - fm) : 8;
        u.pm = fm + ((wgid % nig) % gsz); u.pn = (wgid % nig) / gsz;
        u.A = A0 + (size_t)u.pm * at; u.B = B0 + (size_t)u.pn * bt; return true;
    }
};
struct SplitOrder {
    TileOrder T; int nks;
    __device__ __forceinline__ bool next(int i, Unit& u) const {
        const int L = i * T.G + T.c;
        if (L < T.nwg) return T.next(i, u);
        const int j = L - T.nwg, ns = 2 * T.nN; if (j >= ns * nks) return false;
        const int st = j % ns, ks = j / ns; u.pm = 64 + st / T.nN; u.pn = st % T.nN; u.nt = 4; u.ks = ks;
        u.A = T.A0 + (size_t)u.pm * T.at + (size_t)ks * 512; u.B = T.B0 + (size_t)u.pn * T.bt + (size_t)ks * 512; return true;
    }
};
struct OneUnit { Unit u; __device__ __forceinline__ bool next(int i, Unit& o) const { if (i) return false; o = u; return true; } };
struct S5Order {
    int G, c; const char* A0; const char* B0; int ntk;
    __device__ __forceinline__ bool next(int i, Unit& u) const {
        const int L = i * G + c; if (L >= 256) return false;
        u.nt = ntk; u.ks = -1;
        { const int xcd = L & 7, idx = L >> 3, combo = xcd * 8 + (idx >> 2); u.pn = (combo >> 2) * 4 + (idx & 3); u.pm = combo & 3; }
        u.A = A0 + (size_t)u.pn * (1024 * 384 * 2) + (size_t)u.pm * (BM * 384 * 2); u.B = B0 + (size_t)u.pn * 262144; return true;
    }
};

template <class Epi, class Sched>
__device__ __forceinline__ void gemm_phase(LAS unsigned char* lds, const int lda, const int ldb, const Sched& S, const Epi& E) {
    int tid_ = threadIdx.x; asm volatile("" : "+v"(tid_));
    const int tid = tid_, wid = __builtin_amdgcn_readfirstlane(tid >> 6), lane = tid & 63, wr = wid >> 2, wc = wid & 3, fr = lane & 15, fq = lane >> 4;
    unsigned voffA[2], voffB[2];
#pragma unroll
    for (int i = 0; i < 2; ++i) { int R, C; stage_rc(tid * 16 + i * 8192, R, C); const int Rb = (R & ~31) + perm32(R & 31);
        voffA[i] = (unsigned)(R * lda + C) * 2u; voffB[i] = (unsigned)(Rb * ldb + C) * 2u; }
    const size_t kstep = (size_t)(BK * 2);
    const size_t hstepA = (size_t)HALF * lda * 2, hstepB = (size_t)HALF * ldb * 2;
    const unsigned ldsw = (unsigned)wid * 1024u;
    const int aoff = lds_byte(wr * 64 + fr, fq * 8), boff = lds_byte(wc * 32 + fr, fq * 8);
#define PG8_SA(b, h) (((b) * 2 + (h)) * HTB)
#define PG8_SB(b, h) ((4 + (b) * 2 + (h)) * HTB)
#define PG8_STAGE(bufoff, gbase, voff) do { _Pragma("unroll") for (int _i = 0; _i < 2; ++_i) \
        __builtin_amdgcn_global_load_lds((const unsigned*)((const char*)(gbase) + (voff)[_i]), (LAS unsigned*)(lds + (bufoff) + ldsw + _i * 8192), 16, 0, 0); } while (0)
#define PG8_LDA(dst, b, h) do { _Pragma("unroll") for (int m = 0; m < 4; ++m) _Pragma("unroll") for (int k = 0; k < 2; ++k) dst[m][k] = *(const LAS bf16x8*)(lds + PG8_SA(b, h) + aoff + m * 2048 + k * 1024); } while (0)
#define PG8_LDB(dst, b, h) do { _Pragma("unroll") for (int n = 0; n < 2; ++n) _Pragma("unroll") for (int k = 0; k < 2; ++k) dst[n][k] = *(const LAS bf16x8*)(lds + PG8_SB(b, h) + boff + n * 2048 + k * 1024); } while (0)
#define PG8_MMA(ai, bj, At, Bt) do { __builtin_amdgcn_s_setprio(1); _Pragma("unroll") for (int m = 0; m < 4; ++m) _Pragma("unroll") for (int n = 0; n < 2; ++n) _Pragma("unroll") for (int k = 0; k < 2; ++k) \
        acc[ai][bj][m][n] = __builtin_amdgcn_mfma_f32_16x16x32_bf16(Bt[n][k], At[m][k], acc[ai][bj][m][n], 0, 0, 0); __builtin_amdgcn_s_setprio(0); } while (0)
#define PG8_WAIT_V(n) asm volatile("s_waitcnt vmcnt(" #n ")" ::: "memory")
#define PG8_WAIT_L(n) asm volatile("s_waitcnt lgkmcnt(" #n ")" ::: "memory")
#define PG8_BAR __builtin_amdgcn_s_barrier()
#define PG8_SCHED __builtin_amdgcn_sched_barrier(0)
    Unit cur, nxt; int ui = 0;
    if (!S.next(0, cur)) return;
    f32x4 acc[2][2][4][2];
#pragma unroll
    for (int a = 0; a < 2; ++a)
#pragma unroll
        for (int b = 0; b < 2; ++b)
#pragma unroll
            for (int m = 0; m < 4; ++m)
#pragma unroll
                for (int n = 0; n < 2; ++n) acc[a][b][m][n] = (f32x4){0.f, 0.f, 0.f, 0.f};
    bf16x8 At[4][2], B0[2][2], B1[2][2];
    const char* cA = cur.A; const char* cB = cur.B;
    PG8_STAGE(PG8_SB(0, 0), cB, voffB); PG8_STAGE(PG8_SA(0, 0), cA, voffA); PG8_STAGE(PG8_SB(0, 1), cB + hstepB, voffB); PG8_STAGE(PG8_SA(0, 1), cA + hstepA, voffA);
    if (wr == 1) PG8_BAR;
    PG8_WAIT_V(4); PG8_BAR;
    PG8_STAGE(PG8_SB(1, 0), cB + kstep, voffB); PG8_STAGE(PG8_SA(1, 0), cA + kstep, voffA); PG8_STAGE(PG8_SB(1, 1), cB + hstepB + kstep, voffB);
    PG8_WAIT_V(6); PG8_BAR;
    for (;;) {
        const bool has_next = S.next(ui + 1, nxt);
        const char* nA = has_next ? nxt.A : cA; const char* nB = has_next ? nxt.B : cB;
        const int nt = cur.nt;
        for (int t = 0; t < nt; t += 2) {
            const bool last = (t == nt - 2);
            const char* a1 = cA + (size_t)(t + 1) * kstep;
            const char* a2 = last ? nA : cA + (size_t)(t + 2) * kstep; const char* b2 = last ? nB : cB + (size_t)(t + 2) * kstep;
            const char* a3 = a2 + kstep; const char* b3 = b2 + kstep;
            PG8_LDB(B0, 0, 0); PG8_SCHED; PG8_LDA(At, 0, 0); PG8_STAGE(PG8_SA(1, 1), a1 + hstepA, voffA);
            PG8_WAIT_L(8); PG8_BAR; PG8_WAIT_L(0); PG8_MMA(0, 0, At, B0); PG8_BAR; PG8_SCHED;
            PG8_LDB(B1, 0, 1); PG8_STAGE(PG8_SB(0, 0), b2, voffB);
            PG8_BAR; PG8_WAIT_L(0); PG8_MMA(0, 1, At, B1); PG8_BAR;
            PG8_LDA(At, 0, 1); PG8_STAGE(PG8_SA(0, 0), a2, voffA);
            PG8_BAR; PG8_WAIT_L(0); PG8_MMA(1, 0, At, B0); PG8_BAR; PG8_SCHED;
            PG8_STAGE(PG8_SB(0, 1), b2 + hstepB, voffB);
            PG8_WAIT_V(6); PG8_BAR; PG8_MMA(1, 1, At, B1); PG8_BAR;
            PG8_LDB(B0, 1, 0); PG8_SCHED; PG8_LDA(At, 1, 0); PG8_STAGE(PG8_SA(0, 1), a2 + hstepA, voffA);
            PG8_WAIT_L(8); PG8_BAR; PG8_WAIT_L(0); PG8_MMA(0, 0, At, B0); PG8_BAR; PG8_SCHED;
            PG8_LDB(B1, 1, 1); PG8_STAGE(PG8_SB(1, 0), b3, voffB);
            PG8_BAR; PG8_WAIT_L(0); PG8_MMA(0, 1, At, B1); PG8_BAR;
            PG8_LDA(At, 1, 1); PG8_STAGE(PG8_SA(1, 0), a3, voffA);
            PG8_BAR; PG8_WAIT_L(0); PG8_MMA(1, 0, At, B0); PG8_BAR; PG8_SCHED;
            PG8_STAGE(PG8_SB(1, 1), b3 + hstepB, voffB);
            PG8_WAIT_V(6); PG8_BAR; PG8_MMA(1, 1, At, B1); PG8_BAR;
        }
        E(acc, cur, wr, wc, fr, fq);
        if (!has_next) break;
#pragma unroll
        for (int a = 0; a < 2; ++a)
#pragma unroll
            for (int b = 0; b < 2; ++b)
#pragma unroll
                for (int m = 0; m < 4; ++m)
#pragma unroll
                    for (int n = 0; n < 2; ++n) acc[a][b][m][n] = (f32x4){0.f, 0.f, 0.f, 0.f};
        cur = nxt; cA = nA; cB = nB; ++ui;
    }
    PG8_WAIT_V(0);
    if (wr == 0) PG8_BAR;
    PG8_BAR;
#undef PG8_SA
#undef PG8_SB
#undef PG8_STAGE
#undef PG8_LDA
#undef PG8_LDB
#undef PG8_MMA
#undef PG8_WAIT_V
#undef PG8_WAIT_L
#undef PG8_BAR
#undef PG8_SCHED
}

template <int MODE>
struct EpiGated {
    bf16_t* O; int ldc; const float* bias; float* part;
    __device__ __forceinline__ void operator()(const f32x4 (&acc)[2][2][4][2], const Unit& u, int wr, int wc, int fr, int fq) const {
        const int row0 = u.pm * BM + wr * 64 + fr, col0 = u.pn * 128 + wc * 32 + 8 * fq;
        if (MODE == 1 && u.ks >= 0) {
#pragma unroll
            for (int bj = 0; bj < 2; ++bj)
#pragma unroll
                for (int ai = 0; ai < 2; ++ai)
#pragma unroll
                    for (int m = 0; m < 4; ++m) { float* p = part + ((size_t)u.ks * MS + (row0 + ai * HALF + m * 16 - MP)) * (2 * ldc) + u.pn * BM + bj * HALF + wc * 32 + 8 * fq;
                        *(f32x4*)p = acc[ai][bj][m][0]; *(f32x4*)(p + 4) = acc[ai][bj][m][1]; }
            return;
        }
        f32x4 b0[2], b1[2];
#pragma unroll
        for (int n = 0; n < 2; ++n) { b0[n] = (f32x4){0.f, 0.f, 0.f, 0.f}; b1[n] = b0[n];
            if (MODE == 1) { b0[n] = *(const f32x4*)(bias + col0 + 4 * n); b1[n] = *(const f32x4*)(bias + ldc + col0 + 4 * n); } }
#pragma unroll
        for (int ai = 0; ai < 2; ++ai)
#pragma unroll
            for (int m = 0; m < 4; ++m) {
                float v[8]; const float rs = 1.0f;
#pragma unroll
                for (int n = 0; n < 2; ++n)
#pragma unroll
                    for (int j = 0; j < 4; ++j) { const float a = acc[ai][0][m][n][j] * rs + b0[n][j], b = acc[ai][1][m][n][j] * rs + b1[n][j];
                        v[4 * n + j] = (MODE == 0) ? siluf_(a) * b : a * sigmoidf_(b); }
                u32x4 w; w.x = cvt_pk_bf16(v[0], v[1]); w.y = cvt_pk_bf16(v[2], v[3]); w.z = cvt_pk_bf16(v[4], v[5]); w.w = cvt_pk_bf16(v[6], v[7]);
                *(u32x4*)(O + (size_t)(row0 + ai * HALF + m * 16) * ldc + col0) = w;
            }
    }
};
template <int GLA>
struct EpiPlain {
    bf16_t* O; int ldc; const float* bg; float* part; const float* r2;
    __device__ __forceinline__ void operator()(const f32x4 (&acc)[2][2][4][2], const Unit& u, int wr, int wc, int fr, int fq) const {
        const int row0 = u.pm * BM + wr * 64 + fr, col0 = u.pn * BM + wc * 32 + 8 * fq;
        if (!GLA && u.ks >= 0) {
#pragma unroll
            for (int bj = 0; bj < 2; ++bj)
#pragma unroll
                for (int ai = 0; ai < 2; ++ai)
#pragma unroll
                    for (int m = 0; m < 4; ++m) { float* p = part + ((size_t)u.ks * MS + (row0 + ai * HALF + m * 16 - MP)) * D + col0 + bj * HALF;
                        *(f32x4*)p = acc[ai][bj][m][0]; *(f32x4*)(p + 4) = acc[ai][bj][m][1]; }
            return;
        }
        const bool lf = GLA && (u.pn >= 12);
#pragma unroll
        for (int bj = 0; bj < 2; ++bj) {
            f32x4 bb[2];
#pragma unroll
            for (int n = 0; n < 2; ++n) bb[n] = lf ? *(const f32x4*)(bg + (col0 - 3072) + bj * HALF + 4 * n) : (f32x4){0.f, 0.f, 0.f, 0.f};
#pragma unroll
            for (int ai = 0; ai < 2; ++ai)
#pragma unroll
                for (int m = 0; m < 4; ++m) {
                    float v[8]; const float rs = 1.0f;
#pragma unroll
                    for (int n = 0; n < 2; ++n)
#pragma unroll
                        for (int j = 0; j < 4; ++j) { float a = acc[ai][bj][m][n][j] * rs;
                            if (lf) a += bb[n][j];
                            v[4 * n + j] = a; }
                    u32x4 w; w.x = cvt_pk_bf16(v[0], v[1]); w.y = cvt_pk_bf16(v[2], v[3]); w.z = cvt_pk_bf16(v[4], v[5]); w.w = cvt_pk_bf16(v[6], v[7]);
                    *(u32x4*)(O + (size_t)(row0 + ai * HALF + m * 16) * ldc + col0 + bj * HALF) = w;
                }
        }
    }
};
struct EpiS5A {
    float* HL;
    __device__ __forceinline__ void operator()(const f32x4 (&acc)[2][2][4][2], const Unit& u, int wr, int wc, int fr, int fq) const {
        const int row0 = u.pm * BM + wr * 64 + fr, col0 = wc * 32 + 8 * fq;
#pragma unroll
        for (int ai = 0; ai < 2; ++ai)
#pragma unroll
            for (int m = 0; m < 4; ++m) { float* p = HL + ((size_t)u.pn * 1024 + row0 + ai * HALF + m * 16) * 128 + col0;
                *(f32x4*)p = acc[ai][0][m][0]; *(f32x4*)(p + 4) = acc[ai][0][m][1]; }
    }
};
struct EpiS5B {
    unsigned char* ws; const float* dsk;
    __device__ __forceinline__ void operator()(const f32x4 (&acc)[2][2][4][2], const Unit& u, int wr, int wc, int fr, int fq) const {
        bf16_t* Z = (bf16_t*)(ws + WS_Z); const bf16_t* HS5 = (const bf16_t*)(ws + WS_HS5);
        asm volatile("" : "+v"(fq));
        const int g = u.pn, c0 = (8 * fq) & 15;
        const f32x4 d0 = *(const f32x4*)(dsk + g * 16 + c0), d1 = *(const f32x4*)(dsk + g * 16 + c0 + 4);
#pragma unroll
        for (int bj = 0; bj < 2; ++bj) { const int t = 8 * bj + 2 * wc + (fq >> 1);
#pragma unroll
            for (int ai = 0; ai < 2; ++ai)
#pragma unroll
                for (int m = 0; m < 4; ++m) { const int colr = u.pm * BM + ai * HALF + wr * 64 + m * 16 + fr; const size_t off = (size_t)(colr * 16 + t) * D + g * 16 + c0;
                    const u32x4 uu = *(const u32x4*)(HS5 + ((size_t)g * 1024 + colr) * 384 + t * 16 + c0); const f32x4 a0 = acc[ai][bj][m][0], a1 = acc[ai][bj][m][1];
                    u32x4 w; w.x = cvt_pk_bf16(a0[0] + d0[0] * bflo(uu.x), a0[1] + d0[1] * bfhi(uu.x)); w.y = cvt_pk_bf16(a0[2] + d0[2] * bflo(uu.y), a0[3] + d0[3] * bfhi(uu.y));
                    w.z = cvt_pk_bf16(a1[0] + d1[0] * bflo(uu.z), a1[1] + d1[1] * bfhi(uu.z)); w.w = cvt_pk_bf16(a1[2] + d1[2] * bflo(uu.w), a1[3] + d1[3] * bfhi(uu.w));
                    *(u32x4*)(Z + off) = w; }
        }
    }
};

struct Params { const float* in[23]; float* out; unsigned char* ws; int ph_lo, ph_hi; };

template <int R, int NKS>
__device__ __forceinline__ void row_pass(const float* xf_p, const float* xf_s, bf16_t* XB, float* R2, const bf16_t* Y, const float* g_post, float scale,
                                         const float* part, float* outf, const float* g_pre, bf16_t* HS5, bf16_t* HSMP, const float* glu_bias = nullptr) {
    const int tid = otid(); const int lane = tid & 63, gw = blockIdx.x * 8 + (tid >> 6), NGW = gridDim.x * 8;
    const int KMAX = (M + NGW - 1) / NGW;
    for (int k0 = 0; k0 < KMAX; k0 += R) {
        f32x4 v[R][4], yv[R][4];
#pragma unroll
        for (int r = 0; r < R; ++r) { const int kk = (k0 + r + KMAX - 1) % KMAX, mr = gw + kk * NGW, m = (k0 + r < KMAX && mr < M) ? mr : gw;
            if (xf_p) { const float* xr = (m < MP) ? xf_p + (size_t)m * D : xf_s + (size_t)(m - MP) * D;
#pragma unroll
                for (int j = 0; j < 4; ++j) v[r][j] = *(const f32x4*)(xr + 256 * j + 4 * lane);
            } else {
                const float ir = 1.0f / R2[m];
#pragma unroll
                for (int j = 0; j < 4; ++j) { const u32x2 w = *(const u32x2*)(XB + (size_t)m * D + 256 * j + 4 * lane); v[r][j] = (f32x4){bflo(w.x), bfhi(w.x), bflo(w.y), bfhi(w.y)} * ir; }
            }
            if (Y) {
                if (glu_bias && m >= MP) {
#pragma unroll
                    for (int j = 0; j < 4; ++j) { const int nc = 256 * (2 * j + (lane >> 5)) + 4 * (lane & 31);
                        f32x4 sv = *(const f32x4*)(glu_bias + 256 * j + 4 * lane), sg = *(const f32x4*)(glu_bias + D + 256 * j + 4 * lane);
                        f32x4 tv[NKS], tg[NKS];
#pragma unroll
                        for (int ks = 0; ks < NKS; ++ks) { const float* pp = part + ((size_t)ks * MS + (m - MP)) * (2 * D) + nc; tv[ks] = *(const f32x4*)pp; tg[ks] = *(const f32x4*)(pp + 128); }
#pragma unroll
                        for (int ks = 0; ks < NKS; ++ks) { sv += tv[ks]; sg += tg[ks]; }
                        yv[r][j] = (f32x4){sv.x * sigmoidf_(sg.x), sv.y * sigmoidf_(sg.y), sv.z * sigmoidf_(sg.z), sv.w * sigmoidf_(sg.w)}; }
                } else if (part && m >= MP) {
#pragma unroll
                    for (int j = 0; j < 4; ++j) { f32x4 t[NKS];
#pragma unroll
                        for (int ks = 0; ks < NKS; ++ks) t[ks] = *(const f32x4*)(part + ((size_t)ks * MS + (m - MP)) * D + 256 * j + 4 * lane);
                        f32x4 s = t[0];
#pragma unroll
                        for (int ks = 1; ks < NKS; ++ks) s += t[ks];
                        yv[r][j] = s; }
                } else {
#pragma unroll
                    for (int j = 0; j < 4; ++j) { const u32x2 w = *(const u32x2*)(Y + (size_t)m * D + 256 * j + 4 * lane); yv[r][j] = (f32x4){bflo(w.x), bfhi(w.x), bflo(w.y), bfhi(w.y)}; }
                }
            }
        }
#pragma unroll
        for (int r = 0; r < R; ++r) { const int kk = (k0 + r + KMAX - 1) % KMAX, m = gw + kk * NGW; if (k0 + r >= KMAX || m >= M) continue;
            if (Y) {
                float ss = 0.f;
#pragma unroll
                for (int j = 0; j < 4; ++j) ss += (yv[r][j].x * yv[r][j].x + yv[r][j].y * yv[r][j].y) + (yv[r][j].z * yv[r][j].z + yv[r][j].w * yv[r][j].w);
                const float rr = rsqrtf(wave_sum(ss) * (1.0f / D) + EPS) * scale;
#pragma unroll
                for (int j = 0; j < 4; ++j) { const f32x4 g = *(const f32x4*)(g_post + 256 * j + 4 * lane); v[r][j] = v[r][j] + yv[r][j] * g * rr; }
            }
            if (outf) {
#pragma unroll
                for (int j = 0; j < 4; ++j) *(f32x4*)(outf + (size_t)m * D + 256 * j + 4 * lane) = v[r][j];
            } else {
                float ss = 0.f;
#pragma unroll
                for (int j = 0; j < 4; ++j) ss += (v[r][j].x * v[r][j].x + v[r][j].y * v[r][j].y) + (v[r][j].z * v[r][j].z + v[r][j].w * v[r][j].w);
                const float rr = rsqrtf(wave_sum(ss) * (1.0f / D) + EPS);
#pragma unroll
                for (int j = 0; j < 4; ++j) { u32x2 w; w.x = cvt_pk_bf16(v[r][j].x * rr, v[r][j].y * rr); w.y = cvt_pk_bf16(v[r][j].z * rr, v[r][j].w * rr);
                    *(u32x2*)(XB + (size_t)m * D + 256 * j + 4 * lane) = w; }
                if (lane == 0) R2[m] = rr;
                if (g_pre) {
#pragma unroll
                    for (int j = 0; j < 4; ++j) { const f32x4 g = *(const f32x4*)(g_pre + 256 * j + 4 * lane); const f32x4 h = v[r][j] * g * rr;
                        u32x2 w; w.x = cvt_pk_bf16(h.x, h.y); w.y = cvt_pk_bf16(h.z, h.w);
                        if (m < MP) { const int gi = j * 16 + (lane >> 2), c = (lane & 3) * 4;
                            *(u32x2*)(HS5 + ((size_t)gi * 1024 + (m >> 4)) * 384 + (m & 15) * 16 + c) = w; }
                        else *(u32x2*)(HSMP + (size_t)(m - MP) * D + 256 * j + 4 * lane) = w; }
                }
            }
        }
    }
}

__device__ __forceinline__ void transpose_item(const float* W, int ldw, int K, int scol0, bf16_t* Bt, int drow0, int k0, float scale, const float* gk, LAS bf16_t* scr, int lane) {
    const float* src = W + (size_t)(k0 + (lane >> 5)) * ldw + scol0 + 4 * (lane & 31);
#pragma unroll 16
    for (int i = 0; i < 32; ++i) { const f32x4 w = __builtin_nontemporal_load((const f32x4*)(src + (size_t)(2 * i) * ldw));
        const float sc = gk ? gk[k0 + 2 * i + (lane >> 5)] * scale : scale;
        u32x2 o; o.x = cvt_pk_bf16(w.x * sc, w.y * sc); o.y = cvt_pk_bf16(w.z * sc, w.w * sc);
        *(LAS u32x2*)(scr + (2 * i + (lane >> 5)) * 136 + 4 * (lane & 31)) = o; }
    asm volatile("s_waitcnt lgkmcnt(0)" ::: "memory");
#pragma unroll 4
    for (int t = 0; t < 16; ++t) { const int task = t * 64 + lane, n = task >> 3, kc = task & 7; const LAS bf16_t* s = scr + (kc * 8) * 136 + n;
        u32x4 o; o.x = (unsigned)s[0] | ((unsigned)s[136] << 16); o.y = (unsigned)s[272] | ((unsigned)s[408] << 16);
        o.z = (unsigned)s[544] | ((unsigned)s[680] << 16); o.w = (unsigned)s[816] | ((unsigned)s[952] << 16);
        *(u32x4*)(Bt + (size_t)(drow0 + n) * K + k0 + 8 * kc) = o; }
    asm volatile("s_waitcnt lgkmcnt(0)" ::: "memory");
}

__device__ __forceinline__ void s5_prep_group(const Params& P, LAS unsigned char* lds, int g, int qt) {
    LAS float* apr = (LAS float*)lds;
    LAS float* api = apr + 17 * 64;
    LAS float* bbr = api + 17 * 64;
    LAS float* bbi = bbr + 1024;
    LAS float* cre = bbi + 1024;
    LAS float* cim = cre + 1024;
    LAS float* fre = cim + 1024;
    LAS float* fim = fre + 64;
    LAS float* kmat = fim + 64;
    const int tid = otid();
    float* sm = (float*)(P.ws + WS_SMALL);
    bf16_t* Wm = (bf16_t*)(P.ws + WS_S5M + (size_t)g * S5M_G);
    bf16_t* TE = Wm + 128 * 256;
    if (tid < 64) {
        const int p = tid; const float lr = P.in[13][g * 64 + p], li = P.in[14][g * 64 + p]; const float dt = expf(P.in[15][g]);
        float a1r = 0.f, a1i = 0.f;
        for (int tau = 0; tau <= 16; ++tau) {
            const float mag = expf(lr * dt * (float)tau);
            double rev = (double)li * (double)dt * (double)tau * 0.15915494309189535; rev -= __builtin_rint(rev);
            const float rr = (float)rev; const float s = __builtin_amdgcn_sinf(rr), c = __builtin_amdgcn_cosf(rr);
            apr[tau * 64 + p] = mag * c; api[tau * 64 + p] = mag * s;
            if (tau == 1) { a1r = mag * c; a1i = mag * s; }
            if (tau == 16 && qt == 0) { sm[SM_A16R + g * 64 + p] = mag * c; sm[SM_A16I + g * 64 + p] = mag * s; }
        }
        const float nr = a1r - 1.0f, ni = a1i, den = lr * lr + li * li;
        const float fr_ = (nr * lr + ni * li) / den, fi_ = (ni * lr - nr * li) / den;
        fre[p] = fr_; fim[p] = fi_;
        if (qt == 0) { sm[SM_ARE + g * 64 + p] = a1r; sm[SM_AIM + g * 64 + p] = a1i; sm[SM_FRE + g * 64 + p] = fr_; sm[SM_FIM + g * 64 + p] = fi_; }
    }
    __syncthreads();
    for (int idx = tid; idx < 1024; idx += 512) { const int p = idx >> 4; const float br = P.in[16][g * 1024 + idx], bi = P.in[17][g * 1024 + idx];
        bbr[idx] = fre[p] * br - fim[p] * bi; bbi[idx] = fre[p] * bi + fim[p] * br;
        cre[idx] = P.in[18][g * 1024 + idx]; cim[idx] = P.in[19][g * 1024 + idx]; }
    __syncthreads();
    for (int idx = qt * 8192 + tid; idx < (qt + 1) * 8192; idx += 512) { const int row = idx >> 8, col = idx & 255, s = col >> 4, c = col & 15, p = row & 63, im = row >> 6;
        const float ar = apr[(15 - s) * 64 + p], ai = api[(15 - s) * 64 + p], br = bbr[p * 16 + c], bi = bbi[p * 16 + c];
        Wm[idx] = f2bf(im ? (ar * bi + ai * br) : (ar * br - ai * bi)); }
    for (int i2 = tid; i2 < 1024; i2 += 512) { const int tau = i2 >> 6, cp = 4 * qt + ((i2 >> 4) & 3), c = i2 & 15, idx = (tau << 8) + (cp << 4) + c; float sum = 0.f;
        for (int p = 0; p < 64; ++p) { const float cr = cre[cp * 64 + p], ci = cim[cp * 64 + p], ar = apr[tau * 64 + p], ai = api[tau * 64 + p];
            const float car = cr * ar - ci * ai, cai = cr * ai + ci * ar; sum += car * bbr[p * 16 + c] - cai * bbi[p * 16 + c]; }
        kmat[idx] = sum; }
    __syncthreads();
    for (int i2 = tid; i2 < 64 * 384; i2 += 512) { const int r2 = i2 / 384, col = i2 - r2 * 384, t = r2 >> 2, cp = 4 * qt + (r2 & 3), row = t * 16 + cp, idx = row * 384 + col; float v;
        if (col < 256) { const int s = col >> 4, c = col & 15; v = (s <= t) ? kmat[((t - s) << 8) + (cp << 4) + c] : 0.f; }
        else { const int pp = col - 256, p = pp & 63, im = pp >> 6; const float cr = cre[cp * 64 + p], ci = cim[cp * 64 + p], ar = apr[(t + 1) * 64 + p], ai = api[(t + 1) * 64 + p];
            v = im ? -(cr * ai + ci * ar) : (cr * ar - ci * ai); }
        TE[idx] = f2bf(v); }
    __syncthreads();
}

__device__ __forceinline__ void s5_idle_prep(const Params& P, LAS unsigned char* lds, int slot) {
    const int G = gridDim.x, nfull = ((M / BM) * (NGU / BM)) % G, cb = blockIdx.x;
    if (nfull == 0 || cb < nfull) return;
    const int wi = slot * (G - nfull) + (cb - nfull);
    if (wi < 256) s5_prep_group(P, lds, wi >> 2, wi & 3);
}
__device__ __forceinline__ void s5_idle_prep_inproj(const Params& P, LAS unsigned char* lds) {
    const int G = gridDim.x, nf1 = ((M / BM) * (NGU / BM)) % G, nf2 = ((M / BM) * (NIN / BM)) % G, cb = blockIdx.x;
    if (nf1 == 0 || nf2 == 0 || cb < nf2) return;
    const int wi = 3 * (G - nf1) + (cb - nf2);
    if (wi < 256) s5_prep_group(P, lds, wi >> 2, wi & 3);
}
__device__ __forceinline__ void phase0(const Params& P, LAS unsigned char* lds) {
    const int tid = otid(), lane = tid & 63, wave = tid >> 6;
    const int gw = blockIdx.x * 8 + wave, NGW = gridDim.x * 8;
    LAS bf16_t* scr = (LAS bf16_t*)(lds + wave * 17408);
    bf16_t* WGU = (bf16_t*)(P.ws + WS_WGU); bf16_t* WDN = (bf16_t*)(P.ws + WS_WDN); bf16_t* WIN = (bf16_t*)(P.ws + WS_WIN);
    bf16_t* WOUT = (bf16_t*)(P.ws + WS_WOUT); bf16_t* WGLU = (bf16_t*)(P.ws + WS_WGLU);
    constexpr int I_GU = 4 * 16 * 44, I_DN = 4 * 44 * 8, I_IN = 16 * 24, I_OUT = 16 * 8, I_GLU = 16 * 16;
#pragma unroll 1
    for (int step = 0; step < 2; ++step) {
    if (((blockIdx.x & 1) != 0) == (step == 0)) {
        { const int G_ = gridDim.x, nf1_ = ((M / BM) * (NGU / BM)) % G_, nf2_ = ((M / BM) * (NIN / BM)) % G_;
          const int first_ = (nf1_ && nf2_) ? 3 * (G_ - nf1_) + (G_ - nf2_) : (nf1_ ? 3 * (G_ - nf1_) : 0);
          for (int wi = first_ + blockIdx.x; wi < 256; wi += gridDim.x) s5_prep_group(P, lds, wi >> 2, wi & 3); }
    } else {
    for (int it = blockIdx.x + gridDim.x * wave; it < I_GU + I_DN + I_IN + I_OUT + I_GLU; it += NGW) {
        int r = it;
        if (r < I_GU) { const int lf = r / 704, rr = r % 704, kb = rr / 44, nb = rr % 44, n0 = nb * 128, pn = n0 >> 8, bj = (n0 >> 7) & 1;
            transpose_item(P.in[6] + (size_t)lf * D * NGU, NGU, D, bj * FF + pn * 128, WGU + (size_t)lf * NGU * D, n0, kb * 64, 1.0f, P.in[5] + (size_t)((lf >> 1) * 6 + (lf & 1) * 4) * D, scr, lane); continue; }
        r -= I_GU;
        if (r < I_DN) { const int lf = r / 352, rr = r % 352, kb = rr / 8, nb = rr % 8;
            transpose_item(P.in[7] + (size_t)lf * FF * D, D, FF, nb * 128, WDN + (size_t)lf * D * FF, nb * 128, kb * 64, 1.0f, nullptr, scr, lane); continue; }
        r -= I_DN;
        if (r < I_IN) { const int kb = r / 24, nb = r % 24, n0 = nb * 128;
            transpose_item(P.in[8], LDIN, D, n0, WIN, n0, kb * 64, n0 < 512 ? 0.08838834764831845f : 1.0f, P.in[5] + 2 * D, scr, lane); continue; }
        r -= I_IN;
        if (r < I_OUT) { const int kb = r / 8, nb = r % 8; transpose_item(P.in[12], D, D, nb * 128, WOUT, nb * 128, kb * 64, 1.0f, nullptr, scr, lane); continue; }
        r -= I_OUT;
        { const int kb = r / 16, nb = r % 16, n0 = nb * 128, pn = n0 >> 8, bj = (n0 >> 7) & 1;
            transpose_item(P.in[21], 2 * D, D, bj * D + pn * 128, WGLU, n0, kb * 64, 1.0f, nullptr, scr, lane); }
    }
    for (int idx = blockIdx.x * 512 + tid; idx < 64 * 1024; idx += gridDim.x * 512) { const int jb = idx >> 10, k = idx & 1023;
        const float* wr = P.in[8] + (size_t)k * LDIN + 3072; const f32x4 a0 = *(const f32x4*)wr, a1 = *(const f32x4*)(wr + 4), a2 = *(const f32x4*)(wr + 8), a3 = *(const f32x4*)(wr + 12);
        const float a[16] = {a0.x, a0.y, a0.z, a0.w, a1.x, a1.y, a1.z, a1.w, a2.x, a2.y, a2.z, a2.w, a3.x, a3.y, a3.z, a3.w}; const float gk = P.in[5][2 * D + k];
#pragma unroll
        for (int jj = 0; jj < 8; ++jj) { const int j = jb * 8 + jj; float s = 0.f;
#pragma unroll
            for (int r = 0; r < 16; ++r) s += a[r] * P.in[9][r * 512 + j];
            WIN[(size_t)(3072 + j) * D + k] = f2bf(s * gk); } }
    }
    __syncthreads();
    }
    row_pass<3, 1>(P.in[0], P.in[1], (bf16_t*)(P.ws + WS_H), (float*)(P.ws + WS_SMALL) + SM_R2, nullptr, nullptr, 0.f, nullptr, nullptr, nullptr, nullptr, nullptr);
}

__device__ __forceinline__ void gla_cumsum(LAS float* BC, LAS float* TOT, const u32x4 (&lw)[2], int tid) {
#pragma unroll
    for (int i = 0; i < 2; ++i) { const int e = tid + 512 * i, t = e >> 4, d0 = (e & 15) * 8; const u32x4 w = lw[i];
        LAS float* b = BC + t * 128 + d0; b[0] = logf_gate(bflo(w.x)); b[1] = logf_gate(bfhi(w.x)); b[2] = logf_gate(bflo(w.y)); b[3] = logf_gate(bfhi(w.y));
        b[4] = logf_gate(bflo(w.z)); b[5] = logf_gate(bfhi(w.z)); b[6] = logf_gate(bflo(w.w)); b[7] = logf_gate(bfhi(w.w)); }
    __syncthreads();
    const int dk = tid & 127, seg = tid >> 7; float run = 0.f;
#pragma unroll
    for (int i = 0; i < 16; ++i) { const int t = seg * 16 + i; run += BC[t * 128 + dk]; BC[t * 128 + dk] = run; }
    TOT[seg * 128 + dk] = run;
    __syncthreads();
    float off = 0.f;
    for (int s = 0; s < seg; ++s) off += TOT[s * 128 + dk];
#pragma unroll
    for (int i = 0; i < 16; ++i) BC[(seg * 16 + i) * 128 + dk] += off;
    __syncthreads();
}
__device__ __forceinline__ void gla_load_vt(LAS bf16_t* VT, const u32x4 (&vw)[4], int tid) {
#pragma unroll
    for (int i = 0; i < 4; ++i) { const int e = tid + 512 * i, t = e >> 5, d0 = (e & 31) * 8; const u32x4 w = vw[i];
        LAS bf16_t* p = VT + d0 * 72 + ((((t >> 3) ^ ((d0 >> 3) & 7)) << 3) | (t & 7));
        p[0] = (bf16_t)(w.x & 0xffff); p[72] = (bf16_t)(w.x >> 16); p[144] = (bf16_t)(w.y & 0xffff); p[216] = (bf16_t)(w.y >> 16);
        p[288] = (bf16_t)(w.z & 0xffff); p[360] = (bf16_t)(w.z >> 16); p[432] = (bf16_t)(w.w & 0xffff); p[504] = (bf16_t)(w.w >> 16); }
}

__device__ __forceinline__ void gla_phase_a(const Params& P, LAS unsigned char* lds) {
    const int tid = otid(), lane = tid & 63, w = tid >> 6, l16 = lane & 15, q = lane >> 4;
    LAS float* BC = (LAS float*)lds; LAS float* TOT = (LAS float*)(lds + 32768);
    LAS bf16_t* KT = (LAS bf16_t*)(lds + 34816); LAS bf16_t* VT = (LAS bf16_t*)(lds + 53248);
    const bf16_t* QKV = (const bf16_t*)(P.ws + WS_QKV); bf16_t* KC = (bf16_t*)(P.ws + WS_KC); float* BEND = (float*)(P.ws + WS_BEND);
    for (int item = blockIdx.x; item < 1024; item += gridDim.x) {
        const int b = item >> 7, h = (item >> 5) & 3, c = item & 31; const size_t tok0 = (size_t)b * 2048 + c * 64;
        const bf16_t* base = QKV + tok0 * NIN;
        u32x4 lw[2], kw[2], vw[4];
#pragma unroll
        for (int i = 0; i < 2; ++i) { const int e = tid + 512 * i, t = e >> 4, d0 = (e & 15) * 8; lw[i] = *(const u32x4*)(base + (size_t)t * NIN + 3072 + h * 128 + d0); kw[i] = *(const u32x4*)(base + (size_t)t * NIN + 512 + h * 128 + d0); }
#pragma unroll
        for (int i = 0; i < 4; ++i) { const int e = tid + 512 * i, t = e >> 5, d0 = (e & 31) * 8; vw[i] = *(const u32x4*)(base + (size_t)t * NIN + 1024 + h * 256 + d0); }
        gla_cumsum(BC, TOT, lw, tid);
        if (tid < 128) BEND[item * 128 + tid] = BC[63 * 128 + tid];
#pragma unroll
        for (int i = 0; i < 2; ++i) { const int e = tid + 512 * i, t = e >> 4, d0 = (e & 15) * 8; const u32x4 wv = kw[i];
            float kv[8] = {bflo(wv.x), bfhi(wv.x), bflo(wv.y), bfhi(wv.y), bflo(wv.z), bfhi(wv.z), bflo(wv.w), bfhi(wv.w)};
#pragma unroll
            for (int j = 0; j < 8; ++j) KT[(d0 + j) * 72 + ((((t >> 3) ^ ((d0 >> 3) & 7)) << 3) | (t & 7))] = f2bf(kv[j] * __expf(BC[63 * 128 + d0 + j] - BC[t * 128 + d0 + j])); }
        gla_load_vt(VT, vw, tid);
        __syncthreads();
        f32x4 acc[8][2];
#pragma unroll
        for (int a = 0; a < 8; ++a) { acc[a][0] = (f32x4){0.f, 0.f, 0.f, 0.f}; acc[a][1] = acc[a][0]; }
#pragma unroll
        for (int kk = 0; kk < 2; ++kk) {
            bf16x8 vb[2];
#pragma unroll
            for (int d = 0; d < 2; ++d) vb[d] = *(const LAS bf16x8*)(VT + (16 * (2 * w + d) + l16) * 72 + (((kk * 4 + q) ^ ((2 * (2 * w + d) + (l16 >> 3)) & 7)) << 3));
#pragma unroll
            for (int a = 0; a < 8; ++a) { const bf16x8 ka = *(const LAS bf16x8*)(KT + (16 * a + l16) * 72 + (((kk * 4 + q) ^ ((2 * a + (l16 >> 3)) & 7)) << 3));
#pragma unroll
                for (int d = 0; d < 2; ++d) acc[a][d] = __builtin_amdgcn_mfma_f32_16x16x32_bf16(ka, vb[d], acc[a][d], 0, 0, 0); }
        }
#pragma unroll
        for (int a = 0; a < 8; ++a)
#pragma unroll
            for (int d = 0; d < 2; ++d) { u32x2 o; o.x = cvt_pk_bf16(acc[a][d][0], acc[a][d][1]); o.y = cvt_pk_bf16(acc[a][d][2], acc[a][d][3]);
                *(u32x2*)(KC + ((size_t)item * 256 + 16 * (2 * w + d) + l16) * 128 + 16 * a + 4 * q) = o; }
        __syncthreads();
    }
}
__device__ __forceinline__ void gla_phase_b(const Params& P) {
    bf16_t* KC = (bf16_t*)(P.ws + WS_KC); const float* BEND = (const float*)(P.ws + WS_BEND);
    const int tidb = otid();
    for (int idx = blockIdx.x * 512 + tidb; idx < 32 * 4096; idx += gridDim.x * 512) {
        const int bh = idx >> 12, e = idx & 4095, dv = e >> 4, dk0 = (e & 15) * 8;
        float S[8];
#pragma unroll
        for (int j = 0; j < 8; ++j) S[j] = 0.f;
#pragma unroll 8
        for (int c = 0; c < 32; ++c) { const int item = bh * 32 + c;
            u32x4* p = (u32x4*)(KC + ((size_t)item * 256 + dv) * 128 + dk0); const u32x4 kc = *p;
            const f32x4 e0 = *(const f32x4*)(BEND + item * 128 + dk0), e1 = *(const f32x4*)(BEND + item * 128 + dk0 + 4);
            u32x4 o; o.x = cvt_pk_bf16(S[0], S[1]); o.y = cvt_pk_bf16(S[2], S[3]); o.z = cvt_pk_bf16(S[4], S[5]); o.w = cvt_pk_bf16(S[6], S[7]); *p = o;
            S[0] = __expf(e0.x) * S[0] + bflo(kc.x); S[1] = __expf(e0.y) * S[1] + bfhi(kc.x); S[2] = __expf(e0.z) * S[2] + bflo(kc.y); S[3] = __expf(e0.w) * S[3] + bfhi(kc.y);
            S[4] = __expf(e1.x) * S[4] + bflo(kc.z); S[5] = __expf(e1.y) * S[5] + bfhi(kc.z); S[6] = __expf(e1.z) * S[6] + bflo(kc.w); S[7] = __expf(e1.w) * S[7] + bfhi(kc.w); }
        float* o = P.out + O_GP + (size_t)bh * 32768;
#pragma unroll
        for (int j = 0; j < 8; ++j) o[(dk0 + j) * 256 + dv] = S[j];
    }
}
__device__ __forceinline__ void gla_phase_c(const Params& P, LAS unsigned char* lds) {
    const int tid = otid(), lane = tid & 63, w = tid >> 6, l16 = lane & 15, q = lane >> 4;
    LAS float* BC = (LAS float*)lds; LAS float* TOT = (LAS float*)(lds + 32768); LAS float* PART = (LAS float*)(lds + 34816);
    LAS bf16_t* QT = (LAS bf16_t*)(lds + 36864); LAS bf16_t* KT = (LAS bf16_t*)(lds + 54272);
    LAS bf16_t* VT = (LAS bf16_t*)(lds + 71680); LAS bf16_t* ATT = (LAS bf16_t*)(lds + 108544);
    const bf16_t* QKV = (const bf16_t*)(P.ws + WS_QKV); const bf16_t* KC = (const bf16_t*)(P.ws + WS_KC); bf16_t* Oo = (bf16_t*)(P.ws + WS_O);
    const float* gon = P.in[11];
    for (int item = blockIdx.x; item < 1024; item += gridDim.x) {
        const int b = item >> 7, h = (item >> 5) & 3, c = item & 31; const size_t tok0 = (size_t)b * 2048 + c * 64;
        const bf16_t* base = QKV + tok0 * NIN;
        u32x4 lw[2], qw[2], kw[2], vw[4]; bf16x8 sfr[4][2]; u32x2 rw[4][2];
#pragma unroll
        for (int i = 0; i < 2; ++i) { const int e = tid + 512 * i, t = e >> 4, d0 = (e & 15) * 8; lw[i] = *(const u32x4*)(base + (size_t)t * NIN + 3072 + h * 128 + d0);
            qw[i] = *(const u32x4*)(base + (size_t)t * NIN + h * 128 + d0); kw[i] = *(const u32x4*)(base + (size_t)t * NIN + 512 + h * 128 + d0); }
#pragma unroll
        for (int i = 0; i < 4; ++i) { const int e = tid + 512 * i, t = e >> 5, d0 = (e & 31) * 8; vw[i] = *(const u32x4*)(base + (size_t)t * NIN + 1024 + h * 256 + d0); }
#pragma unroll
        for (int kk = 0; kk < 4; ++kk)
#pragma unroll
            for (int d = 0; d < 2; ++d) sfr[kk][d] = *(const bf16x8*)(KC + ((size_t)item * 256 + 16 * (2 * w + d) + l16) * 128 + kk * 32 + q * 8);
#pragma unroll
        for (int tm = 0; tm < 4; ++tm)
#pragma unroll
            for (int d = 0; d < 2; ++d) rw[tm][d] = *(const u32x2*)(QKV + (tok0 + 16 * tm + l16) * NIN + 2048 + h * 256 + 16 * (2 * w + d) + 4 * q);
        gla_cumsum(BC, TOT, lw, tid);
#pragma unroll
        for (int i = 0; i < 2; ++i) { const int e = tid + 512 * i, t = e >> 4, d0 = (e & 15) * 8;
            const u32x4 wq = qw[i], wk = kw[i];
            float qv[8] = {bflo(wq.x), bfhi(wq.x), bflo(wq.y), bfhi(wq.y), bflo(wq.z), bfhi(wq.z), bflo(wq.w), bfhi(wq.w)};
            float kv[8] = {bflo(wk.x), bfhi(wk.x), bflo(wk.y), bfhi(wk.y), bflo(wk.z), bfhi(wk.z), bflo(wk.w), bfhi(wk.w)};
            float eb[8];
#pragma unroll
            for (int j = 0; j < 8; ++j) { eb[j] = BC[t * 128 + d0 + j]; qv[j] *= __expf(eb[j]); kv[j] *= __expf(-eb[j]); }
            u32x4 oq, ok; oq.x = cvt_pk_bf16(qv[0], qv[1]); oq.y = cvt_pk_bf16(qv[2], qv[3]); oq.z = cvt_pk_bf16(qv[4], qv[5]); oq.w = cvt_pk_bf16(qv[6], qv[7]);
            ok.x = cvt_pk_bf16(kv[0], kv[1]); ok.y = cvt_pk_bf16(kv[2], kv[3]); ok.z = cvt_pk_bf16(kv[4], kv[5]); ok.w = cvt_pk_bf16(kv[6], kv[7]);
            *(LAS u32x4*)(QT + t * 136 + d0) = oq; *(LAS u32x4*)(KT + t * 136 + d0) = ok; }
        gla_load_vt(VT, vw, tid);
        __syncthreads();
        {
            const int tm = w >> 1;
#pragma unroll
            for (int d = 0; d < 2; ++d) { const int sn = 2 * (w & 1) + d; f32x4 a = (f32x4){0.f, 0.f, 0.f, 0.f};
                if (sn <= tm) {
#pragma unroll
                    for (int kk = 0; kk < 4; ++kk) { const bf16x8 kf = *(const LAS bf16x8*)(KT + (16 * sn + l16) * 136 + kk * 32 + q * 8);
                        const bf16x8 qf = *(const LAS bf16x8*)(QT + (16 * tm + l16) * 136 + kk * 32 + q * 8);
                        a = __builtin_amdgcn_mfma_f32_16x16x32_bf16(kf, qf, a, 0, 0, 0); }
                }
                const int t = 16 * tm + l16, s0 = 16 * sn + 4 * q;
#pragma unroll
                for (int i = 0; i < 4; ++i) if (s0 + i > t) a[i] = 0.f;
                u32x2 o; o.x = cvt_pk_bf16(a[0], a[1]); o.y = cvt_pk_bf16(a[2], a[3]);
                *(LAS u32x2*)(ATT + t * 72 + s0) = o; }
        }
        __syncthreads();
        f32x4 acc[2][4];
#pragma unroll
        for (int d = 0; d < 2; ++d)
#pragma unroll
            for (int tm = 0; tm < 4; ++tm) acc[d][tm] = (f32x4){0.f, 0.f, 0.f, 0.f};
#pragma unroll
        for (int kk = 0; kk < 2; ++kk) {
            bf16x8 vf[2], af[4];
#pragma unroll
            for (int d = 0; d < 2; ++d) vf[d] = *(const LAS bf16x8*)(VT + (16 * (2 * w + d) + l16) * 72 + (((kk * 4 + q) ^ ((2 * (2 * w + d) + (l16 >> 3)) & 7)) << 3));
#pragma unroll
            for (int tm = 0; tm < 4; ++tm) af[tm] = *(const LAS bf16x8*)(ATT + (16 * tm + l16) * 72 + kk * 32 + q * 8);
#pragma unroll
            for (int d = 0; d < 2; ++d)
#pragma unroll
                for (int tm = 0; tm < 4; ++tm) acc[d][tm] = __builtin_amdgcn_mfma_f32_16x16x32_bf16(vf[d], af[tm], acc[d][tm], 0, 0, 0);
        }
#pragma unroll
        for (int kk = 0; kk < 4; ++kk) {
            bf16x8 sf[2], qf[4];
#pragma unroll
            for (int d = 0; d < 2; ++d) sf[d] = sfr[kk][d];
#pragma unroll
            for (int tm = 0; tm < 4; ++tm) qf[tm] = *(const LAS bf16x8*)(QT + (16 * tm + l16) * 136 + kk * 32 + q * 8);
#pragma unroll
            for (int d = 0; d < 2; ++d)
#pragma unroll
                for (int tm = 0; tm < 4; ++tm) acc[d][tm] = __builtin_amdgcn_mfma_f32_16x16x32_bf16(sf[d], qf[tm], acc[d][tm], 0, 0, 0);
        }
#pragma unroll
        for (int tm = 0; tm < 4; ++tm) { float ss = 0.f;
#pragma unroll
            for (int d = 0; d < 2; ++d) ss += (acc[d][tm][0] * acc[d][tm][0] + acc[d][tm][1] * acc[d][tm][1]) + (acc[d][tm][2] * acc[d][tm][2] + acc[d][tm][3] * acc[d][tm][3]);
            ss += __shfl_xor(ss, 16); ss += __shfl_xor(ss, 32);
            if (q == 0) PART[w * 64 + 16 * tm + l16] = ss; }
        __syncthreads();
#pragma unroll
        for (int tm = 0; tm < 4; ++tm) { float tot = 0.f;
#pragma unroll
            for (int ww = 0; ww < 8; ++ww) tot += PART[ww * 64 + 16 * tm + l16];
            const float rs = rsqrtf(tot * (1.0f / 256.0f) + EPS); const size_t tok = tok0 + 16 * tm + l16;
#pragma unroll
            for (int d = 0; d < 2; ++d) { const int dv0 = 16 * (2 * w + d) + 4 * q; const f32x4 g = *(const f32x4*)(gon + dv0);
                const u32x2 rr = rw[tm][d];
                u32x2 o; o.x = cvt_pk_bf16(acc[d][tm][0] * rs * g.x * siluf_(bflo(rr.x)), acc[d][tm][1] * rs * g.y * siluf_(bfhi(rr.x)));
                o.y = cvt_pk_bf16(acc[d][tm][2] * rs * g.z * siluf_(bflo(rr.y)), acc[d][tm][3] * rs * g.w * siluf_(bfhi(rr.y)));
                *(u32x2*)(Oo + tok * D + h * 256 + dv0) = o; } }
        __syncthreads();
    }
    LAS float* SQ = (LAS float*)lds; LAS float* SK = SQ + 512; LAS float* SE = SK + 512; LAS float* OS = SE + 512;   LAS float* WP = OS + 2048;
    for (int item = blockIdx.x; item < 512; item += gridDim.x) {
        const int b = item >> 2, h = item & 3; const size_t row0 = (size_t)MP + b * 4;
        { const int t = tid >> 7, dk = tid & 127; const bf16_t* r = QKV + (row0 + t) * NIN;
            SQ[tid] = bf2f(r[h * 128 + dk]); SK[tid] = bf2f(r[512 + h * 128 + dk]); SE[tid] = __expf(logf_gate(bf2f(r[3072 + h * 128 + dk]))); }
        __syncthreads();
        const int dv = tid & 255, half = tid >> 8;
        const float* s0 = P.in[2] + ((size_t)item * 128 + half * 64) * 256 + dv;
        float S[64];
#pragma unroll
        for (int i = 0; i < 64; ++i) S[i] = s0[i * 256];
        float vv[4];
#pragma unroll
        for (int t = 0; t < 4; ++t) vv[t] = bf2f(QKV[(row0 + t) * NIN + 1024 + h * 256 + dv]);
#pragma unroll
        for (int t = 0; t < 4; ++t) { float op = 0.f;
#pragma unroll
            for (int i = 0; i < 64; ++i) { const int dk = half * 64 + i; S[i] = SE[t * 128 + dk] * S[i] + SK[t * 128 + dk] * vv[t]; op += SQ[t * 128 + dk] * S[i]; }
            OS[(half * 4 + t) * 256 + dv] = op; }
        float* so = P.out + O_GS + ((size_t)item * 128 + half * 64) * 256 + dv;
#pragma unroll
        for (int i = 0; i < 64; ++i) so[i * 256] = S[i];
        __syncthreads();
        float o4[4];
#pragma unroll
        for (int t = 0; t < 4; ++t) { o4[t] = OS[t * 256 + dv] + OS[(4 + t) * 256 + dv]; const float s = wave_sum(o4[t] * o4[t]); if (tid < 256 && lane == 0) WP[w * 4 + t] = s; }
        __syncthreads();
        if (tid < 256) {
#pragma unroll
            for (int t = 0; t < 4; ++t) { const float tot = WP[t] + WP[4 + t] + WP[8 + t] + WP[12 + t]; const float rs = rsqrtf(tot * (1.0f / 256.0f) + EPS);
                const float r = bf2f(QKV[(row0 + t) * NIN + 2048 + h * 256 + dv]);
                Oo[(row0 + t) * D + h * 256 + dv] = f2bf(o4[t] * rs * gon[dv] * siluf_(r)); }
        }
        __syncthreads();
    }
}

__device__ __forceinline__ void s5_prefix_and_sample(const Params& P, LAS unsigned char* lds) {
    const int tid = otid(); const int lane = tid & 63, w = tid >> 6, gw = blockIdx.x * 8 + w, NGW = gridDim.x * 8;
    const float* sm = (const float*)(P.ws + WS_SMALL); const float* HL = (const float*)(P.ws + WS_HLOC); bf16_t* HS5 = (bf16_t*)(P.ws + WS_HS5);
    LAS float* TOT = (LAS float*)lds;
    for (int L = blockIdx.x; L < 256; L += gridDim.x) {
        int g, mt; { const int xcd = L & 7, idx = L >> 3, combo = xcd * 8 + (idx >> 2); g = (combo >> 2) * 4 + (idx & 3); mt = combo & 3; }
        const char* Aop = (const char*)(P.ws + WS_HS5) + (size_t)g * (1024 * 384 * 2) + (size_t)mt * (BM * 384 * 2);
        { OneUnit S1{{Aop, (const char*)(P.ws + WS_S5M) + (size_t)g * 262144, mt, g, 4, -1}}; EpiS5A E1{(float*)(P.ws + WS_HLOC)}; gemm_phase(lds, 384, 256, S1, E1); }
        asm volatile("s_waitcnt vmcnt(0)" ::: "memory"); __syncthreads();
        {
        const int seg = w & 3, b = 2 * mt + (w >> 2);
        const float ar = sm[SM_A16R + g * 64 + lane], ai = sm[SM_A16I + g * 64 + lane];
        const size_t col0 = (size_t)g * 1024 + b * 128 + seg * 32;
        float lr[32], li[32];
#pragma unroll
        for (int c = 0; c < 32; ++c) { lr[c] = HL[(col0 + c) * 128 + lane]; li[c] = HL[(col0 + c) * 128 + 64 + lane]; }
        float hr = 0.f, hi = 0.f;
#pragma unroll
        for (int c = 0; c < 32; ++c) { const float tr = lr[c], ti = li[c]; lr[c] = hr; li[c] = hi; const float nr = ar * hr - ai * hi + tr, ni = ar * hi + ai * hr + ti; hr = nr; hi = ni; }
        TOT[(w * 2 + 0) * 64 + lane] = hr; TOT[(w * 2 + 1) * 64 + lane] = hi;
        __syncthreads();
        float a32r = ar, a32i = ai;
#pragma unroll
        for (int k = 0; k < 5; ++k) { const float nr = a32r * a32r - a32i * a32i, ni = 2.f * a32r * a32i; a32r = nr; a32i = ni; }
        float cr = 0.f, ci = 0.f;
        for (int s = 0; s < seg; ++s) { const int ws_ = (w & 4) + s; const float tr = TOT[(ws_ * 2 + 0) * 64 + lane], ti = TOT[(ws_ * 2 + 1) * 64 + lane];
            const float nr = a32r * cr - a32i * ci + tr, ni = a32r * ci + a32i * cr + ti; cr = nr; ci = ni; }
        float pr_ = cr, pi_ = ci;
#pragma unroll
        for (int c = 0; c < 32; ++c) { HS5[(col0 + c) * 384 + 256 + lane] = f2bf(lr[c] + pr_); HS5[(col0 + c) * 384 + 320 + lane] = f2bf(li[c] + pi_);
            const float nr = ar * pr_ - ai * pi_, ni = ar * pi_ + ai * pr_; pr_ = nr; pi_ = ni; }
        if (seg == 3) { P.out[O_RP + (size_t)b * 4096 + g * 64 + lane] = hr + pr_; P.out[O_IP + (size_t)b * 4096 + g * 64 + lane] = hi + pi_; }
        }
        asm volatile("s_waitcnt vmcnt(0)" ::: "memory"); __syncthreads();
        { OneUnit S2{{Aop, (const char*)(P.ws + WS_S5M + 65536) + (size_t)g * 262144, mt, g, 6, -1}}; EpiS5B E2{P.ws, P.in[20]}; gemm_phase(lds, 384, 384, S2, E2); }
        __syncthreads();
    }
    const bf16_t* HSMP = (const bf16_t*)(P.ws + WS_HSMP); bf16_t* Z = (bf16_t*)(P.ws + WS_Z);
    LAS float* cb_ = (LAS float*)(lds + 4096 + w * 10752);
    LAS float* hb = cb_ + 2 * 16 * 68;
    for (int wv = gw; wv < 64 * 32; wv += NGW) {
        const int g = wv & 63, b0 = (wv >> 6) * 4, p = lane;
        const float ar = sm[SM_ARE + g * 64 + p], ai = sm[SM_AIM + g * 64 + p], fr = sm[SM_FRE + g * 64 + p], fi = sm[SM_FIM + g * 64 + p];
        f32x4 brv[4], biv[4], crv[4], civ[4];
#pragma unroll
        for (int c4 = 0; c4 < 4; ++c4) { brv[c4] = *(const f32x4*)(P.in[16] + ((size_t)g * 64 + p) * 16 + 4 * c4); biv[c4] = *(const f32x4*)(P.in[17] + ((size_t)g * 64 + p) * 16 + 4 * c4);
            crv[c4] = *(const f32x4*)(P.in[18] + (size_t)g * 1024 + (lane + 64 * c4) * 4); civ[c4] = *(const f32x4*)(P.in[19] + (size_t)g * 1024 + (lane + 64 * c4) * 4); }
        const int t = lane >> 4, cp = lane & 15; const float dsk = P.in[20][g * 16 + cp];
        float bbr[16], bbi[16];
#pragma unroll
        for (int c4 = 0; c4 < 4; ++c4) {
#pragma unroll
            for (int j = 0; j < 4; ++j) { bbr[4 * c4 + j] = fr * brv[c4][j] - fi * biv[c4][j]; bbi[4 * c4 + j] = fr * biv[c4][j] + fi * brv[c4][j]; }
            const int f = lane + 64 * c4, row = f >> 4, col = (f & 15) * 4;
            *(LAS f32x4*)(cb_ + row * 68 + col) = crv[c4]; *(LAS f32x4*)(cb_ + 16 * 68 + row * 68 + col) = civ[c4]; }
#pragma unroll 1
        for (int bb = 0; bb < 4; ++bb) { const int b = b0 + bb;
            u32x4 ua[4], ub[4];
#pragma unroll
            for (int tt = 0; tt < 4; ++tt) { ua[tt] = *(const u32x4*)(HSMP + (size_t)(b * 4 + tt) * D + g * 16); ub[tt] = *(const u32x4*)(HSMP + (size_t)(b * 4 + tt) * D + g * 16 + 8); }
            float hr = P.in[3][(size_t)b * 4096 + g * 64 + p], hi = P.in[4][(size_t)b * 4096 + g * 64 + p];
            const size_t row = (size_t)b * 4 + t; const float uu = bf2f(HSMP[row * D + g * 16 + cp]);
#pragma unroll
            for (int tt = 0; tt < 4; ++tt) { const u32x4 u0 = ua[tt], u1 = ub[tt];
                const float u[16] = {bflo(u0.x), bfhi(u0.x), bflo(u0.y), bfhi(u0.y), bflo(u0.z), bfhi(u0.z), bflo(u0.w), bfhi(u0.w),
                                     bflo(u1.x), bfhi(u1.x), bflo(u1.y), bfhi(u1.y), bflo(u1.z), bfhi(u1.z), bflo(u1.w), bfhi(u1.w)};
                float br = 0.f, bi = 0.f;
#pragma unroll
                for (int c = 0; c < 16; ++c) { br += bbr[c] * u[c]; bi += bbi[c] * u[c]; }
                const float nr = ar * hr - ai * hi + br, ni = ar * hi + ai * hr + bi; hr = nr; hi = ni;
                hb[(tt * 2 + 0) * 64 + p] = hr; hb[(tt * 2 + 1) * 64 + p] = hi; }
            P.out[O_RS + (size_t)b * 4096 + g * 64 + p] = hr; P.out[O_IS + (size_t)b * 4096 + g * 64 + p] = hi;
            asm volatile("s_waitcnt lgkmcnt(0)" ::: "memory");
            float y = 0.f;
#pragma unroll
            for (int i = 0; i < 16; ++i) { const f32x4 c4r = *(const LAS f32x4*)(cb_ + cp * 68 + 4 * i), c4i = *(const LAS f32x4*)(cb_ + 16 * 68 + cp * 68 + 4 * i);
                const f32x4 h4r = *(const LAS f32x4*)(hb + (t * 2 + 0) * 64 + 4 * i), h4i = *(const LAS f32x4*)(hb + (t * 2 + 1) * 64 + 4 * i);
                y += (c4r.x * h4r.x - c4i.x * h4i.x) + (c4r.y * h4r.y - c4i.y * h4i.y) + (c4r.z * h4r.z - c4i.z * h4i.z) + (c4r.w * h4r.w - c4i.w * h4i.w); }
            Z[((size_t)MP + row) * D + g * 16 + cp] = f2bf(y + dsk * uu);
            asm volatile("s_waitcnt lgkmcnt(0)" ::: "memory");
        }
    }
}

#define XB_TMO      128
#define XB_XCNT(j)  (256  + 64 * (j))
#define XB_XSUB(j)  (1280 + 64 * (j))
#define XB_XGEN(j)  (2304 + 64 * (j))
#define XB_TOP      3328
#define XB_TOPGEN   3392
#define XCD_BAR_WORDS 3456
#define XB_SPIN_CAP (1u << 22)
__device__ __forceinline__ unsigned xb_ld(unsigned* p)              { return __hip_atomic_load(p, __ATOMIC_RELAXED, __HIP_MEMORY_SCOPE_AGENT); }
__device__ __forceinline__ unsigned xb_add(unsigned* p, unsigned v) { return __hip_atomic_fetch_add(p, v, __ATOMIC_RELAXED, __HIP_MEMORY_SCOPE_AGENT); }
__device__ __forceinline__ unsigned xb_xcc_id() { return (unsigned)__builtin_amdgcn_s_getreg((3 << 11) | 20) & 0xFu; }
#define XB_SPIN(cond, bar) do { unsigned _sp = 0; while (cond) { __builtin_amdgcn_s_sleep(1); \
    if ((++_sp & 255u) == 0u) { if (xb_ld(&(bar)[XB_TMO])) break; if (_sp > XB_SPIN_CAP) { atomicAdd(&(bar)[XB_TMO], 1u); break; } } } } while (0)
struct XcdBarrier { unsigned* bar; unsigned x; volatile LAS unsigned* st; };
__device__ __forceinline__ XcdBarrier xcd_barrier_post(unsigned* bar, volatile LAS unsigned* st) {
    XcdBarrier b; b.bar = bar; b.x = xb_xcc_id(); b.st = st;
    if (threadIdx.x == 0) (void)xb_add(&bar[XB_XCNT(b.x)], 1u);
    return b;
}
__device__ __forceinline__ void xcd_barrier_complete(unsigned* bar, unsigned x, unsigned& nloc, unsigned& nx) {
    const unsigned G = gridDim.x * gridDim.y * gridDim.z;
    unsigned sum, cnt, mine, sp = 0u;
    for (;;) {
        sum = 0u; cnt = 0u; mine = 0u;
#pragma unroll
        for (unsigned j = 0; j < 16; ++j) { const unsigned c = xb_ld(&bar[XB_XCNT(j)]); sum += c; cnt += (c > 0u) ? 1u : 0u; mine = (j == x) ? c : mine; }
        if (sum == G) break;
        __builtin_amdgcn_s_sleep(1);
        if ((++sp & 255u) == 0u) { if (xb_ld(&bar[XB_TMO])) break; if (sp > XB_SPIN_CAP) { atomicAdd(&bar[XB_TMO], 1u); break; } }
    }
    nloc = mine > 0u ? mine : 1u; nx = cnt > 0u ? cnt : 1u;
}
__device__ __forceinline__ void xcd_barrier(const XcdBarrier& b) {
    asm volatile("s_waitcnt vmcnt(0)" ::: "memory");
    __syncthreads();
    if (threadIdx.x == 0) {
        unsigned* bar = b.bar;
        __builtin_amdgcn_s_waitcnt(0);
        unsigned nloc = b.st[0], nx = b.st[1];
        if (nloc == 0u) { xcd_barrier_complete(bar, b.x, nloc, nx); b.st[0] = nloc; b.st[1] = nx; }
        const unsigned old = xb_add(&bar[XB_XSUB(b.x)], 1u);
        const unsigned gen = old / nloc;
        if (old + 1u == (gen + 1u) * nloc) {
            __builtin_amdgcn_fence(__ATOMIC_RELEASE, "agent");
            asm volatile("s_waitcnt vmcnt(0)" ::: "memory");
            const unsigned og = xb_add(&bar[XB_TOP], 1u);
            const unsigned tg = og / nx;
            if (og + 1u == (tg + 1u) * nx) xb_add(&bar[XB_TOPGEN], 1u);
            else XB_SPIN(xb_ld(&bar[XB_TOPGEN]) == tg, bar);
            __builtin_amdgcn_fence(__ATOMIC_ACQUIRE, "agent");
            xb_add(&bar[XB_XGEN(b.x)], 1u);
            asm volatile("s_waitcnt vmcnt(0)" ::: "memory");
        } else {
            XB_SPIN(xb_ld(&bar[XB_XGEN(b.x)]) == gen, bar);
            __builtin_amdgcn_fence(__ATOMIC_ACQUIRE, "agent");
            asm volatile("s_waitcnt vmcnt(0)" ::: "memory");
        }
    }
    __syncthreads();
}

__global__ void __launch_bounds__(512, 2) fwd_kernel(Params P) {
    extern __shared__ __attribute__((aligned(16))) unsigned char lds_raw[];
    LAS unsigned char* lds = (LAS unsigned char*)lds_raw;
    cg::grid_group grid = cg::this_grid();
    const int lo = P.ph_lo, hi = P.ph_hi; int ph = 0;
    const int G = gridDim.x, cb = blockIdx.x;
    unsigned char* ws = P.ws;
    bf16_t* XB = (bf16_t*)(ws + WS_H); bf16_t* ACT = (bf16_t*)(ws + WS_ACT); bf16_t* Y = (bf16_t*)(ws + WS_Y);
    float* R2 = (float*)(ws + WS_SMALL) + SM_R2;
    unsigned long long pr_acc = 0ull, pr_t0 = 0ull;
#define PH_BEGIN if (PROBE_MASK) pr_t0 = __builtin_amdgcn_s_memrealtime(); if (lo <= ph && ph < hi) {
#define PH_END } ++ph; if (lo < ph && ph < hi) xcd_barrier(xbar); \
    if (PROBE_MASK && ((PROBE_MASK >> (ph - 1)) & 1u)) pr_acc += __builtin_amdgcn_s_memrealtime() - pr_t0;
    volatile LAS unsigned* xst = (volatile LAS unsigned*)(lds + LDS_BYTES - 64);
    if (threadIdx.x < 2) xst[threadIdx.x] = 0u;
    __syncthreads();
    if (ws == nullptr) grid.sync();
    XcdBarrier xbar; xbar.bar = (unsigned*)ws; xbar.x = 0; xbar.st = xst;
    if (hi - lo > 1) xbar = xcd_barrier_post((unsigned*)ws, xst);

    PH_BEGIN phase0(P, lds); PH_END

#define MIXER_GLA \
    PH_BEGIN { TileOrder S{M / BM, NIN / BM, (M / BM) * (NIN / BM), G, cb, (const char*)XB, (const char*)(ws + WS_WIN), (size_t)BM * D * 2, (size_t)BM * D * 2, D / BK}; \
        EpiPlain<1> E{(bf16_t*)(ws + WS_QKV), NIN, P.in[10], nullptr, R2}; gemm_phase(lds, D, D, S, E); } s5_idle_prep_inproj(P, lds); PH_END \
    PH_BEGIN gla_phase_a(P, lds); PH_END \
    PH_BEGIN gla_phase_b(P); PH_END \
    PH_BEGIN gla_phase_c(P, lds); PH_END \
    PH_BEGIN { SplitOrder S{{MP / BM, D / BM, (MP / BM) * (D / BM), G, cb, (const char*)(ws + WS_O), (const char*)(ws + WS_WOUT), (size_t)BM * D * 2, (size_t)BM * D * 2, D / BK}, D / 256}; \
        EpiPlain<0> E{Y, D, nullptr, PART, nullptr}; gemm_phase(lds, D, D, S, E); } PH_END
#define MIXER_S5 \
    PH_BEGIN s5_prefix_and_sample(P, lds); PH_END \
    PH_BEGIN { SplitOrder S{{MP / BM, 2 * D / BM, (MP / BM) * (2 * D / BM), G, cb, (const char*)(ws + WS_Z), (const char*)(ws + WS_WGLU), (size_t)BM * D * 2, (size_t)BM * D * 2, D / BK}, D / 256}; \
        EpiGated<1> E{Y, D, P.in[22], (float*)(ws + WS_HLOC)}; gemm_phase(lds, D, D, S, E); } PH_END
#define FFN_GEMMS(l, f, HOOK) \
    PH_BEGIN { TileOrder S{M / BM, NGU / BM, (M / BM) * (NGU / BM), G, cb, (const char*)XB, (const char*)(ws + WS_WGU + (size_t)((l) * 2 + (f)) * NGU * D * 2), (size_t)BM * D * 2, (size_t)BM * D * 2, D / BK}; \
        EpiGated<0> E{ACT, FF, nullptr, nullptr}; gemm_phase(lds, D, D, S, E); } HOOK PH_END \
    PH_BEGIN { SplitOrder S{{MP / BM, D / BM, (MP / BM) * (D / BM), G, cb, (const char*)ACT, (const char*)(ws + WS_WDN + (size_t)((l) * 2 + (f)) * D * FF * 2), (size_t)BM * FF * 2, (size_t)BM * FF * 2, FF / BK}, FF / 256}; \
        EpiPlain<0> E{Y, D, nullptr, PART, nullptr}; gemm_phase(lds, FF, FF, S, E); } PH_END
    const float* ng0 = P.in[5]; const float* ng1 = P.in[5] + 6 * D;
    float* PART = (float*)(ws + WS_PART);
    FFN_GEMMS(0, 0, s5_idle_prep(P, lds, 0);)
    PH_BEGIN row_pass<3, FF / 256>(P.in[0], P.in[1], XB, R2, Y, ng0 + 1 * D, 0.5f, PART, nullptr, nullptr, nullptr, nullptr); PH_END
    MIXER_GLA
    PH_BEGIN row_pass<3, D / 256>(nullptr, nullptr, XB, R2, Y, ng0 + 3 * D, 1.0f, PART, nullptr, nullptr, nullptr, nullptr); PH_END
    FFN_GEMMS(0, 1, s5_idle_prep(P, lds, 1);)
    PH_BEGIN row_pass<3, FF / 256>(nullptr, nullptr, XB, R2, Y, ng0 + 5 * D, 0.5f, PART, nullptr, nullptr, nullptr, nullptr); PH_END
    FFN_GEMMS(1, 0, s5_idle_prep(P, lds, 2);)
    PH_BEGIN row_pass<3, FF / 256>(nullptr, nullptr, XB, R2, Y, ng1 + 1 * D, 0.5f, PART, nullptr, ng1 + 2 * D, (bf16_t*)(ws + WS_HS5), (bf16_t*)(ws + WS_HSMP)); PH_END
    MIXER_S5
    PH_BEGIN row_pass<3, D / 256>(nullptr, nullptr, XB, R2, Y, ng1 + 3 * D, 1.0f, (const float*)(ws + WS_HLOC), nullptr, nullptr, nullptr, nullptr, P.in[22]); PH_END
    FFN_GEMMS(1, 1, )
    PH_BEGIN row_pass<2, FF / 256>(nullptr, nullptr, XB, R2, Y, ng1 + 5 * D, 0.5f, PART, P.out + O_X, nullptr, nullptr, nullptr); PH_END
    if (PROBE_MASK && blockIdx.x == 0 && threadIdx.x == 0) { const unsigned long long t1 = __builtin_amdgcn_s_memrealtime(); while (__builtin_amdgcn_s_memrealtime() - t1 < pr_acc) __builtin_amdgcn_s_sleep(8); }
#undef PH_BEGIN
#undef PH_END
}

__global__ void dbg_checksum(const unsigned* w, size_t nwords, float* out, size_t nout) {
    for (size_t i = (size_t)blockIdx.x * blockDim.x + threadIdx.x; i < nout; i += (size_t)gridDim.x * blockDim.x) {
        unsigned h = 0; for (int j = 0; j < 3; ++j) { const size_t k = 3 * i + j; if (k < nwords) h = h * 0x9E3779B1u + w[k]; }
        out[i] = (float)(h & 0xffffu);
    }
}
extern "C" void kernel_launch(void* const* d_in, const int* in_sizes, int n_in, void* d_out, int out_size, void* d_ws, size_t ws_size, hipStream_t stream) {
    static int grid = 0;
    if (grid == 0) {
        if (n_in != 23 || ws_size < WS_END) { fprintf(stderr, "kernel_launch: unexpected n_in %d or ws_size %zu (< %zu)\n", n_in, ws_size, (size_t)WS_END); grid = -1; return; }
        int dev = 0, cus = 0, per_cu = 0;
        hipGetDevice(&dev); hipDeviceGetAttribute(&cus, hipDeviceAttributeMultiprocessorCount, dev);
        if (hipFuncSetAttribute((const void*)fwd_kernel, hipFuncAttributeMaxDynamicSharedMemorySize, LDS_BYTES) != hipSuccess) { fprintf(stderr, "kernel_launch: hipFuncSetAttribute failed\n"); grid = -1; return; }
        if (hipOccupancyMaxActiveBlocksPerMultiprocessor(&per_cu, (const void*)fwd_kernel, 512, LDS_BYTES) != hipSuccess || per_cu < 1) { fprintf(stderr, "kernel_launch: occupancy query failed (%d)\n", per_cu); grid = -1; return; }
        grid = cus * per_cu;
    }
    if (grid < 0) return;
    if (hipMemsetAsync(d_ws, 0, 16384, stream) != hipSuccess) { fprintf(stderr, "kernel_launch: memset failed\n"); return; }
    Params p{};
    for (int i = 0; i < 23; ++i) p.in[i] = (const float*)d_in[i];
    p.out = (float*)d_out; p.ws = (unsigned char*)d_ws;
#if MULTI_LAUNCH
    for (int k = 0; k < (DBG_NPH ? DBG_NPH : NPH); ++k) { p.ph_lo = k; p.ph_hi = k + 1; hipLaunchKernelGGL(fwd_kernel, dim3(grid), dim3(512), LDS_BYTES, stream, p); }
#if DBG_NPH
    hipLaunchKernelGGL(dbg_checksum, dim3(2048), dim3(256), 0, stream, (const unsigned*)d_ws, (size_t)(WS_END / 4), (float*)d_out, (size_t)out_size);
#endif
#else
    p.ph_lo = 0; p.ph_hi = NPH;
    void* args[] = {&p};
    hipError_t e = hipLaunchCooperativeKernel((const void*)fwd_kernel, dim3(grid), dim3(512), args, LDS_BYTES, stream);
    if (e != hipSuccess) fprintf(stderr, "cooperative launch failed: %s (grid %d)\n", hipGetErrorString(e), grid);
#endif
}
```

```cpp
#include <hip/hip_runtime.h>
#include <hip/hip_cooperative_groups.h>
#include <cstdio>
namespace cg = cooperative_groups;

#ifndef MULTI_LAUNCH
#define MULTI_LAUNCH 0
#endif

#ifndef PROBE_MASK
#define PROBE_MASK 0u
#endif
#ifndef DBG_NPH
#define DBG_NPH 0
#endif
#define LAS __attribute__((address_space(3)))
typedef unsigned short bf16_t;
typedef short bf16x8 __attribute__((ext_vector_type(8)));
typedef float f32x4 __attribute__((ext_vector_type(4)));
typedef unsigned u32x4 __attribute__((ext_vector_type(4)));
typedef unsigned u32x2 __attribute__((ext_vector_type(2)));

constexpr int D = 1024, FF = 2816, NGU = 5632, MP = 16384, MS = 512, M = MP + MS;
constexpr int NIN = 3584;
constexpr int LDIN = 3088;
constexpr float EPS = 1e-6f;
constexpr int NPH = 22;

constexpr size_t O_X = 0, O_GP = 17301504, O_RP = 18350080, O_IP = 18382848, O_GS = 18415616, O_RS = 35192832, O_IS = 35717120;

constexpr size_t MiB = 1u << 20;
constexpr size_t WS_WGU = 1 * MiB;
constexpr size_t WS_WDN = WS_WGU + 44 * MiB;
constexpr size_t WS_WIN = WS_WDN + 22 * MiB;
constexpr size_t WS_WOUT = WS_WIN + 7 * MiB;
constexpr size_t WS_WGLU = WS_WOUT + 2 * MiB;
constexpr size_t WS_S5M = WS_WGLU + 4 * MiB;
constexpr size_t WS_SMALL = WS_S5M + 16 * MiB;
constexpr size_t WS_HSMP = WS_SMALL + 1 * MiB;
constexpr size_t WS_H = WS_SMALL + 2 * MiB;
constexpr size_t WS_BIG = WS_H + 33 * MiB;
constexpr size_t WS_ACT = WS_BIG;
constexpr size_t WS_Y = WS_BIG + 92 * MiB;
constexpr size_t WS_QKV = WS_BIG;
constexpr size_t WS_KC = WS_BIG + 116 * MiB;
constexpr size_t WS_BEND = WS_BIG + 180 * MiB;
constexpr size_t WS_HS5 = WS_BIG;
constexpr size_t WS_HLOC = WS_BIG + 48 * MiB;
constexpr size_t WS_Z = WS_BIG + 128 * MiB;
constexpr size_t WS_PART = WS_BIG + 128 * MiB;
constexpr size_t WS_O = WS_BIG + 181 * MiB;
constexpr size_t WS_END = WS_BIG + 214 * MiB;
constexpr size_t S5M_G = 262144;
constexpr int SM_R2 = 32768;
constexpr int SM_ARE = 0, SM_AIM = 4096, SM_FRE = 8192, SM_FIM = 12288, SM_A16R = 16384, SM_A16I = 20480;

constexpr int LDS_BYTES = 147456;

typedef __bf16 bf16x2_t __attribute__((ext_vector_type(2)));
typedef float f32x2_t __attribute__((ext_vector_type(2)));
__device__ __forceinline__ unsigned cvt_pk_bf16(float lo, float hi) { const f32x2_t v = {lo, hi}; const bf16x2_t b = __builtin_convertvector(v, bf16x2_t); return __builtin_bit_cast(unsigned, b); }
__device__ __forceinline__ float bflo(unsigned w) { return __uint_as_float(w << 16); }
__device__ __forceinline__ float bfhi(unsigned w) { return __uint_as_float(w & 0xffff0000u); }
__device__ __forceinline__ float bf2f(bf16_t b) { return __uint_as_float(((unsigned)b) << 16); }
__device__ __forceinline__ bf16_t f2bf(float f) { return (bf16_t)(cvt_pk_bf16(f, 0.f) & 0xffffu); }
__device__ __forceinline__ float wave_sum(float v) {
#pragma unroll
    for (int o = 1; o < 64; o <<= 1) v += __shfl_xor(v, o);
    return v;
}
__device__ __forceinline__ int otid() { int t = threadIdx.x; asm volatile("" : "+v"(t)); return t; }
__device__ __forceinline__ float sigmoidf_(float a) { return __builtin_amdgcn_rcpf(1.0f + __expf(-a)); }
__device__ __forceinline__ float siluf_(float a) { return a * sigmoidf_(a); }
__device__ __forceinline__ float logf_gate(float z) { return (fminf(z, 0.f) - __logf(1.0f + __expf(-fabsf(z)))) * 0.0625f; }

constexpr int BM = 256, BK = 64, HALF = 128, HTB = HALF * BK * 2;
__device__ __forceinline__ int lds_byte(int r, int c) { const int st = (r >> 4) * 2 + (c >> 5), rr = r & 15, cc = c & 31, ob = rr * 64 + cc * 2; return st * 1024 + (ob ^ (((ob >> 9) & 1) << 5)); }
__device__ __forceinline__ void stage_rc(int b, int& R, int& C) { const int st = b / 1024, sb = b % 1024, swz = sb ^ (((sb >> 9) & 1) << 5); R = (st >> 1) * 16 + swz / 64; C = (st & 1) * 32 + (swz % 64) / 2; }
__device__ __forceinline__ int perm32(int rho) { const int n = rho >> 4, i = rho & 15; return 8 * (i >> 2) + 4 * n + (i & 3); }

struct Unit { const char* A; const char* B; int pm, pn, nt, ks; };

struct TileOrder {
    int nM, nN, nwg, G, c; const char* A0; const char* B0; size_t at, bt; int ntk;
    __device__ __forceinline__ bool next(int i, Unit& u) const {
        const long L = (long)i * G + c; if (L >= nwg) return false;
        u.nt = ntk; u.ks = -1;
        int wgid = (int)L; { const int q = nwg / 8, r = nwg % 8, xcd = wgid % 8, off = wgid / 8; wgid = (xcd < r ? xcd * (q + 1) : r * (q + 1) + (xcd - r) * q) + off; }
        const int nig = 8 * nN, gid = wgid / nig, fm = gid * 8, gsz = (nM - fm) < 8 ? (nM - fm) : 8;
        u.pm = fm + ((wgid % nig) % gsz); u.pn = (wgid % nig) / gsz;
        u.A = A0 + (size_t)u.pm * at; u.B = B0 + (size_t)u.pn * bt; return true;
    }
};
struct SplitOrder {
    TileOrder T; int nks;
    __device__ __forceinline__ bool next(int i, Unit& u) const {
        const int L = i * T.G + T.c;
        if (L < T.nwg) return T.next(i, u);
        const int j = L - T.nwg, ns = 2 * T.nN; if (j >= ns * nks) return false;
        const int st = j % ns, ks = j / ns; u.pm = 64 + st / T.nN; u.pn = st % T.nN; u.nt = 4; u.ks = ks;
        u.A = T.A0 + (size_t)u.pm * T.at + (size_t)ks * 512; u.B = T.B0 + (size_t)u.pn * T.bt + (size_t)ks * 512; return true;
    }
};
struct OneUnit { Unit u; __device__ __forceinline__ bool next(int i, Unit& o) const { if (i) return false; o = u; return true; } };
struct S5Order {
    int G, c; const char* A0; const char* B0; int ntk;
    __device__ __forceinline__ bool next(int i, Unit& u) const {
        const int L = i * G + c; if (L >= 256) return false;
        u.nt = ntk; u.ks = -1;
        { const int xcd = L & 7, idx = L >> 3, combo = xcd * 8 + (idx >> 2); u.pn = (combo >> 2) * 4 + (idx & 3); u.pm = combo & 3; }
        u.A = A0 + (size_t)u.pn * (1024 * 384 * 2) + (size_t)u.pm * (BM * 384 * 2); u.B = B0 + (size_t)u.pn * 262144; return true;
    }
};

template <class Epi, class Sched>
__device__ __forceinline__ void gemm_phase(LAS unsigned char* lds, const int lda, const int ldb, const Sched& S, const Epi& E) {
    int tid_ = threadIdx.x; asm volatile("" : "+v"(tid_));
    const int tid = tid_, wid = __builtin_amdgcn_readfirstlane(tid >> 6), lane = tid & 63, wr = wid >> 2, wc = wid & 3, fr = lane & 15, fq = lane >> 4;
    unsigned voffA[2], voffB[2];
#pragma unroll
    for (int i = 0; i < 2; ++i) { int R, C; stage_rc(tid * 16 + i * 8192, R, C); const int Rb = (R & ~31) + perm32(R & 31);
        voffA[i] = (unsigned)(R * lda + C) * 2u; voffB[i] = (unsigned)(Rb * ldb + C) * 2u; }
    const size_t kstep = (size_t)(BK * 2);
    const size_t hstepA = (size_t)HALF * lda * 2, hstepB = (size_t)HALF * ldb * 2;
    const unsigned ldsw = (unsigned)wid * 1024u;
    const int aoff = lds_byte(wr * 64 + fr, fq * 8), boff = lds_byte(wc * 32 + fr, fq * 8);
#define PG8_SA(b, h) (((b) * 2 + (h)) * HTB)
#define PG8_SB(b, h) ((4 + (b) * 2 + (h)) * HTB)
#define PG8_STAGE(bufoff, gbase, voff) do { _Pragma("unroll") for (int _i = 0; _i < 2; ++_i) \
        __builtin_amdgcn_global_load_lds((const unsigned*)((const char*)(gbase) + (voff)[_i]), (LAS unsigned*)(lds + (bufoff) + ldsw + _i * 8192), 16, 0, 0); } while (0)
#define PG8_LDA(dst, b, h) do { _Pragma("unroll") for (int m = 0; m < 4; ++m) _Pragma("unroll") for (int k = 0; k < 2; ++k) dst[m][k] = *(const LAS bf16x8*)(lds + PG8_SA(b, h) + aoff + m * 2048 + k * 1024); } while (0)
#define PG8_LDB(dst, b, h) do { _Pragma("unroll") for (int n = 0; n < 2; ++n) _Pragma("unroll") for (int k = 0; k < 2; ++k) dst[n][k] = *(const LAS bf16x8*)(lds + PG8_SB(b, h) + boff + n * 2048 + k * 1024); } while (0)
#define PG8_MMA(ai, bj, At, Bt) do { __builtin_amdgcn_s_setprio(1); _Pragma("unroll") for (int m = 0; m < 4; ++m) _Pragma("unroll") for (int n = 0; n < 2; ++n) _Pragma("unroll") for (int k = 0; k < 2; ++k) \
        acc[ai][bj][m][n] = __builtin_amdgcn_mfma_f32_16x16x32_bf16(Bt[n][k], At[m][k], acc[ai][bj][m][n], 0, 0, 0); __builtin_amdgcn_s_setprio(0); } while (0)
#define PG8_WAIT_V(n) asm volatile("s_waitcnt vmcnt(" #n ")" ::: "memory")
#define PG8_WAIT_L(n) asm volatile("s_waitcnt lgkmcnt(" #n ")" ::: "memory")
#define PG8_BAR __builtin_amdgcn_s_barrier()
#define PG8_SCHED __builtin_amdgcn_sched_barrier(0)
    Unit cur, nxt; int ui = 0;
    if (!S.next(0, cur)) return;
    f32x4 acc[2][2][4][2];
#pragma unroll
    for (int a = 0; a < 2; ++a)
#pragma unroll
        for (int b = 0; b < 2; ++b)
#pragma unroll
            for (int m = 0; m < 4; ++m)
#pragma unroll
                for (int n = 0; n < 2; ++n) acc[a][b][m][n] = (f32x4){0.f, 0.f, 0.f, 0.f};
    bf16x8 At[4][2], B0[2][2], B1[2][2];
    const char* cA = cur.A; const char* cB = cur.B;
    PG8_STAGE(PG8_SB(0, 0), cB, voffB); PG8_STAGE(PG8_SA(0, 0), cA, voffA); PG8_STAGE(PG8_SB(0, 1), cB + hstepB, voffB); PG8_STAGE(PG8_SA(0, 1), cA + hstepA, voffA);
    if (wr == 1) PG8_BAR;
    PG8_WAIT_V(4); PG8_BAR;
    PG8_STAGE(PG8_SB(1, 0), cB + kstep, voffB); PG8_STAGE(PG8_SA(1, 0), cA + kstep, voffA); PG8_STAGE(PG8_SB(1, 1), cB + hstepB + kstep, voffB);
    PG8_WAIT_V(6); PG8_BAR;
    for (;;) {
        const bool has_next = S.next(ui + 1, nxt);
        const char* nA = has_next ? nxt.A : cA; const char* nB = has_next ? nxt.B : cB;
        const int nt = cur.nt;
        for (int t = 0; t < nt; t += 2) {
            const bool last = (t == nt - 2);
            const char* a1 = cA + (size_t)(t + 1) * kstep;
            const char* a2 = last ? nA : cA + (size_t)(t + 2) * kstep; const char* b2 = last ? nB : cB + (size_t)(t + 2) * kstep;
            const char* a3 = a2 + kstep; const char* b3 = b2 + kstep;
            PG8_LDB(B0, 0, 0); PG8_SCHED; PG8_LDA(At, 0, 0); PG8_STAGE(PG8_SA(1, 1), a1 + hstepA, voffA);
            PG8_WAIT_L(8); PG8_BAR; PG8_WAIT_L(0); PG8_MMA(0, 0, At, B0); PG8_BAR; PG8_SCHED;
            PG8_LDB(B1, 0, 1); PG8_STAGE(PG8_SB(0, 0), b2, voffB);
            PG8_BAR; PG8_WAIT_L(0); PG8_MMA(0, 1, At, B1); PG8_BAR;
            PG8_LDA(At, 0, 1); PG8_STAGE(PG8_SA(0, 0), a2, voffA);
            PG8_BAR; PG8_WAIT_L(0); PG8_MMA(1, 0, At, B0); PG8_BAR; PG8_SCHED;
            PG8_STAGE(PG8_SB(0, 1), b2 + hstepB, voffB);
            PG8_WAIT_V(6); PG8_BAR; PG8_MMA(1, 1, At, B1); PG8_BAR;
            PG8_LDB(B0, 1, 0); PG8_SCHED; PG8_LDA(At, 1, 0); PG8_STAGE(PG8_SA(0, 1), a2 + hstepA, voffA);
            PG8_WAIT_L(8); PG8_BAR; PG8_WAIT_L(0); PG8_MMA(0, 0, At, B0); PG8_BAR; PG8_SCHED;
            PG8_LDB(B1, 1, 1); PG8_STAGE(PG8_SB(1, 0), b3, voffB);
            PG8_BAR; PG8_WAIT_L(0); PG8_MMA(0, 1, At, B1); PG8_BAR;
            PG8_LDA(At, 1, 1); PG8_STAGE(PG8_SA(1, 0), a3, voffA);
            PG8_BAR; PG8_WAIT_L(0); PG8_MMA(1, 0, At, B0); PG8_BAR; PG8_SCHED;
            PG8_STAGE(PG8_SB(1, 1), b3 + hstepB, voffB);
            PG8_WAIT_V(6); PG8_BAR; PG8_MMA(1, 1, At, B1); PG8_BAR;
        }
        E(acc, cur, wr, wc, fr, fq);
        if (!has_next) break;
#pragma unroll
        for (int a = 0; a < 2; ++a)
#pragma unroll
            for (int b = 0; b < 2; ++b)
#pragma unroll
                for (int m = 0; m < 4; ++m)
#pragma unroll
                    for (int n = 0; n < 2; ++n) acc[a][b][m][n] = (f32x4){0.f, 0.f, 0.f, 0.f};
        cur = nxt; cA = nA; cB = nB; ++ui;
    }
    PG8_WAIT_V(0);
    if (wr == 0) PG8_BAR;
    PG8_BAR;
#undef PG8_SA
#undef PG8_SB
#undef PG8_STAGE
#undef PG8_LDA
#undef PG8_LDB
#undef PG8_MMA
#undef PG8_WAIT_V
#undef PG8_WAIT_L
#undef PG8_BAR
#undef PG8_SCHED
}

template <int MODE>
struct EpiGated {
    bf16_t* O; int ldc; const float* bias; float* part;
    __device__ __forceinline__ void operator()(const f32x4 (&acc)[2][2][4][2], const Unit& u, int wr, int wc, int fr, int fq) const {
        const int row0 = u.pm * BM + wr * 64 + fr, col0 = u.pn * 128 + wc * 32 + 8 * fq;
        if (MODE == 1 && u.ks >= 0) {
#pragma unroll
            for (int bj = 0; bj < 2; ++bj)
#pragma unroll
                for (int ai = 0; ai < 2; ++ai)
#pragma unroll
                    for (int m = 0; m < 4; ++m) { float* p = part + ((size_t)u.ks * MS + (row0 + ai * HALF + m * 16 - MP)) * (2 * ldc) + u.pn * BM + bj * HALF + wc * 32 + 8 * fq;
                        *(f32x4*)p = acc[ai][bj][m][0]; *(f32x4*)(p + 4) = acc[ai][bj][m][1]; }
            return;
        }
        f32x4 b0[2], b1[2];
#pragma unroll
        for (int n = 0; n < 2; ++n) { b0[n] = (f32x4){0.f, 0.f, 0.f, 0.f}; b1[n] = b0[n];
            if (MODE == 1) { b0[n] = *(const f32x4*)(bias + col0 + 4 * n); b1[n] = *(const f32x4*)(bias + ldc + col0 + 4 * n); } }
#pragma unroll
        for (int ai = 0; ai < 2; ++ai)
#pragma unroll
            for (int m = 0; m < 4; ++m) {
                float v[8]; const float rs = 1.0f;
#pragma unroll
                for (int n = 0; n < 2; ++n)
#pragma unroll
                    for (int j = 0; j < 4; ++j) { const float a = acc[ai][0][m][n][j] * rs + b0[n][j], b = acc[ai][1][m][n][j] * rs + b1[n][j];
                        v[4 * n + j] = (MODE == 0) ? siluf_(a) * b : a * sigmoidf_(b); }
                u32x4 w; w.x = cvt_pk_bf16(v[0], v[1]); w.y = cvt_pk_bf16(v[2], v[3]); w.z = cvt_pk_bf16(v[4], v[5]); w.w = cvt_pk_bf16(v[6], v[7]);
                *(u32x4*)(O + (size_t)(row0 + ai * HALF + m * 16) * ldc + col0) = w;
            }
    }
};
template <int GLA>
struct EpiPlain {
    bf16_t* O; int ldc; const float* bg; float* part; const float* r2;
    __device__ __forceinline__ void operator()(const f32x4 (&acc)[2][2][4][2], const Unit& u, int wr, int wc, int fr, int fq) const {
        const int row0 = u.pm * BM + wr * 64 + fr, col0 = u.pn * BM + wc * 32 + 8 * fq;
        if (!GLA && u.ks >= 0) {
#pragma unroll
            for (int bj = 0; bj < 2; ++bj)
#pragma unroll
                for (int ai = 0; ai < 2; ++ai)
#pragma unroll
                    for (int m = 0; m < 4; ++m) { float* p = part + ((size_t)u.ks * MS + (row0 + ai * HALF + m * 16 - MP)) * D + col0 + bj * HALF;
                        *(f32x4*)p = acc[ai][bj][m][0]; *(f32x4*)(p + 4) = acc[ai][bj][m][1]; }
            return;
        }
        const bool lf = GLA && (u.pn >= 12);
#pragma unroll
        for (int bj = 0; bj < 2; ++bj) {
            f32x4 bb[2];
#pragma unroll
            for (int n = 0; n < 2; ++n) bb[n] = lf ? *(const f32x4*)(bg + (col0 - 3072) + bj * HALF + 4 * n) : (f32x4){0.f, 0.f, 0.f, 0.f};
#pragma unroll
            for (int ai = 0; ai < 2; ++ai)
#pragma unroll
                for (int m = 0; m < 4; ++m) {
                    float v[8]; const float rs = 1.0f;
#pragma unroll
                    for (int n = 0; n < 2; ++n)
#pragma unroll
                        for (int j = 0; j < 4; ++j) { float a = acc[ai][bj][m][n][j] * rs;
                            if (lf) a += bb[n][j];
                            v[4 * n + j] = a; }
                    u32x4 w; w.x = cvt_pk_bf16(v[0], v[1]); w.y = cvt_pk_bf16(v[2], v[3]); w.z = cvt_pk_bf16(v[4], v[5]); w.w = cvt_pk_bf16(v[6], v[7]);
                    *(u32x4*)(O + (size_t)(row0 + ai * HALF + m * 16) * ldc + col0 + bj * HALF) = w;
                }
        }
    }
};
struct EpiS5A {
    float* HL;
    __device__ __forceinline__ void operator()(const f32x4 (&acc)[2][2][4][2], const Unit& u, int wr, int wc, int fr, int fq) const {
        const int row0 = u.pm * BM + wr * 64 + fr, col0 = wc * 32 + 8 * fq;
#pragma unroll
        for (int ai = 0; ai < 2; ++ai)
#pragma unroll
            for (int m = 0; m < 4; ++m) { float* p = HL + ((size_t)u.pn * 1024 + row0 + ai * HALF + m * 16) * 128 + col0;
                *(f32x4*)p = acc[ai][0][m][0]; *(f32x4*)(p + 4) = acc[ai][0][m][1]; }
    }
};
struct EpiS5B {
    unsigned char* ws; const float* dsk;
    __device__ __forceinline__ void operator()(const f32x4 (&acc)[2][2][4][2], const Unit& u, int wr, int wc, int fr, int fq) const {
        bf16_t* Z = (bf16_t*)(ws + WS_Z); const bf16_t* HS5 = (const bf16_t*)(ws + WS_HS5);
        asm volatile("" : "+v"(fq));
        const int g = u.pn, c0 = (8 * fq) & 15;
        const f32x4 d0 = *(const f32x4*)(dsk + g * 16 + c0), d1 = *(const f32x4*)(dsk + g * 16 + c0 + 4);
#pragma unroll
        for (int bj = 0; bj < 2; ++bj) { const int t = 8 * bj + 2 * wc + (fq >> 1);
#pragma unroll
            for (int ai = 0; ai < 2; ++ai)
#pragma unroll
                for (int m = 0; m < 4; ++m) { const int colr = u.pm * BM + ai * HALF + wr * 64 + m * 16 + fr; const size_t off = (size_t)(colr * 16 + t) * D + g * 16 + c0;
                    const u32x4 uu = *(const u32x4*)(HS5 + ((size_t)g * 1024 + colr) * 384 + t * 16 + c0); const f32x4 a0 = acc[ai][bj][m][0], a1 = acc[ai][bj][m][1];
                    u32x4 w; w.x = cvt_pk_bf16(a0[0] + d0[0] * bflo(uu.x), a0[1] + d0[1] * bfhi(uu.x)); w.y = cvt_pk_bf16(a0[2] + d0[2] * bflo(uu.y), a0[3] + d0[3] * bfhi(uu.y));
                    w.z = cvt_pk_bf16(a1[0] + d1[0] * bflo(uu.z), a1[1] + d1[1] * bfhi(uu.z)); w.w = cvt_pk_bf16(a1[2] + d1[2] * bflo(uu.w), a1[3] + d1[3] * bfhi(uu.w));
                    *(u32x4*)(Z + off) = w; }
        }
    }
};

struct Params { const float* in[23]; float* out; unsigned char* ws; int ph_lo, ph_hi; };

__device__ __forceinline__ int rp_row(int kidx, int gw, int NGW) {
    if (NGW % MS == 0) { const int stride = NGW / MS, kp = (MP + NGW - 1) / NGW;
        if (kidx == 0) return (gw % stride == 0) ? MP + gw / stride : -1;
        if (kidx > kp) return -1;
        const int m = gw + (kidx - 1) * NGW; return m < MP ? m : -1; }
    const int KMAX = (M + NGW - 1) / NGW; if (kidx >= KMAX) return -1;
    const int kk = (kidx + KMAX - 1) % KMAX, m = gw + kk * NGW; return m < M ? m : -1;
}
template <int R, int NKS>
__device__ __forceinline__ void row_pass(const float* xf_p, const float* xf_s, bf16_t* XB, float* R2, const bf16_t* Y, const float* g_post, float scale,
                                         const float* part, float* outf, const float* g_pre, bf16_t* HS5, bf16_t* HSMP, const float* glu_bias = nullptr) {
    const int tid = otid(); const int lane = tid & 63, gw = blockIdx.x * 8 + (tid >> 6), NGW = gridDim.x * 8;
#define CJ(j) (512 * ((j) >> 1) + 8 * lane + 4 * ((j) & 1))
    const int KMAX = (NGW % MS == 0) ? (MP + NGW - 1) / NGW + 1 : (M + NGW - 1) / NGW;
    for (int k0 = 0; k0 < KMAX; k0 += R) {
        f32x4 v[R][4], yv[R][4];
#pragma unroll
        for (int r = 0; r < R; ++r) { const int mi = rp_row(k0 + r, gw, NGW), m = mi >= 0 ? mi : gw;
            if (xf_p) { const float* xr = (m < MP) ? xf_p + (size_t)m * D : xf_s + (size_t)(m - MP) * D;
#pragma unroll
                for (int j = 0; j < 4; ++j) v[r][j] = *(const f32x4*)(xr + CJ(j));
            } else {
                const float ir = 1.0f / R2[m];
#pragma unroll
                for (int jj = 0; jj < 2; ++jj) { const u32x4 w = *(const u32x4*)(XB + (size_t)m * D + 512 * jj + 8 * lane);
                    v[r][2 * jj] = (f32x4){bflo(w.x), bfhi(w.x), bflo(w.y), bfhi(w.y)} * ir; v[r][2 * jj + 1] = (f32x4){bflo(w.z), bfhi(w.z), bflo(w.w), bfhi(w.w)} * ir; }
            }
            if (Y) {
                if (glu_bias && m >= MP) {
#pragma unroll
                    for (int j = 0; j < 4; ++j) { const int nc = 256 * (4 * (j >> 1) + (lane >> 4)) + 8 * (lane & 15) + 4 * (j & 1);
                        f32x4 sv = *(const f32x4*)(glu_bias + CJ(j)), sg = *(const f32x4*)(glu_bias + D + CJ(j));
                        f32x4 tv[NKS], tg[NKS];
#pragma unroll
                        for (int ks = 0; ks < NKS; ++ks) { const float* pp = part + ((size_t)ks * MS + (m - MP)) * (2 * D) + nc; tv[ks] = *(const f32x4*)pp; tg[ks] = *(const f32x4*)(pp + 128); }
#pragma unroll
                        for (int ks = 0; ks < NKS; ++ks) { sv += tv[ks]; sg += tg[ks]; }
                        yv[r][j] = (f32x4){sv.x * sigmoidf_(sg.x), sv.y * sigmoidf_(sg.y), sv.z * sigmoidf_(sg.z), sv.w * sigmoidf_(sg.w)}; }
                } else if (part && m >= MP) {
#pragma unroll
                    for (int j = 0; j < 4; ++j) { f32x4 t[NKS];
#pragma unroll
                        for (int ks = 0; ks < NKS; ++ks) t[ks] = *(const f32x4*)(part + ((size_t)ks * MS + (m - MP)) * D + CJ(j));
                        f32x4 s = t[0];
#pragma unroll
                        for (int ks = 1; ks < NKS; ++ks) s += t[ks];
                        yv[r][j] = s; }
                } else {
#pragma unroll
                    for (int jj = 0; jj < 2; ++jj) { const u32x4 w = *(const u32x4*)(Y + (size_t)m * D + 512 * jj + 8 * lane);
                        yv[r][2 * jj] = (f32x4){bflo(w.x), bfhi(w.x), bflo(w.y), bfhi(w.y)}; yv[r][2 * jj + 1] = (f32x4){bflo(w.z), bfhi(w.z), bflo(w.w), bfhi(w.w)}; }
                }
            }
        }
#pragma unroll
        for (int r = 0; r < R; ++r) { const int m = rp_row(k0 + r, gw, NGW); if (m < 0) continue;
            if (Y) {
                float ss = 0.f;
#pragma unroll
                for (int j = 0; j < 4; ++j) ss += (yv[r][j].x * yv[r][j].x + yv[r][j].y * yv[r][j].y) + (yv[r][j].z * yv[r][j].z + yv[r][j].w * yv[r][j].w);
                const float rr = rsqrtf(wave_sum(ss) * (1.0f / D) + EPS) * scale;
#pragma unroll
                for (int j = 0; j < 4; ++j) { const f32x4 g = *(const f32x4*)(g_post + CJ(j)); v[r][j] = v[r][j] + yv[r][j] * g * rr; }
            }
            if (outf) {
#pragma unroll
                for (int j = 0; j < 4; ++j) *(f32x4*)(outf + (size_t)m * D + CJ(j)) = v[r][j];
            } else {
                float ss = 0.f;
#pragma unroll
                for (int j = 0; j < 4; ++j) ss += (v[r][j].x * v[r][j].x + v[r][j].y * v[r][j].y) + (v[r][j].z * v[r][j].z + v[r][j].w * v[r][j].w);
                const float rr = rsqrtf(wave_sum(ss) * (1.0f / D) + EPS);
#pragma unroll
                for (int jj = 0; jj < 2; ++jj) { const f32x4 a = v[r][2 * jj] * rr, b = v[r][2 * jj + 1] * rr;
                    u32x4 w; w.x = cvt_pk_bf16(a.x, a.y); w.y = cvt_pk_bf16(a.z, a.w); w.z = cvt_pk_bf16(b.x, b.y); w.w = cvt_pk_bf16(b.z, b.w);
                    *(u32x4*)(XB + (size_t)m * D + 512 * jj + 8 * lane) = w; }
                if (lane == 0) R2[m] = rr;
                if (g_pre) {
#pragma unroll
                    for (int jj = 0; jj < 2; ++jj) { const f32x4 ga = *(const f32x4*)(g_pre + CJ(2 * jj)), gb = *(const f32x4*)(g_pre + CJ(2 * jj + 1));
                        const f32x4 ha = v[r][2 * jj] * ga * rr, hb = v[r][2 * jj + 1] * gb * rr;
                        u32x4 w; w.x = cvt_pk_bf16(ha.x, ha.y); w.y = cvt_pk_bf16(ha.z, ha.w); w.z = cvt_pk_bf16(hb.x, hb.y); w.w = cvt_pk_bf16(hb.z, hb.w);
                        if (m < MP) { const int gi = 32 * jj + (lane >> 1), c = (lane & 1) * 8;
                            *(u32x4*)(HS5 + ((size_t)gi * 1024 + (m >> 4)) * 384 + (m & 15) * 16 + c) = w; }
                        else *(u32x4*)(HSMP + (size_t)(m - MP) * D + 512 * jj + 8 * lane) = w; }
                }
            }
        }
    }
}
#undef CJ

__device__ __forceinline__ void transpose_item(const float* W, int ldw, int K, int scol0, bf16_t* Bt, int drow0, int k0, float scale, const float* gk, LAS bf16_t* scr, int lane) {
    const float* src = W + (size_t)(k0 + (lane >> 5)) * ldw + scol0 + 4 * (lane & 31);
#pragma unroll 16
    for (int i = 0; i < 32; ++i) { const f32x4 w = __builtin_nontemporal_load((const f32x4*)(src + (size_t)(2 * i) * ldw));
        const float sc = gk ? gk[k0 + 2 * i + (lane >> 5)] * scale : scale;
        u32x2 o; o.x = cvt_pk_bf16(w.x * sc, w.y * sc); o.y = cvt_pk_bf16(w.z * sc, w.w * sc);
        *(LAS u32x2*)(scr + (2 * i + (lane >> 5)) * 136 + 4 * (lane & 31)) = o; }
    asm volatile("s_waitcnt lgkmcnt(0)" ::: "memory");
#pragma unroll 4
    for (int t = 0; t < 16; ++t) { const int task = t * 64 + lane, n = task >> 3, kc = task & 7; const LAS bf16_t* s = scr + (kc * 8) * 136 + n;
        u32x4 o; o.x = (unsigned)s[0] | ((unsigned)s[136] << 16); o.y = (unsigned)s[272] | ((unsigned)s[408] << 16);
        o.z = (unsigned)s[544] | ((unsigned)s[680] << 16); o.w = (unsigned)s[816] | ((unsigned)s[952] << 16);
        *(u32x4*)(Bt + (size_t)(drow0 + n) * K + k0 + 8 * kc) = o; }
    asm volatile("s_waitcnt lgkmcnt(0)" ::: "memory");
}

__device__ __forceinline__ void s5_prep_group(const Params& P, LAS unsigned char* lds, int g, int qt) {
    LAS float* apr = (LAS float*)lds;
    LAS float* api = apr + 17 * 64;
    LAS float* bbr = api + 17 * 64;
    LAS float* bbi = bbr + 1024;
    LAS float* cre = bbi + 1024;
    LAS float* cim = cre + 1024;
    LAS float* fre = cim + 1024;
    LAS float* fim = fre + 64;
    LAS float* kmat = fim + 64;
    const int tid = otid();
    float* sm = (float*)(P.ws + WS_SMALL);
    bf16_t* Wm = (bf16_t*)(P.ws + WS_S5M + (size_t)g * S5M_G);
    bf16_t* TE = Wm + 128 * 256;
    if (tid < 64) {
        const int p = tid; const float lr = P.in[13][g * 64 + p], li = P.in[14][g * 64 + p]; const float dt = expf(P.in[15][g]);
        float a1r = 0.f, a1i = 0.f;
        for (int tau = 0; tau <= 16; ++tau) {
            const float mag = expf(lr * dt * (float)tau);
            double rev = (double)li * (double)dt * (double)tau * 0.15915494309189535; rev -= __builtin_rint(rev);
            const float rr = (float)rev; const float s = __builtin_amdgcn_sinf(rr), c = __builtin_amdgcn_cosf(rr);
            apr[tau * 64 + p] = mag * c; api[tau * 64 + p] = mag * s;
            if (tau == 1) { a1r = mag * c; a1i = mag * s; }
            if (tau == 16 && qt == 0) { sm[SM_A16R + g * 64 + p] = mag * c; sm[SM_A16I + g * 64 + p] = mag * s; }
        }
        const float nr = a1r - 1.0f, ni = a1i, den = lr * lr + li * li;
        const float fr_ = (nr * lr + ni * li) / den, fi_ = (ni * lr - nr * li) / den;
        fre[p] = fr_; fim[p] = fi_;
        if (qt == 0) { sm[SM_ARE + g * 64 + p] = a1r; sm[SM_AIM + g * 64 + p] = a1i; sm[SM_FRE + g * 64 + p] = fr_; sm[SM_FIM + g * 64 + p] = fi_; }
    }
    __syncthreads();
    for (int idx = tid; idx < 1024; idx += 512) { const int p = idx >> 4; const float br = P.in[16][g * 1024 + idx], bi = P.in[17][g * 1024 + idx];
        bbr[idx] = fre[p] * br - fim[p] * bi; bbi[idx] = fre[p] * bi + fim[p] * br;
        cre[idx] = P.in[18][g * 1024 + idx]; cim[idx] = P.in[19][g * 1024 + idx]; }
    __syncthreads();
    for (int idx = qt * 8192 + tid; idx < (qt + 1) * 8192; idx += 512) { const int row = idx >> 8, col = idx & 255, s = col >> 4, c = col & 15, p = row & 63, im = row >> 6;
        const float ar = apr[(15 - s) * 64 + p], ai = api[(15 - s) * 64 + p], br = bbr[p * 16 + c], bi = bbi[p * 16 + c];
        Wm[idx] = f2bf(im ? (ar * bi + ai * br) : (ar * br - ai * bi)); }
    for (int i2 = tid; i2 < 1024; i2 += 512) { const int tau = i2 >> 6, cp = 4 * qt + ((i2 >> 4) & 3), c = i2 & 15, idx = (tau << 8) + (cp << 4) + c; float sum = 0.f;
        for (int p = 0; p < 64; ++p) { const float cr = cre[cp * 64 + p], ci = cim[cp * 64 + p], ar = apr[tau * 64 + p], ai = api[tau * 64 + p];
            const float car = cr * ar - ci * ai, cai = cr * ai + ci * ar; sum += car * bbr[p * 16 + c] - cai * bbi[p * 16 + c]; }
        kmat[idx] = sum; }
    __syncthreads();
    for (int i2 = tid; i2 < 64 * 384; i2 += 512) { const int r2 = i2 / 384, col = i2 - r2 * 384, t = r2 >> 2, cp = 4 * qt + (r2 & 3), row = t * 16 + cp, idx = row * 384 + col; float v;
        if (col < 256) { const int s = col >> 4, c = col & 15; v = (s <= t) ? kmat[((t - s) << 8) + (cp << 4) + c] : 0.f; }
        else { const int pp = col - 256, p = pp & 63, im = pp >> 6; const float cr = cre[cp * 64 + p], ci = cim[cp * 64 + p], ar = apr[(t + 1) * 64 + p], ai = api[(t + 1) * 64 + p];
            v = im ? -(cr * ai + ci * ar) : (cr * ar - ci * ai); }
        TE[idx] = f2bf(v); }
    __syncthreads();
}

__device__ __forceinline__ void s5_idle_prep(const Params& P, LAS unsigned char* lds, int slot) {
    const int G = gridDim.x, nfull = ((M / BM) * (NGU / BM)) % G, cb = blockIdx.x;
    if (nfull == 0 || cb < nfull) return;
    const int wi = slot * (G - nfull) + (cb - nfull);
    if (wi < 256) s5_prep_group(P, lds, wi >> 2, wi & 3);
}
__device__ __forceinline__ void s5_idle_prep_inproj(const Params& P, LAS unsigned char* lds) {
    const int G = gridDim.x, nf1 = ((M / BM) * (NGU / BM)) % G, nf2 = ((M / BM) * (NIN / BM)) % G, cb = blockIdx.x;
    if (nf1 == 0 || nf2 == 0 || cb < nf2) return;
    const int wi = 3 * (G - nf1) + (cb - nf2);
    if (wi < 256) s5_prep_group(P, lds, wi >> 2, wi & 3);
}
__device__ __forceinline__ void phase0(const Params& P, LAS unsigned char* lds) {
    const int tid = otid(), lane = tid & 63, wave = tid >> 6;
    const int gw = blockIdx.x * 8 + wave, NGW = gridDim.x * 8;
    LAS bf16_t* scr = (LAS bf16_t*)(lds + wave * 17408);
    bf16_t* WGU = (bf16_t*)(P.ws + WS_WGU); bf16_t* WDN = (bf16_t*)(P.ws + WS_WDN); bf16_t* WIN = (bf16_t*)(P.ws + WS_WIN);
    bf16_t* WOUT = (bf16_t*)(P.ws + WS_WOUT); bf16_t* WGLU = (bf16_t*)(P.ws + WS_WGLU);
    constexpr int I_GU = 4 * 16 * 44, I_DN = 4 * 44 * 8, I_IN = 16 * 24, I_OUT = 16 * 8, I_GLU = 16 * 16;
#pragma unroll 1
    for (int step = 0; step < 2; ++step) {
    if (((blockIdx.x & 1) != 0) == (step == 0)) {
        { const int G_ = gridDim.x, nf1_ = ((M / BM) * (NGU / BM)) % G_, nf2_ = ((M / BM) * (NIN / BM)) % G_;
          const int first_ = (nf1_ && nf2_) ? 3 * (G_ - nf1_) + (G_ - nf2_) : (nf1_ ? 3 * (G_ - nf1_) : 0);
          for (int wi = first_ + blockIdx.x; wi < 256; wi += gridDim.x) s5_prep_group(P, lds, wi >> 2, wi & 3); }
    } else {
    for (int it = blockIdx.x + gridDim.x * wave; it < I_GU + I_DN + I_IN + I_OUT + I_GLU; it += NGW) {
        int r = it;
        if (r < I_GU) { const int lf = r / 704, rr = r % 704, kb = rr / 44, nb = rr % 44, n0 = nb * 128, pn = n0 >> 8, bj = (n0 >> 7) & 1;
            transpose_item(P.in[6] + (size_t)lf * D * NGU, NGU, D, bj * FF + pn * 128, WGU + (size_t)lf * NGU * D, n0, kb * 64, 1.0f, P.in[5] + (size_t)((lf >> 1) * 6 + (lf & 1) * 4) * D, scr, lane); continue; }
        r -= I_GU;
        if (r < I_DN) { const int lf = r / 352, rr = r % 352, kb = rr / 8, nb = rr % 8;
            transpose_item(P.in[7] + (size_t)lf * FF * D, D, FF, nb * 128, WDN + (size_t)lf * D * FF, nb * 128, kb * 64, 1.0f, nullptr, scr, lane); continue; }
        r -= I_DN;
        if (r < I_IN) { const int kb = r / 24, nb = r % 24, n0 = nb * 128;
            transpose_item(P.in[8], LDIN, D, n0, WIN, n0, kb * 64, n0 < 512 ? 0.08838834764831845f : 1.0f, P.in[5] + 2 * D, scr, lane); continue; }
        r -= I_IN;
        if (r < I_OUT) { const int kb = r / 8, nb = r % 8; transpose_item(P.in[12], D, D, nb * 128, WOUT, nb * 128, kb * 64, 1.0f, nullptr, scr, lane); continue; }
        r -= I_OUT;
        { const int kb = r / 16, nb = r % 16, n0 = nb * 128, pn = n0 >> 8, bj = (n0 >> 7) & 1;
            transpose_item(P.in[21], 2 * D, D, bj * D + pn * 128, WGLU, n0, kb * 64, 1.0f, nullptr, scr, lane); }
    }
    for (int idx = blockIdx.x * 512 + tid; idx < 64 * 1024; idx += gridDim.x * 512) { const int jb = idx >> 10, k = idx & 1023;
        const float* wr = P.in[8] + (size_t)k * LDIN + 3072; const f32x4 a0 = *(const f32x4*)wr, a1 = *(const f32x4*)(wr + 4), a2 = *(const f32x4*)(wr + 8), a3 = *(const f32x4*)(wr + 12);
        const float a[16] = {a0.x, a0.y, a0.z, a0.w, a1.x, a1.y, a1.z, a1.w, a2.x, a2.y, a2.z, a2.w, a3.x, a3.y, a3.z, a3.w}; const float gk = P.in[5][2 * D + k];
#pragma unroll
        for (int jj = 0; jj < 8; ++jj) { const int j = jb * 8 + jj; float s = 0.f;
#pragma unroll
            for (int r = 0; r < 16; ++r) s += a[r] * P.in[9][r * 512 + j];
            WIN[(size_t)(3072 + j) * D + k] = f2bf(s * gk); } }
    }
    __syncthreads();
    }
    row_pass<3, 1>(P.in[0], P.in[1], (bf16_t*)(P.ws + WS_H), (float*)(P.ws + WS_SMALL) + SM_R2, nullptr, nullptr, 0.f, nullptr, nullptr, nullptr, nullptr, nullptr);
}

__device__ __forceinline__ void gla_cumsum(LAS float* BC, LAS float* TOT, const u32x4 (&lw)[2], int tid) {
#pragma unroll
    for (int i = 0; i < 2; ++i) { const int e = tid + 512 * i, t = e >> 4, d0 = (e & 15) * 8; const u32x4 w = lw[i];
        LAS float* b = BC + t * 128 + d0; b[0] = logf_gate(bflo(w.x)); b[1] = logf_gate(bfhi(w.x)); b[2] = logf_gate(bflo(w.y)); b[3] = logf_gate(bfhi(w.y));
        b[4] = logf_gate(bflo(w.z)); b[5] = logf_gate(bfhi(w.z)); b[6] = logf_gate(bflo(w.w)); b[7] = logf_gate(bfhi(w.w)); }
    __syncthreads();
    const int dk = tid & 127, seg = tid >> 7; float run = 0.f;
#pragma unroll
    for (int i = 0; i < 16; ++i) { const int t = seg * 16 + i; run += BC[t * 128 + dk]; BC[t * 128 + dk] = run; }
    TOT[seg * 128 + dk] = run;
    __syncthreads();
    float off = 0.f;
    for (int s = 0; s < seg; ++s) off += TOT[s * 128 + dk];
#pragma unroll
    for (int i = 0; i < 16; ++i) BC[(seg * 16 + i) * 128 + dk] += off;
    __syncthreads();
}
__device__ __forceinline__ void gla_load_vt(LAS bf16_t* VT, const u32x4 (&vw)[4], int tid) {
#pragma unroll
    for (int i = 0; i < 4; ++i) { const int e = tid + 512 * i, t = e >> 5, d0 = (e & 31) * 8; const u32x4 w = vw[i];
        LAS bf16_t* p = VT + d0 * 72 + ((((t >> 3) ^ ((d0 >> 3) & 7)) << 3) | (t & 7));
        p[0] = (bf16_t)(w.x & 0xffff); p[72] = (bf16_t)(w.x >> 16); p[144] = (bf16_t)(w.y & 0xffff); p[216] = (bf16_t)(w.y >> 16);
        p[288] = (bf16_t)(w.z & 0xffff); p[360] = (bf16_t)(w.z >> 16); p[432] = (bf16_t)(w.w & 0xffff); p[504] = (bf16_t)(w.w >> 16); }
}

__device__ __forceinline__ void gla_phase_a(const Params& P, LAS unsigned char* lds) {
    const int tid = otid(), lane = tid & 63, w = tid >> 6, l16 = lane & 15, q = lane >> 4;
    LAS float* BC = (LAS float*)lds; LAS float* TOT = (LAS float*)(lds + 32768);
    LAS bf16_t* KT = (LAS bf16_t*)(lds + 34816); LAS bf16_t* VT = (LAS bf16_t*)(lds + 53248);
    const bf16_t* QKV = (const bf16_t*)(P.ws + WS_QKV); bf16_t* KC = (bf16_t*)(P.ws + WS_KC); float* BEND = (float*)(P.ws + WS_BEND);
    for (int item = blockIdx.x; item < 1024; item += gridDim.x) {
        const int b = item >> 7, h = (item >> 5) & 3, c = item & 31; const size_t tok0 = (size_t)b * 2048 + c * 64;
        const bf16_t* base = QKV + tok0 * NIN;
        u32x4 lw[2], kw[2], vw[4];
#pragma unroll
        for (int i = 0; i < 2; ++i) { const int e = tid + 512 * i, t = e >> 4, d0 = (e & 15) * 8; lw[i] = *(const u32x4*)(base + (size_t)t * NIN + 3072 + h * 128 + d0); kw[i] = *(const u32x4*)(base + (size_t)t * NIN + 512 + h * 128 + d0); }
#pragma unroll
        for (int i = 0; i < 4; ++i) { const int e = tid + 512 * i, t = e >> 5, d0 = (e & 31) * 8; vw[i] = *(const u32x4*)(base + (size_t)t * NIN + 1024 + h * 256 + d0); }
        gla_cumsum(BC, TOT, lw, tid);
        if (tid < 128) BEND[item * 128 + tid] = BC[63 * 128 + tid];
#pragma unroll
        for (int i = 0; i < 2; ++i) { const int e = tid + 512 * i, t = e >> 4, d0 = (e & 15) * 8; const u32x4 wv = kw[i];
            float kv[8] = {bflo(wv.x), bfhi(wv.x), bflo(wv.y), bfhi(wv.y), bflo(wv.z), bfhi(wv.z), bflo(wv.w), bfhi(wv.w)};
#pragma unroll
            for (int j = 0; j < 8; ++j) KT[(d0 + j) * 72 + ((((t >> 3) ^ ((d0 >> 3) & 7)) << 3) | (t & 7))] = f2bf(kv[j] * __expf(BC[63 * 128 + d0 + j] - BC[t * 128 + d0 + j])); }
        gla_load_vt(VT, vw, tid);
        __syncthreads();
        f32x4 acc[8][2];
#pragma unroll
        for (int a = 0; a < 8; ++a) { acc[a][0] = (f32x4){0.f, 0.f, 0.f, 0.f}; acc[a][1] = acc[a][0]; }
#pragma unroll
        for (int kk = 0; kk < 2; ++kk) {
            bf16x8 vb[2];
#pragma unroll
            for (int d = 0; d < 2; ++d) vb[d] = *(const LAS bf16x8*)(VT + (16 * (2 * w + d) + l16) * 72 + (((kk * 4 + q) ^ ((2 * (2 * w + d) + (l16 >> 3)) & 7)) << 3));
#pragma unroll
            for (int a = 0; a < 8; ++a) { const bf16x8 ka = *(const LAS bf16x8*)(KT + (16 * a + l16) * 72 + (((kk * 4 + q) ^ ((2 * a + (l16 >> 3)) & 7)) << 3));
#pragma unroll
                for (int d = 0; d < 2; ++d) acc[a][d] = __builtin_amdgcn_mfma_f32_16x16x32_bf16(ka, vb[d], acc[a][d], 0, 0, 0); }
        }
#pragma unroll
        for (int a = 0; a < 8; ++a)
#pragma unroll
            for (int d = 0; d < 2; ++d) { u32x2 o; o.x = cvt_pk_bf16(acc[a][d][0], acc[a][d][1]); o.y = cvt_pk_bf16(acc[a][d][2], acc[a][d][3]);
                *(u32x2*)(KC + ((size_t)item * 256 + 16 * (2 * w + d) + l16) * 128 + 16 * a + 4 * q) = o; }
        __syncthreads();
    }
}
__device__ __forceinline__ void gla_phase_b(const Params& P) {
    bf16_t* KC = (bf16_t*)(P.ws + WS_KC); const float* BEND = (const float*)(P.ws + WS_BEND);
    const int tidb = otid();
    for (int idx = blockIdx.x * 512 + tidb; idx < 32 * 4096; idx += gridDim.x * 512) {
        const int bh = idx >> 12, e = idx & 4095, dv = e >> 4, dk0 = (e & 15) * 8;
        float S[8];
#pragma unroll
        for (int j = 0; j < 8; ++j) S[j] = 0.f;
#pragma unroll 8
        for (int c = 0; c < 32; ++c) { const int item = bh * 32 + c;
            u32x4* p = (u32x4*)(KC + ((size_t)item * 256 + dv) * 128 + dk0); const u32x4 kc = *p;
            const f32x4 e0 = *(const f32x4*)(BEND + item * 128 + dk0), e1 = *(const f32x4*)(BEND + item * 128 + dk0 + 4);
            u32x4 o; o.x = cvt_pk_bf16(S[0], S[1]); o.y = cvt_pk_bf16(S[2], S[3]); o.z = cvt_pk_bf16(S[4], S[5]); o.w = cvt_pk_bf16(S[6], S[7]); *p = o;
            S[0] = __expf(e0.x) * S[0] + bflo(kc.x); S[1] = __expf(e0.y) * S[1] + bfhi(kc.x); S[2] = __expf(e0.z) * S[2] + bflo(kc.y); S[3] = __expf(e0.w) * S[3] + bfhi(kc.y);
            S[4] = __expf(e1.x) * S[4] + bflo(kc.z); S[5] = __expf(e1.y) * S[5] + bfhi(kc.z); S[6] = __expf(e1.z) * S[6] + bflo(kc.w); S[7] = __expf(e1.w) * S[7] + bfhi(kc.w); }
        float* o = P.out + O_GP + (size_t)bh * 32768;
#pragma unroll
        for (int j = 0; j < 8; ++j) o[(dk0 + j) * 256 + dv] = S[j];
    }
}
__device__ __forceinline__ void gla_phase_c(const Params& P, LAS unsigned char* lds) {
    const int tid = otid(), lane = tid & 63, w = tid >> 6, l16 = lane & 15, q = lane >> 4;
    LAS float* BC = (LAS float*)lds; LAS float* TOT = (LAS float*)(lds + 32768); LAS float* PART = (LAS float*)(lds + 34816);
    LAS bf16_t* QT = (LAS bf16_t*)(lds + 36864); LAS bf16_t* KT = (LAS bf16_t*)(lds + 54272);
    LAS bf16_t* VT = (LAS bf16_t*)(lds + 71680); LAS bf16_t* ATT = (LAS bf16_t*)(lds + 108544);
    const bf16_t* QKV = (const bf16_t*)(P.ws + WS_QKV); const bf16_t* KC = (const bf16_t*)(P.ws + WS_KC); bf16_t* Oo = (bf16_t*)(P.ws + WS_O);
    const float* gon = P.in[11];
    for (int item = blockIdx.x; item < 1024; item += gridDim.x) {
        const int b = item >> 7, h = (item >> 5) & 3, c = item & 31; const size_t tok0 = (size_t)b * 2048 + c * 64;
        const bf16_t* base = QKV + tok0 * NIN;
        u32x4 lw[2], qw[2], kw[2], vw[4]; bf16x8 sfr[4][2]; u32x2 rw[4][2];
#pragma unroll
        for (int i = 0; i < 2; ++i) { const int e = tid + 512 * i, t = e >> 4, d0 = (e & 15) * 8; lw[i] = *(const u32x4*)(base + (size_t)t * NIN + 3072 + h * 128 + d0);
            qw[i] = *(const u32x4*)(base + (size_t)t * NIN + h * 128 + d0); kw[i] = *(const u32x4*)(base + (size_t)t * NIN + 512 + h * 128 + d0); }
#pragma unroll
        for (int i = 0; i < 4; ++i) { const int e = tid + 512 * i, t = e >> 5, d0 = (e & 31) * 8; vw[i] = *(const u32x4*)(base + (size_t)t * NIN + 1024 + h * 256 + d0); }
#pragma unroll
        for (int kk = 0; kk < 4; ++kk)
#pragma unroll
            for (int d = 0; d < 2; ++d) sfr[kk][d] = *(const bf16x8*)(KC + ((size_t)item * 256 + 16 * (2 * w + d) + l16) * 128 + kk * 32 + q * 8);
#pragma unroll
        for (int tm = 0; tm < 4; ++tm)
#pragma unroll
            for (int d = 0; d < 2; ++d) rw[tm][d] = *(const u32x2*)(QKV + (tok0 + 16 * tm + l16) * NIN + 2048 + h * 256 + 16 * (2 * w + d) + 4 * q);
        gla_cumsum(BC, TOT, lw, tid);
#pragma unroll
        for (int i = 0; i < 2; ++i) { const int e = tid + 512 * i, t = e >> 4, d0 = (e & 15) * 8;
            const u32x4 wq = qw[i], wk = kw[i];
            float qv[8] = {bflo(wq.x), bfhi(wq.x), bflo(wq.y), bfhi(wq.y), bflo(wq.z), bfhi(wq.z), bflo(wq.w), bfhi(wq.w)};
            float kv[8] = {bflo(wk.x), bfhi(wk.x), bflo(wk.y), bfhi(wk.y), bflo(wk.z), bfhi(wk.z), bflo(wk.w), bfhi(wk.w)};
            float eb[8];
#pragma unroll
            for (int j = 0; j < 8; ++j) { eb[j] = BC[t * 128 + d0 + j]; qv[j] *= __expf(eb[j]); kv[j] *= __expf(-eb[j]); }
            u32x4 oq, ok; oq.x = cvt_pk_bf16(qv[0], qv[1]); oq.y = cvt_pk_bf16(qv[2], qv[3]); oq.z = cvt_pk_bf16(qv[4], qv[5]); oq.w = cvt_pk_bf16(qv[6], qv[7]);
            ok.x = cvt_pk_bf16(kv[0], kv[1]); ok.y = cvt_pk_bf16(kv[2], kv[3]); ok.z = cvt_pk_bf16(kv[4], kv[5]); ok.w = cvt_pk_bf16(kv[6], kv[7]);
            *(LAS u32x4*)(QT + t * 136 + d0) = oq; *(LAS u32x4*)(KT + t * 136 + d0) = ok; }
        gla_load_vt(VT, vw, tid);
        __syncthreads();
        {
            const int tm = w >> 1;
#pragma unroll
            for (int d = 0; d < 2; ++d) { const int sn = 2 * (w & 1) + d; f32x4 a = (f32x4){0.f, 0.f, 0.f, 0.f};
                if (sn <= tm) {
#pragma unroll
                    for (int kk = 0; kk < 4; ++kk) { const bf16x8 kf = *(const LAS bf16x8*)(KT + (16 * sn + l16) * 136 + kk * 32 + q * 8);
                        const bf16x8 qf = *(const LAS bf16x8*)(QT + (16 * tm + l16) * 136 + kk * 32 + q * 8);
                        a = __builtin_amdgcn_mfma_f32_16x16x32_bf16(kf, qf, a, 0, 0, 0); }
                }
                const int t = 16 * tm + l16, s0 = 16 * sn + 4 * q;
#pragma unroll
                for (int i = 0; i < 4; ++i) if (s0 + i > t) a[i] = 0.f;
                u32x2 o; o.x = cvt_pk_bf16(a[0], a[1]); o.y = cvt_pk_bf16(a[2], a[3]);
                *(LAS u32x2*)(ATT + t * 72 + s0) = o; }
        }
        __syncthreads();
        f32x4 acc[2][4];
#pragma unroll
        for (int d = 0; d < 2; ++d)
#pragma unroll
            for (int tm = 0; tm < 4; ++tm) acc[d][tm] = (f32x4){0.f, 0.f, 0.f, 0.f};
#pragma unroll
        for (int kk = 0; kk < 2; ++kk) {
            bf16x8 vf[2], af[4];
#pragma unroll
            for (int d = 0; d < 2; ++d) vf[d] = *(const LAS bf16x8*)(VT + (16 * (2 * w + d) + l16) * 72 + (((kk * 4 + q) ^ ((2 * (2 * w + d) + (l16 >> 3)) & 7)) << 3));
#pragma unroll
            for (int tm = 0; tm < 4; ++tm) af[tm] = *(const LAS bf16x8*)(ATT + (16 * tm + l16) * 72 + kk * 32 + q * 8);
#pragma unroll
            for (int d = 0; d < 2; ++d)
#pragma unroll
                for (int tm = 0; tm < 4; ++tm) acc[d][tm] = __builtin_amdgcn_mfma_f32_16x16x32_bf16(vf[d], af[tm], acc[d][tm], 0, 0, 0);
        }
#pragma unroll
        for (int kk = 0; kk < 4; ++kk) {
            bf16x8 sf[2], qf[4];
#pragma unroll
            for (int d = 0; d < 2; ++d) sf[d] = sfr[kk][d];
#pragma unroll
            for (int tm = 0; tm < 4; ++tm) qf[tm] = *(const LAS bf16x8*)(QT + (16 * tm + l16) * 136 + kk * 32 + q * 8);
#pragma unroll
            for (int d = 0; d < 2; ++d)
#pragma unroll
                for (int tm = 0; tm < 4; ++tm) acc[d][tm] = __builtin_amdgcn_mfma_f32_16x16x32_bf16(sf[d], qf[tm], acc[d][tm], 0, 0, 0);
        }
#pragma unroll
        for (int tm = 0; tm < 4; ++tm) { float ss = 0.f;
#pragma unroll
            for (int d = 0; d < 2; ++d) ss += (acc[d][tm][0] * acc[d][tm][0] + acc[d][tm][1] * acc[d][tm][1]) + (acc[d][tm][2] * acc[d][tm][2] + acc[d][tm][3] * acc[d][tm][3]);
            ss += __shfl_xor(ss, 16); ss += __shfl_xor(ss, 32);
            if (q == 0) PART[w * 64 + 16 * tm + l16] = ss; }
        __syncthreads();
#pragma unroll
        for (int tm = 0; tm < 4; ++tm) { float tot = 0.f;
#pragma unroll
            for (int ww = 0; ww < 8; ++ww) tot += PART[ww * 64 + 16 * tm + l16];
            const float rs = rsqrtf(tot * (1.0f / 256.0f) + EPS); const size_t tok = tok0 + 16 * tm + l16;
#pragma unroll
            for (int d = 0; d < 2; ++d) { const int dv0 = 16 * (2 * w + d) + 4 * q; const f32x4 g = *(const f32x4*)(gon + dv0);
                const u32x2 rr = rw[tm][d];
                u32x2 o; o.x = cvt_pk_bf16(acc[d][tm][0] * rs * g.x * siluf_(bflo(rr.x)), acc[d][tm][1] * rs * g.y * siluf_(bfhi(rr.x)));
                o.y = cvt_pk_bf16(acc[d][tm][2] * rs * g.z * siluf_(bflo(rr.y)), acc[d][tm][3] * rs * g.w * siluf_(bfhi(rr.y)));
                *(u32x2*)(Oo + tok * D + h * 256 + dv0) = o; } }
        __syncthreads();
    }
    LAS float* SQ = (LAS float*)lds; LAS float* SK = SQ + 512; LAS float* SE = SK + 512; LAS float* OS = SE + 512;   LAS float* WP = OS + 2048;
    for (int item = blockIdx.x; item < 512; item += gridDim.x) {
        const int b = item >> 2, h = item & 3; const size_t row0 = (size_t)MP + b * 4;
        { const int t = tid >> 7, dk = tid & 127; const bf16_t* r = QKV + (row0 + t) * NIN;
            SQ[tid] = bf2f(r[h * 128 + dk]); SK[tid] = bf2f(r[512 + h * 128 + dk]); SE[tid] = __expf(logf_gate(bf2f(r[3072 + h * 128 + dk]))); }
        __syncthreads();
        const int dv = tid & 255, half = tid >> 8;
        const float* s0 = P.in[2] + ((size_t)item * 128 + half * 64) * 256 + dv;
        float S[64];
#pragma unroll
        for (int i = 0; i < 64; ++i) S[i] = s0[i * 256];
        float vv[4];
#pragma unroll
        for (int t = 0; t < 4; ++t) vv[t] = bf2f(QKV[(row0 + t) * NIN + 1024 + h * 256 + dv]);
#pragma unroll
        for (int t = 0; t < 4; ++t) { float op = 0.f;
#pragma unroll
            for (int i = 0; i < 64; ++i) { const int dk = half * 64 + i; S[i] = SE[t * 128 + dk] * S[i] + SK[t * 128 + dk] * vv[t]; op += SQ[t * 128 + dk] * S[i]; }
            OS[(half * 4 + t) * 256 + dv] = op; }
        float* so = P.out + O_GS + ((size_t)item * 128 + half * 64) * 256 + dv;
#pragma unroll
        for (int i = 0; i < 64; ++i) so[i * 256] = S[i];
        __syncthreads();
        float o4[4];
#pragma unroll
        for (int t = 0; t < 4; ++t) { o4[t] = OS[t * 256 + dv] + OS[(4 + t) * 256 + dv]; const float s = wave_sum(o4[t] * o4[t]); if (tid < 256 && lane == 0) WP[w * 4 + t] = s; }
        __syncthreads();
        if (tid < 256) {
#pragma unroll
            for (int t = 0; t < 4; ++t) { const float tot = WP[t] + WP[4 + t] + WP[8 + t] + WP[12 + t]; const float rs = rsqrtf(tot * (1.0f / 256.0f) + EPS);
                const float r = bf2f(QKV[(row0 + t) * NIN + 2048 + h * 256 + dv]);
                Oo[(row0 + t) * D + h * 256 + dv] = f2bf(o4[t] * rs * gon[dv] * siluf_(r)); }
        }
        __syncthreads();
    }
}

__device__ __forceinline__ void s5_prefix_and_sample(const Params& P, LAS unsigned char* lds) {
    const int tid = otid(); const int lane = tid & 63, w = tid >> 6, gw = blockIdx.x * 8 + w, NGW = gridDim.x * 8;
    const float* sm = (const float*)(P.ws + WS_SMALL); const float* HL = (const float*)(P.ws + WS_HLOC); bf16_t* HS5 = (bf16_t*)(P.ws + WS_HS5);
    LAS float* TOT = (LAS float*)lds;
    for (int L = blockIdx.x; L < 256; L += gridDim.x) {
        int g, mt; { const int xcd = L & 7, idx = L >> 3, combo = xcd * 8 + (idx >> 2); g = (combo >> 2) * 4 + (idx & 3); mt = combo & 3; }
        const char* Aop = (const char*)(P.ws + WS_HS5) + (size_t)g * (1024 * 384 * 2) + (size_t)mt * (BM * 384 * 2);
        { OneUnit S1{{Aop, (const char*)(P.ws + WS_S5M) + (size_t)g * 262144, mt, g, 4, -1}}; EpiS5A E1{(float*)(P.ws + WS_HLOC)}; gemm_phase(lds, 384, 256, S1, E1); }
        asm volatile("s_waitcnt vmcnt(0)" ::: "memory"); __syncthreads();
        {
        const int seg = w & 3, b = 2 * mt + (w >> 2);
        const float ar = sm[SM_A16R + g * 64 + lane], ai = sm[SM_A16I + g * 64 + lane];
        const size_t col0 = (size_t)g * 1024 + b * 128 + seg * 32;
        float lr[32], li[32];
#pragma unroll
        for (int c = 0; c < 32; ++c) { lr[c] = HL[(col0 + c) * 128 + lane]; li[c] = HL[(col0 + c) * 128 + 64 + lane]; }
        float hr = 0.f, hi = 0.f;
#pragma unroll
        for (int c = 0; c < 32; ++c) { const float tr = lr[c], ti = li[c]; lr[c] = hr; li[c] = hi; const float nr = ar * hr - ai * hi + tr, ni = ar * hi + ai * hr + ti; hr = nr; hi = ni; }
        TOT[(w * 2 + 0) * 64 + lane] = hr; TOT[(w * 2 + 1) * 64 + lane] = hi;
        __syncthreads();
        float a32r = ar, a32i = ai;
#pragma unroll
        for (int k = 0; k < 5; ++k) { const float nr = a32r * a32r - a32i * a32i, ni = 2.f * a32r * a32i; a32r = nr; a32i = ni; }
        float cr = 0.f, ci = 0.f;
        for (int s = 0; s < seg; ++s) { const int ws_ = (w & 4) + s; const float tr = TOT[(ws_ * 2 + 0) * 64 + lane], ti = TOT[(ws_ * 2 + 1) * 64 + lane];
            const float nr = a32r * cr - a32i * ci + tr, ni = a32r * ci + a32i * cr + ti; cr = nr; ci = ni; }
        float pr_ = cr, pi_ = ci;
#pragma unroll
        for (int c = 0; c < 32; ++c) { HS5[(col0 + c) * 384 + 256 + lane] = f2bf(lr[c] + pr_); HS5[(col0 + c) * 384 + 320 + lane] = f2bf(li[c] + pi_);
            const float nr = ar * pr_ - ai * pi_, ni = ar * pi_ + ai * pr_; pr_ = nr; pi_ = ni; }
        if (seg == 3) { P.out[O_RP + (size_t)b * 4096 + g * 64 + lane] = hr + pr_; P.out[O_IP + (size_t)b * 4096 + g * 64 + lane] = hi + pi_; }
        }
        asm volatile("s_waitcnt vmcnt(0)" ::: "memory"); __syncthreads();
        { OneUnit S2{{Aop, (const char*)(P.ws + WS_S5M + 65536) + (size_t)g * 262144, mt, g, 6, -1}}; EpiS5B E2{P.ws, P.in[20]}; gemm_phase(lds, 384, 384, S2, E2); }
        __syncthreads();
    }
    const bf16_t* HSMP = (const bf16_t*)(P.ws + WS_HSMP); bf16_t* Z = (bf16_t*)(P.ws + WS_Z);
    LAS float* cb_ = (LAS float*)(lds + 4096 + w * 10752);
    LAS float* hb = cb_ + 2 * 16 * 68;
    for (int wv = gw; wv < 64 * 32; wv += NGW) {
        const int g = wv & 63, b0 = (wv >> 6) * 4, p = lane;
        const float ar = sm[SM_ARE + g * 64 + p], ai = sm[SM_AIM + g * 64 + p], fr = sm[SM_FRE + g * 64 + p], fi = sm[SM_FIM + g * 64 + p];
        f32x4 brv[4], biv[4], crv[4], civ[4];
#pragma unroll
        for (int c4 = 0; c4 < 4; ++c4) { brv[c4] = *(const f32x4*)(P.in[16] + ((size_t)g * 64 + p) * 16 + 4 * c4); biv[c4] = *(const f32x4*)(P.in[17] + ((size_t)g * 64 + p) * 16 + 4 * c4);
            crv[c4] = *(const f32x4*)(P.in[18] + (size_t)g * 1024 + (lane + 64 * c4) * 4); civ[c4] = *(const f32x4*)(P.in[19] + (size_t)g * 1024 + (lane + 64 * c4) * 4); }
        const int t = lane >> 4, cp = lane & 15; const float dsk = P.in[20][g * 16 + cp];
        float bbr[16], bbi[16];
#pragma unroll
        for (int c4 = 0; c4 < 4; ++c4) {
#pragma unroll
            for (int j = 0; j < 4; ++j) { bbr[4 * c4 + j] = fr * brv[c4][j] - fi * biv[c4][j]; bbi[4 * c4 + j] = fr * biv[c4][j] + fi * brv[c4][j]; }
            const int f = lane + 64 * c4, row = f >> 4, col = (f & 15) * 4;
            *(LAS f32x4*)(cb_ + row * 68 + col) = crv[c4]; *(LAS f32x4*)(cb_ + 16 * 68 + row * 68 + col) = civ[c4]; }
#pragma unroll 1
        for (int bb = 0; bb < 4; ++bb) { const int b = b0 + bb;
            u32x4 ua[4], ub[4];
#pragma unroll
            for (int tt = 0; tt < 4; ++tt) { ua[tt] = *(const u32x4*)(HSMP + (size_t)(b * 4 + tt) * D + g * 16); ub[tt] = *(const u32x4*)(HSMP + (size_t)(b * 4 + tt) * D + g * 16 + 8); }
            float hr = P.in[3][(size_t)b * 4096 + g * 64 + p], hi = P.in[4][(size_t)b * 4096 + g * 64 + p];
            const size_t row = (size_t)b * 4 + t; const float uu = bf2f(HSMP[row * D + g * 16 + cp]);
#pragma unroll
            for (int tt = 0; tt < 4; ++tt) { const u32x4 u0 = ua[tt], u1 = ub[tt];
                const float u[16] = {bflo(u0.x), bfhi(u0.x), bflo(u0.y), bfhi(u0.y), bflo(u0.z), bfhi(u0.z), bflo(u0.w), bfhi(u0.w),
                                     bflo(u1.x), bfhi(u1.x), bflo(u1.y), bfhi(u1.y), bflo(u1.z), bfhi(u1.z), bflo(u1.w), bfhi(u1.w)};
                float br = 0.f, bi = 0.f;
#pragma unroll
                for (int c = 0; c < 16; ++c) { br += bbr[c] * u[c]; bi += bbi[c] * u[c]; }
                const float nr = ar * hr - ai * hi + br, ni = ar * hi + ai * hr + bi; hr = nr; hi = ni;
                hb[(tt * 2 + 0) * 64 + p] = hr; hb[(tt * 2 + 1) * 64 + p] = hi; }
            P.out[O_RS + (size_t)b * 4096 + g * 64 + p] = hr; P.out[O_IS + (size_t)b * 4096 + g * 64 + p] = hi;
            asm volatile("s_waitcnt lgkmcnt(0)" ::: "memory");
            float y = 0.f;
#pragma unroll
            for (int i = 0; i < 16; ++i) { const f32x4 c4r = *(const LAS f32x4*)(cb_ + cp * 68 + 4 * i), c4i = *(const LAS f32x4*)(cb_ + 16 * 68 + cp * 68 + 4 * i);
                const f32x4 h4r = *(const LAS f32x4*)(hb + (t * 2 + 0) * 64 + 4 * i), h4i = *(const LAS f32x4*)(hb + (t * 2 + 1) * 64 + 4 * i);
                y += (c4r.x * h4r.x - c4i.x * h4i.x) + (c4r.y * h4r.y - c4i.y * h4i.y) + (c4r.z * h4r.z - c4i.z * h4i.z) + (c4r.w * h4r.w - c4i.w * h4i.w); }
            Z[((size_t)MP + row) * D + g * 16 + cp] = f2bf(y + dsk * uu);
            asm volatile("s_waitcnt lgkmcnt(0)" ::: "memory");
        }
    }
}

#define XB_TMO      128
#define XB_XCNT(j)  (256  + 64 * (j))
#define XB_XSUB(j)  (1280 + 64 * (j))
#define XB_XGEN(j)  (2304 + 64 * (j))
#define XB_TOP      3328
#define XB_TOPGEN   3392
#define XCD_BAR_WORDS 3456
#define XB_SPIN_CAP (1u << 22)
__device__ __forceinline__ unsigned xb_ld(unsigned* p)              { return __hip_atomic_load(p, __ATOMIC_RELAXED, __HIP_MEMORY_SCOPE_AGENT); }
__device__ __forceinline__ unsigned xb_add(unsigned* p, unsigned v) { return __hip_atomic_fetch_add(p, v, __ATOMIC_RELAXED, __HIP_MEMORY_SCOPE_AGENT); }
__device__ __forceinline__ unsigned xb_xcc_id() { return (unsigned)__builtin_amdgcn_s_getreg((3 << 11) | 20) & 0xFu; }
#define XB_SPIN(cond, bar) do { unsigned _sp = 0; while (cond) { __builtin_amdgcn_s_sleep(1); \
    if ((++_sp & 255u) == 0u) { if (xb_ld(&(bar)[XB_TMO])) break; if (_sp > XB_SPIN_CAP) { atomicAdd(&(bar)[XB_TMO], 1u); break; } } } } while (0)
struct XcdBarrier { unsigned* bar; unsigned x; volatile LAS unsigned* st; };
__device__ __forceinline__ XcdBarrier xcd_barrier_post(unsigned* bar, volatile LAS unsigned* st) {
    XcdBarrier b; b.bar = bar; b.x = xb_xcc_id(); b.st = st;
    if (threadIdx.x == 0) (void)xb_add(&bar[XB_XCNT(b.x)], 1u);
    return b;
}
__device__ __forceinline__ void xcd_barrier_complete(unsigned* bar, unsigned x, unsigned& nloc, unsigned& nx) {
    const unsigned G = gridDim.x * gridDim.y * gridDim.z;
    unsigned sum, cnt, mine, sp = 0u;
    for (;;) {
        sum = 0u; cnt = 0u; mine = 0u;
#pragma unroll
        for (unsigned j = 0; j < 16; ++j) { const unsigned c = xb_ld(&bar[XB_XCNT(j)]); sum += c; cnt += (c > 0u) ? 1u : 0u; mine = (j == x) ? c : mine; }
        if (sum == G) break;
        __builtin_amdgcn_s_sleep(1);
        if ((++sp & 255u) == 0u) { if (xb_ld(&bar[XB_TMO])) break; if (sp > XB_SPIN_CAP) { atomicAdd(&bar[XB_TMO], 1u); break; } }
    }
    nloc = mine > 0u ? mine : 1u; nx = cnt > 0u ? cnt : 1u;
}
__device__ __forceinline__ void xcd_barrier(const XcdBarrier& b) {
    asm volatile("s_waitcnt vmcnt(0)" ::: "memory");
    __syncthreads();
    if (threadIdx.x == 0) {
        unsigned* bar = b.bar;
        __builtin_amdgcn_s_waitcnt(0);
        unsigned nloc = b.st[0], nx = b.st[1];
        if (nloc == 0u) { xcd_barrier_complete(bar, b.x, nloc, nx); b.st[0] = nloc; b.st[1] = nx; }
        const unsigned old = xb_add(&bar[XB_XSUB(b.x)], 1u);
        const unsigned gen = old / nloc;
        if (old + 1u == (gen + 1u) * nloc) {
            __builtin_amdgcn_fence(__ATOMIC_RELEASE, "agent");
            asm volatile("s_waitcnt vmcnt(0)" ::: "memory");
            const unsigned og = xb_add(&bar[XB_TOP], 1u);
            const unsigned tg = og / nx;
            if (og + 1u == (tg + 1u) * nx) xb_add(&bar[XB_TOPGEN], 1u);
            else XB_SPIN(xb_ld(&bar[XB_TOPGEN]) == tg, bar);
            __builtin_amdgcn_fence(__ATOMIC_ACQUIRE, "agent");
            xb_add(&bar[XB_XGEN(b.x)], 1u);
            asm volatile("s_waitcnt vmcnt(0)" ::: "memory");
        } else {
            XB_SPIN(xb_ld(&bar[XB_XGEN(b.x)]) == gen, bar);
            __builtin_amdgcn_fence(__ATOMIC_ACQUIRE, "agent");
            asm volatile("s_waitcnt vmcnt(0)" ::: "memory");
        }
    }
    __syncthreads();
}

__global__ void __launch_bounds__(512, 2) fwd_kernel(Params P) {
    extern __shared__ __attribute__((aligned(16))) unsigned char lds_raw[];
    LAS unsigned char* lds = (LAS unsigned char*)lds_raw;
    cg::grid_group grid = cg::this_grid();
    const int lo = P.ph_lo, hi = P.ph_hi; int ph = 0;
    const int G = gridDim.x, cb = blockIdx.x;
    unsigned char* ws = P.ws;
    bf16_t* XB = (bf16_t*)(ws + WS_H); bf16_t* ACT = (bf16_t*)(ws + WS_ACT); bf16_t* Y = (bf16_t*)(ws + WS_Y);
    float* R2 = (float*)(ws + WS_SMALL) + SM_R2;
    unsigned long long pr_acc = 0ull, pr_t0 = 0ull;
#define PH_BEGIN if (PROBE_MASK) pr_t0 = __builtin_amdgcn_s_memrealtime(); if (lo <= ph && ph < hi) {
#define PH_END } ++ph; if (lo < ph && ph < hi) xcd_barrier(xbar); \
    if (PROBE_MASK && ((PROBE_MASK >> (ph - 1)) & 1u)) pr_acc += __builtin_amdgcn_s_memrealtime() - pr_t0;
    volatile LAS unsigned* xst = (volatile LAS unsigned*)(lds + LDS_BYTES - 64);
    if (threadIdx.x < 2) xst[threadIdx.x] = 0u;
    __syncthreads();
    if (ws == nullptr) grid.sync();
    XcdBarrier xbar; xbar.bar = (unsigned*)ws; xbar.x = 0; xbar.st = xst;
    if (hi - lo > 1) xbar = xcd_barrier_post((unsigned*)ws, xst);

    PH_BEGIN phase0(P, lds); PH_END

#define MIXER_GLA \
    PH_BEGIN { TileOrder S{M / BM, NIN / BM, (M / BM) * (NIN / BM), G, cb, (const char*)XB, (const char*)(ws + WS_WIN), (size_t)BM * D * 2, (size_t)BM * D * 2, D / BK}; \
        EpiPlain<1> E{(bf16_t*)(ws + WS_QKV), NIN, P.in[10], nullptr, R2}; gemm_phase(lds, D, D, S, E); } s5_idle_prep_inproj(P, lds); PH_END \
    PH_BEGIN gla_phase_a(P, lds); PH_END \
    PH_BEGIN gla_phase_b(P); PH_END \
    PH_BEGIN gla_phase_c(P, lds); PH_END \
    PH_BEGIN { SplitOrder S{{MP / BM, D / BM, (MP / BM) * (D / BM), G, cb, (const char*)(ws + WS_O), (const char*)(ws + WS_WOUT), (size_t)BM * D * 2, (size_t)BM * D * 2, D / BK}, D / 256}; \
        EpiPlain<0> E{Y, D, nullptr, PART, nullptr}; gemm_phase(lds, D, D, S, E); } PH_END
#define MIXER_S5 \
    PH_BEGIN s5_prefix_and_sample(P, lds); PH_END \
    PH_BEGIN { SplitOrder S{{MP / BM, 2 * D / BM, (MP / BM) * (2 * D / BM), G, cb, (const char*)(ws + WS_Z), (const char*)(ws + WS_WGLU), (size_t)BM * D * 2, (size_t)BM * D * 2, D / BK}, D / 256}; \
        EpiGated<1> E{Y, D, P.in[22], (float*)(ws + WS_HLOC)}; gemm_phase(lds, D, D, S, E); } PH_END
#define FFN_GEMMS(l, f, HOOK) \
    PH_BEGIN { TileOrder S{M / BM, NGU / BM, (M / BM) * (NGU / BM), G, cb, (const char*)XB, (const char*)(ws + WS_WGU + (size_t)((l) * 2 + (f)) * NGU * D * 2), (size_t)BM * D * 2, (size_t)BM * D * 2, D / BK}; \
        EpiGated<0> E{ACT, FF, nullptr, nullptr}; gemm_phase(lds, D, D, S, E); } HOOK PH_END \
    PH_BEGIN { SplitOrder S{{MP / BM, D / BM, (MP / BM) * (D / BM), G, cb, (const char*)ACT, (const char*)(ws + WS_WDN + (size_t)((l) * 2 + (f)) * D * FF * 2), (size_t)BM * FF * 2, (size_t)BM * FF * 2, FF / BK}, FF / 256}; \
        EpiPlain<0> E{Y, D, nullptr, PART, nullptr}; gemm_phase(lds, FF, FF, S, E); } PH_END
    const float* ng0 = P.in[5]; const float* ng1 = P.in[5] + 6 * D;
    float* PART = (float*)(ws + WS_PART);
    FFN_GEMMS(0, 0, s5_idle_prep(P, lds, 0);)
    PH_BEGIN row_pass<3, FF / 256>(P.in[0], P.in[1], XB, R2, Y, ng0 + 1 * D, 0.5f, PART, nullptr, nullptr, nullptr, nullptr); PH_END
    MIXER_GLA
    PH_BEGIN row_pass<3, D / 256>(nullptr, nullptr, XB, R2, Y, ng0 + 3 * D, 1.0f, PART, nullptr, nullptr, nullptr, nullptr); PH_END
    FFN_GEMMS(0, 1, s5_idle_prep(P, lds, 1);)
    PH_BEGIN row_pass<3, FF / 256>(nullptr, nullptr, XB, R2, Y, ng0 + 5 * D, 0.5f, PART, nullptr, nullptr, nullptr, nullptr); PH_END
    FFN_GEMMS(1, 0, s5_idle_prep(P, lds, 2);)
    PH_BEGIN row_pass<3, FF / 256>(nullptr, nullptr, XB, R2, Y, ng1 + 1 * D, 0.5f, PART, nullptr, ng1 + 2 * D, (bf16_t*)(ws + WS_HS5), (bf16_t*)(ws + WS_HSMP)); PH_END
    MIXER_S5
    PH_BEGIN row_pass<3, D / 256>(nullptr, nullptr, XB, R2, Y, ng1 + 3 * D, 1.0f, (const float*)(ws + WS_HLOC), nullptr, nullptr, nullptr, nullptr, P.in[22]); PH_END
    FFN_GEMMS(1, 1, )
    PH_BEGIN row_pass<2, FF / 256>(nullptr, nullptr, XB, R2, Y, ng1 + 5 * D, 0.5f, PART, P.out + O_X, nullptr, nullptr, nullptr); PH_END
    if (PROBE_MASK && blockIdx.x == 0 && threadIdx.x == 0) { const unsigned long long t1 = __builtin_amdgcn_s_memrealtime(); while (__builtin_amdgcn_s_memrealtime() - t1 < pr_acc) __builtin_amdgcn_s_sleep(8); }
#undef PH_BEGIN
#undef PH_END
}

__global__ void dbg_checksum(const unsigned* w, size_t nwords, float* out, size_t nout) {
    for (size_t i = (size_t)blockIdx.x * blockDim.x + threadIdx.x; i < nout; i += (size_t)gridDim.x * blockDim.x) {
        unsigned h = 0; for (int j = 0; j < 3; ++j) { const size_t k = 3 * i + j; if (k < nwords) h = h * 0x9E3779B1u + w[k]; }
        out[i] = (float)(h & 0xffffu);
    }
}
extern "C" void kernel_launch(void* const* d_in, const int* in_sizes, int n_in, void* d_out, int out_size, void* d_ws, size_t ws_size, hipStream_t stream) {
    static int grid = 0;
    if (grid == 0) {
        if (n_in != 23 || ws_size < WS_END) { fprintf(stderr, "kernel_launch: unexpected n_in %d or ws_size %zu (< %zu)\n", n_in, ws_size, (size_t)WS_END); grid = -1; return; }
        int dev = 0, cus = 0, per_cu = 0;
        hipGetDevice(&dev); hipDeviceGetAttribute(&cus, hipDeviceAttributeMultiprocessorCount, dev);
        if (hipFuncSetAttribute((const void*)fwd_kernel, hipFuncAttributeMaxDynamicSharedMemorySize, LDS_BYTES) != hipSuccess) { fprintf(stderr, "kernel_launch: hipFuncSetAttribute failed\n"); grid = -1; return; }
        if (hipOccupancyMaxActiveBlocksPerMultiprocessor(&per_cu, (const void*)fwd_kernel, 512, LDS_BYTES) != hipSuccess || per_cu < 1) { fprintf(stderr, "kernel_launch: occupancy query failed (%d)\n", per_cu); grid = -1; return; }
        grid = cus * per_cu;
    }
    if (grid < 0) return;
    if (hipMemsetAsync(d_ws, 0, 16384, stream) != hipSuccess) { fprintf(stderr, "kernel_launch: memset failed\n"); return; }
    Params p{};
    for (int i = 0; i < 23; ++i) p.in[i] = (const float*)d_in[i];
    p.out = (float*)d_out; p.ws = (unsigned char*)d_ws;
#if MULTI_LAUNCH
    for (int k = 0; k < (DBG_NPH ? DBG_NPH : NPH); ++k) { p.ph_lo = k; p.ph_hi = k + 1; hipLaunchKernelGGL(fwd_kernel, dim3(grid), dim3(512), LDS_BYTES, stream, p); }
#if DBG_NPH
    hipLaunchKernelGGL(dbg_checksum, dim3(2048), dim3(256), 0, stream, (const unsigned*)d_ws, (size_t)(WS_END / 4), (float*)d_out, (size_t)out_size);
#endif
#else
    p.ph_lo = 0; p.ph_hi = NPH;
    void* args[] = {&p};
    hipError_t e = hipLaunchCooperativeKernel((const void*)fwd_kernel, dim3(grid), dim3(512), args, LDS_BYTES, stream);
    if (e != hipSuccess) fprintf(stderr, "cooperative launch failed: %s (grid %d)\n", hipGetErrorString(e), grid);
#endif
}
```

```cpp
#include <hip/hip_runtime.h>
#include <hip/hip_cooperative_groups.h>
#include <cstdio>
namespace cg = cooperative_groups;

#ifndef MULTI_LAUNCH
#define MULTI_LAUNCH 0
#endif

#ifndef PROBE_MASK
#define PROBE_MASK 0u
#endif
#ifndef DBG_NPH
#define DBG_NPH 0
#endif
#define LAS __attribute__((address_space(3)))
typedef unsigned short bf16_t;
typedef short bf16x8 __attribute__((ext_vector_type(8)));
typedef float f32x4 __attribute__((ext_vector_type(4)));
typedef unsigned u32x4 __attribute__((ext_vector_type(4)));
typedef unsigned u32x2 __attribute__((ext_vector_type(2)));

constexpr int D = 1024, FF = 2816, NGU = 5632, MP = 16384, MS = 512, M = MP + MS;
constexpr int NIN = 3584;
constexpr int LDIN = 3088;
constexpr float EPS = 1e-6f;
constexpr int NPH = 22;

constexpr size_t O_X = 0, O_GP = 17301504, O_RP = 18350080, O_IP = 18382848, O_GS = 18415616, O_RS = 35192832, O_IS = 35717120;

constexpr size_t MiB = 1u << 20;
constexpr size_t WS_WGU = 1 * MiB;
constexpr size_t WS_WDN = WS_WGU + 44 * MiB;
constexpr size_t WS_WIN = WS_WDN + 22 * MiB;
constexpr size_t WS_WOUT = WS_WIN + 7 * MiB;
constexpr size_t WS_WGLU = WS_WOUT + 2 * MiB;
constexpr size_t WS_S5M = WS_WGLU + 4 * MiB;
constexpr size_t WS_SMALL = WS_S5M + 16 * MiB;
constexpr size_t WS_HSMP = WS_SMALL + 1 * MiB;
constexpr size_t WS_H = WS_SMALL + 2 * MiB;
constexpr size_t WS_BIG = WS_H + 33 * MiB;
constexpr size_t WS_ACT = WS_BIG;
constexpr size_t WS_Y = WS_BIG + 92 * MiB;
constexpr size_t WS_QKV = WS_BIG;
constexpr size_t WS_KC = WS_BIG + 116 * MiB;
constexpr size_t WS_BEND = WS_BIG + 180 * MiB;
constexpr size_t WS_HS5 = WS_BIG;
constexpr size_t WS_HLOC = WS_BIG + 48 * MiB;
constexpr size_t WS_Z = WS_BIG + 128 * MiB;
constexpr size_t WS_PART = WS_BIG + 128 * MiB;
constexpr size_t WS_O = WS_BIG + 181 * MiB;
constexpr size_t WS_END = WS_BIG + 214 * MiB;
constexpr size_t S5M_G = 262144;
constexpr int SM_R2 = 32768;
constexpr int SM_ARE = 0, SM_AIM = 4096, SM_FRE = 8192, SM_FIM = 12288, SM_A16R = 16384, SM_A16I = 20480;

constexpr int LDS_BYTES = 147456;

typedef __bf16 bf16x2_t __attribute__((ext_vector_type(2)));
typedef float f32x2_t __attribute__((ext_vector_type(2)));
__device__ __forceinline__ unsigned cvt_pk_bf16(float lo, float hi) { const f32x2_t v = {lo, hi}; const bf16x2_t b = __builtin_convertvector(v, bf16x2_t); return __builtin_bit_cast(unsigned, b); }
__device__ __forceinline__ float bflo(unsigned w) { return __uint_as_float(w << 16); }
__device__ __forceinline__ float bfhi(unsigned w) { return __uint_as_float(w & 0xffff0000u); }
__device__ __forceinline__ float bf2f(bf16_t b) { return __uint_as_float(((unsigned)b) << 16); }
__device__ __forceinline__ bf16_t f2bf(float f) { return (bf16_t)(cvt_pk_bf16(f, 0.f) & 0xffffu); }
__device__ __forceinline__ float wave_sum(float v) {
#pragma unroll
    for (int o = 1; o < 64; o <<= 1) v += __shfl_xor(v, o);
    return v;
}
__device__ __forceinline__ int otid() { int t = threadIdx.x; asm volatile("" : "+v"(t)); return t; }
__device__ __forceinline__ float sigmoidf_(float a) { return __builtin_amdgcn_rcpf(1.0f + __expf(-a)); }
__device__ __forceinline__ float siluf_(float a) { return a * sigmoidf_(a); }
__device__ __forceinline__ float logf_gate(float z) { return (fminf(z, 0.f) - __logf(1.0f + __expf(-fabsf(z)))) * 0.0625f; }

constexpr int BM = 256, BK = 64, HALF = 128, HTB = HALF * BK * 2;
__device__ __forceinline__ int lds_byte(int r, int c) { const int st = (r >> 4) * 2 + (c >> 5), rr = r & 15, cc = c & 31, ob = rr * 64 + cc * 2; return st * 1024 + (ob ^ (((ob >> 9) & 1) << 5)); }
__device__ __forceinline__ void stage_rc(int b, int& R, int& C) { const int st = b / 1024, sb = b % 1024, swz = sb ^ (((sb >> 9) & 1) << 5); R = (st >> 1) * 16 + swz / 64; C = (st & 1) * 32 + (swz % 64) / 2; }
__device__ __forceinline__ int perm32(int rho) { const int n = rho >> 4, i = rho & 15; return 8 * (i >> 2) + 4 * n + (i & 3); }

struct Unit { const char* A; const char* B; int pm, pn, nt, ks; };

struct TileOrder {
    int nM, nN, nwg, G, c; const char* A0; const char* B0; size_t at, bt; int ntk;
    __device__ __forceinline__ bool next(int i, Unit& u) const {
        const long L = (long)i * G + c; if (L >= nwg) return false;
        u.nt = ntk; u.ks = -1;
        int wgid = (int)L; { const int q = nwg / 8, r = nwg % 8, xcd = wgid % 8, off = wgid / 8; wgid = (xcd < r ? xcd * (q + 1) : r * (q + 1) + (xcd - r) * q) + off; }
        const int nig = 8 * nN, gid = wgid / nig, fm = gid * 8, gsz = (nM - fm) < 8 ? (nM - fm) : 8;
        u.pm = fm + ((wgid % nig) % gsz); u.pn = (wgid % nig) / gsz;
        u.A = A0 + (size_t)u.pm * at; u.B = B0 + (size_t)u.pn * bt; return true;
    }
};
struct SplitOrder {
    TileOrder T; int nks;
    __device__ __forceinline__ bool next(int i, Unit& u) const {
        const int L = i * T.G + T.c;
        if (L < T.nwg) return T.next(i, u);
        const int j = L - T.nwg, ns = 2 * T.nN; if (j >= ns * nks) return false;
        const int st = j % ns, ks = j / ns; u.pm = 64 + st / T.nN; u.pn = st % T.nN; u.nt = 4; u.ks = ks;
        u.A = T.A0 + (size_t)u.pm * T.at + (size_t)ks * 512; u.B = T.B0 + (size_t)u.pn * T.bt + (size_t)ks * 512; return true;
    }
};
struct OneUnit { Unit u; __device__ __forceinline__ bool next(int i, Unit& o) const { if (i) return false; o = u; return true; } };
struct S5Order {
    int G, c; const char* A0; const char* B0; int ntk;
    __device__ __forceinline__ bool next(int i, Unit& u) const {
        const int L = i * G + c; if (L >= 256) return false;
        u.nt = ntk; u.ks = -1;
        { const int xcd = L & 7, idx = L >> 3, combo = xcd * 8 + (idx >> 2); u.pn = (combo >> 2) * 4 + (idx & 3); u.pm = combo & 3; }
        u.A = A0 + (size_t)u.pn * (1024 * 384 * 2) + (size_t)u.pm * (BM * 384 * 2); u.B = B0 + (size_t)u.pn * 262144; return true;
    }
};

template <class Epi, class Sched>
__device__ __forceinline__ void gemm_phase(LAS unsigned char* lds, const int lda, const int ldb, const Sched& S, const Epi& E) {
    int tid_ = threadIdx.x; asm volatile("" : "+v"(tid_));
    const int tid = tid_, wid = __builtin_amdgcn_readfirstlane(tid >> 6), lane = tid & 63, wr = wid >> 2, wc = wid & 3, fr = lane & 15, fq = lane >> 4;
    unsigned voffA[2], voffB[2];
#pragma unroll
    for (int i = 0; i < 2; ++i) { int R, C; stage_rc(tid * 16 + i * 8192, R, C); const int Rb = (R & ~31) + perm32(R & 31);
        voffA[i] = (unsigned)(R * lda + C) * 2u; voffB[i] = (unsigned)(Rb * ldb + C) * 2u; }
    const size_t kstep = (size_t)(BK * 2);
    const size_t hstepA = (size_t)HALF * lda * 2, hstepB = (size_t)HALF * ldb * 2;
    const unsigned ldsw = (unsigned)wid * 1024u;
    const int aoff = lds_byte(wr * 64 + fr, fq * 8), boff = lds_byte(wc * 32 + fr, fq * 8);
#define PG8_SA(b, h) (((b) * 2 + (h)) * HTB)
#define PG8_SB(b, h) ((4 + (b) * 2 + (h)) * HTB)
#define PG8_STAGE(bufoff, gbase, voff) do { _Pragma("unroll") for (int _i = 0; _i < 2; ++_i) \
        __builtin_amdgcn_global_load_lds((const unsigned*)((const char*)(gbase) + (voff)[_i]), (LAS unsigned*)(lds + (bufoff) + ldsw + _i * 8192), 16, 0, 0); } while (0)
#define PG8_LDA(dst, b, h) do { _Pragma("unroll") for (int m = 0; m < 4; ++m) _Pragma("unroll") for (int k = 0; k < 2; ++k) dst[m][k] = *(const LAS bf16x8*)(lds + PG8_SA(b, h) + aoff + m * 2048 + k * 1024); } while (0)
#define PG8_LDB(dst, b, h) do { _Pragma("unroll") for (int n = 0; n < 2; ++n) _Pragma("unroll") for (int k = 0; k < 2; ++k) dst[n][k] = *(const LAS bf16x8*)(lds + PG8_SB(b, h) + boff + n * 2048 + k * 1024); } while (0)
#define PG8_MMA(ai, bj, At, Bt) do { __builtin_amdgcn_s_setprio(1); _Pragma("unroll") for (int m = 0; m < 4; ++m) _Pragma("unroll") for (int n = 0; n < 2; ++n) _Pragma("unroll") for (int k = 0; k < 2; ++k) \
        acc[ai][bj][m][n] = __builtin_amdgcn_mfma_f32_16x16x32_bf16(Bt[n][k], At[m][k], acc[ai][bj][m][n], 0, 0, 0); __builtin_amdgcn_s_setprio(0); } while (0)
#define PG8_WAIT_V(n) asm volatile("s_waitcnt vmcnt(" #n ")" ::: "memory")
#define PG8_WAIT_L(n) asm volatile("s_waitcnt lgkmcnt(" #n ")" ::: "memory")
#define PG8_BAR __builtin_amdgcn_s_barrier()
#define PG8_SCHED __builtin_amdgcn_sched_barrier(0)
    Unit cur, nxt; int ui = 0;
    if (!S.next(0, cur)) return;
    f32x4 acc[2][2][4][2];
#pragma unroll
    for (int a = 0; a < 2; ++a)
#pragma unroll
        for (int b = 0; b < 2; ++b)
#pragma unroll
            for (int m = 0; m < 4; ++m)
#pragma unroll
                for (int n = 0; n < 2; ++n) acc[a][b][m][n] = (f32x4){0.f, 0.f, 0.f, 0.f};
    bf16x8 At[4][2], B0[2][2], B1[2][2];
    const char* cA = cur.A; const char* cB = cur.B;
    PG8_STAGE(PG8_SB(0, 0), cB, voffB); PG8_STAGE(PG8_SA(0, 0), cA, voffA); PG8_STAGE(PG8_SB(0, 1), cB + hstepB, voffB); PG8_STAGE(PG8_SA(0, 1), cA + hstepA, voffA);
    if (wr == 1) PG8_BAR;
    PG8_WAIT_V(4); PG8_BAR;
    PG8_STAGE(PG8_SB(1, 0), cB + kstep, voffB); PG8_STAGE(PG8_SA(1, 0), cA + kstep, voffA); PG8_STAGE(PG8_SB(1, 1), cB + hstepB + kstep, voffB);
    PG8_WAIT_V(6); PG8_BAR;
    for (;;) {
        const bool has_next = S.next(ui + 1, nxt);
        const char* nA = has_next ? nxt.A : cA; const char* nB = has_next ? nxt.B : cB;
        const int nt = cur.nt;
        for (int t = 0; t < nt; t += 2) {
            const bool last = (t == nt - 2);
            const char* a1 = cA + (size_t)(t + 1) * kstep;
            const char* a2 = last ? nA : cA + (size_t)(t + 2) * kstep; const char* b2 = last ? nB : cB + (size_t)(t + 2) * kstep;
            const char* a3 = a2 + kstep; const char* b3 = b2 + kstep;
            PG8_LDB(B0, 0, 0); PG8_SCHED; PG8_LDA(At, 0, 0); PG8_STAGE(PG8_SA(1, 1), a1 + hstepA, voffA);
            PG8_WAIT_L(8); PG8_BAR; PG8_WAIT_L(0); PG8_MMA(0, 0, At, B0); PG8_BAR; PG8_SCHED;
            PG8_LDB(B1, 0, 1); PG8_STAGE(PG8_SB(0, 0), b2, voffB);
            PG8_BAR; PG8_WAIT_L(0); PG8_MMA(0, 1, At, B1); PG8_BAR;
            PG8_LDA(At, 0, 1); PG8_STAGE(PG8_SA(0, 0), a2, voffA);
            PG8_BAR; PG8_WAIT_L(0); PG8_MMA(1, 0, At, B0); PG8_BAR; PG8_SCHED;
            PG8_STAGE(PG8_SB(0, 1), b2 + hstepB, voffB);
            PG8_WAIT_V(6); PG8_BAR; PG8_MMA(1, 1, At, B1); PG8_BAR;
            PG8_LDB(B0, 1, 0); PG8_SCHED; PG8_LDA(At, 1, 0); PG8_STAGE(PG8_SA(0, 1), a2 + hstepA, voffA);
            PG8_WAIT_L(8); PG8_BAR; PG8_WAIT_L(0); PG8_MMA(0, 0, At, B0); PG8_BAR; PG8_SCHED;
            PG8_LDB(B1, 1, 1); PG8_STAGE(PG8_SB(1, 0), b3, voffB);
            PG8_BAR; PG8_WAIT_L(0); PG8_MMA(0, 1, At, B1); PG8_BAR;
            PG8_LDA(At, 1, 1); PG8_STAGE(PG8_SA(1, 0), a3, voffA);
            PG8_BAR; PG8_WAIT_L(0); PG8_MMA(1, 0, At, B0); PG8_BAR; PG8_SCHED;
            PG8_STAGE(PG8_SB(1, 1), b3 + hstepB, voffB);
            PG8_WAIT_V(6); PG8_BAR; PG8_MMA(1, 1, At, B1); PG8_BAR;
        }
        E(acc, cur, wr, wc, fr, fq);
        if (!has_next) break;
#pragma unroll
        for (int a = 0; a < 2; ++a)
#pragma unroll
            for (int b = 0; b < 2; ++b)
#pragma unroll
                for (int m = 0; m < 4; ++m)
#pragma unroll
                    for (int n = 0; n < 2; ++n) acc[a][b][m][n] = (f32x4){0.f, 0.f, 0.f, 0.f};
        cur = nxt; cA = nA; cB = nB; ++ui;
    }
    PG8_WAIT_V(0);
    if (wr == 0) PG8_BAR;
    PG8_BAR;
#undef PG8_SA
#undef PG8_SB
#undef PG8_STAGE
#undef PG8_LDA
#undef PG8_LDB
#undef PG8_MMA
#undef PG8_WAIT_V
#undef PG8_WAIT_L
#undef PG8_BAR
#undef PG8_SCHED
}

template <int MODE>
struct EpiGated {
    bf16_t* O; int ldc; const float* bias; float* part;
    __device__ __forceinline__ void operator()(const f32x4 (&acc)[2][2][4][2], const Unit& u, int wr, int wc, int fr, int fq) const {
        const int row0 = u.pm * BM + wr * 64 + fr, col0 = u.pn * 128 + wc * 32 + 8 * fq;
        if (MODE == 1 && u.ks >= 0) {
#pragma unroll
            for (int bj = 0; bj < 2; ++bj)
#pragma unroll
                for (int ai = 0; ai < 2; ++ai)
#pragma unroll
                    for (int m = 0; m < 4; ++m) { float* p = part + ((size_t)u.ks * MS + (row0 + ai * HALF + m * 16 - MP)) * (2 * ldc) + u.pn * BM + bj * HALF + wc * 32 + 8 * fq;
                        *(f32x4*)p = acc[ai][bj][m][0]; *(f32x4*)(p + 4) = acc[ai][bj][m][1]; }
            return;
        }
        f32x4 b0[2], b1[2];
#pragma unroll
        for (int n = 0; n < 2; ++n) { b0[n] = (f32x4){0.f, 0.f, 0.f, 0.f}; b1[n] = b0[n];
            if (MODE == 1) { b0[n] = *(const f32x4*)(bias + col0 + 4 * n); b1[n] = *(const f32x4*)(bias + ldc + col0 + 4 * n); } }
#pragma unroll
        for (int ai = 0; ai < 2; ++ai)
#pragma unroll
            for (int m = 0; m < 4; ++m) {
                float v[8]; const float rs = 1.0f;
#pragma unroll
                for (int n = 0; n < 2; ++n)
#pragma unroll
                    for (int j = 0; j < 4; ++j) { const float a = acc[ai][0][m][n][j] * rs + b0[n][j], b = acc[ai][1][m][n][j] * rs + b1[n][j];
                        v[4 * n + j] = (MODE == 0) ? (a * b) * __builtin_amdgcn_rcpf(1.0f + __builtin_amdgcn_exp2f(-a))
                                                   : a * sigmoidf_(b); }
                u32x4 w; w.x = cvt_pk_bf16(v[0], v[1]); w.y = cvt_pk_bf16(v[2], v[3]); w.z = cvt_pk_bf16(v[4], v[5]); w.w = cvt_pk_bf16(v[6], v[7]);
                *(u32x4*)(O + (size_t)(row0 + ai * HALF + m * 16) * ldc + col0) = w;
            }
    }
};
template <int GLA>
struct EpiPlain {
    bf16_t* O; int ldc; const float* bg; float* part; const float* r2;
    __device__ __forceinline__ void operator()(const f32x4 (&acc)[2][2][4][2], const Unit& u, int wr, int wc, int fr, int fq) const {
        const int row0 = u.pm * BM + wr * 64 + fr, col0 = u.pn * BM + wc * 32 + 8 * fq;
        if (!GLA && u.ks >= 0) {
#pragma unroll
            for (int bj = 0; bj < 2; ++bj)
#pragma unroll
                for (int ai = 0; ai < 2; ++ai)
#pragma unroll
                    for (int m = 0; m < 4; ++m) { float* p = part + ((size_t)u.ks * MS + (row0 + ai * HALF + m * 16 - MP)) * D + col0 + bj * HALF;
                        *(f32x4*)p = acc[ai][bj][m][0]; *(f32x4*)(p + 4) = acc[ai][bj][m][1]; }
            return;
        }
        const bool lf = GLA && (u.pn >= 12);
#pragma unroll
        for (int bj = 0; bj < 2; ++bj) {
            f32x4 bb[2];
#pragma unroll
            for (int n = 0; n < 2; ++n) bb[n] = lf ? *(const f32x4*)(bg + (col0 - 3072) + bj * HALF + 4 * n) : (f32x4){0.f, 0.f, 0.f, 0.f};
#pragma unroll
            for (int ai = 0; ai < 2; ++ai)
#pragma unroll
                for (int m = 0; m < 4; ++m) {
                    float v[8]; const float rs = 1.0f;
#pragma unroll
                    for (int n = 0; n < 2; ++n)
#pragma unroll
                        for (int j = 0; j < 4; ++j) { float a = acc[ai][bj][m][n][j] * rs;
                            if (lf) a += bb[n][j];
                            v[4 * n + j] = a; }
                    u32x4 w; w.x = cvt_pk_bf16(v[0], v[1]); w.y = cvt_pk_bf16(v[2], v[3]); w.z = cvt_pk_bf16(v[4], v[5]); w.w = cvt_pk_bf16(v[6], v[7]);
                    *(u32x4*)(O + (size_t)(row0 + ai * HALF + m * 16) * ldc + col0 + bj * HALF) = w;
                }
        }
    }
};
struct EpiS5A {
    bf16_t* HL;
    __device__ __forceinline__ void operator()(const f32x4 (&acc)[2][2][4][2], const Unit& u, int wr, int wc, int fr, int fq) const {
        const int row0 = u.pm * BM + wr * 64 + fr, col0 = wc * 32 + 8 * fq;
#pragma unroll
        for (int ai = 0; ai < 2; ++ai)
#pragma unroll
            for (int m = 0; m < 4; ++m) { const f32x4 a0 = acc[ai][0][m][0], a1 = acc[ai][0][m][1];
                u32x4 w; w.x = cvt_pk_bf16(a0[0], a0[1]); w.y = cvt_pk_bf16(a0[2], a0[3]); w.z = cvt_pk_bf16(a1[0], a1[1]); w.w = cvt_pk_bf16(a1[2], a1[3]);
                *(u32x4*)(HL + ((size_t)u.pn * 1024 + row0 + ai * HALF + m * 16) * 128 + col0) = w; }
    }
};
struct EpiS5B {
    unsigned char* ws; const float* dsk;
    __device__ __forceinline__ void operator()(const f32x4 (&acc)[2][2][4][2], const Unit& u, int wr, int wc, int fr, int fq) const {
        bf16_t* Z = (bf16_t*)(ws + WS_Z); const bf16_t* HS5 = (const bf16_t*)(ws + WS_HS5);
        asm volatile("" : "+v"(fq));
        const int g = u.pn, c0 = (8 * fq) & 15;
        const f32x4 d0 = *(const f32x4*)(dsk + g * 16 + c0), d1 = *(const f32x4*)(dsk + g * 16 + c0 + 4);
#pragma unroll
        for (int bj = 0; bj < 2; ++bj) { const int t = 8 * bj + 2 * wc + (fq >> 1);
#pragma unroll
            for (int ai = 0; ai < 2; ++ai)
#pragma unroll
                for (int m = 0; m < 4; ++m) { const int colr = u.pm * BM + ai * HALF + wr * 64 + m * 16 + fr; const size_t off = (size_t)(colr * 16 + t) * D + g * 16 + c0;
                    const u32x4 uu = *(const u32x4*)(HS5 + ((size_t)g * 1024 + colr) * 384 + t * 16 + c0); const f32x4 a0 = acc[ai][bj][m][0], a1 = acc[ai][bj][m][1];
                    u32x4 w; w.x = cvt_pk_bf16(a0[0] + d0[0] * bflo(uu.x), a0[1] + d0[1] * bfhi(uu.x)); w.y = cvt_pk_bf16(a0[2] + d0[2] * bflo(uu.y), a0[3] + d0[3] * bfhi(uu.y));
                    w.z = cvt_pk_bf16(a1[0] + d1[0] * bflo(uu.z), a1[1] + d1[1] * bfhi(uu.z)); w.w = cvt_pk_bf16(a1[2] + d1[2] * bflo(uu.w), a1[3] + d1[3] * bfhi(uu.w));
                    *(u32x4*)(Z + off) = w; }
        }
    }
};

struct Params { const float* in[23]; float* out; unsigned char* ws; int ph_lo, ph_hi; };

__device__ __forceinline__ int rp_row(int kidx, int gw, int NGW) {
    if (NGW % MS == 0) { const int stride = NGW / MS, kp = (MP + NGW - 1) / NGW;
        if (kidx == 0) return (gw % stride == 0) ? MP + gw / stride : -1;
        if (kidx > kp) return -1;
        const int m = gw + (kidx - 1) * NGW; return m < MP ? m : -1; }
    const int KMAX = (M + NGW - 1) / NGW; if (kidx >= KMAX) return -1;
    const int kk = (kidx + KMAX - 1) % KMAX, m = gw + kk * NGW; return m < M ? m : -1;
}
template <int R, int NKS>
__device__ __forceinline__ void row_pass(const float* xf_p, const float* xf_s, bf16_t* XB, float* R2, const bf16_t* Y, const float* g_post, float scale,
                                         const float* part, float* outf, const float* g_pre, bf16_t* HS5, bf16_t* HSMP, const float* glu_bias = nullptr) {
    const int tid = otid(); const int lane = tid & 63, gw = blockIdx.x * 8 + (tid >> 6), NGW = gridDim.x * 8;
#define CJ(j) (512 * ((j) >> 1) + 8 * lane + 4 * ((j) & 1))
    const int KMAX = (NGW % MS == 0) ? (MP + NGW - 1) / NGW + 1 : (M + NGW - 1) / NGW;
    for (int k0 = 0; k0 < KMAX; k0 += R) {
        f32x4 v[R][4], yv[R][4];
#pragma unroll
        for (int r = 0; r < R; ++r) { const int mi = rp_row(k0 + r, gw, NGW), m = mi >= 0 ? mi : gw;
            if (xf_p) { const float* xr = (m < MP) ? xf_p + (size_t)m * D : xf_s + (size_t)(m - MP) * D;
#pragma unroll
                for (int j = 0; j < 4; ++j) v[r][j] = *(const f32x4*)(xr + CJ(j));
            } else {
                const float ir = 1.0f / R2[m];
#pragma unroll
                for (int jj = 0; jj < 2; ++jj) { const u32x4 w = *(const u32x4*)(XB + (size_t)m * D + 512 * jj + 8 * lane);
                    v[r][2 * jj] = (f32x4){bflo(w.x), bfhi(w.x), bflo(w.y), bfhi(w.y)} * ir; v[r][2 * jj + 1] = (f32x4){bflo(w.z), bfhi(w.z), bflo(w.w), bfhi(w.w)} * ir; }
            }
            if (Y) {
                if (glu_bias && m >= MP) {
#pragma unroll
                    for (int j = 0; j < 4; ++j) { const int nc = 256 * (4 * (j >> 1) + (lane >> 4)) + 8 * (lane & 15) + 4 * (j & 1);
                        f32x4 sv = *(const f32x4*)(glu_bias + CJ(j)), sg = *(const f32x4*)(glu_bias + D + CJ(j));
                        f32x4 tv[NKS], tg[NKS];
#pragma unroll
                        for (int ks = 0; ks < NKS; ++ks) { const float* pp = part + ((size_t)ks * MS + (m - MP)) * (2 * D) + nc; tv[ks] = *(const f32x4*)pp; tg[ks] = *(const f32x4*)(pp + 128); }
#pragma unroll
                        for (int ks = 0; ks < NKS; ++ks) { sv += tv[ks]; sg += tg[ks]; }
                        yv[r][j] = (f32x4){sv.x * sigmoidf_(sg.x), sv.y * sigmoidf_(sg.y), sv.z * sigmoidf_(sg.z), sv.w * sigmoidf_(sg.w)}; }
                } else if (part && m >= MP) {
#pragma unroll
                    for (int j = 0; j < 4; ++j) { f32x4 t[NKS];
#pragma unroll
                        for (int ks = 0; ks < NKS; ++ks) t[ks] = *(const f32x4*)(part + ((size_t)ks * MS + (m - MP)) * D + CJ(j));
                        f32x4 s = t[0];
#pragma unroll
                        for (int ks = 1; ks < NKS; ++ks) s += t[ks];
                        yv[r][j] = s; }
                } else {
#pragma unroll
                    for (int jj = 0; jj < 2; ++jj) { const u32x4 w = *(const u32x4*)(Y + (size_t)m * D + 512 * jj + 8 * lane);
                        yv[r][2 * jj] = (f32x4){bflo(w.x), bfhi(w.x), bflo(w.y), bfhi(w.y)}; yv[r][2 * jj + 1] = (f32x4){bflo(w.z), bfhi(w.z), bflo(w.w), bfhi(w.w)}; }
                }
            }
        }
#pragma unroll
        for (int r = 0; r < R; ++r) { const int m = rp_row(k0 + r, gw, NGW); if (m < 0) continue;
            if (Y) {
                float ss = 0.f;
#pragma unroll
                for (int j = 0; j < 4; ++j) ss += (yv[r][j].x * yv[r][j].x + yv[r][j].y * yv[r][j].y) + (yv[r][j].z * yv[r][j].z + yv[r][j].w * yv[r][j].w);
                const float rr = rsqrtf(wave_sum(ss) * (1.0f / D) + EPS) * scale;
#pragma unroll
                for (int j = 0; j < 4; ++j) { const f32x4 g = *(const f32x4*)(g_post + CJ(j)); v[r][j] = v[r][j] + yv[r][j] * g * rr; }
            }
            if (outf) {
#pragma unroll
                for (int j = 0; j < 4; ++j) *(f32x4*)(outf + (size_t)m * D + CJ(j)) = v[r][j];
            } else {
                float ss = 0.f;
#pragma unroll
                for (int j = 0; j < 4; ++j) ss += (v[r][j].x * v[r][j].x + v[r][j].y * v[r][j].y) + (v[r][j].z * v[r][j].z + v[r][j].w * v[r][j].w);
                const float rr = rsqrtf(wave_sum(ss) * (1.0f / D) + EPS);
#pragma unroll
                for (int jj = 0; jj < 2; ++jj) { const f32x4 a = v[r][2 * jj] * rr, b = v[r][2 * jj + 1] * rr;
                    u32x4 w; w.x = cvt_pk_bf16(a.x, a.y); w.y = cvt_pk_bf16(a.z, a.w); w.z = cvt_pk_bf16(b.x, b.y); w.w = cvt_pk_bf16(b.z, b.w);
                    *(u32x4*)(XB + (size_t)m * D + 512 * jj + 8 * lane) = w; }
                if (lane == 0) R2[m] = rr;
                if (g_pre) {
#pragma unroll
                    for (int jj = 0; jj < 2; ++jj) { const f32x4 ga = *(const f32x4*)(g_pre + CJ(2 * jj)), gb = *(const f32x4*)(g_pre + CJ(2 * jj + 1));
                        const f32x4 ha = v[r][2 * jj] * ga * rr, hb = v[r][2 * jj + 1] * gb * rr;
                        u32x4 w; w.x = cvt_pk_bf16(ha.x, ha.y); w.y = cvt_pk_bf16(ha.z, ha.w); w.z = cvt_pk_bf16(hb.x, hb.y); w.w = cvt_pk_bf16(hb.z, hb.w);
                        if (m < MP) { const int gi = 32 * jj + (lane >> 1), c = (lane & 1) * 8;
                            *(u32x4*)(HS5 + ((size_t)gi * 1024 + (m >> 4)) * 384 + (m & 15) * 16 + c) = w; }
                        else *(u32x4*)(HSMP + (size_t)(m - MP) * D + 512 * jj + 8 * lane) = w; }
                }
            }
        }
    }
}
#undef CJ

__device__ __forceinline__ void transpose_item(const float* W, int ldw, int K, int scol0, bf16_t* Bt, int drow0, int k0, float scale, const float* gk, LAS bf16_t* scr, int lane) {
    const float* src = W + (size_t)(k0 + (lane >> 5)) * ldw + scol0 + 4 * (lane & 31);
#pragma unroll 16
    for (int i = 0; i < 32; ++i) { const f32x4 w = __builtin_nontemporal_load((const f32x4*)(src + (size_t)(2 * i) * ldw));
        const float sc = gk ? gk[k0 + 2 * i + (lane >> 5)] * scale : scale;
        u32x2 o; o.x = cvt_pk_bf16(w.x * sc, w.y * sc); o.y = cvt_pk_bf16(w.z * sc, w.w * sc);
        *(LAS u32x2*)(scr + (2 * i + (lane >> 5)) * 136 + 4 * (lane & 31)) = o; }
    asm volatile("s_waitcnt lgkmcnt(0)" ::: "memory");
#pragma unroll 4
    for (int t = 0; t < 16; ++t) { const int task = t * 64 + lane, n = task >> 3, kc = task & 7; const LAS bf16_t* s = scr + (kc * 8) * 136 + n;
        u32x4 o; o.x = (unsigned)s[0] | ((unsigned)s[136] << 16); o.y = (unsigned)s[272] | ((unsigned)s[408] << 16);
        o.z = (unsigned)s[544] | ((unsigned)s[680] << 16); o.w = (unsigned)s[816] | ((unsigned)s[952] << 16);
        *(u32x4*)(Bt + (size_t)(drow0 + n) * K + k0 + 8 * kc) = o; }
    asm volatile("s_waitcnt lgkmcnt(0)" ::: "memory");
}

__device__ __forceinline__ void s5_prep_group(const Params& P, LAS unsigned char* lds, int g, int qt) {
    LAS float* apr = (LAS float*)lds;
    LAS float* api = apr + 17 * 64;
    LAS float* bbr = api + 17 * 64;
    LAS float* bbi = bbr + 1024;
    LAS float* cre = bbi + 1024;
    LAS float* cim = cre + 1024;
    LAS float* fre = cim + 1024;
    LAS float* fim = fre + 64;
    LAS float* kmat = fim + 64;
    const int tid = otid();
    float* sm = (float*)(P.ws + WS_SMALL);
    bf16_t* Wm = (bf16_t*)(P.ws + WS_S5M + (size_t)g * S5M_G);
    bf16_t* TE = Wm + 128 * 256;
    if (tid < 64) {
        const int p = tid; const float lr = P.in[13][g * 64 + p], li = P.in[14][g * 64 + p]; const float dt = expf(P.in[15][g]);
        float a1r = 0.f, a1i = 0.f;
        for (int tau = 0; tau <= 16; ++tau) {
            const float mag = expf(lr * dt * (float)tau);
            double rev = (double)li * (double)dt * (double)tau * 0.15915494309189535; rev -= __builtin_rint(rev);
            const float rr = (float)rev; const float s = __builtin_amdgcn_sinf(rr), c = __builtin_amdgcn_cosf(rr);
            apr[tau * 64 + p] = mag * c; api[tau * 64 + p] = mag * s;
            if (tau == 1) { a1r = mag * c; a1i = mag * s; }
            if (tau == 16 && qt == 0) { sm[SM_A16R + g * 64 + p] = mag * c; sm[SM_A16I + g * 64 + p] = mag * s; }
        }
        const float nr = a1r - 1.0f, ni = a1i, den = lr * lr + li * li;
        const float fr_ = (nr * lr + ni * li) / den, fi_ = (ni * lr - nr * li) / den;
        fre[p] = fr_; fim[p] = fi_;
        if (qt == 0) { sm[SM_ARE + g * 64 + p] = a1r; sm[SM_AIM + g * 64 + p] = a1i; sm[SM_FRE + g * 64 + p] = fr_; sm[SM_FIM + g * 64 + p] = fi_; }
    }
    __syncthreads();
    for (int idx = tid; idx < 1024; idx += 512) { const int p = idx >> 4; const float br = P.in[16][g * 1024 + idx], bi = P.in[17][g * 1024 + idx];
        bbr[idx] = fre[p] * br - fim[p] * bi; bbi[idx] = fre[p] * bi + fim[p] * br;
        cre[idx] = P.in[18][g * 1024 + idx]; cim[idx] = P.in[19][g * 1024 + idx]; }
    __syncthreads();
    for (int idx = qt * 8192 + tid; idx < (qt + 1) * 8192; idx += 512) { const int row = idx >> 8, col = idx & 255, s = col >> 4, c = col & 15, p = row & 63, im = row >> 6;
        const float ar = apr[(15 - s) * 64 + p], ai = api[(15 - s) * 64 + p], br = bbr[p * 16 + c], bi = bbi[p * 16 + c];
        Wm[idx] = f2bf(im ? (ar * bi + ai * br) : (ar * br - ai * bi)); }
    for (int i2 = tid; i2 < 1024; i2 += 512) { const int tau = i2 >> 6, cp = 4 * qt + ((i2 >> 4) & 3), c = i2 & 15, idx = (tau << 8) + (cp << 4) + c; float sum = 0.f;
        for (int p = 0; p < 64; ++p) { const float cr = cre[cp * 64 + p], ci = cim[cp * 64 + p], ar = apr[tau * 64 + p], ai = api[tau * 64 + p];
            const float car = cr * ar - ci * ai, cai = cr * ai + ci * ar; sum += car * bbr[p * 16 + c] - cai * bbi[p * 16 + c]; }
        kmat[idx] = sum; }
    __syncthreads();
    for (int i2 = tid; i2 < 64 * 384; i2 += 512) { const int r2 = i2 / 384, col = i2 - r2 * 384, t = r2 >> 2, cp = 4 * qt + (r2 & 3), row = t * 16 + cp, idx = row * 384 + col; float v;
        if (col < 256) { const int s = col >> 4, c = col & 15; v = (s <= t) ? kmat[((t - s) << 8) + (cp << 4) + c] : 0.f; }
        else { const int pp = col - 256, p = pp & 63, im = pp >> 6; const float cr = cre[cp * 64 + p], ci = cim[cp * 64 + p], ar = apr[(t + 1) * 64 + p], ai = api[(t + 1) * 64 + p];
            v = im ? -(cr * ai + ci * ar) : (cr * ar - ci * ai); }
        TE[idx] = f2bf(v); }
    __syncthreads();
}

__device__ __forceinline__ void s5_idle_prep(const Params& P, LAS unsigned char* lds, int slot) {
    const int G = gridDim.x, nfull = ((M / BM) * (NGU / BM)) % G, cb = blockIdx.x;
    if (nfull == 0 || cb < nfull) return;
    const int wi = slot * (G - nfull) + (cb - nfull);
    if (wi < 256) s5_prep_group(P, lds, wi >> 2, wi & 3);
}
__device__ __forceinline__ void s5_idle_prep_inproj(const Params& P, LAS unsigned char* lds) {
    const int G = gridDim.x, nf1 = ((M / BM) * (NGU / BM)) % G, nf2 = ((M / BM) * (NIN / BM)) % G, cb = blockIdx.x;
    if (nf1 == 0 || nf2 == 0 || cb < nf2) return;
    const int wi = 3 * (G - nf1) + (cb - nf2);
    if (wi < 256) s5_prep_group(P, lds, wi >> 2, wi & 3);
}
__device__ __forceinline__ void phase0(const Params& P, LAS unsigned char* lds) {
    const int tid = otid(), lane = tid & 63, wave = tid >> 6;
    const int gw = blockIdx.x * 8 + wave, NGW = gridDim.x * 8;
    LAS bf16_t* scr = (LAS bf16_t*)(lds + wave * 17408);
    bf16_t* WGU = (bf16_t*)(P.ws + WS_WGU); bf16_t* WDN = (bf16_t*)(P.ws + WS_WDN); bf16_t* WIN = (bf16_t*)(P.ws + WS_WIN);
    bf16_t* WOUT = (bf16_t*)(P.ws + WS_WOUT); bf16_t* WGLU = (bf16_t*)(P.ws + WS_WGLU);
    constexpr int I_GU = 4 * 16 * 44, I_DN = 4 * 44 * 8, I_IN = 16 * 24, I_OUT = 16 * 8, I_GLU = 16 * 16;
#pragma unroll 1
    for (int step = 0; step < 2; ++step) {
    if (((blockIdx.x & 1) != 0) == (step == 0)) {
        { const int G_ = gridDim.x, nf1_ = ((M / BM) * (NGU / BM)) % G_, nf2_ = ((M / BM) * (NIN / BM)) % G_;
          const int first_ = (nf1_ && nf2_) ? 3 * (G_ - nf1_) + (G_ - nf2_) : (nf1_ ? 3 * (G_ - nf1_) : 0);
          for (int wi = first_ + blockIdx.x; wi < 256; wi += gridDim.x) s5_prep_group(P, lds, wi >> 2, wi & 3); }
    } else {
    for (int it = blockIdx.x + gridDim.x * wave; it < I_GU + I_DN + I_IN + I_OUT + I_GLU; it += NGW) {
        int r = it;
        if (r < I_GU) { const int lf = r / 704, rr = r % 704, kb = rr / 44, nb = rr % 44, n0 = nb * 128, pn = n0 >> 8, bj = (n0 >> 7) & 1;
            transpose_item(P.in[6] + (size_t)lf * D * NGU, NGU, D, bj * FF + pn * 128, WGU + (size_t)lf * NGU * D, n0, kb * 64, bj ? 0.6931471805599453f : 1.4426950408889634f, P.in[5] + (size_t)((lf >> 1) * 6 + (lf & 1) * 4) * D, scr, lane); continue; }
        r -= I_GU;
        if (r < I_DN) { const int lf = r / 352, rr = r % 352, kb = rr / 8, nb = rr % 8;
            transpose_item(P.in[7] + (size_t)lf * FF * D, D, FF, nb * 128, WDN + (size_t)lf * D * FF, nb * 128, kb * 64, 1.0f, nullptr, scr, lane); continue; }
        r -= I_DN;
        if (r < I_IN) { const int kb = r / 24, nb = r % 24, n0 = nb * 128;
            transpose_item(P.in[8], LDIN, D, n0, WIN, n0, kb * 64, n0 < 512 ? 0.08838834764831845f : 1.0f, P.in[5] + 2 * D, scr, lane); continue; }
        r -= I_IN;
        if (r < I_OUT) { const int kb = r / 8, nb = r % 8; transpose_item(P.in[12], D, D, nb * 128, WOUT, nb * 128, kb * 64, 1.0f, nullptr, scr, lane); continue; }
        r -= I_OUT;
        { const int kb = r / 16, nb = r % 16, n0 = nb * 128, pn = n0 >> 8, bj = (n0 >> 7) & 1;
            transpose_item(P.in[21], 2 * D, D, bj * D + pn * 128, WGLU, n0, kb * 64, 1.0f, nullptr, scr, lane); }
    }
    for (int idx = blockIdx.x * 512 + tid; idx < 64 * 1024; idx += gridDim.x * 512) { const int jb = idx >> 10, k = idx & 1023;
        const float* wr = P.in[8] + (size_t)k * LDIN + 3072; const f32x4 a0 = *(const f32x4*)wr, a1 = *(const f32x4*)(wr + 4), a2 = *(const f32x4*)(wr + 8), a3 = *(const f32x4*)(wr + 12);
        const float a[16] = {a0.x, a0.y, a0.z, a0.w, a1.x, a1.y, a1.z, a1.w, a2.x, a2.y, a2.z, a2.w, a3.x, a3.y, a3.z, a3.w}; const float gk = P.in[5][2 * D + k];
#pragma unroll
        for (int jj = 0; jj < 8; ++jj) { const int j = jb * 8 + jj; float s = 0.f;
#pragma unroll
            for (int r = 0; r < 16; ++r) s += a[r] * P.in[9][r * 512 + j];
            WIN[(size_t)(3072 + j) * D + k] = f2bf(s * gk); } }
    }
    __syncthreads();
    }
    row_pass<3, 1>(P.in[0], P.in[1], (bf16_t*)(P.ws + WS_H), (float*)(P.ws + WS_SMALL) + SM_R2, nullptr, nullptr, 0.f, nullptr, nullptr, nullptr, nullptr, nullptr);
}

__device__ __forceinline__ void gla_cumsum(LAS float* BC, LAS float* TOT, const u32x4 (&lw)[2], int tid) {
#pragma unroll
    for (int i = 0; i < 2; ++i) { const int e = tid + 512 * i, t = e >> 4, d0 = (e & 15) * 8; const u32x4 w = lw[i];
        LAS float* b = BC + t * 128 + d0; b[0] = logf_gate(bflo(w.x)); b[1] = logf_gate(bfhi(w.x)); b[2] = logf_gate(bflo(w.y)); b[3] = logf_gate(bfhi(w.y));
        b[4] = logf_gate(bflo(w.z)); b[5] = logf_gate(bfhi(w.z)); b[6] = logf_gate(bflo(w.w)); b[7] = logf_gate(bfhi(w.w)); }
    __syncthreads();
    const int dk = tid & 127, seg = tid >> 7; float run = 0.f;
#pragma unroll
    for (int i = 0; i < 16; ++i) { const int t = seg * 16 + i; run += BC[t * 128 + dk]; BC[t * 128 + dk] = run; }
    TOT[seg * 128 + dk] = run;
    __syncthreads();
    float off = 0.f;
    for (int s = 0; s < seg; ++s) off += TOT[s * 128 + dk];
#pragma unroll
    for (int i = 0; i < 16; ++i) BC[(seg * 16 + i) * 128 + dk] += off;
    __syncthreads();
}
__device__ __forceinline__ void gla_load_vt(LAS bf16_t* VT, const u32x4 (&vw)[4], int tid) {
#pragma unroll
    for (int i = 0; i < 4; ++i) { const int e = tid + 512 * i, t = e >> 5, d0 = (e & 31) * 8; const u32x4 w = vw[i];
        LAS bf16_t* p = VT + d0 * 72 + ((((t >> 3) ^ ((d0 >> 3) & 7)) << 3) | (t & 7));
        p[0] = (bf16_t)(w.x & 0xffff); p[72] = (bf16_t)(w.x >> 16); p[144] = (bf16_t)(w.y & 0xffff); p[216] = (bf16_t)(w.y >> 16);
        p[288] = (bf16_t)(w.z & 0xffff); p[360] = (bf16_t)(w.z >> 16); p[432] = (bf16_t)(w.w & 0xffff); p[504] = (bf16_t)(w.w >> 16); }
}

__device__ __forceinline__ void gla_phase_a(const Params& P, LAS unsigned char* lds) {
    const int tid = otid(), lane = tid & 63, w = tid >> 6, l16 = lane & 15, q = lane >> 4;
    LAS float* BC = (LAS float*)lds; LAS float* TOT = (LAS float*)(lds + 32768);
    LAS bf16_t* KT = (LAS bf16_t*)(lds + 34816); LAS bf16_t* VT = (LAS bf16_t*)(lds + 53248);
    const bf16_t* QKV = (const bf16_t*)(P.ws + WS_QKV); bf16_t* KC = (bf16_t*)(P.ws + WS_KC); float* BEND = (float*)(P.ws + WS_BEND);
    for (int item = blockIdx.x; item < 1024; item += gridDim.x) {
        const int b = item >> 7, h = (item >> 5) & 3, c = item & 31; const size_t tok0 = (size_t)b * 2048 + c * 64;
        const bf16_t* base = QKV + tok0 * NIN;
        u32x4 lw[2], kw[2], vw[4];
#pragma unroll
        for (int i = 0; i < 2; ++i) { const int e = tid + 512 * i, t = e >> 4, d0 = (e & 15) * 8; lw[i] = *(const u32x4*)(base + (size_t)t * NIN + 3072 + h * 128 + d0); kw[i] = *(const u32x4*)(base + (size_t)t * NIN + 512 + h * 128 + d0); }
#pragma unroll
        for (int i = 0; i < 4; ++i) { const int e = tid + 512 * i, t = e >> 5, d0 = (e & 31) * 8; vw[i] = *(const u32x4*)(base + (size_t)t * NIN + 1024 + h * 256 + d0); }
        gla_cumsum(BC, TOT, lw, tid);
        if (tid < 128) BEND[item * 128 + tid] = BC[63 * 128 + tid];
#pragma unroll
        for (int i = 0; i < 2; ++i) { const int e = tid + 512 * i, t = e >> 4, d0 = (e & 15) * 8; const u32x4 wv = kw[i];
            float kv[8] = {bflo(wv.x), bfhi(wv.x), bflo(wv.y), bfhi(wv.y), bflo(wv.z), bfhi(wv.z), bflo(wv.w), bfhi(wv.w)};
#pragma unroll
            for (int j = 0; j < 8; ++j) KT[(d0 + j) * 72 + ((((t >> 3) ^ ((d0 >> 3) & 7)) << 3) | (t & 7))] = f2bf(kv[j] * __expf(BC[63 * 128 + d0 + j] - BC[t * 128 + d0 + j])); }
        gla_load_vt(VT, vw, tid);
        __syncthreads();
        f32x4 acc[8][2];
#pragma unroll
        for (int a = 0; a < 8; ++a) { acc[a][0] = (f32x4){0.f, 0.f, 0.f, 0.f}; acc[a][1] = acc[a][0]; }
#pragma unroll
        for (int kk = 0; kk < 2; ++kk) {
            bf16x8 vb[2];
#pragma unroll
            for (int d = 0; d < 2; ++d) vb[d] = *(const LAS bf16x8*)(VT + (16 * (2 * w + d) + l16) * 72 + (((kk * 4 + q) ^ ((2 * (2 * w + d) + (l16 >> 3)) & 7)) << 3));
#pragma unroll
            for (int a = 0; a < 8; ++a) { const bf16x8 ka = *(const LAS bf16x8*)(KT + (16 * a + l16) * 72 + (((kk * 4 + q) ^ ((2 * a + (l16 >> 3)) & 7)) << 3));
#pragma unroll
                for (int d = 0; d < 2; ++d) acc[a][d] = __builtin_amdgcn_mfma_f32_16x16x32_bf16(ka, vb[d], acc[a][d], 0, 0, 0); }
        }
#pragma unroll
        for (int a = 0; a < 8; ++a)
#pragma unroll
            for (int d = 0; d < 2; ++d) { u32x2 o; o.x = cvt_pk_bf16(acc[a][d][0], acc[a][d][1]); o.y = cvt_pk_bf16(acc[a][d][2], acc[a][d][3]);
                *(u32x2*)(KC + ((size_t)item * 256 + 16 * (2 * w + d) + l16) * 128 + 16 * a + 4 * q) = o; }
        __syncthreads();
    }
}
__device__ __forceinline__ void gla_phase_b(const Params& P) {
    bf16_t* KC = (bf16_t*)(P.ws + WS_KC); const float* BEND = (const float*)(P.ws + WS_BEND);
    const int tidb = otid();
    for (int idx = blockIdx.x * 512 + tidb; idx < 32 * 4096; idx += gridDim.x * 512) {
        const int bh = idx >> 12, e = idx & 4095, dv = e >> 4, dk0 = (e & 15) * 8;
        float S[8];
#pragma unroll
        for (int j = 0; j < 8; ++j) S[j] = 0.f;
#pragma unroll 8
        for (int c = 0; c < 32; ++c) { const int item = bh * 32 + c;
            u32x4* p = (u32x4*)(KC + ((size_t)item * 256 + dv) * 128 + dk0); const u32x4 kc = *p;
            const f32x4 e0 = *(const f32x4*)(BEND + item * 128 + dk0), e1 = *(const f32x4*)(BEND + item * 128 + dk0 + 4);
            u32x4 o; o.x = cvt_pk_bf16(S[0], S[1]); o.y = cvt_pk_bf16(S[2], S[3]); o.z = cvt_pk_bf16(S[4], S[5]); o.w = cvt_pk_bf16(S[6], S[7]); *p = o;
            S[0] = __expf(e0.x) * S[0] + bflo(kc.x); S[1] = __expf(e0.y) * S[1] + bfhi(kc.x); S[2] = __expf(e0.z) * S[2] + bflo(kc.y); S[3] = __expf(e0.w) * S[3] + bfhi(kc.y);
            S[4] = __expf(e1.x) * S[4] + bflo(kc.z); S[5] = __expf(e1.y) * S[5] + bfhi(kc.z); S[6] = __expf(e1.z) * S[6] + bflo(kc.w); S[7] = __expf(e1.w) * S[7] + bfhi(kc.w); }
        float* o = P.out + O_GP + (size_t)bh * 32768;
#pragma unroll
        for (int j = 0; j < 8; ++j) o[(dk0 + j) * 256 + dv] = S[j];
    }
}
__device__ __forceinline__ void gla_phase_c(const Params& P, LAS unsigned char* lds) {
    const int tid = otid(), lane = tid & 63, w = tid >> 6, l16 = lane & 15, q = lane >> 4;
    LAS float* BC = (LAS float*)lds; LAS float* TOT = (LAS float*)(lds + 32768); LAS float* PART = (LAS float*)(lds + 34816);
    LAS bf16_t* QT = (LAS bf16_t*)(lds + 36864); LAS bf16_t* KT = (LAS bf16_t*)(lds + 54272);
    LAS bf16_t* VT = (LAS bf16_t*)(lds + 71680); LAS bf16_t* ATT = (LAS bf16_t*)(lds + 108544);
    const bf16_t* QKV = (const bf16_t*)(P.ws + WS_QKV); const bf16_t* KC = (const bf16_t*)(P.ws + WS_KC); bf16_t* Oo = (bf16_t*)(P.ws + WS_O);
    const float* gon = P.in[11];
    for (int item = blockIdx.x; item < 1024; item += gridDim.x) {
        const int b = item >> 7, h = (item >> 5) & 3, c = item & 31; const size_t tok0 = (size_t)b * 2048 + c * 64;
        const bf16_t* base = QKV + tok0 * NIN;
        u32x4 lw[2], qw[2], kw[2], vw[4]; bf16x8 sfr[4][2]; u32x2 rw[4][2];
#pragma unroll
        for (int i = 0; i < 2; ++i) { const int e = tid + 512 * i, t = e >> 4, d0 = (e & 15) * 8; lw[i] = *(const u32x4*)(base + (size_t)t * NIN + 3072 + h * 128 + d0);
            qw[i] = *(const u32x4*)(base + (size_t)t * NIN + h * 128 + d0); kw[i] = *(const u32x4*)(base + (size_t)t * NIN + 512 + h * 128 + d0); }
#pragma unroll
        for (int i = 0; i < 4; ++i) { const int e = tid + 512 * i, t = e >> 5, d0 = (e & 31) * 8; vw[i] = *(const u32x4*)(base + (size_t)t * NIN + 1024 + h * 256 + d0); }
#pragma unroll
        for (int kk = 0; kk < 4; ++kk)
#pragma unroll
            for (int d = 0; d < 2; ++d) sfr[kk][d] = *(const bf16x8*)(KC + ((size_t)item * 256 + 16 * (2 * w + d) + l16) * 128 + kk * 32 + q * 8);
#pragma unroll
        for (int tm = 0; tm < 4; ++tm)
#pragma unroll
            for (int d = 0; d < 2; ++d) rw[tm][d] = *(const u32x2*)(QKV + (tok0 + 16 * tm + l16) * NIN + 2048 + h * 256 + 16 * (2 * w + d) + 4 * q);
        gla_cumsum(BC, TOT, lw, tid);
#pragma unroll
        for (int i = 0; i < 2; ++i) { const int e = tid + 512 * i, t = e >> 4, d0 = (e & 15) * 8;
            const u32x4 wq = qw[i], wk = kw[i];
            float qv[8] = {bflo(wq.x), bfhi(wq.x), bflo(wq.y), bfhi(wq.y), bflo(wq.z), bfhi(wq.z), bflo(wq.w), bfhi(wq.w)};
            float kv[8] = {bflo(wk.x), bfhi(wk.x), bflo(wk.y), bfhi(wk.y), bflo(wk.z), bfhi(wk.z), bflo(wk.w), bfhi(wk.w)};
            float eb[8];
#pragma unroll
            for (int j = 0; j < 8; ++j) { eb[j] = BC[t * 128 + d0 + j]; qv[j] *= __expf(eb[j]); kv[j] *= __expf(-eb[j]); }
            u32x4 oq, ok; oq.x = cvt_pk_bf16(qv[0], qv[1]); oq.y = cvt_pk_bf16(qv[2], qv[3]); oq.z = cvt_pk_bf16(qv[4], qv[5]); oq.w = cvt_pk_bf16(qv[6], qv[7]);
            ok.x = cvt_pk_bf16(kv[0], kv[1]); ok.y = cvt_pk_bf16(kv[2], kv[3]); ok.z = cvt_pk_bf16(kv[4], kv[5]); ok.w = cvt_pk_bf16(kv[6], kv[7]);
            *(LAS u32x4*)(QT + t * 136 + d0) = oq; *(LAS u32x4*)(KT + t * 136 + d0) = ok; }
        gla_load_vt(VT, vw, tid);
        __syncthreads();
        {
            const int tm = w >> 1;
#pragma unroll
            for (int d = 0; d < 2; ++d) { const int sn = 2 * (w & 1) + d; f32x4 a = (f32x4){0.f, 0.f, 0.f, 0.f};
                if (sn <= tm) {
#pragma unroll
                    for (int kk = 0; kk < 4; ++kk) { const bf16x8 kf = *(const LAS bf16x8*)(KT + (16 * sn + l16) * 136 + kk * 32 + q * 8);
                        const bf16x8 qf = *(const LAS bf16x8*)(QT + (16 * tm + l16) * 136 + kk * 32 + q * 8);
                        a = __builtin_amdgcn_mfma_f32_16x16x32_bf16(kf, qf, a, 0, 0, 0); }
                }
                const int t = 16 * tm + l16, s0 = 16 * sn + 4 * q;
#pragma unroll
                for (int i = 0; i < 4; ++i) if (s0 + i > t) a[i] = 0.f;
                u32x2 o; o.x = cvt_pk_bf16(a[0], a[1]); o.y = cvt_pk_bf16(a[2], a[3]);
                *(LAS u32x2*)(ATT + t * 72 + s0) = o; }
        }
        __syncthreads();
        f32x4 acc[2][4];
#pragma unroll
        for (int d = 0; d < 2; ++d)
#pragma unroll
            for (int tm = 0; tm < 4; ++tm) acc[d][tm] = (f32x4){0.f, 0.f, 0.f, 0.f};
#pragma unroll
        for (int kk = 0; kk < 2; ++kk) {
            bf16x8 vf[2], af[4];
#pragma unroll
            for (int d = 0; d < 2; ++d) vf[d] = *(const LAS bf16x8*)(VT + (16 * (2 * w + d) + l16) * 72 + (((kk * 4 + q) ^ ((2 * (2 * w + d) + (l16 >> 3)) & 7)) << 3));
#pragma unroll
            for (int tm = 0; tm < 4; ++tm) af[tm] = *(const LAS bf16x8*)(ATT + (16 * tm + l16) * 72 + kk * 32 + q * 8);
#pragma unroll
            for (int d = 0; d < 2; ++d)
#pragma unroll
                for (int tm = 0; tm < 4; ++tm) acc[d][tm] = __builtin_amdgcn_mfma_f32_16x16x32_bf16(vf[d], af[tm], acc[d][tm], 0, 0, 0);
        }
#pragma unroll
        for (int kk = 0; kk < 4; ++kk) {
            bf16x8 sf[2], qf[4];
#pragma unroll
            for (int d = 0; d < 2; ++d) sf[d] = sfr[kk][d];
#pragma unroll
            for (int tm = 0; tm < 4; ++tm) qf[tm] = *(const LAS bf16x8*)(QT + (16 * tm + l16) * 136 + kk * 32 + q * 8);
#pragma unroll
            for (int d = 0; d < 2; ++d)
#pragma unroll
                for (int tm = 0; tm < 4; ++tm) acc[d][tm] = __builtin_amdgcn_mfma_f32_16x16x32_bf16(sf[d], qf[tm], acc[d][tm], 0, 0, 0);
        }
#pragma unroll
        for (int tm = 0; tm < 4; ++tm) { float ss = 0.f;
#pragma unroll
            for (int d = 0; d < 2; ++d) ss += (acc[d][tm][0] * acc[d][tm][0] + acc[d][tm][1] * acc[d][tm][1]) + (acc[d][tm][2] * acc[d][tm][2] + acc[d][tm][3] * acc[d][tm][3]);
            ss += __shfl_xor(ss, 16); ss += __shfl_xor(ss, 32);
            if (q == 0) PART[w * 64 + 16 * tm + l16] = ss; }
        __syncthreads();
#pragma unroll
        for (int tm = 0; tm < 4; ++tm) { float tot = 0.f;
#pragma unroll
            for (int ww = 0; ww < 8; ++ww) tot += PART[ww * 64 + 16 * tm + l16];
            const float rs = rsqrtf(tot * (1.0f / 256.0f) + EPS); const size_t tok = tok0 + 16 * tm + l16;
#pragma unroll
            for (int d = 0; d < 2; ++d) { const int dv0 = 16 * (2 * w + d) + 4 * q; const f32x4 g = *(const f32x4*)(gon + dv0);
                const u32x2 rr = rw[tm][d];
                u32x2 o; o.x = cvt_pk_bf16(acc[d][tm][0] * rs * g.x * siluf_(bflo(rr.x)), acc[d][tm][1] * rs * g.y * siluf_(bfhi(rr.x)));
                o.y = cvt_pk_bf16(acc[d][tm][2] * rs * g.z * siluf_(bflo(rr.y)), acc[d][tm][3] * rs * g.w * siluf_(bfhi(rr.y)));
                *(u32x2*)(Oo + tok * D + h * 256 + dv0) = o; } }
        __syncthreads();
    }
    LAS float* SQ = (LAS float*)lds; LAS float* SK = SQ + 512; LAS float* SE = SK + 512; LAS float* OS = SE + 512;   LAS float* WP = OS + 2048;
    for (int item = blockIdx.x; item < 512; item += gridDim.x) {
        const int b = item >> 2, h = item & 3; const size_t row0 = (size_t)MP + b * 4;
        { const int t = tid >> 7, dk = tid & 127; const bf16_t* r = QKV + (row0 + t) * NIN;
            SQ[tid] = bf2f(r[h * 128 + dk]); SK[tid] = bf2f(r[512 + h * 128 + dk]); SE[tid] = __expf(logf_gate(bf2f(r[3072 + h * 128 + dk]))); }
        __syncthreads();
        const int dv = tid & 255, half = tid >> 8;
        const float* s0 = P.in[2] + ((size_t)item * 128 + half * 64) * 256 + dv;
        float S[64];
#pragma unroll
        for (int i = 0; i < 64; ++i) S[i] = s0[i * 256];
        float vv[4];
#pragma unroll
        for (int t = 0; t < 4; ++t) vv[t] = bf2f(QKV[(row0 + t) * NIN + 1024 + h * 256 + dv]);
#pragma unroll
        for (int t = 0; t < 4; ++t) { float op = 0.f;
#pragma unroll
            for (int i = 0; i < 64; ++i) { const int dk = half * 64 + i; S[i] = SE[t * 128 + dk] * S[i] + SK[t * 128 + dk] * vv[t]; op += SQ[t * 128 + dk] * S[i]; }
            OS[(half * 4 + t) * 256 + dv] = op; }
        float* so = P.out + O_GS + ((size_t)item * 128 + half * 64) * 256 + dv;
#pragma unroll
        for (int i = 0; i < 64; ++i) so[i * 256] = S[i];
        __syncthreads();
        float o4[4];
#pragma unroll
        for (int t = 0; t < 4; ++t) { o4[t] = OS[t * 256 + dv] + OS[(4 + t) * 256 + dv]; const float s = wave_sum(o4[t] * o4[t]); if (tid < 256 && lane == 0) WP[w * 4 + t] = s; }
        __syncthreads();
        if (tid < 256) {
#pragma unroll
            for (int t = 0; t < 4; ++t) { const float tot = WP[t] + WP[4 + t] + WP[8 + t] + WP[12 + t]; const float rs = rsqrtf(tot * (1.0f / 256.0f) + EPS);
                const float r = bf2f(QKV[(row0 + t) * NIN + 2048 + h * 256 + dv]);
                Oo[(row0 + t) * D + h * 256 + dv] = f2bf(o4[t] * rs * gon[dv] * siluf_(r)); }
        }
        __syncthreads();
    }
}

__device__ __forceinline__ void s5_prefix_and_sample(const Params& P, LAS unsigned char* lds) {
    const int tid = otid(); const int lane = tid & 63, w = tid >> 6, gw = blockIdx.x * 8 + w, NGW = gridDim.x * 8;
    const float* sm = (const float*)(P.ws + WS_SMALL); const bf16_t* HL = (const bf16_t*)(P.ws + WS_HLOC); bf16_t* HS5 = (bf16_t*)(P.ws + WS_HS5);
    LAS float* TOT = (LAS float*)lds;
    for (int L = blockIdx.x; L < 256; L += gridDim.x) {
        int g, mt; { const int xcd = L & 7, idx = L >> 3, combo = xcd * 8 + (idx >> 2); g = (combo >> 2) * 4 + (idx & 3); mt = combo & 3; }
        const char* Aop = (const char*)(P.ws + WS_HS5) + (size_t)g * (1024 * 384 * 2) + (size_t)mt * (BM * 384 * 2);
        { OneUnit S1{{Aop, (const char*)(P.ws + WS_S5M) + (size_t)g * 262144, mt, g, 4, -1}}; EpiS5A E1{(bf16_t*)(P.ws + WS_HLOC)}; gemm_phase(lds, 384, 256, S1, E1); }
        asm volatile("s_waitcnt vmcnt(0)" ::: "memory"); __syncthreads();
        {
        const int seg = w & 3, b = 2 * mt + (w >> 2);
        const float ar = sm[SM_A16R + g * 64 + lane], ai = sm[SM_A16I + g * 64 + lane];
        const size_t col0 = (size_t)g * 1024 + b * 128 + seg * 32;
        float lr[32], li[32];
#pragma unroll
        for (int c = 0; c < 32; ++c) { lr[c] = bf2f(HL[(col0 + c) * 128 + lane]); li[c] = bf2f(HL[(col0 + c) * 128 + 64 + lane]); }
        float hr = 0.f, hi = 0.f;
#pragma unroll
        for (int c = 0; c < 32; ++c) { const float tr = lr[c], ti = li[c]; lr[c] = hr; li[c] = hi; const float nr = ar * hr - ai * hi + tr, ni = ar * hi + ai * hr + ti; hr = nr; hi = ni; }
        TOT[(w * 2 + 0) * 64 + lane] = hr; TOT[(w * 2 + 1) * 64 + lane] = hi;
        __syncthreads();
        float a32r = ar, a32i = ai;
#pragma unroll
        for (int k = 0; k < 5; ++k) { const float nr = a32r * a32r - a32i * a32i, ni = 2.f * a32r * a32i; a32r = nr; a32i = ni; }
        float cr = 0.f, ci = 0.f;
        for (int s = 0; s < seg; ++s) { const int ws_ = (w & 4) + s; const float tr = TOT[(ws_ * 2 + 0) * 64 + lane], ti = TOT[(ws_ * 2 + 1) * 64 + lane];
            const float nr = a32r * cr - a32i * ci + tr, ni = a32r * ci + a32i * cr + ti; cr = nr; ci = ni; }
        float pr_ = cr, pi_ = ci;
#pragma unroll
        for (int c = 0; c < 32; ++c) { HS5[(col0 + c) * 384 + 256 + lane] = f2bf(lr[c] + pr_); HS5[(col0 + c) * 384 + 320 + lane] = f2bf(li[c] + pi_);
            const float nr = ar * pr_ - ai * pi_, ni = ar * pi_ + ai * pr_; pr_ = nr; pi_ = ni; }
        if (seg == 3) { P.out[O_RP + (size_t)b * 4096 + g * 64 + lane] = hr + pr_; P.out[O_IP + (size_t)b * 4096 + g * 64 + lane] = hi + pi_; }
        }
        asm volatile("s_waitcnt vmcnt(0)" ::: "memory"); __syncthreads();
        { OneUnit S2{{Aop, (const char*)(P.ws + WS_S5M + 65536) + (size_t)g * 262144, mt, g, 6, -1}}; EpiS5B E2{P.ws, P.in[20]}; gemm_phase(lds, 384, 384, S2, E2); }
        __syncthreads();
    }
    const bf16_t* HSMP = (const bf16_t*)(P.ws + WS_HSMP); bf16_t* Z = (bf16_t*)(P.ws + WS_Z);
    LAS float* cb_ = (LAS float*)(lds + 4096 + w * 10752);
    LAS float* hb = cb_ + 2 * 16 * 68;
    for (int wv = gw; wv < 64 * 32; wv += NGW) {
        const int g = wv & 63, b0 = (wv >> 6) * 4, p = lane;
        const float ar = sm[SM_ARE + g * 64 + p], ai = sm[SM_AIM + g * 64 + p], fr = sm[SM_FRE + g * 64 + p], fi = sm[SM_FIM + g * 64 + p];
        f32x4 brv[4], biv[4], crv[4], civ[4];
#pragma unroll
        for (int c4 = 0; c4 < 4; ++c4) { brv[c4] = *(const f32x4*)(P.in[16] + ((size_t)g * 64 + p) * 16 + 4 * c4); biv[c4] = *(const f32x4*)(P.in[17] + ((size_t)g * 64 + p) * 16 + 4 * c4);
            crv[c4] = *(const f32x4*)(P.in[18] + (size_t)g * 1024 + (lane + 64 * c4) * 4); civ[c4] = *(const f32x4*)(P.in[19] + (size_t)g * 1024 + (lane + 64 * c4) * 4); }
        const int t = lane >> 4, cp = lane & 15; const float dsk = P.in[20][g * 16 + cp];
        float bbr[16], bbi[16];
#pragma unroll
        for (int c4 = 0; c4 < 4; ++c4) {
#pragma unroll
            for (int j = 0; j < 4; ++j) { bbr[4 * c4 + j] = fr * brv[c4][j] - fi * biv[c4][j]; bbi[4 * c4 + j] = fr * biv[c4][j] + fi * brv[c4][j]; }
            const int f = lane + 64 * c4, row = f >> 4, col = (f & 15) * 4;
            *(LAS f32x4*)(cb_ + row * 68 + col) = crv[c4]; *(LAS f32x4*)(cb_ + 16 * 68 + row * 68 + col) = civ[c4]; }
#pragma unroll 1
        for (int bb = 0; bb < 4; ++bb) { const int b = b0 + bb;
            u32x4 ua[4], ub[4];
#pragma unroll
            for (int tt = 0; tt < 4; ++tt) { ua[tt] = *(const u32x4*)(HSMP + (size_t)(b * 4 + tt) * D + g * 16); ub[tt] = *(const u32x4*)(HSMP + (size_t)(b * 4 + tt) * D + g * 16 + 8); }
            float hr = P.in[3][(size_t)b * 4096 + g * 64 + p], hi = P.in[4][(size_t)b * 4096 + g * 64 + p];
            const size_t row = (size_t)b * 4 + t; const float uu = bf2f(HSMP[row * D + g * 16 + cp]);
#pragma unroll
            for (int tt = 0; tt < 4; ++tt) { const u32x4 u0 = ua[tt], u1 = ub[tt];
                const float u[16] = {bflo(u0.x), bfhi(u0.x), bflo(u0.y), bfhi(u0.y), bflo(u0.z), bfhi(u0.z), bflo(u0.w), bfhi(u0.w),
                                     bflo(u1.x), bfhi(u1.x), bflo(u1.y), bfhi(u1.y), bflo(u1.z), bfhi(u1.z), bflo(u1.w), bfhi(u1.w)};
                float br = 0.f, bi = 0.f;
#pragma unroll
                for (int c = 0; c < 16; ++c) { br += bbr[c] * u[c]; bi += bbi[c] * u[c]; }
                const float nr = ar * hr - ai * hi + br, ni = ar * hi + ai * hr + bi; hr = nr; hi = ni;
                hb[(tt * 2 + 0) * 64 + p] = hr; hb[(tt * 2 + 1) * 64 + p] = hi; }
            P.out[O_RS + (size_t)b * 4096 + g * 64 + p] = hr; P.out[O_IS + (size_t)b * 4096 + g * 64 + p] = hi;
            asm volatile("s_waitcnt lgkmcnt(0)" ::: "memory");
            float y = 0.f;
#pragma unroll
            for (int i = 0; i < 16; ++i) { const f32x4 c4r = *(const LAS f32x4*)(cb_ + cp * 68 + 4 * i), c4i = *(const LAS f32x4*)(cb_ + 16 * 68 + cp * 68 + 4 * i);
                const f32x4 h4r = *(const LAS f32x4*)(hb + (t * 2 + 0) * 64 + 4 * i), h4i = *(const LAS f32x4*)(hb + (t * 2 + 1) * 64 + 4 * i);
                y += (c4r.x * h4r.x - c4i.x * h4i.x) + (c4r.y * h4r.y - c4i.y * h4i.y) + (c4r.z * h4r.z - c4i.z * h4i.z) + (c4r.w * h4r.w - c4i.w * h4i.w); }
            Z[((size_t)MP + row) * D + g * 16 + cp] = f2bf(y + dsk * uu);
            asm volatile("s_waitcnt lgkmcnt(0)" ::: "memory");
        }
    }
}

#define XB_TMO      128
#define XB_XCNT(j)  (256  + 64 * (j))
#define XB_XSUB(j)  (1280 + 64 * (j))
#define XB_XGEN(j)  (2304 + 64 * (j))
#define XB_TOP      3328
#define XB_TOPGEN   3392
#define XCD_BAR_WORDS 3456
#define XB_SPIN_CAP (1u << 22)
__device__ __forceinline__ unsigned xb_ld(unsigned* p)              { return __hip_atomic_load(p, __ATOMIC_RELAXED, __HIP_MEMORY_SCOPE_AGENT); }
__device__ __forceinline__ unsigned xb_add(unsigned* p, unsigned v) { return __hip_atomic_fetch_add(p, v, __ATOMIC_RELAXED, __HIP_MEMORY_SCOPE_AGENT); }
__device__ __forceinline__ unsigned xb_xcc_id() { return (unsigned)__builtin_amdgcn_s_getreg((3 << 11) | 20) & 0xFu; }
#define XB_SPIN(cond, bar) do { unsigned _sp = 0; while (cond) { __builtin_amdgcn_s_sleep(1); \
    if ((++_sp & 255u) == 0u) { if (xb_ld(&(bar)[XB_TMO])) break; if (_sp > XB_SPIN_CAP) { atomicAdd(&(bar)[XB_TMO], 1u); break; } } } } while (0)
struct XcdBarrier { unsigned* bar; unsigned x; volatile LAS unsigned* st; };
__device__ __forceinline__ XcdBarrier xcd_barrier_post(unsigned* bar, volatile LAS unsigned* st) {
    XcdBarrier b; b.bar = bar; b.x = xb_xcc_id(); b.st = st;
    if (threadIdx.x == 0) (void)xb_add(&bar[XB_XCNT(b.x)], 1u);
    return b;
}
__device__ __forceinline__ void xcd_barrier_complete(unsigned* bar, unsigned x, unsigned& nloc, unsigned& nx) {
    const unsigned G = gridDim.x * gridDim.y * gridDim.z;
    unsigned sum, cnt, mine, sp = 0u;
    for (;;) {
        sum = 0u; cnt = 0u; mine = 0u;
#pragma unroll
        for (unsigned j = 0; j < 16; ++j) { const unsigned c = xb_ld(&bar[XB_XCNT(j)]); sum += c; cnt += (c > 0u) ? 1u : 0u; mine = (j == x) ? c : mine; }
        if (sum == G) break;
        __builtin_amdgcn_s_sleep(1);
        if ((++sp & 255u) == 0u) { if (xb_ld(&bar[XB_TMO])) break; if (sp > XB_SPIN_CAP) { atomicAdd(&bar[XB_TMO], 1u); break; } }
    }
    nloc = mine > 0u ? mine : 1u; nx = cnt > 0u ? cnt : 1u;
}
__device__ __forceinline__ void xcd_barrier(const XcdBarrier& b) {
    asm volatile("s_waitcnt vmcnt(0)" ::: "memory");
    __syncthreads();
    if (threadIdx.x == 0) {
        unsigned* bar = b.bar;
        __builtin_amdgcn_s_waitcnt(0);
        unsigned nloc = b.st[0], nx = b.st[1];
        if (nloc == 0u) { xcd_barrier_complete(bar, b.x, nloc, nx); b.st[0] = nloc; b.st[1] = nx; }
        const unsigned old = xb_add(&bar[XB_XSUB(b.x)], 1u);
        const unsigned gen = old / nloc;
        if (old + 1u == (gen + 1u) * nloc) {
            __builtin_amdgcn_fence(__ATOMIC_RELEASE, "agent");
            asm volatile("s_waitcnt vmcnt(0)" ::: "memory");
            const unsigned og = xb_add(&bar[XB_TOP], 1u);
            const unsigned tg = og / nx;
            if (og + 1u == (tg + 1u) * nx) xb_add(&bar[XB_TOPGEN], 1u);
            else XB_SPIN(xb_ld(&bar[XB_TOPGEN]) == tg, bar);
            __builtin_amdgcn_fence(__ATOMIC_ACQUIRE, "agent");
            xb_add(&bar[XB_XGEN(b.x)], 1u);
            asm volatile("s_waitcnt vmcnt(0)" ::: "memory");
        } else {
            XB_SPIN(xb_ld(&bar[XB_XGEN(b.x)]) == gen, bar);
            __builtin_amdgcn_fence(__ATOMIC_ACQUIRE, "agent");
            asm volatile("s_waitcnt vmcnt(0)" ::: "memory");
        }
    }
    __syncthreads();
}

__global__ void __launch_bounds__(512, 2) fwd_kernel(Params P) {
    extern __shared__ __attribute__((aligned(16))) unsigned char lds_raw[];
    LAS unsigned char* lds = (LAS unsigned char*)lds_raw;
    cg::grid_group grid = cg::this_grid();
    const int lo = P.ph_lo, hi = P.ph_hi; int ph = 0;
    const int G = gridDim.x, cb = blockIdx.x;
    unsigned char* ws = P.ws;
    bf16_t* XB = (bf16_t*)(ws + WS_H); bf16_t* ACT = (bf16_t*)(ws + WS_ACT); bf16_t* Y = (bf16_t*)(ws + WS_Y);
    float* R2 = (float*)(ws + WS_SMALL) + SM_R2;
    unsigned long long pr_acc = 0ull, pr_t0 = 0ull;
#define PH_BEGIN if (PROBE_MASK) pr_t0 = __builtin_amdgcn_s_memrealtime(); if (lo <= ph && ph < hi) {
#define PH_END } ++ph; if (lo < ph && ph < hi) xcd_barrier(xbar); \
    if (PROBE_MASK && ((PROBE_MASK >> (ph - 1)) & 1u)) pr_acc += __builtin_amdgcn_s_memrealtime() - pr_t0;
    volatile LAS unsigned* xst = (volatile LAS unsigned*)(lds + LDS_BYTES - 64);
    if (threadIdx.x < 2) xst[threadIdx.x] = 0u;
    __syncthreads();
    if (ws == nullptr) grid.sync();
    XcdBarrier xbar; xbar.bar = (unsigned*)ws; xbar.x = 0; xbar.st = xst;
    if (hi - lo > 1) xbar = xcd_barrier_post((unsigned*)ws, xst);

    PH_BEGIN phase0(P, lds); PH_END

#define MIXER_GLA \
    PH_BEGIN { TileOrder S{M / BM, NIN / BM, (M / BM) * (NIN / BM), G, cb, (const char*)XB, (const char*)(ws + WS_WIN), (size_t)BM * D * 2, (size_t)BM * D * 2, D / BK}; \
        EpiPlain<1> E{(bf16_t*)(ws + WS_QKV), NIN, P.in[10], nullptr, R2}; gemm_phase(lds, D, D, S, E); } s5_idle_prep_inproj(P, lds); PH_END \
    PH_BEGIN gla_phase_a(P, lds); PH_END \
    PH_BEGIN gla_phase_b(P); PH_END \
    PH_BEGIN gla_phase_c(P, lds); PH_END \
    PH_BEGIN { SplitOrder S{{MP / BM, D / BM, (MP / BM) * (D / BM), G, cb, (const char*)(ws + WS_O), (const char*)(ws + WS_WOUT), (size_t)BM * D * 2, (size_t)BM * D * 2, D / BK}, D / 256}; \
        EpiPlain<0> E{Y, D, nullptr, PART, nullptr}; gemm_phase(lds, D, D, S, E); } PH_END
#define MIXER_S5 \
    PH_BEGIN s5_prefix_and_sample(P, lds); PH_END \
    PH_BEGIN { SplitOrder S{{MP / BM, 2 * D / BM, (MP / BM) * (2 * D / BM), G, cb, (const char*)(ws + WS_Z), (const char*)(ws + WS_WGLU), (size_t)BM * D * 2, (size_t)BM * D * 2, D / BK}, D / 256}; \
        EpiGated<1> E{Y, D, P.in[22], (float*)(ws + WS_HLOC)}; gemm_phase(lds, D, D, S, E); } PH_END
#define FFN_GEMMS(l, f, HOOK) \
    PH_BEGIN { TileOrder S{M / BM, NGU / BM, (M / BM) * (NGU / BM), G, cb, (const char*)XB, (const char*)(ws + WS_WGU + (size_t)((l) * 2 + (f)) * NGU * D * 2), (size_t)BM * D * 2, (size_t)BM * D * 2, D / BK}; \
        EpiGated<0> E{ACT, FF, nullptr, nullptr}; gemm_phase(lds, D, D, S, E); } HOOK PH_END \
    PH_BEGIN { SplitOrder S{{MP / BM, D / BM, (MP / BM) * (D / BM), G, cb, (const char*)ACT, (const char*)(ws + WS_WDN + (size_t)((l) * 2 + (f)) * D * FF * 2), (size_t)BM * FF * 2, (size_t)BM * FF * 2, FF / BK}, FF / 256}; \
        EpiPlain<0> E{Y, D, nullptr, PART, nullptr}; gemm_phase(lds, FF, FF, S, E); } PH_END
    const float* ng0 = P.in[5]; const float* ng1 = P.in[5] + 6 * D;
    float* PART = (float*)(ws + WS_PART);
    FFN_GEMMS(0, 0, s5_idle_prep(P, lds, 0);)
    PH_BEGIN row_pass<3, FF / 256>(P.in[0], P.in[1], XB, R2, Y, ng0 + 1 * D, 0.5f, PART, nullptr, nullptr, nullptr, nullptr); PH_END
    MIXER_GLA
    PH_BEGIN row_pass<3, D / 256>(nullptr, nullptr, XB, R2, Y, ng0 + 3 * D, 1.0f, PART, nullptr, nullptr, nullptr, nullptr); PH_END
    FFN_GEMMS(0, 1, s5_idle_prep(P, lds, 1);)
    PH_BEGIN row_pass<3, FF / 256>(nullptr, nullptr, XB, R2, Y, ng0 + 5 * D, 0.5f, PART, nullptr, nullptr, nullptr, nullptr); PH_END
    FFN_GEMMS(1, 0, s5_idle_prep(P, lds, 2);)
    PH_BEGIN row_pass<3, FF / 256>(nullptr, nullptr, XB, R2, Y, ng1 + 1 * D, 0.5f, PART, nullptr, ng1 + 2 * D, (bf16_t*)(ws + WS_HS5), (bf16_t*)(ws + WS_HSMP)); PH_END
    MIXER_S5
    PH_BEGIN row_pass<3, D / 256>(nullptr, nullptr, XB, R2, Y, ng1 + 3 * D, 1.0f, (const float*)(ws + WS_HLOC), nullptr, nullptr, nullptr, nullptr, P.in[22]); PH_END
    FFN_GEMMS(1, 1, )
    PH_BEGIN row_pass<2, FF / 256>(nullptr, nullptr, XB, R2, Y, ng1 + 5 * D, 0.5f, PART, P.out + O_X, nullptr, nullptr, nullptr); PH_END
    if (PROBE_MASK && blockIdx.x == 0 && threadIdx.x == 0) { const unsigned long long t1 = __builtin_amdgcn_s_memrealtime(); while (__builtin_amdgcn_s_memrealtime() - t1 < pr_acc) __builtin_amdgcn_s_sleep(8); }
#undef PH_BEGIN
#undef PH_END
}

__global__ void dbg_checksum(const unsigned* w, size_t nwords, float* out, size_t nout) {
    for (size_t i = (size_t)blockIdx.x * blockDim.x + threadIdx.x; i < nout; i += (size_t)gridDim.x * blockDim.x) {
        unsigned h = 0; for (int j = 0; j < 3; ++j) { const size_t k = 3 * i + j; if (k < nwords) h = h * 0x9E3779B1u + w[k]; }
        out[i] = (float)(h & 0xffffu);
    }
}
extern "C" void kernel_launch(void* const* d_in, const int* in_sizes, int n_in, void* d_out, int out_size, void* d_ws, size_t ws_size, hipStream_t stream) {
    static int grid = 0;
    if (grid == 0) {
        if (n_in != 23 || ws_size < WS_END) { fprintf(stderr, "kernel_launch: unexpected n_in %d or ws_size %zu (< %zu)\n", n_in, ws_size, (size_t)WS_END); grid = -1; return; }
        int dev = 0, cus = 0, per_cu = 0;
        hipGetDevice(&dev); hipDeviceGetAttribute(&cus, hipDeviceAttributeMultiprocessorCount, dev);
        if (hipFuncSetAttribute((const void*)fwd_kernel, hipFuncAttributeMaxDynamicSharedMemorySize, LDS_BYTES) != hipSuccess) { fprintf(stderr, "kernel_launch: hipFuncSetAttribute failed\n"); grid = -1; return; }
        if (hipOccupancyMaxActiveBlocksPerMultiprocessor(&per_cu, (const void*)fwd_kernel, 512, LDS_BYTES) != hipSuccess || per_cu < 1) { fprintf(stderr, "kernel_launch: occupancy query failed (%d)\n", per_cu); grid = -1; return; }
        grid = cus * per_cu;
    }
    if (grid < 0) return;
    if (hipMemsetAsync(d_ws, 0, 16384, stream) != hipSuccess) { fprintf(stderr, "kernel_launch: memset failed\n"); return; }
    Params p{};
    for (int i = 0; i < 23; ++i) p.in[i] = (const float*)d_in[i];
    p.out = (float*)d_out; p.ws = (unsigned char*)d_ws;
#if MULTI_LAUNCH
    for (int k = 0; k < (DBG_NPH ? DBG_NPH : NPH); ++k) { p.ph_lo = k; p.ph_hi = k + 1; hipLaunchKernelGGL(fwd_kernel, dim3(grid), dim3(512), LDS_BYTES, stream, p); }
#if DBG_NPH
    hipLaunchKernelGGL(dbg_checksum, dim3(2048), dim3(256), 0, stream, (const unsigned*)d_ws, (size_t)(WS_END / 4), (float*)d_out, (size_t)out_size);
#endif
#else
    p.ph_lo = 0; p.ph_hi = NPH;
    void* args[] = {&p};
    hipError_t e = hipLaunchCooperativeKernel((const void*)fwd_kernel, dim3(grid), dim3(512), args, LDS_BYTES, stream);
    if (e != hipSuccess) fprintf(stderr, "cooperative launch failed: %s (grid %d)\n", hipGetErrorString(e), grid);
#endif
}
```

```cpp
#include <hip/hip_runtime.h>
#include <hip/hip_cooperative_groups.h>
#include <cstdio>
namespace cg = cooperative_groups;

#ifndef MULTI_LAUNCH
#define MULTI_LAUNCH 0
#endif

#ifndef PROBE_MASK
#define PROBE_MASK 0u
#endif
#ifndef DBG_NPH
#define DBG_NPH 0
#endif
#define LAS __attribute__((address_space(3)))
typedef unsigned short bf16_t;
typedef short bf16x8 __attribute__((ext_vector_type(8)));
typedef float f32x4 __attribute__((ext_vector_type(4)));
typedef unsigned u32x4 __attribute__((ext_vector_type(4)));
typedef unsigned u32x2 __attribute__((ext_vector_type(2)));

constexpr int D = 1024, FF = 2816, NGU = 5632, MP = 16384, MS = 512, M = MP + MS;
constexpr int NIN = 3584;
constexpr int LDIN = 3088;
constexpr float EPS = 1e-6f;
constexpr int NPH = 22;

constexpr size_t O_X = 0, O_GP = 17301504, O_RP = 18350080, O_IP = 18382848, O_GS = 18415616, O_RS = 35192832, O_IS = 35717120;

constexpr size_t MiB = 1u << 20;
constexpr size_t WS_WGU = 1 * MiB;
constexpr size_t WS_WDN = WS_WGU + 44 * MiB;
constexpr size_t WS_WIN = WS_WDN + 22 * MiB;
constexpr size_t WS_WOUT = WS_WIN + 7 * MiB;
constexpr size_t WS_WGLU = WS_WOUT + 2 * MiB;
constexpr size_t WS_S5M = WS_WGLU + 4 * MiB;
constexpr size_t WS_SMALL = WS_S5M + 16 * MiB;
constexpr size_t WS_HSMP = WS_SMALL + 1 * MiB;
constexpr size_t WS_H = WS_SMALL + 2 * MiB;
constexpr size_t WS_BIG = WS_H + 33 * MiB;
constexpr size_t WS_ACT = WS_BIG;
constexpr size_t WS_Y = WS_BIG + 92 * MiB;
constexpr size_t WS_QKV = WS_BIG;
constexpr size_t WS_KC = WS_BIG + 116 * MiB;
constexpr size_t WS_BEND = WS_BIG + 180 * MiB;
constexpr size_t WS_HS5 = WS_BIG;
constexpr size_t WS_HLOC = WS_BIG + 48 * MiB;
constexpr size_t WS_Z = WS_BIG + 128 * MiB;
constexpr size_t WS_PART = WS_BIG + 128 * MiB;
constexpr size_t WS_O = WS_BIG + 181 * MiB;
constexpr size_t WS_END = WS_BIG + 214 * MiB;
constexpr size_t S5M_G = 262144;
constexpr int SM_R2 = 32768;
constexpr int SM_ARE = 0, SM_AIM = 4096, SM_FRE = 8192, SM_FIM = 12288, SM_A16R = 16384, SM_A16I = 20480;

constexpr int LDS_BYTES = 147456;

typedef __bf16 bf16x2_t __attribute__((ext_vector_type(2)));
typedef float f32x2_t __attribute__((ext_vector_type(2)));
__device__ __forceinline__ unsigned cvt_pk_bf16(float lo, float hi) { const f32x2_t v = {lo, hi}; const bf16x2_t b = __builtin_convertvector(v, bf16x2_t); return __builtin_bit_cast(unsigned, b); }
__device__ __forceinline__ float bflo(unsigned w) { return __uint_as_float(w << 16); }
__device__ __forceinline__ float bfhi(unsigned w) { return __uint_as_float(w & 0xffff0000u); }
__device__ __forceinline__ float bf2f(bf16_t b) { return __uint_as_float(((unsigned)b) << 16); }
__device__ __forceinline__ bf16_t f2bf(float f) { return (bf16_t)(cvt_pk_bf16(f, 0.f) & 0xffffu); }
__device__ __forceinline__ float wave_sum(float v) {
#pragma unroll
    for (int o = 1; o < 64; o <<= 1) v += __shfl_xor(v, o);
    return v;
}
__device__ __forceinline__ int otid() { int t = threadIdx.x; asm volatile("" : "+v"(t)); return t; }
__device__ __forceinline__ float sigmoidf_(float a) { return __builtin_amdgcn_rcpf(1.0f + __expf(-a)); }
__device__ __forceinline__ float siluf_(float a) { return a * sigmoidf_(a); }
__device__ __forceinline__ float logf_gate(float z) { return (fminf(z, 0.f) - __logf(1.0f + __expf(-fabsf(z)))) * 0.0625f; }

constexpr int BM = 256, BK = 64, HALF = 128, HTB = HALF * BK * 2;
__device__ __forceinline__ int lds_byte(int r, int c) { const int st = (r >> 4) * 2 + (c >> 5), rr = r & 15, cc = c & 31, ob = rr * 64 + cc * 2; return st * 1024 + (ob ^ (((ob >> 9) & 1) << 5)); }
__device__ __forceinline__ void stage_rc(int b, int& R, int& C) { const int st = b / 1024, sb = b % 1024, swz = sb ^ (((sb >> 9) & 1) << 5); R = (st >> 1) * 16 + swz / 64; C = (st & 1) * 32 + (swz % 64) / 2; }
__device__ __forceinline__ int perm32(int rho) { const int n = rho >> 4, i = rho & 15; return 8 * (i >> 2) + 4 * n + (i & 3); }

struct Unit { const char* A; const char* B; int pm, pn, nt, ks; };

struct TileOrder {
    int nM, nN, nwg, G, c; const char* A0; const char* B0; size_t at, bt; int ntk;
    __device__ __forceinline__ bool next(int i, Unit& u) const {
        const long L = (long)i * G + c; if (L >= nwg) return false;
        u.nt = ntk; u.ks = -1;
        int wgid = (int)L; { const int q = nwg / 8, r = nwg % 8, xcd = wgid % 8, off = wgid / 8; wgid = (xcd < r ? xcd * (q + 1) : r * (q + 1) + (xcd - r) * q) + off; }
        const int nig = 8 * nN, gid = wgid / nig, fm = gid * 8, gsz = (nM - fm) < 8 ? (nM - fm) : 8;
        u.pm = fm + ((wgid % nig) % gsz); u.pn = (wgid % nig) / gsz;
        u.A = A0 + (size_t)u.pm * at; u.B = B0 + (size_t)u.pn * bt; return true;
    }
};
struct SplitOrder {
    TileOrder T; int nks;
    __device__ __forceinline__ bool next(int i, Unit& u) const {
        const int L = i * T.G + T.c;
        if (L < T.nwg) return T.next(i, u);
        const int j = L - T.nwg, ns = 2 * T.nN; if (j >= ns * nks) return false;
        const int st = j % ns, ks = j / ns; u.pm = 64 + st / T.nN; u.pn = st % T.nN; u.nt = 4; u.ks = ks;
        u.A = T.A0 + (size_t)u.pm * T.at + (size_t)ks * 512; u.B = T.B0 + (size_t)u.pn * T.bt + (size_t)ks * 512; return true;
    }
};
struct OneUnit { Unit u; __device__ __forceinline__ bool next(int i, Unit& o) const { if (i) return false; o = u; return true; } };
struct S5Order {
    int G, c; const char* A0; const char* B0; int ntk;
    __device__ __forceinline__ bool next(int i, Unit& u) const {
        const int L = i * G + c; if (L >= 256) return false;
        u.nt = ntk; u.ks = -1;
        { const int xcd = L & 7, idx = L >> 3, combo = xcd * 8 + (idx >> 2); u.pn = (combo >> 2) * 4 + (idx & 3); u.pm = combo & 3; }
        u.A = A0 + (size_t)u.pn * (1024 * 384 * 2) + (size_t)u.pm * (BM * 384 * 2); u.B = B0 + (size_t)u.pn * 262144; return true;
    }
};

template <class Epi, class Sched>
__device__ __forceinline__ void gemm_phase(LAS unsigned char* lds, const int lda, const int ldb, const Sched& S, const Epi& E) {
    int tid_ = threadIdx.x; asm volatile("" : "+v"(tid_));
    const int tid = tid_, wid = __builtin_amdgcn_readfirstlane(tid >> 6), lane = tid & 63, wr = wid >> 2, wc = wid & 3, fr = lane & 15, fq = lane >> 4;
    unsigned voffA[2], voffB[2];
#pragma unroll
    for (int i = 0; i < 2; ++i) { int R, C; stage_rc(tid * 16 + i * 8192, R, C); const int Rb = (R & ~31) + perm32(R & 31);
        voffA[i] = (unsigned)(R * lda + C) * 2u; voffB[i] = (unsigned)(Rb * ldb + C) * 2u; }
    const size_t kstep = (size_t)(BK * 2);
    const size_t hstepA = (size_t)HALF * lda * 2, hstepB = (size_t)HALF * ldb * 2;
    const unsigned ldsw = (unsigned)wid * 1024u;
    const int aoff = lds_byte(wr * 64 + fr, fq * 8), boff = lds_byte(wc * 32 + fr, fq * 8);
#define PG8_SA(b, h) (((b) * 2 + (h)) * HTB)
#define PG8_SB(b, h) ((4 + (b) * 2 + (h)) * HTB)
#define PG8_STAGE(bufoff, gbase, voff) do { _Pragma("unroll") for (int _i = 0; _i < 2; ++_i) \
        __builtin_amdgcn_global_load_lds((const unsigned*)((const char*)(gbase) + (voff)[_i]), (LAS unsigned*)(lds + (bufoff) + ldsw + _i * 8192), 16, 0, 0); } while (0)
#define PG8_LDA(dst, b, h) do { _Pragma("unroll") for (int m = 0; m < 4; ++m) _Pragma("unroll") for (int k = 0; k < 2; ++k) dst[m][k] = *(const LAS bf16x8*)(lds + PG8_SA(b, h) + aoff + m * 2048 + k * 1024); } while (0)
#define PG8_LDB(dst, b, h) do { _Pragma("unroll") for (int n = 0; n < 2; ++n) _Pragma("unroll") for (int k = 0; k < 2; ++k) dst[n][k] = *(const LAS bf16x8*)(lds + PG8_SB(b, h) + boff + n * 2048 + k * 1024); } while (0)
#define PG8_MMA(ai, bj, At, Bt) do { __builtin_amdgcn_s_setprio(1); _Pragma("unroll") for (int m = 0; m < 4; ++m) _Pragma("unroll") for (int n = 0; n < 2; ++n) _Pragma("unroll") for (int k = 0; k < 2; ++k) \
        acc[ai][bj][m][n] = __builtin_amdgcn_mfma_f32_16x16x32_bf16(Bt[n][k], At[m][k], acc[ai][bj][m][n], 0, 0, 0); __builtin_amdgcn_s_setprio(0); } while (0)
#define PG8_WAIT_V(n) asm volatile("s_waitcnt vmcnt(" #n ")" ::: "memory")
#define PG8_WAIT_L(n) asm volatile("s_waitcnt lgkmcnt(" #n ")" ::: "memory")
#define PG8_BAR __builtin_amdgcn_s_barrier()
#define PG8_SCHED __builtin_amdgcn_sched_barrier(0)
    Unit cur, nxt; int ui = 0;
    if (!S.next(0, cur)) return;
    f32x4 acc[2][2][4][2];
#pragma unroll
    for (int a = 0; a < 2; ++a)
#pragma unroll
        for (int b = 0; b < 2; ++b)
#pragma unroll
            for (int m = 0; m < 4; ++m)
#pragma unroll
                for (int n = 0; n < 2; ++n) acc[a][b][m][n] = (f32x4){0.f, 0.f, 0.f, 0.f};
    bf16x8 At[4][2], B0[2][2], B1[2][2];
    const char* cA = cur.A; const char* cB = cur.B;
    PG8_STAGE(PG8_SB(0, 0), cB, voffB); PG8_STAGE(PG8_SA(0, 0), cA, voffA); PG8_STAGE(PG8_SB(0, 1), cB + hstepB, voffB); PG8_STAGE(PG8_SA(0, 1), cA + hstepA, voffA);
    if (wr == 1) PG8_BAR;
    PG8_WAIT_V(4); PG8_BAR;
    PG8_STAGE(PG8_SB(1, 0), cB + kstep, voffB); PG8_STAGE(PG8_SA(1, 0), cA + kstep, voffA); PG8_STAGE(PG8_SB(1, 1), cB + hstepB + kstep, voffB);
    PG8_WAIT_V(6); PG8_BAR;
    for (;;) {
        const bool has_next = S.next(ui + 1, nxt);
        const char* nA = has_next ? nxt.A : cA; const char* nB = has_next ? nxt.B : cB;
        const int nt = cur.nt;
        for (int t = 0; t < nt; t += 2) {
            const bool last = (t == nt - 2);
            const char* a1 = cA + (size_t)(t + 1) * kstep;
            const char* a2 = last ? nA : cA + (size_t)(t + 2) * kstep; const char* b2 = last ? nB : cB + (size_t)(t + 2) * kstep;
            const char* a3 = a2 + kstep; const char* b3 = b2 + kstep;
            PG8_LDB(B0, 0, 0); PG8_SCHED; PG8_LDA(At, 0, 0); PG8_STAGE(PG8_SA(1, 1), a1 + hstepA, voffA);
            PG8_WAIT_L(8); PG8_BAR; PG8_WAIT_L(0); PG8_MMA(0, 0, At, B0); PG8_BAR; PG8_SCHED;
            PG8_LDB(B1, 0, 1); PG8_STAGE(PG8_SB(0, 0), b2, voffB);
            PG8_BAR; PG8_WAIT_L(0); PG8_MMA(0, 1, At, B1); PG8_BAR;
            PG8_LDA(At, 0, 1); PG8_STAGE(PG8_SA(0, 0), a2, voffA);
            PG8_BAR; PG8_WAIT_L(0); PG8_MMA(1, 0, At, B0); PG8_BAR; PG8_SCHED;
            PG8_STAGE(PG8_SB(0, 1), b2 + hstepB, voffB);
            PG8_WAIT_V(6); PG8_BAR; PG8_MMA(1, 1, At, B1); PG8_BAR;
            PG8_LDB(B0, 1, 0); PG8_SCHED; PG8_LDA(At, 1, 0); PG8_STAGE(PG8_SA(0, 1), a2 + hstepA, voffA);
            PG8_WAIT_L(8); PG8_BAR; PG8_WAIT_L(0); PG8_MMA(0, 0, At, B0); PG8_BAR; PG8_SCHED;
            PG8_LDB(B1, 1, 1); PG8_STAGE(PG8_SB(1, 0), b3, voffB);
            PG8_BAR; PG8_WAIT_L(0); PG8_MMA(0, 1, At, B1); PG8_BAR;
            PG8_LDA(At, 1, 1); PG8_STAGE(PG8_SA(1, 0), a3, voffA);
            PG8_BAR; PG8_WAIT_L(0); PG8_MMA(1, 0, At, B0); PG8_BAR; PG8_SCHED;
            PG8_STAGE(PG8_SB(1, 1), b3 + hstepB, voffB);
            PG8_WAIT_V(6); PG8_BAR; PG8_MMA(1, 1, At, B1); PG8_BAR;
        }
        E(acc, cur, wr, wc, fr, fq);
        if (!has_next) break;
#pragma unroll
        for (int a = 0; a < 2; ++a)
#pragma unroll
            for (int b = 0; b < 2; ++b)
#pragma unroll
                for (int m = 0; m < 4; ++m)
#pragma unroll
                    for (int n = 0; n < 2; ++n) acc[a][b][m][n] = (f32x4){0.f, 0.f, 0.f, 0.f};
        cur = nxt; cA = nA; cB = nB; ++ui;
    }
    PG8_WAIT_V(0);
    if (wr == 0) PG8_BAR;
    PG8_BAR;
#undef PG8_SA
#undef PG8_SB
#undef PG8_STAGE
#undef PG8_LDA
#undef PG8_LDB
#undef PG8_MMA
#undef PG8_WAIT_V
#undef PG8_WAIT_L
#undef PG8_BAR
#undef PG8_SCHED
}

template <int MODE>
struct EpiGated {
    bf16_t* O; int ldc; const float* bias; float* part;
    __device__ __forceinline__ void operator()(const f32x4 (&acc)[2][2][4][2], const Unit& u, int wr, int wc, int fr, int fq) const {
        const int row0 = u.pm * BM + wr * 64 + fr, col0 = u.pn * 128 + wc * 32 + 8 * fq;
        if (MODE == 1 && u.ks >= 0) {
#pragma unroll
            for (int bj = 0; bj < 2; ++bj)
#pragma unroll
                for (int ai = 0; ai < 2; ++ai)
#pragma unroll
                    for (int m = 0; m < 4; ++m) { float* p = part + ((size_t)u.ks * MS + (row0 + ai * HALF + m * 16 - MP)) * (2 * ldc) + u.pn * BM + bj * HALF + wc * 32 + 8 * fq;
                        *(f32x4*)p = acc[ai][bj][m][0]; *(f32x4*)(p + 4) = acc[ai][bj][m][1]; }
            return;
        }
        f32x4 b0[2], b1[2];
#pragma unroll
        for (int n = 0; n < 2; ++n) { b0[n] = (f32x4){0.f, 0.f, 0.f, 0.f}; b1[n] = b0[n];
            if (MODE == 1) { b0[n] = *(const f32x4*)(bias + col0 + 4 * n); b1[n] = *(const f32x4*)(bias + ldc + col0 + 4 * n); } }
#pragma unroll
        for (int ai = 0; ai < 2; ++ai)
#pragma unroll
            for (int m = 0; m < 4; ++m) {
                float v[8]; const float rs = 1.0f;
#pragma unroll
                for (int n = 0; n < 2; ++n)
#pragma unroll
                    for (int j = 0; j < 4; ++j) { const float a = acc[ai][0][m][n][j] * rs + b0[n][j], b = acc[ai][1][m][n][j] * rs + b1[n][j];
                        v[4 * n + j] = (MODE == 0) ? (a * b) * __builtin_amdgcn_rcpf(1.0f + __builtin_amdgcn_exp2f(-a))
                                                   : a * sigmoidf_(b); }
                u32x4 w; w.x = cvt_pk_bf16(v[0], v[1]); w.y = cvt_pk_bf16(v[2], v[3]); w.z = cvt_pk_bf16(v[4], v[5]); w.w = cvt_pk_bf16(v[6], v[7]);
                *(u32x4*)(O + (size_t)(row0 + ai * HALF + m * 16) * ldc + col0) = w;
            }
    }
};
template <int GLA>
struct EpiPlain {
    bf16_t* O; int ldc; const float* bg; float* part; const float* r2;
    __device__ __forceinline__ void operator()(const f32x4 (&acc)[2][2][4][2], const Unit& u, int wr, int wc, int fr, int fq) const {
        const int row0 = u.pm * BM + wr * 64 + fr, col0 = u.pn * BM + wc * 32 + 8 * fq;
        if (!GLA && u.ks >= 0) {
#pragma unroll
            for (int bj = 0; bj < 2; ++bj)
#pragma unroll
                for (int ai = 0; ai < 2; ++ai)
#pragma unroll
                    for (int m = 0; m < 4; ++m) { float* p = part + ((size_t)u.ks * MS + (row0 + ai * HALF + m * 16 - MP)) * D + col0 + bj * HALF;
                        *(f32x4*)p = acc[ai][bj][m][0]; *(f32x4*)(p + 4) = acc[ai][bj][m][1]; }
            return;
        }
        const bool lf = false;
#pragma unroll
        for (int bj = 0; bj < 2; ++bj) {
            f32x4 bb[2];
#pragma unroll
            for (int n = 0; n < 2; ++n) bb[n] = lf ? *(const f32x4*)(bg + (col0 - 3072) + bj * HALF + 4 * n) : (f32x4){0.f, 0.f, 0.f, 0.f};
#pragma unroll
            for (int ai = 0; ai < 2; ++ai)
#pragma unroll
                for (int m = 0; m < 4; ++m) {
                    float v[8]; const float rs = 1.0f;
#pragma unroll
                    for (int n = 0; n < 2; ++n)
#pragma unroll
                        for (int j = 0; j < 4; ++j) { float a = acc[ai][bj][m][n][j] * rs;
                            if (lf) a += bb[n][j];
                            v[4 * n + j] = a; }
                    u32x4 w; w.x = cvt_pk_bf16(v[0], v[1]); w.y = cvt_pk_bf16(v[2], v[3]); w.z = cvt_pk_bf16(v[4], v[5]); w.w = cvt_pk_bf16(v[6], v[7]);
                    *(u32x4*)(O + (size_t)(row0 + ai * HALF + m * 16) * ldc + col0 + bj * HALF) = w;
                }
        }
    }
};
struct EpiS5A {
    bf16_t* HL;
    __device__ __forceinline__ void operator()(const f32x4 (&acc)[2][2][4][2], const Unit& u, int wr, int wc, int fr, int fq) const {
        const int row0 = u.pm * BM + wr * 64 + fr, col0 = wc * 32 + 8 * fq;
#pragma unroll
        for (int ai = 0; ai < 2; ++ai)
#pragma unroll
            for (int m = 0; m < 4; ++m) { const f32x4 a0 = acc[ai][0][m][0], a1 = acc[ai][0][m][1];
                u32x4 w; w.x = cvt_pk_bf16(a0[0], a0[1]); w.y = cvt_pk_bf16(a0[2], a0[3]); w.z = cvt_pk_bf16(a1[0], a1[1]); w.w = cvt_pk_bf16(a1[2], a1[3]);
                *(u32x4*)(HL + ((size_t)u.pn * 1024 + row0 + ai * HALF + m * 16) * 128 + col0) = w; }
    }
};
struct EpiS5B {
    unsigned char* ws; const float* dsk;
    __device__ __forceinline__ void operator()(const f32x4 (&acc)[2][2][4][2], const Unit& u, int wr, int wc, int fr, int fq) const {
        bf16_t* Z = (bf16_t*)(ws + WS_Z); const bf16_t* HS5 = (const bf16_t*)(ws + WS_HS5);
        asm volatile("" : "+v"(fq));
        const int g = u.pn, c0 = (8 * fq) & 15;
        const f32x4 d0 = *(const f32x4*)(dsk + g * 16 + c0), d1 = *(const f32x4*)(dsk + g * 16 + c0 + 4);
#pragma unroll
        for (int bj = 0; bj < 2; ++bj) { const int t = 8 * bj + 2 * wc + (fq >> 1);
#pragma unroll
            for (int ai = 0; ai < 2; ++ai)
#pragma unroll
                for (int m = 0; m < 4; ++m) { const int colr = u.pm * BM + ai * HALF + wr * 64 + m * 16 + fr; const size_t off = (size_t)(colr * 16 + t) * D + g * 16 + c0;
                    const u32x4 uu = *(const u32x4*)(HS5 + ((size_t)g * 1024 + colr) * 384 + t * 16 + c0); const f32x4 a0 = acc[ai][bj][m][0], a1 = acc[ai][bj][m][1];
                    u32x4 w; w.x = cvt_pk_bf16(a0[0] + d0[0] * bflo(uu.x), a0[1] + d0[1] * bfhi(uu.x)); w.y = cvt_pk_bf16(a0[2] + d0[2] * bflo(uu.y), a0[3] + d0[3] * bfhi(uu.y));
                    w.z = cvt_pk_bf16(a1[0] + d1[0] * bflo(uu.z), a1[1] + d1[1] * bfhi(uu.z)); w.w = cvt_pk_bf16(a1[2] + d1[2] * bflo(uu.w), a1[3] + d1[3] * bfhi(uu.w));
                    *(u32x4*)(Z + off) = w; }
        }
    }
};

struct Params { const float* in[23]; float* out; unsigned char* ws; int ph_lo, ph_hi; };

__device__ __forceinline__ int rp_row(int kidx, int gw, int NGW) {
    if (NGW % MS == 0) { const int stride = NGW / MS, kp = (MP + NGW - 1) / NGW;
        if (kidx == 0) return (gw % stride == 0) ? MP + gw / stride : -1;
        if (kidx > kp) return -1;
        const int m = gw + (kidx - 1) * NGW; return m < MP ? m : -1; }
    const int KMAX = (M + NGW - 1) / NGW; if (kidx >= KMAX) return -1;
    const int kk = (kidx + KMAX - 1) % KMAX, m = gw + kk * NGW; return m < M ? m : -1;
}
template <int R, int NKS>
__device__ __forceinline__ void row_pass(const float* xf_p, const float* xf_s, bf16_t* XB, float* R2, const bf16_t* Y, const float* g_post, float scale,
                                         const float* part, float* outf, const float* g_pre, bf16_t* HS5, bf16_t* HSMP, const float* glu_bias = nullptr) {
    const int tid = otid(); const int lane = tid & 63, gw = blockIdx.x * 8 + (tid >> 6), NGW = gridDim.x * 8;
#define CJ(j) (512 * ((j) >> 1) + 8 * lane + 4 * ((j) & 1))
    const int KMAX = (NGW % MS == 0) ? (MP + NGW - 1) / NGW + 1 : (M + NGW - 1) / NGW;
    for (int k0 = 0; k0 < KMAX; k0 += R) {
        f32x4 v[R][4], yv[R][4];
#pragma unroll
        for (int r = 0; r < R; ++r) { const int mi = rp_row(k0 + r, gw, NGW), m = mi >= 0 ? mi : gw;
            if (xf_p) { const float* xr = (m < MP) ? xf_p + (size_t)m * D : xf_s + (size_t)(m - MP) * D;
#pragma unroll
                for (int j = 0; j < 4; ++j) v[r][j] = *(const f32x4*)(xr + CJ(j));
            } else {
                const float ir = 1.0f / R2[m];
#pragma unroll
                for (int jj = 0; jj < 2; ++jj) { const u32x4 w = *(const u32x4*)(XB + (size_t)m * D + 512 * jj + 8 * lane);
                    v[r][2 * jj] = (f32x4){bflo(w.x), bfhi(w.x), bflo(w.y), bfhi(w.y)} * ir; v[r][2 * jj + 1] = (f32x4){bflo(w.z), bfhi(w.z), bflo(w.w), bfhi(w.w)} * ir; }
            }
            if (Y) {
                if (glu_bias && m >= MP) {
#pragma unroll
                    for (int j = 0; j < 4; ++j) { const int nc = 256 * (4 * (j >> 1) + (lane >> 4)) + 8 * (lane & 15) + 4 * (j & 1);
                        f32x4 sv = *(const f32x4*)(glu_bias + CJ(j)), sg = *(const f32x4*)(glu_bias + D + CJ(j));
                        f32x4 tv[NKS], tg[NKS];
#pragma unroll
                        for (int ks = 0; ks < NKS; ++ks) { const float* pp = part + ((size_t)ks * MS + (m - MP)) * (2 * D) + nc; tv[ks] = *(const f32x4*)pp; tg[ks] = *(const f32x4*)(pp + 128); }
#pragma unroll
                        for (int ks = 0; ks < NKS; ++ks) { sv += tv[ks]; sg += tg[ks]; }
                        yv[r][j] = (f32x4){sv.x * sigmoidf_(sg.x), sv.y * sigmoidf_(sg.y), sv.z * sigmoidf_(sg.z), sv.w * sigmoidf_(sg.w)}; }
                } else if (part && m >= MP) {
#pragma unroll
                    for (int j = 0; j < 4; ++j) { f32x4 t[NKS];
#pragma unroll
                        for (int ks = 0; ks < NKS; ++ks) t[ks] = *(const f32x4*)(part + ((size_t)ks * MS + (m - MP)) * D + CJ(j));
                        f32x4 s = t[0];
#pragma unroll
                        for (int ks = 1; ks < NKS; ++ks) s += t[ks];
                        yv[r][j] = s; }
                } else {
#pragma unroll
                    for (int jj = 0; jj < 2; ++jj) { const u32x4 w = *(const u32x4*)(Y + (size_t)m * D + 512 * jj + 8 * lane);
                        yv[r][2 * jj] = (f32x4){bflo(w.x), bfhi(w.x), bflo(w.y), bfhi(w.y)}; yv[r][2 * jj + 1] = (f32x4){bflo(w.z), bfhi(w.z), bflo(w.w), bfhi(w.w)}; }
                }
            }
        }
#pragma unroll
        for (int r = 0; r < R; ++r) { const int m = rp_row(k0 + r, gw, NGW); if (m < 0) continue;
            if (Y) {
                float ss = 0.f;
#pragma unroll
                for (int j = 0; j < 4; ++j) ss += (yv[r][j].x * yv[r][j].x + yv[r][j].y * yv[r][j].y) + (yv[r][j].z * yv[r][j].z + yv[r][j].w * yv[r][j].w);
                const float rr = rsqrtf(wave_sum(ss) * (1.0f / D) + EPS) * scale;
#pragma unroll
                for (int j = 0; j < 4; ++j) { const f32x4 g = *(const f32x4*)(g_post + CJ(j)); v[r][j] = v[r][j] + yv[r][j] * g * rr; }
            }
            if (outf) {
#pragma unroll
                for (int j = 0; j < 4; ++j) *(f32x4*)(outf + (size_t)m * D + CJ(j)) = v[r][j];
            } else {
                float ss = 0.f;
#pragma unroll
                for (int j = 0; j < 4; ++j) ss += (v[r][j].x * v[r][j].x + v[r][j].y * v[r][j].y) + (v[r][j].z * v[r][j].z + v[r][j].w * v[r][j].w);
                const float rr = rsqrtf(wave_sum(ss) * (1.0f / D) + EPS);
#pragma unroll
                for (int jj = 0; jj < 2; ++jj) { const f32x4 a = v[r][2 * jj] * rr, b = v[r][2 * jj + 1] * rr;
                    u32x4 w; w.x = cvt_pk_bf16(a.x, a.y); w.y = cvt_pk_bf16(a.z, a.w); w.z = cvt_pk_bf16(b.x, b.y); w.w = cvt_pk_bf16(b.z, b.w);
                    *(u32x4*)(XB + (size_t)m * D + 512 * jj + 8 * lane) = w; }
                if (lane == 0) R2[m] = rr;
                if (g_pre) {
#pragma unroll
                    for (int jj = 0; jj < 2; ++jj) { const f32x4 ga = *(const f32x4*)(g_pre + CJ(2 * jj)), gb = *(const f32x4*)(g_pre + CJ(2 * jj + 1));
                        const f32x4 ha = v[r][2 * jj] * ga * rr, hb = v[r][2 * jj + 1] * gb * rr;
                        u32x4 w; w.x = cvt_pk_bf16(ha.x, ha.y); w.y = cvt_pk_bf16(ha.z, ha.w); w.z = cvt_pk_bf16(hb.x, hb.y); w.w = cvt_pk_bf16(hb.z, hb.w);
                        if (m < MP) { const int gi = 32 * jj + (lane >> 1), c = (lane & 1) * 8;
                            *(u32x4*)(HS5 + ((size_t)gi * 1024 + (m >> 4)) * 384 + (m & 15) * 16 + c) = w; }
                        else *(u32x4*)(HSMP + (size_t)(m - MP) * D + 512 * jj + 8 * lane) = w; }
                }
            }
        }
    }
}
#undef CJ

__device__ __forceinline__ void transpose_item(const float* W, int ldw, int K, int scol0, bf16_t* Bt, int drow0, int k0, float scale, const float* gk, LAS bf16_t* scr, int lane) {
    const float* src = W + (size_t)(k0 + (lane >> 5)) * ldw + scol0 + 4 * (lane & 31);
#pragma unroll 16
    for (int i = 0; i < 32; ++i) { const f32x4 w = __builtin_nontemporal_load((const f32x4*)(src + (size_t)(2 * i) * ldw));
        const float sc = gk ? gk[k0 + 2 * i + (lane >> 5)] * scale : scale;
        u32x2 o; o.x = cvt_pk_bf16(w.x * sc, w.y * sc); o.y = cvt_pk_bf16(w.z * sc, w.w * sc);
        *(LAS u32x2*)(scr + (2 * i + (lane >> 5)) * 136 + 4 * (lane & 31)) = o; }
    asm volatile("s_waitcnt lgkmcnt(0)" ::: "memory");
#pragma unroll 4
    for (int t = 0; t < 16; ++t) { const int task = t * 64 + lane, n = task >> 3, kc = task & 7; const LAS bf16_t* s = scr + (kc * 8) * 136 + n;
        u32x4 o; o.x = (unsigned)s[0] | ((unsigned)s[136] << 16); o.y = (unsigned)s[272] | ((unsigned)s[408] << 16);
        o.z = (unsigned)s[544] | ((unsigned)s[680] << 16); o.w = (unsigned)s[816] | ((unsigned)s[952] << 16);
        *(u32x4*)(Bt + (size_t)(drow0 + n) * K + k0 + 8 * kc) = o; }
    asm volatile("s_waitcnt lgkmcnt(0)" ::: "memory");
}

__device__ __forceinline__ void s5_prep_group(const Params& P, LAS unsigned char* lds, int g, int qt) {
    LAS float* apr = (LAS float*)lds;
    LAS float* api = apr + 17 * 64;
    LAS float* bbr = api + 17 * 64;
    LAS float* bbi = bbr + 1024;
    LAS float* cre = bbi + 1024;
    LAS float* cim = cre + 1024;
    LAS float* fre = cim + 1024;
    LAS float* fim = fre + 64;
    LAS float* kmat = fim + 64;
    const int tid = otid();
    float* sm = (float*)(P.ws + WS_SMALL);
    bf16_t* Wm = (bf16_t*)(P.ws + WS_S5M + (size_t)g * S5M_G);
    bf16_t* TE = Wm + 128 * 256;
    if (tid < 64) {
        const int p = tid; const float lr = P.in[13][g * 64 + p], li = P.in[14][g * 64 + p]; const float dt = expf(P.in[15][g]);
        float a1r = 0.f, a1i = 0.f;
        for (int tau = 0; tau <= 16; ++tau) {
            const float mag = expf(lr * dt * (float)tau);
            double rev = (double)li * (double)dt * (double)tau * 0.15915494309189535; rev -= __builtin_rint(rev);
            const float rr = (float)rev; const float s = __builtin_amdgcn_sinf(rr), c = __builtin_amdgcn_cosf(rr);
            apr[tau * 64 + p] = mag * c; api[tau * 64 + p] = mag * s;
            if (tau == 1) { a1r = mag * c; a1i = mag * s; }
            if (tau == 16 && qt == 0) { sm[SM_A16R + g * 64 + p] = mag * c; sm[SM_A16I + g * 64 + p] = mag * s; }
        }
        const float nr = a1r - 1.0f, ni = a1i, den = lr * lr + li * li;
        const float fr_ = (nr * lr + ni * li) / den, fi_ = (ni * lr - nr * li) / den;
        fre[p] = fr_; fim[p] = fi_;
        if (qt == 0) { sm[SM_ARE + g * 64 + p] = a1r; sm[SM_AIM + g * 64 + p] = a1i; sm[SM_FRE + g * 64 + p] = fr_; sm[SM_FIM + g * 64 + p] = fi_; }
    }
    __syncthreads();
    for (int idx = tid; idx < 1024; idx += 512) { const int p = idx >> 4; const float br = P.in[16][g * 1024 + idx], bi = P.in[17][g * 1024 + idx];
        bbr[idx] = fre[p] * br - fim[p] * bi; bbi[idx] = fre[p] * bi + fim[p] * br;
        cre[idx] = P.in[18][g * 1024 + idx]; cim[idx] = P.in[19][g * 1024 + idx]; }
    __syncthreads();
    for (int idx = qt * 8192 + tid; idx < (qt + 1) * 8192; idx += 512) { const int row = idx >> 8, col = idx & 255, s = col >> 4, c = col & 15, p = row & 63, im = row >> 6;
        const float ar = apr[(15 - s) * 64 + p], ai = api[(15 - s) * 64 + p], br = bbr[p * 16 + c], bi = bbi[p * 16 + c];
        Wm[idx] = f2bf(im ? (ar * bi + ai * br) : (ar * br - ai * bi)); }
    for (int i2 = tid; i2 < 1024; i2 += 512) { const int tau = i2 >> 6, cp = 4 * qt + ((i2 >> 4) & 3), c = i2 & 15, idx = (tau << 8) + (cp << 4) + c; float sum = 0.f;
        for (int p = 0; p < 64; ++p) { const float cr = cre[cp * 64 + p], ci = cim[cp * 64 + p], ar = apr[tau * 64 + p], ai = api[tau * 64 + p];
            const float car = cr * ar - ci * ai, cai = cr * ai + ci * ar; sum += car * bbr[p * 16 + c] - cai * bbi[p * 16 + c]; }
        kmat[idx] = sum; }
    __syncthreads();
    for (int i2 = tid; i2 < 64 * 384; i2 += 512) { const int r2 = i2 / 384, col = i2 - r2 * 384, t = r2 >> 2, cp = 4 * qt + (r2 & 3), row = t * 16 + cp, idx = row * 384 + col; float v;
        if (col < 256) { const int s = col >> 4, c = col & 15; v = (s <= t) ? kmat[((t - s) << 8) + (cp << 4) + c] : 0.f; }
        else { const int pp = col - 256, p = pp & 63, im = pp >> 6; const float cr = cre[cp * 64 + p], ci = cim[cp * 64 + p], ar = apr[(t + 1) * 64 + p], ai = api[(t + 1) * 64 + p];
            v = im ? -(cr * ai + ci * ar) : (cr * ar - ci * ai); }
        TE[idx] = f2bf(v); }
    __syncthreads();
}

__device__ __forceinline__ void s5_idle_prep(const Params& P, LAS unsigned char* lds, int slot) {
    const int G = gridDim.x, nfull = ((M / BM) * (NGU / BM)) % G, cb = blockIdx.x;
    if (nfull == 0 || cb < nfull) return;
    const int wi = slot * (G - nfull) + (cb - nfull);
    if (wi < 256) s5_prep_group(P, lds, wi >> 2, wi & 3);
}
__device__ __forceinline__ void s5_idle_prep_inproj(const Params& P, LAS unsigned char* lds) {
    const int G = gridDim.x, nf1 = ((M / BM) * (NGU / BM)) % G, nf2 = ((M / BM) * (NIN / BM)) % G, cb = blockIdx.x;
    if (nf1 == 0 || nf2 == 0 || cb < nf2) return;
    const int wi = 3 * (G - nf1) + (cb - nf2);
    if (wi < 256) s5_prep_group(P, lds, wi >> 2, wi & 3);
}
__device__ __forceinline__ void phase0(const Params& P, LAS unsigned char* lds) {
    const int tid = otid(), lane = tid & 63, wave = tid >> 6;
    const int gw = blockIdx.x * 8 + wave, NGW = gridDim.x * 8;
    LAS bf16_t* scr = (LAS bf16_t*)(lds + wave * 17408);
    bf16_t* WGU = (bf16_t*)(P.ws + WS_WGU); bf16_t* WDN = (bf16_t*)(P.ws + WS_WDN); bf16_t* WIN = (bf16_t*)(P.ws + WS_WIN);
    bf16_t* WOUT = (bf16_t*)(P.ws + WS_WOUT); bf16_t* WGLU = (bf16_t*)(P.ws + WS_WGLU);
    constexpr int I_GU = 4 * 16 * 44, I_DN = 4 * 44 * 8, I_IN = 16 * 24, I_OUT = 16 * 8, I_GLU = 16 * 16;
#pragma unroll 1
    for (int step = 0; step < 2; ++step) {
    if (((blockIdx.x & 1) != 0) == (step == 0)) {
        { const int G_ = gridDim.x, nf1_ = ((M / BM) * (NGU / BM)) % G_, nf2_ = ((M / BM) * (NIN / BM)) % G_;
          const int first_ = (nf1_ && nf2_) ? 3 * (G_ - nf1_) + (G_ - nf2_) : (nf1_ ? 3 * (G_ - nf1_) : 0);
          for (int wi = first_ + blockIdx.x; wi < 256; wi += gridDim.x) s5_prep_group(P, lds, wi >> 2, wi & 3); }
    } else {
    for (int it = blockIdx.x + gridDim.x * wave; it < I_GU + I_DN + I_IN + I_OUT + I_GLU; it += NGW) {
        int r = it;
        if (r < I_GU) { const int lf = r / 704, rr = r % 704, kb = rr / 44, nb = rr % 44, n0 = nb * 128, pn = n0 >> 8, bj = (n0 >> 7) & 1;
            transpose_item(P.in[6] + (size_t)lf * D * NGU, NGU, D, bj * FF + pn * 128, WGU + (size_t)lf * NGU * D, n0, kb * 64, bj ? 0.6931471805599453f : 1.4426950408889634f, P.in[5] + (size_t)((lf >> 1) * 6 + (lf & 1) * 4) * D, scr, lane); continue; }
        r -= I_GU;
        if (r < I_DN) { const int lf = r / 352, rr = r % 352, kb = rr / 8, nb = rr % 8;
            transpose_item(P.in[7] + (size_t)lf * FF * D, D, FF, nb * 128, WDN + (size_t)lf * D * FF, nb * 128, kb * 64, 1.0f, nullptr, scr, lane); continue; }
        r -= I_DN;
        if (r < I_IN) { const int kb = r / 24, nb = r % 24, n0 = nb * 128;
            transpose_item(P.in[8], LDIN, D, n0, WIN, n0, kb * 64, n0 < 512 ? 0.08838834764831845f : 1.0f, P.in[5] + 2 * D, scr, lane); continue; }
        r -= I_IN;
        if (r < I_OUT) { const int kb = r / 8, nb = r % 8; transpose_item(P.in[12], D, D, nb * 128, WOUT, nb * 128, kb * 64, 1.0f, nullptr, scr, lane); continue; }
        r -= I_OUT;
        { const int kb = r / 16, nb = r % 16, n0 = nb * 128, pn = n0 >> 8, bj = (n0 >> 7) & 1;
            transpose_item(P.in[21], 2 * D, D, bj * D + pn * 128, WGLU, n0, kb * 64, 1.0f, nullptr, scr, lane); }
    }
    for (int idx = blockIdx.x * 512 + tid; idx < 64 * 1024; idx += gridDim.x * 512) { const int jb = idx >> 10, k = idx & 1023;
        const float* wr = P.in[8] + (size_t)k * LDIN + 3072; const f32x4 a0 = *(const f32x4*)wr, a1 = *(const f32x4*)(wr + 4), a2 = *(const f32x4*)(wr + 8), a3 = *(const f32x4*)(wr + 12);
        const float a[16] = {a0.x, a0.y, a0.z, a0.w, a1.x, a1.y, a1.z, a1.w, a2.x, a2.y, a2.z, a2.w, a3.x, a3.y, a3.z, a3.w}; const float gk = P.in[5][2 * D + k];
#pragma unroll
        for (int jj = 0; jj < 8; ++jj) { const int j = jb * 8 + jj; float s = 0.f;
#pragma unroll
            for (int r = 0; r < 16; ++r) s += a[r] * P.in[9][r * 512 + j];
            WIN[(size_t)(3072 + j) * D + k] = f2bf(s * gk); } }
    }
    __syncthreads();
    }
    row_pass<3, 1>(P.in[0], P.in[1], (bf16_t*)(P.ws + WS_H), (float*)(P.ws + WS_SMALL) + SM_R2, nullptr, nullptr, 0.f, nullptr, nullptr, nullptr, nullptr, nullptr);
}

__device__ __forceinline__ void gla_cumsum(LAS float* BC, LAS float* TOT, const u32x4 (&lw)[2], const f32x4 (&bgv)[2], int tid) {
#pragma unroll
    for (int i = 0; i < 2; ++i) { const int e = tid + 512 * i, t = e >> 4, d0 = (e & 15) * 8; const u32x4 w = lw[i];
        LAS float* b = BC + t * 128 + d0; b[0] = logf_gate(bflo(w.x) + bgv[0].x); b[1] = logf_gate(bfhi(w.x) + bgv[0].y); b[2] = logf_gate(bflo(w.y) + bgv[0].z); b[3] = logf_gate(bfhi(w.y) + bgv[0].w);
        b[4] = logf_gate(bflo(w.z) + bgv[1].x); b[5] = logf_gate(bfhi(w.z) + bgv[1].y); b[6] = logf_gate(bflo(w.w) + bgv[1].z); b[7] = logf_gate(bfhi(w.w) + bgv[1].w); }
    __syncthreads();
    const int dk = tid & 127, seg = tid >> 7; float run = 0.f;
#pragma unroll
    for (int i = 0; i < 16; ++i) { const int t = seg * 16 + i; run += BC[t * 128 + dk]; BC[t * 128 + dk] = run; }
    TOT[seg * 128 + dk] = run;
    __syncthreads();
    float off = 0.f;
    for (int s = 0; s < seg; ++s) off += TOT[s * 128 + dk];
#pragma unroll
    for (int i = 0; i < 16; ++i) BC[(seg * 16 + i) * 128 + dk] += off;
    __syncthreads();
}
__device__ __forceinline__ void gla_load_vt(LAS bf16_t* VT, const u32x4 (&vw)[4], int tid) {
#pragma unroll
    for (int i = 0; i < 4; ++i) { const int e = tid + 512 * i, t = e >> 5, d0 = (e & 31) * 8; const u32x4 w = vw[i];
        LAS bf16_t* p = VT + d0 * 72 + ((((t >> 3) ^ ((d0 >> 3) & 7)) << 3) | (t & 7));
        p[0] = (bf16_t)(w.x & 0xffff); p[72] = (bf16_t)(w.x >> 16); p[144] = (bf16_t)(w.y & 0xffff); p[216] = (bf16_t)(w.y >> 16);
        p[288] = (bf16_t)(w.z & 0xffff); p[360] = (bf16_t)(w.z >> 16); p[432] = (bf16_t)(w.w & 0xffff); p[504] = (bf16_t)(w.w >> 16); }
}

__device__ __forceinline__ void gla_phase_a(const Params& P, LAS unsigned char* lds) {
    const int tid = otid(), lane = tid & 63, w = tid >> 6, l16 = lane & 15, q = lane >> 4;
    LAS float* BC = (LAS float*)lds; LAS float* TOT = (LAS float*)(lds + 32768);
    LAS bf16_t* KT = (LAS bf16_t*)(lds + 34816); LAS bf16_t* VT = (LAS bf16_t*)(lds + 53248);
    const bf16_t* QKV = (const bf16_t*)(P.ws + WS_QKV); bf16_t* KC = (bf16_t*)(P.ws + WS_KC); float* BEND = (float*)(P.ws + WS_BEND);
    for (int item = blockIdx.x; item < 1024; item += gridDim.x) {
        const int b = item >> 7, h = (item >> 5) & 3, c = item & 31; const size_t tok0 = (size_t)b * 2048 + c * 64;
        const bf16_t* base = QKV + tok0 * NIN;
        u32x4 lw[2], kw[2], vw[4]; f32x4 bgv[2]; bgv[0] = *(const f32x4*)(P.in[10] + h * 128 + (tid & 15) * 8); bgv[1] = *(const f32x4*)(P.in[10] + h * 128 + (tid & 15) * 8 + 4);
#pragma unroll
        for (int i = 0; i < 2; ++i) { const int e = tid + 512 * i, t = e >> 4, d0 = (e & 15) * 8; lw[i] = *(const u32x4*)(base + (size_t)t * NIN + 3072 + h * 128 + d0); kw[i] = *(const u32x4*)(base + (size_t)t * NIN + 512 + h * 128 + d0); }
#pragma unroll
        for (int i = 0; i < 4; ++i) { const int e = tid + 512 * i, t = e >> 5, d0 = (e & 31) * 8; vw[i] = *(const u32x4*)(base + (size_t)t * NIN + 1024 + h * 256 + d0); }
        gla_cumsum(BC, TOT, lw, bgv, tid);
        if (tid < 128) BEND[item * 128 + tid] = BC[63 * 128 + tid];
#pragma unroll
        for (int i = 0; i < 2; ++i) { const int e = tid + 512 * i, t = e >> 4, d0 = (e & 15) * 8; const u32x4 wv = kw[i];
            float kv[8] = {bflo(wv.x), bfhi(wv.x), bflo(wv.y), bfhi(wv.y), bflo(wv.z), bfhi(wv.z), bflo(wv.w), bfhi(wv.w)};
#pragma unroll
            for (int j = 0; j < 8; ++j) KT[(d0 + j) * 72 + ((((t >> 3) ^ ((d0 >> 3) & 7)) << 3) | (t & 7))] = f2bf(kv[j] * __expf(BC[63 * 128 + d0 + j] - BC[t * 128 + d0 + j])); }
        gla_load_vt(VT, vw, tid);
        __syncthreads();
        f32x4 acc[8][2];
#pragma unroll
        for (int a = 0; a < 8; ++a) { acc[a][0] = (f32x4){0.f, 0.f, 0.f, 0.f}; acc[a][1] = acc[a][0]; }
#pragma unroll
        for (int kk = 0; kk < 2; ++kk) {
            bf16x8 vb[2];
#pragma unroll
            for (int d = 0; d < 2; ++d) vb[d] = *(const LAS bf16x8*)(VT + (16 * (2 * w + d) + l16) * 72 + (((kk * 4 + q) ^ ((2 * (2 * w + d) + (l16 >> 3)) & 7)) << 3));
#pragma unroll
            for (int a = 0; a < 8; ++a) { const bf16x8 ka = *(const LAS bf16x8*)(KT + (16 * a + l16) * 72 + (((kk * 4 + q) ^ ((2 * a + (l16 >> 3)) & 7)) << 3));
#pragma unroll
                for (int d = 0; d < 2; ++d) acc[a][d] = __builtin_amdgcn_mfma_f32_16x16x32_bf16(ka, vb[d], acc[a][d], 0, 0, 0); }
        }
#pragma unroll
        for (int a = 0; a < 8; ++a)
#pragma unroll
            for (int d = 0; d < 2; ++d) { u32x2 o; o.x = cvt_pk_bf16(acc[a][d][0], acc[a][d][1]); o.y = cvt_pk_bf16(acc[a][d][2], acc[a][d][3]);
                *(u32x2*)(KC + ((size_t)item * 256 + 16 * (2 * w + d) + l16) * 128 + 16 * a + 4 * q) = o; }
        __syncthreads();
    }
}
__device__ __forceinline__ void gla_phase_b(const Params& P) {
    bf16_t* KC = (bf16_t*)(P.ws + WS_KC); const float* BEND = (const float*)(P.ws + WS_BEND);
    const int tidb = otid();
    for (int idx = blockIdx.x * 512 + tidb; idx < 32 * 4096; idx += gridDim.x * 512) {
        const int bh = idx >> 12, e = idx & 4095, dv = e >> 4, dk0 = (e & 15) * 8;
        float S[8];
#pragma unroll
        for (int j = 0; j < 8; ++j) S[j] = 0.f;
#pragma unroll 8
        for (int c = 0; c < 32; ++c) { const int item = bh * 32 + c;
            u32x4* p = (u32x4*)(KC + ((size_t)item * 256 + dv) * 128 + dk0); const u32x4 kc = *p;
            const f32x4 e0 = *(const f32x4*)(BEND + item * 128 + dk0), e1 = *(const f32x4*)(BEND + item * 128 + dk0 + 4);
            u32x4 o; o.x = cvt_pk_bf16(S[0], S[1]); o.y = cvt_pk_bf16(S[2], S[3]); o.z = cvt_pk_bf16(S[4], S[5]); o.w = cvt_pk_bf16(S[6], S[7]); *p = o;
            S[0] = __expf(e0.x) * S[0] + bflo(kc.x); S[1] = __expf(e0.y) * S[1] + bfhi(kc.x); S[2] = __expf(e0.z) * S[2] + bflo(kc.y); S[3] = __expf(e0.w) * S[3] + bfhi(kc.y);
            S[4] = __expf(e1.x) * S[4] + bflo(kc.z); S[5] = __expf(e1.y) * S[5] + bfhi(kc.z); S[6] = __expf(e1.z) * S[6] + bflo(kc.w); S[7] = __expf(e1.w) * S[7] + bfhi(kc.w); }
        float* o = P.out + O_GP + (size_t)bh * 32768;
#pragma unroll
        for (int j = 0; j < 8; ++j) o[(dk0 + j) * 256 + dv] = S[j];
    }
}
__device__ __forceinline__ void gla_phase_c(const Params& P, LAS unsigned char* lds) {
    const int tid = otid(), lane = tid & 63, w = tid >> 6, l16 = lane & 15, q = lane >> 4;
    LAS float* BC = (LAS float*)lds; LAS float* TOT = (LAS float*)(lds + 32768); LAS float* PART = (LAS float*)(lds + 34816);
    LAS bf16_t* QT = (LAS bf16_t*)(lds + 36864); LAS bf16_t* KT = (LAS bf16_t*)(lds + 54272);
    LAS bf16_t* VT = (LAS bf16_t*)(lds + 71680); LAS bf16_t* ATT = (LAS bf16_t*)(lds + 108544);
    const bf16_t* QKV = (const bf16_t*)(P.ws + WS_QKV); const bf16_t* KC = (const bf16_t*)(P.ws + WS_KC); bf16_t* Oo = (bf16_t*)(P.ws + WS_O);
    const float* gon = P.in[11];
    for (int item = blockIdx.x; item < 1024; item += gridDim.x) {
        const int b = item >> 7, h = (item >> 5) & 3, c = item & 31; const size_t tok0 = (size_t)b * 2048 + c * 64;
        const bf16_t* base = QKV + tok0 * NIN;
        u32x4 lw[2], qw[2], kw[2], vw[4]; bf16x8 sfr[4][2]; u32x2 rw[4][2]; f32x4 bgv[2]; bgv[0] = *(const f32x4*)(P.in[10] + h * 128 + (tid & 15) * 8); bgv[1] = *(const f32x4*)(P.in[10] + h * 128 + (tid & 15) * 8 + 4);
#pragma unroll
        for (int i = 0; i < 2; ++i) { const int e = tid + 512 * i, t = e >> 4, d0 = (e & 15) * 8; lw[i] = *(const u32x4*)(base + (size_t)t * NIN + 3072 + h * 128 + d0);
            qw[i] = *(const u32x4*)(base + (size_t)t * NIN + h * 128 + d0); kw[i] = *(const u32x4*)(base + (size_t)t * NIN + 512 + h * 128 + d0); }
#pragma unroll
        for (int i = 0; i < 4; ++i) { const int e = tid + 512 * i, t = e >> 5, d0 = (e & 31) * 8; vw[i] = *(const u32x4*)(base + (size_t)t * NIN + 1024 + h * 256 + d0); }
#pragma unroll
        for (int kk = 0; kk < 4; ++kk)
#pragma unroll
            for (int d = 0; d < 2; ++d) sfr[kk][d] = *(const bf16x8*)(KC + ((size_t)item * 256 + 16 * (2 * w + d) + l16) * 128 + kk * 32 + q * 8);
#pragma unroll
        for (int tm = 0; tm < 4; ++tm)
#pragma unroll
            for (int d = 0; d < 2; ++d) rw[tm][d] = *(const u32x2*)(QKV + (tok0 + 16 * tm + l16) * NIN + 2048 + h * 256 + 16 * (2 * w + d) + 4 * q);
        gla_cumsum(BC, TOT, lw, bgv, tid);
#pragma unroll
        for (int i = 0; i < 2; ++i) { const int e = tid + 512 * i, t = e >> 4, d0 = (e & 15) * 8;
            const u32x4 wq = qw[i], wk = kw[i];
            float qv[8] = {bflo(wq.x), bfhi(wq.x), bflo(wq.y), bfhi(wq.y), bflo(wq.z), bfhi(wq.z), bflo(wq.w), bfhi(wq.w)};
            float kv[8] = {bflo(wk.x), bfhi(wk.x), bflo(wk.y), bfhi(wk.y), bflo(wk.z), bfhi(wk.z), bflo(wk.w), bfhi(wk.w)};
            float eb[8];
#pragma unroll
            for (int j = 0; j < 8; ++j) { eb[j] = BC[t * 128 + d0 + j]; qv[j] *= __expf(eb[j]); kv[j] *= __expf(-eb[j]); }
            u32x4 oq, ok; oq.x = cvt_pk_bf16(qv[0], qv[1]); oq.y = cvt_pk_bf16(qv[2], qv[3]); oq.z = cvt_pk_bf16(qv[4], qv[5]); oq.w = cvt_pk_bf16(qv[6], qv[7]);
            ok.x = cvt_pk_bf16(kv[0], kv[1]); ok.y = cvt_pk_bf16(kv[2], kv[3]); ok.z = cvt_pk_bf16(kv[4], kv[5]); ok.w = cvt_pk_bf16(kv[6], kv[7]);
            *(LAS u32x4*)(QT + t * 136 + d0) = oq; *(LAS u32x4*)(KT + t * 136 + d0) = ok; }
        gla_load_vt(VT, vw, tid);
        __syncthreads();
        {
            const int tm = w >> 1;
#pragma unroll
            for (int d = 0; d < 2; ++d) { const int sn = 2 * (w & 1) + d; f32x4 a = (f32x4){0.f, 0.f, 0.f, 0.f};
                if (sn <= tm) {
#pragma unroll
                    for (int kk = 0; kk < 4; ++kk) { const bf16x8 kf = *(const LAS bf16x8*)(KT + (16 * sn + l16) * 136 + kk * 32 + q * 8);
                        const bf16x8 qf = *(const LAS bf16x8*)(QT + (16 * tm + l16) * 136 + kk * 32 + q * 8);
                        a = __builtin_amdgcn_mfma_f32_16x16x32_bf16(kf, qf, a, 0, 0, 0); }
                }
                const int t = 16 * tm + l16, s0 = 16 * sn + 4 * q;
#pragma unroll
                for (int i = 0; i < 4; ++i) if (s0 + i > t) a[i] = 0.f;
                u32x2 o; o.x = cvt_pk_bf16(a[0], a[1]); o.y = cvt_pk_bf16(a[2], a[3]);
                *(LAS u32x2*)(ATT + t * 72 + s0) = o; }
        }
        __syncthreads();
        f32x4 acc[2][4];
#pragma unroll
        for (int d = 0; d < 2; ++d)
#pragma unroll
            for (int tm = 0; tm < 4; ++tm) acc[d][tm] = (f32x4){0.f, 0.f, 0.f, 0.f};
#pragma unroll
        for (int kk = 0; kk < 2; ++kk) {
            bf16x8 vf[2], af[4];
#pragma unroll
            for (int d = 0; d < 2; ++d) vf[d] = *(const LAS bf16x8*)(VT + (16 * (2 * w + d) + l16) * 72 + (((kk * 4 + q) ^ ((2 * (2 * w + d) + (l16 >> 3)) & 7)) << 3));
#pragma unroll
            for (int tm = 0; tm < 4; ++tm) af[tm] = *(const LAS bf16x8*)(ATT + (16 * tm + l16) * 72 + kk * 32 + q * 8);
#pragma unroll
            for (int d = 0; d < 2; ++d)
#pragma unroll
                for (int tm = 0; tm < 4; ++tm) acc[d][tm] = __builtin_amdgcn_mfma_f32_16x16x32_bf16(vf[d], af[tm], acc[d][tm], 0, 0, 0);
        }
#pragma unroll
        for (int kk = 0; kk < 4; ++kk) {
            bf16x8 sf[2], qf[4];
#pragma unroll
            for (int d = 0; d < 2; ++d) sf[d] = sfr[kk][d];
#pragma unroll
            for (int tm = 0; tm < 4; ++tm) qf[tm] = *(const LAS bf16x8*)(QT + (16 * tm + l16) * 136 + kk * 32 + q * 8);
#pragma unroll
            for (int d = 0; d < 2; ++d)
#pragma unroll
                for (int tm = 0; tm < 4; ++tm) acc[d][tm] = __builtin_amdgcn_mfma_f32_16x16x32_bf16(sf[d], qf[tm], acc[d][tm], 0, 0, 0);
        }
#pragma unroll
        for (int tm = 0; tm < 4; ++tm) { float ss = 0.f;
#pragma unroll
            for (int d = 0; d < 2; ++d) ss += (acc[d][tm][0] * acc[d][tm][0] + acc[d][tm][1] * acc[d][tm][1]) + (acc[d][tm][2] * acc[d][tm][2] + acc[d][tm][3] * acc[d][tm][3]);
            ss += __shfl_xor(ss, 16); ss += __shfl_xor(ss, 32);
            if (q == 0) PART[w * 64 + 16 * tm + l16] = ss; }
        __syncthreads();
#pragma unroll
        for (int tm = 0; tm < 4; ++tm) { float tot = 0.f;
#pragma unroll
            for (int ww = 0; ww < 8; ++ww) tot += PART[ww * 64 + 16 * tm + l16];
            const float rs = rsqrtf(tot * (1.0f / 256.0f) + EPS); const size_t tok = tok0 + 16 * tm + l16;
#pragma unroll
            for (int d = 0; d < 2; ++d) { const int dv0 = 16 * (2 * w + d) + 4 * q; const f32x4 g = *(const f32x4*)(gon + dv0);
                const u32x2 rr = rw[tm][d];
                u32x2 o; o.x = cvt_pk_bf16(acc[d][tm][0] * rs * g.x * siluf_(bflo(rr.x)), acc[d][tm][1] * rs * g.y * siluf_(bfhi(rr.x)));
                o.y = cvt_pk_bf16(acc[d][tm][2] * rs * g.z * siluf_(bflo(rr.y)), acc[d][tm][3] * rs * g.w * siluf_(bfhi(rr.y)));
                *(u32x2*)(Oo + tok * D + h * 256 + dv0) = o; } }
        __syncthreads();
    }
    LAS float* SQ = (LAS float*)lds; LAS float* SK = SQ + 512; LAS float* SE = SK + 512; LAS float* OS = SE + 512;   LAS float* WP = OS + 2048;
    for (int item = blockIdx.x; item < 512; item += gridDim.x) {
        const int b = item >> 2, h = item & 3; const size_t row0 = (size_t)MP + b * 4;
        { const int t = tid >> 7, dk = tid & 127; const bf16_t* r = QKV + (row0 + t) * NIN;
            SQ[tid] = bf2f(r[h * 128 + dk]); SK[tid] = bf2f(r[512 + h * 128 + dk]); SE[tid] = __expf(logf_gate(bf2f(r[3072 + h * 128 + dk]) + P.in[10][h * 128 + dk])); }
        __syncthreads();
        const int dv = tid & 255, half = tid >> 8;
        const float* s0 = P.in[2] + ((size_t)item * 128 + half * 64) * 256 + dv;
        float S[64];
#pragma unroll
        for (int i = 0; i < 64; ++i) S[i] = s0[i * 256];
        float vv[4];
#pragma unroll
        for (int t = 0; t < 4; ++t) vv[t] = bf2f(QKV[(row0 + t) * NIN + 1024 + h * 256 + dv]);
#pragma unroll
        for (int t = 0; t < 4; ++t) { float op = 0.f;
#pragma unroll
            for (int i = 0; i < 64; ++i) { const int dk = half * 64 + i; S[i] = SE[t * 128 + dk] * S[i] + SK[t * 128 + dk] * vv[t]; op += SQ[t * 128 + dk] * S[i]; }
            OS[(half * 4 + t) * 256 + dv] = op; }
        float* so = P.out + O_GS + ((size_t)item * 128 + half * 64) * 256 + dv;
#pragma unroll
        for (int i = 0; i < 64; ++i) so[i * 256] = S[i];
        __syncthreads();
        float o4[4];
#pragma unroll
        for (int t = 0; t < 4; ++t) { o4[t] = OS[t * 256 + dv] + OS[(4 + t) * 256 + dv]; const float s = wave_sum(o4[t] * o4[t]); if (tid < 256 && lane == 0) WP[w * 4 + t] = s; }
        __syncthreads();
        if (tid < 256) {
#pragma unroll
            for (int t = 0; t < 4; ++t) { const float tot = WP[t] + WP[4 + t] + WP[8 + t] + WP[12 + t]; const float rs = rsqrtf(tot * (1.0f / 256.0f) + EPS);
                const float r = bf2f(QKV[(row0 + t) * NIN + 2048 + h * 256 + dv]);
                Oo[(row0 + t) * D + h * 256 + dv] = f2bf(o4[t] * rs * gon[dv] * siluf_(r)); }
        }
        __syncthreads();
    }
}

__device__ __forceinline__ void s5_prefix_and_sample(const Params& P, LAS unsigned char* lds) {
    const int tid = otid(); const int lane = tid & 63, w = tid >> 6, gw = blockIdx.x * 8 + w, NGW = gridDim.x * 8;
    const float* sm = (const float*)(P.ws + WS_SMALL); const bf16_t* HL = (const bf16_t*)(P.ws + WS_HLOC); bf16_t* HS5 = (bf16_t*)(P.ws + WS_HS5);
    LAS float* TOT = (LAS float*)lds;
    for (int L = blockIdx.x; L < 256; L += gridDim.x) {
        int g, mt; { const int xcd = L & 7, idx = L >> 3, combo = xcd * 8 + (idx >> 2); g = (combo >> 2) * 4 + (idx & 3); mt = combo & 3; }
        const char* Aop = (const char*)(P.ws + WS_HS5) + (size_t)g * (1024 * 384 * 2) + (size_t)mt * (BM * 384 * 2);
        { OneUnit S1{{Aop, (const char*)(P.ws + WS_S5M) + (size_t)g * 262144, mt, g, 4, -1}}; EpiS5A E1{(bf16_t*)(P.ws + WS_HLOC)}; gemm_phase(lds, 384, 256, S1, E1); }
        asm volatile("s_waitcnt vmcnt(0)" ::: "memory"); __syncthreads();
        {
        const int seg = w & 3, b = 2 * mt + (w >> 2);
        const float ar = sm[SM_A16R + g * 64 + lane], ai = sm[SM_A16I + g * 64 + lane];
        const size_t col0 = (size_t)g * 1024 + b * 128 + seg * 32;
        float lr[32], li[32];
#pragma unroll
        for (int c = 0; c < 32; ++c) { lr[c] = bf2f(HL[(col0 + c) * 128 + lane]); li[c] = bf2f(HL[(col0 + c) * 128 + 64 + lane]); }
        float hr = 0.f, hi = 0.f;
#pragma unroll
        for (int c = 0; c < 32; ++c) { const float tr = lr[c], ti = li[c]; lr[c] = hr; li[c] = hi; const float nr = ar * hr - ai * hi + tr, ni = ar * hi + ai * hr + ti; hr = nr; hi = ni; }
        TOT[(w * 2 + 0) * 64 + lane] = hr; TOT[(w * 2 + 1) * 64 + lane] = hi;
        __syncthreads();
        float a32r = ar, a32i = ai;
#pragma unroll
        for (int k = 0; k < 5; ++k) { const float nr = a32r * a32r - a32i * a32i, ni = 2.f * a32r * a32i; a32r = nr; a32i = ni; }
        float cr = 0.f, ci = 0.f;
        for (int s = 0; s < seg; ++s) { const int ws_ = (w & 4) + s; const float tr = TOT[(ws_ * 2 + 0) * 64 + lane], ti = TOT[(ws_ * 2 + 1) * 64 + lane];
            const float nr = a32r * cr - a32i * ci + tr, ni = a32r * ci + a32i * cr + ti; cr = nr; ci = ni; }
        float pr_ = cr, pi_ = ci;
#pragma unroll
        for (int c = 0; c < 32; ++c) { HS5[(col0 + c) * 384 + 256 + lane] = f2bf(lr[c] + pr_); HS5[(col0 + c) * 384 + 320 + lane] = f2bf(li[c] + pi_);
            const float nr = ar * pr_ - ai * pi_, ni = ar * pi_ + ai * pr_; pr_ = nr; pi_ = ni; }
        if (seg == 3) { P.out[O_RP + (size_t)b * 4096 + g * 64 + lane] = hr + pr_; P.out[O_IP + (size_t)b * 4096 + g * 64 + lane] = hi + pi_; }
        }
        asm volatile("s_waitcnt vmcnt(0)" ::: "memory"); __syncthreads();
        { OneUnit S2{{Aop, (const char*)(P.ws + WS_S5M + 65536) + (size_t)g * 262144, mt, g, 6, -1}}; EpiS5B E2{P.ws, P.in[20]}; gemm_phase(lds, 384, 384, S2, E2); }
        __syncthreads();
    }
    const bf16_t* HSMP = (const bf16_t*)(P.ws + WS_HSMP); bf16_t* Z = (bf16_t*)(P.ws + WS_Z);
    LAS float* cb_ = (LAS float*)(lds + 4096 + w * 10752);
    LAS float* hb = cb_ + 2 * 16 * 68;
    for (int wv = gw; wv < 64 * 32; wv += NGW) {
        const int g = wv & 63, b0 = (wv >> 6) * 4, p = lane;
        const float ar = sm[SM_ARE + g * 64 + p], ai = sm[SM_AIM + g * 64 + p], fr = sm[SM_FRE + g * 64 + p], fi = sm[SM_FIM + g * 64 + p];
        f32x4 brv[4], biv[4], crv[4], civ[4];
#pragma unroll
        for (int c4 = 0; c4 < 4; ++c4) { brv[c4] = *(const f32x4*)(P.in[16] + ((size_t)g * 64 + p) * 16 + 4 * c4); biv[c4] = *(const f32x4*)(P.in[17] + ((size_t)g * 64 + p) * 16 + 4 * c4);
            crv[c4] = *(const f32x4*)(P.in[18] + (size_t)g * 1024 + (lane + 64 * c4) * 4); civ[c4] = *(const f32x4*)(P.in[19] + (size_t)g * 1024 + (lane + 64 * c4) * 4); }
        const int t = lane >> 4, cp = lane & 15; const float dsk = P.in[20][g * 16 + cp];
        float bbr[16], bbi[16];
#pragma unroll
        for (int c4 = 0; c4 < 4; ++c4) {
#pragma unroll
            for (int j = 0; j < 4; ++j) { bbr[4 * c4 + j] = fr * brv[c4][j] - fi * biv[c4][j]; bbi[4 * c4 + j] = fr * biv[c4][j] + fi * brv[c4][j]; }
            const int f = lane + 64 * c4, row = f >> 4, col = (f & 15) * 4;
            *(LAS f32x4*)(cb_ + row * 68 + col) = crv[c4]; *(LAS f32x4*)(cb_ + 16 * 68 + row * 68 + col) = civ[c4]; }
#pragma unroll 1
        for (int bb = 0; bb < 4; ++bb) { const int b = b0 + bb;
            u32x4 ua[4], ub[4];
#pragma unroll
            for (int tt = 0; tt < 4; ++tt) { ua[tt] = *(const u32x4*)(HSMP + (size_t)(b * 4 + tt) * D + g * 16); ub[tt] = *(const u32x4*)(HSMP + (size_t)(b * 4 + tt) * D + g * 16 + 8); }
            float hr = P.in[3][(size_t)b * 4096 + g * 64 + p], hi = P.in[4][(size_t)b * 4096 + g * 64 + p];
            const size_t row = (size_t)b * 4 + t; const float uu = bf2f(HSMP[row * D + g * 16 + cp]);
#pragma unroll
            for (int tt = 0; tt < 4; ++tt) { const u32x4 u0 = ua[tt], u1 = ub[tt];
                const float u[16] = {bflo(u0.x), bfhi(u0.x), bflo(u0.y), bfhi(u0.y), bflo(u0.z), bfhi(u0.z), bflo(u0.w), bfhi(u0.w),
                                     bflo(u1.x), bfhi(u1.x), bflo(u1.y), bfhi(u1.y), bflo(u1.z), bfhi(u1.z), bflo(u1.w), bfhi(u1.w)};
                float br = 0.f, bi = 0.f;
#pragma unroll
                for (int c = 0; c < 16; ++c) { br += bbr[c] * u[c]; bi += bbi[c] * u[c]; }
                const float nr = ar * hr - ai * hi + br, ni = ar * hi + ai * hr + bi; hr = nr; hi = ni;
                hb[(tt * 2 + 0) * 64 + p] = hr; hb[(tt * 2 + 1) * 64 + p] = hi; }
            P.out[O_RS + (size_t)b * 4096 + g * 64 + p] = hr; P.out[O_IS + (size_t)b * 4096 + g * 64 + p] = hi;
            asm volatile("s_waitcnt lgkmcnt(0)" ::: "memory");
            float y = 0.f;
#pragma unroll
            for (int i = 0; i < 16; ++i) { const f32x4 c4r = *(const LAS f32x4*)(cb_ + cp * 68 + 4 * i), c4i = *(const LAS f32x4*)(cb_ + 16 * 68 + cp * 68 + 4 * i);
                const f32x4 h4r = *(const LAS f32x4*)(hb + (t * 2 + 0) * 64 + 4 * i), h4i = *(const LAS f32x4*)(hb + (t * 2 + 1) * 64 + 4 * i);
                y += (c4r.x * h4r.x - c4i.x * h4i.x) + (c4r.y * h4r.y - c4i.y * h4i.y) + (c4r.z * h4r.z - c4i.z * h4i.z) + (c4r.w * h4r.w - c4i.w * h4i.w); }
            Z[((size_t)MP + row) * D + g * 16 + cp] = f2bf(y + dsk * uu);
            asm volatile("s_waitcnt lgkmcnt(0)" ::: "memory");
        }
    }
}

#define XB_TMO      128
#define XB_XCNT(j)  (256  + 64 * (j))
#define XB_XSUB(j)  (1280 + 64 * (j))
#define XB_XGEN(j)  (2304 + 64 * (j))
#define XB_TOP      3328
#define XB_TOPGEN   3392
#define XCD_BAR_WORDS 3456
#define XB_SPIN_CAP (1u << 22)
__device__ __forceinline__ unsigned xb_ld(unsigned* p)              { return __hip_atomic_load(p, __ATOMIC_RELAXED, __HIP_MEMORY_SCOPE_AGENT); }
__device__ __forceinline__ unsigned xb_add(unsigned* p, unsigned v) { return __hip_atomic_fetch_add(p, v, __ATOMIC_RELAXED, __HIP_MEMORY_SCOPE_AGENT); }
__device__ __forceinline__ unsigned xb_xcc_id() { return (unsigned)__builtin_amdgcn_s_getreg((3 << 11) | 20) & 0xFu; }
#define XB_SPIN(cond, bar) do { unsigned _sp = 0; while (cond) { __builtin_amdgcn_s_sleep(1); \
    if ((++_sp & 255u) == 0u) { if (xb_ld(&(bar)[XB_TMO])) break; if (_sp > XB_SPIN_CAP) { atomicAdd(&(bar)[XB_TMO], 1u); break; } } } } while (0)
struct XcdBarrier { unsigned* bar; unsigned x; volatile LAS unsigned* st; };
__device__ __forceinline__ XcdBarrier xcd_barrier_post(unsigned* bar, volatile LAS unsigned* st) {
    XcdBarrier b; b.bar = bar; b.x = xb_xcc_id(); b.st = st;
    if (threadIdx.x == 0) (void)xb_add(&bar[XB_XCNT(b.x)], 1u);
    return b;
}
__device__ __forceinline__ void xcd_barrier_complete(unsigned* bar, unsigned x, unsigned& nloc, unsigned& nx) {
    const unsigned G = gridDim.x * gridDim.y * gridDim.z;
    unsigned sum, cnt, mine, sp = 0u;
    for (;;) {
        sum = 0u; cnt = 0u; mine = 0u;
#pragma unroll
        for (unsigned j = 0; j < 16; ++j) { const unsigned c = xb_ld(&bar[XB_XCNT(j)]); sum += c; cnt += (c > 0u) ? 1u : 0u; mine = (j == x) ? c : mine; }
        if (sum == G) break;
        __builtin_amdgcn_s_sleep(1);
        if ((++sp & 255u) == 0u) { if (xb_ld(&bar[XB_TMO])) break; if (sp > XB_SPIN_CAP) { atomicAdd(&bar[XB_TMO], 1u); break; } }
    }
    nloc = mine > 0u ? mine : 1u; nx = cnt > 0u ? cnt : 1u;
}
__device__ __forceinline__ void xcd_barrier(const XcdBarrier& b) {
    asm volatile("s_waitcnt vmcnt(0)" ::: "memory");
    __syncthreads();
    if (threadIdx.x == 0) {
        unsigned* bar = b.bar;
        __builtin_amdgcn_s_waitcnt(0);
        unsigned nloc = b.st[0], nx = b.st[1];
        if (nloc == 0u) { xcd_barrier_complete(bar, b.x, nloc, nx); b.st[0] = nloc; b.st[1] = nx; }
        const unsigned old = xb_add(&bar[XB_XSUB(b.x)], 1u);
        const unsigned gen = old / nloc;
        if (old + 1u == (gen + 1u) * nloc) {
            __builtin_amdgcn_fence(__ATOMIC_RELEASE, "agent");
            asm volatile("s_waitcnt vmcnt(0)" ::: "memory");
            const unsigned og = xb_add(&bar[XB_TOP], 1u);
            const unsigned tg = og / nx;
            if (og + 1u == (tg + 1u) * nx) xb_add(&bar[XB_TOPGEN], 1u);
            else XB_SPIN(xb_ld(&bar[XB_TOPGEN]) == tg, bar);
            __builtin_amdgcn_fence(__ATOMIC_ACQUIRE, "agent");
            xb_add(&bar[XB_XGEN(b.x)], 1u);
            asm volatile("s_waitcnt vmcnt(0)" ::: "memory");
        } else {
            XB_SPIN(xb_ld(&bar[XB_XGEN(b.x)]) == gen, bar);
            __builtin_amdgcn_fence(__ATOMIC_ACQUIRE, "agent");
            asm volatile("s_waitcnt vmcnt(0)" ::: "memory");
        }
    }
    __syncthreads();
}

__global__ void __launch_bounds__(512, 2) fwd_kernel(Params P) {
    extern __shared__ __attribute__((aligned(16))) unsigned char lds_raw[];
    LAS unsigned char* lds = (LAS unsigned char*)lds_raw;
    cg::grid_group grid = cg::this_grid();
    const int lo = P.ph_lo, hi = P.ph_hi; int ph = 0;
    const int G = gridDim.x, cb = blockIdx.x;
    unsigned char* ws = P.ws;
    bf16_t* XB = (bf16_t*)(ws + WS_H); bf16_t* ACT = (bf16_t*)(ws + WS_ACT); bf16_t* Y = (bf16_t*)(ws + WS_Y);
    float* R2 = (float*)(ws + WS_SMALL) + SM_R2;
    unsigned long long pr_acc = 0ull, pr_t0 = 0ull;
#define PH_BEGIN if (PROBE_MASK) pr_t0 = __builtin_amdgcn_s_memrealtime(); if (lo <= ph && ph < hi) {
#define PH_END } ++ph; if (lo < ph && ph < hi) xcd_barrier(xbar); \
    if (PROBE_MASK && ((PROBE_MASK >> (ph - 1)) & 1u)) pr_acc += __builtin_amdgcn_s_memrealtime() - pr_t0;
    volatile LAS unsigned* xst = (volatile LAS unsigned*)(lds + LDS_BYTES - 64);
    if (threadIdx.x < 2) xst[threadIdx.x] = 0u;
    __syncthreads();
    if (ws == nullptr) grid.sync();
    XcdBarrier xbar; xbar.bar = (unsigned*)ws; xbar.x = 0; xbar.st = xst;
    if (hi - lo > 1) xbar = xcd_barrier_post((unsigned*)ws, xst);

    PH_BEGIN phase0(P, lds); PH_END

#define MIXER_GLA \
    PH_BEGIN { TileOrder S{M / BM, NIN / BM, (M / BM) * (NIN / BM), G, cb, (const char*)XB, (const char*)(ws + WS_WIN), (size_t)BM * D * 2, (size_t)BM * D * 2, D / BK}; \
        EpiPlain<1> E{(bf16_t*)(ws + WS_QKV), NIN, P.in[10], nullptr, R2}; gemm_phase(lds, D, D, S, E); } s5_idle_prep_inproj(P, lds); PH_END \
    PH_BEGIN gla_phase_a(P, lds); PH_END \
    PH_BEGIN gla_phase_b(P); PH_END \
    PH_BEGIN gla_phase_c(P, lds); PH_END \
    PH_BEGIN { SplitOrder S{{MP / BM, D / BM, (MP / BM) * (D / BM), G, cb, (const char*)(ws + WS_O), (const char*)(ws + WS_WOUT), (size_t)BM * D * 2, (size_t)BM * D * 2, D / BK}, D / 256}; \
        EpiPlain<0> E{Y, D, nullptr, PART, nullptr}; gemm_phase(lds, D, D, S, E); } PH_END
#define MIXER_S5 \
    PH_BEGIN s5_prefix_and_sample(P, lds); PH_END \
    PH_BEGIN { SplitOrder S{{MP / BM, 2 * D / BM, (MP / BM) * (2 * D / BM), G, cb, (const char*)(ws + WS_Z), (const char*)(ws + WS_WGLU), (size_t)BM * D * 2, (size_t)BM * D * 2, D / BK}, D / 256}; \
        EpiGated<1> E{Y, D, P.in[22], (float*)(ws + WS_HLOC)}; gemm_phase(lds, D, D, S, E); } PH_END
#define FFN_GEMMS(l, f, HOOK) \
    PH_BEGIN { TileOrder S{M / BM, NGU / BM, (M / BM) * (NGU / BM), G, cb, (const char*)XB, (const char*)(ws + WS_WGU + (size_t)((l) * 2 + (f)) * NGU * D * 2), (size_t)BM * D * 2, (size_t)BM * D * 2, D / BK}; \
        EpiGated<0> E{ACT, FF, nullptr, nullptr}; gemm_phase(lds, D, D, S, E); } HOOK PH_END \
    PH_BEGIN { SplitOrder S{{MP / BM, D / BM, (MP / BM) * (D / BM), G, cb, (const char*)ACT, (const char*)(ws + WS_WDN + (size_t)((l) * 2 + (f)) * D * FF * 2), (size_t)BM * FF * 2, (size_t)BM * FF * 2, FF / BK}, FF / 256}; \
        EpiPlain<0> E{Y, D, nullptr, PART, nullptr}; gemm_phase(lds, FF, FF, S, E); } PH_END
    const float* ng0 = P.in[5]; const float* ng1 = P.in[5] + 6 * D;
    float* PART = (float*)(ws + WS_PART);
    FFN_GEMMS(0, 0, s5_idle_prep(P, lds, 0);)
    PH_BEGIN row_pass<3, FF / 256>(P.in[0], P.in[1], XB, R2, Y, ng0 + 1 * D, 0.5f, PART, nullptr, nullptr, nullptr, nullptr); PH_END
    MIXER_GLA
    PH_BEGIN row_pass<3, D / 256>(nullptr, nullptr, XB, R2, Y, ng0 + 3 * D, 1.0f, PART, nullptr, nullptr, nullptr, nullptr); PH_END
    FFN_GEMMS(0, 1, s5_idle_prep(P, lds, 1);)
    PH_BEGIN row_pass<3, FF / 256>(nullptr, nullptr, XB, R2, Y, ng0 + 5 * D, 0.5f, PART, nullptr, nullptr, nullptr, nullptr); PH_END
    FFN_GEMMS(1, 0, s5_idle_prep(P, lds, 2);)
    PH_BEGIN row_pass<3, FF / 256>(nullptr, nullptr, XB, R2, Y, ng1 + 1 * D, 0.5f, PART, nullptr, ng1 + 2 * D, (bf16_t*)(ws + WS_HS5), (bf16_t*)(ws + WS_HSMP)); PH_END
    MIXER_S5
    PH_BEGIN row_pass<3, D / 256>(nullptr, nullptr, XB, R2, Y, ng1 + 3 * D, 1.0f, (const float*)(ws + WS_HLOC), nullptr, nullptr, nullptr, nullptr, P.in[22]); PH_END
    FFN_GEMMS(1, 1, )
    PH_BEGIN row_pass<2, FF / 256>(nullptr, nullptr, XB, R2, Y, ng1 + 5 * D, 0.5f, PART, P.out + O_X, nullptr, nullptr, nullptr); PH_END
    if (PROBE_MASK && blockIdx.x == 0 && threadIdx.x == 0) { const unsigned long long t1 = __builtin_amdgcn_s_memrealtime(); while (__builtin_amdgcn_s_memrealtime() - t1 < pr_acc) __builtin_amdgcn_s_sleep(8); }
#undef PH_BEGIN
#undef PH_END
}

__global__ void dbg_checksum(const unsigned* w, size_t nwords, float* out, size_t nout) {
    for (size_t i = (size_t)blockIdx.x * blockDim.x + threadIdx.x; i < nout; i += (size_t)gridDim.x * blockDim.x) {
        unsigned h = 0; for (int j = 0; j < 3; ++j) { const size_t k = 3 * i + j; if (k < nwords) h = h * 0x9E3779B1u + w[k]; }
        out[i] = (float)(h & 0xffffu);
    }
}
extern "C" void kernel_launch(void* const* d_in, const int* in_sizes, int n_in, void* d_out, int out_size, void* d_ws, size_t ws_size, hipStream_t stream) {
    static int grid = 0;
    if (grid == 0) {
        if (n_in != 23 || ws_size < WS_END) { fprintf(stderr, "kernel_launch: unexpected n_in %d or ws_size %zu (< %zu)\n", n_in, ws_size, (size_t)WS_END); grid = -1; return; }
        int dev = 0, cus = 0, per_cu = 0;
        hipGetDevice(&dev); hipDeviceGetAttribute(&cus, hipDeviceAttributeMultiprocessorCount, dev);
        if (hipFuncSetAttribute((const void*)fwd_kernel, hipFuncAttributeMaxDynamicSharedMemorySize, LDS_BYTES) != hipSuccess) { fprintf(stderr, "kernel_launch: hipFuncSetAttribute failed\n"); grid = -1; return; }
        if (hipOccupancyMaxActiveBlocksPerMultiprocessor(&per_cu, (const void*)fwd_kernel, 512, LDS_BYTES) != hipSuccess || per_cu < 1) { fprintf(stderr, "kernel_launch: occupancy query failed (%d)\n", per_cu); grid = -1; return; }
        grid = cus * per_cu;
    }
    if (grid < 0) return;
    if (hipMemsetAsync(d_ws, 0, 16384, stream) != hipSuccess) { fprintf(stderr, "kernel_launch: memset failed\n"); return; }
    Params p{};
    for (int i = 0; i < 23; ++i) p.in[i] = (const float*)d_in[i];
    p.out = (float*)d_out; p.ws = (unsigned char*)d_ws;
#if MULTI_LAUNCH
    for (int k = 0; k < (DBG_NPH ? DBG_NPH : NPH); ++k) { p.ph_lo = k; p.ph_hi = k + 1; hipLaunchKernelGGL(fwd_kernel, dim3(grid), dim3(512), LDS_BYTES, stream, p); }
#if DBG_NPH
    hipLaunchKernelGGL(dbg_checksum, dim3(2048), dim3(256), 0, stream, (const unsigned*)d_ws, (size_t)(WS_END / 4), (float*)d_out, (size_t)out_size);
#endif
#else
    p.ph_lo = 0; p.ph_hi = NPH;
    void* args[] = {&p};
    hipError_t e = hipLaunchCooperativeKernel((const void*)fwd_kernel, dim3(grid), dim3(512), args, LDS_BYTES, stream);
    if (e != hipSuccess) fprintf(stderr, "cooperative launch failed: %s (grid %d)\n", hipGetErrorString(e), grid);
#endif
}
```

```cpp
#include <hip/hip_runtime.h>
#include <hip/hip_cooperative_groups.h>
#include <cstdio>
namespace cg = cooperative_groups;

#ifndef MULTI_LAUNCH
#define MULTI_LAUNCH 0
#endif

#ifndef PROBE_MASK
#define PROBE_MASK 0u
#endif
#ifndef DBG_NPH
#define DBG_NPH 0
#endif
#define LAS __attribute__((address_space(3)))
typedef unsigned short bf16_t;
typedef short bf16x8 __attribute__((ext_vector_type(8)));
typedef float f32x4 __attribute__((ext_vector_type(4)));
typedef unsigned u32x4 __attribute__((ext_vector_type(4)));
typedef unsigned u32x2 __attribute__((ext_vector_type(2)));

constexpr int D = 1024, FF = 2816, NGU = 5632, MP = 16384, MS = 512, M = MP + MS;
constexpr int NIN = 3584;
constexpr int LDIN = 3088;
constexpr float EPS = 1e-6f;
constexpr int NPH = 22;

constexpr size_t O_X = 0, O_GP = 17301504, O_RP = 18350080, O_IP = 18382848, O_GS = 18415616, O_RS = 35192832, O_IS = 35717120;

constexpr size_t MiB = 1u << 20;
constexpr size_t WS_WGU = 1 * MiB;
constexpr size_t WS_WDN = WS_WGU + 44 * MiB;
constexpr size_t WS_WIN = WS_WDN + 22 * MiB;
constexpr size_t WS_WOUT = WS_WIN + 7 * MiB;
constexpr size_t WS_WGLU = WS_WOUT + 2 * MiB;
constexpr size_t WS_S5M = WS_WGLU + 4 * MiB;
constexpr size_t WS_SMALL = WS_S5M + 16 * MiB;
constexpr size_t WS_HSMP = WS_SMALL + 1 * MiB;
constexpr size_t WS_H = WS_SMALL + 2 * MiB;
constexpr size_t WS_BIG = WS_H + 33 * MiB;
constexpr size_t WS_ACT = WS_BIG;
constexpr size_t WS_Y = WS_BIG + 92 * MiB;
constexpr size_t WS_QKV = WS_BIG;
constexpr size_t WS_KC = WS_BIG + 116 * MiB;
constexpr size_t WS_BEND = WS_BIG + 180 * MiB;
constexpr size_t WS_HS5 = WS_BIG;
constexpr size_t WS_HLOC = WS_BIG + 48 * MiB;
constexpr size_t WS_Z = WS_BIG + 128 * MiB;
constexpr size_t WS_PART = WS_BIG + 128 * MiB;
constexpr size_t WS_O = WS_BIG + 181 * MiB;
constexpr size_t WS_END = WS_BIG + 214 * MiB;
constexpr size_t S5M_G = 262144;
constexpr int SM_R2 = 32768;
constexpr int SM_ARE = 0, SM_AIM = 4096, SM_FRE = 8192, SM_FIM = 12288, SM_A16R = 16384, SM_A16I = 20480;

constexpr int LDS_BYTES = 147456;

typedef __bf16 bf16x2_t __attribute__((ext_vector_type(2)));
typedef float f32x2_t __attribute__((ext_vector_type(2)));
__device__ __forceinline__ unsigned cvt_pk_bf16(float lo, float hi) { const f32x2_t v = {lo, hi}; const bf16x2_t b = __builtin_convertvector(v, bf16x2_t); return __builtin_bit_cast(unsigned, b); }
__device__ __forceinline__ float bflo(unsigned w) { return __uint_as_float(w << 16); }
__device__ __forceinline__ float bfhi(unsigned w) { return __uint_as_float(w & 0xffff0000u); }
__device__ __forceinline__ float bf2f(bf16_t b) { return __uint_as_float(((unsigned)b) << 16); }
__device__ __forceinline__ bf16_t f2bf(float f) { return (bf16_t)(cvt_pk_bf16(f, 0.f) & 0xffffu); }
__device__ __forceinline__ float wave_sum(float v) {
#pragma unroll
    for (int o = 1; o < 64; o <<= 1) v += __shfl_xor(v, o);
    return v;
}
__device__ __forceinline__ int otid() { int t = threadIdx.x; asm volatile("" : "+v"(t)); return t; }
__device__ __forceinline__ float sigmoidf_(float a) { return __builtin_amdgcn_rcpf(1.0f + __expf(-a)); }
__device__ __forceinline__ float siluf_(float a) { return a * sigmoidf_(a); }
__device__ __forceinline__ float logf_gate(float z) { return (fminf(z, 0.f) - __logf(1.0f + __expf(-fabsf(z)))) * 0.0625f; }

constexpr int BM = 256, BK = 64, HALF = 128, HTB = HALF * BK * 2;
__device__ __forceinline__ int lds_byte(int r, int c) { const int st = (r >> 4) * 2 + (c >> 5), rr = r & 15, cc = c & 31, ob = rr * 64 + cc * 2; return st * 1024 + (ob ^ (((ob >> 9) & 1) << 5)); }
__device__ __forceinline__ void stage_rc(int b, int& R, int& C) { const int st = b / 1024, sb = b % 1024, swz = sb ^ (((sb >> 9) & 1) << 5); R = (st >> 1) * 16 + swz / 64; C = (st & 1) * 32 + (swz % 64) / 2; }
__device__ __forceinline__ int perm32(int rho) { const int n = rho >> 4, i = rho & 15; return 8 * (i >> 2) + 4 * n + (i & 3); }

struct Unit { const char* A; const char* B; int pm, pn, nt, ks; };

struct TileOrder {
    int nM, nN, nwg, G, c; const char* A0; const char* B0; size_t at, bt; int ntk;
    __device__ __forceinline__ bool next(int i, Unit& u) const {
        const long L = (long)i * G + c; if (L >= nwg) return false;
        u.nt = ntk; u.ks = -1;
        int wgid = (int)L; { const int q = nwg / 8, r = nwg % 8, xcd = wgid % 8, off = wgid / 8; wgid = (xcd < r ? xcd * (q + 1) : r * (q + 1) + (xcd - r) * q) + off; }
        const int nig = 8 * nN, gid = wgid / nig, fm = gid * 8, gsz = (nM - fm) < 8 ? (nM - fm) : 8;
        u.pm = fm + ((wgid % nig) % gsz); u.pn = (wgid % nig) / gsz;
        u.A = A0 + (size_t)u.pm * at; u.B = B0 + (size_t)u.pn * bt; return true;
    }
};
struct SplitOrder {
    TileOrder T; int nks;
    __device__ __forceinline__ bool next(int i, Unit& u) const {
        const int L = i * T.G + T.c;
        if (L < T.nwg) return T.next(i, u);
        const int j = L - T.nwg, ns = 2 * T.nN; if (j >= ns * nks) return false;
        const int st = j % ns, ks = j / ns; u.pm = 64 + st / T.nN; u.pn = st % T.nN; u.nt = 4; u.ks = ks;
        u.A = T.A0 + (size_t)u.pm * T.at + (size_t)ks * 512; u.B = T.B0 + (size_t)u.pn * T.bt + (size_t)ks * 512; return true;
    }
};
struct OneUnit { Unit u; __device__ __forceinline__ bool next(int i, Unit& o) const { if (i) return false; o = u; return true; } };
struct S5Order {
    int G, c; const char* A0; const char* B0; int ntk;
    __device__ __forceinline__ bool next(int i, Unit& u) const {
        const int L = i * G + c; if (L >= 256) return false;
        u.nt = ntk; u.ks = -1;
        { const int xcd = L & 7, idx = L >> 3, combo = xcd * 8 + (idx >> 2); u.pn = (combo >> 2) * 4 + (idx & 3); u.pm = combo & 3; }
        u.A = A0 + (size_t)u.pn * (1024 * 384 * 2) + (size_t)u.pm * (BM * 384 * 2); u.B = B0 + (size_t)u.pn * 262144; return true;
    }
};

template <class Epi, class Sched>
__device__ __forceinline__ void gemm_phase(LAS unsigned char* lds, const int lda, const int ldb, const Sched& S, const Epi& E) {
    int tid_ = threadIdx.x; asm volatile("" : "+v"(tid_));
    const int tid = tid_, wid = __builtin_amdgcn_readfirstlane(tid >> 6), lane = tid & 63, wr = wid >> 2, wc = wid & 3, fr = lane & 15, fq = lane >> 4;
    unsigned voffA[2], voffB[2];
#pragma unroll
    for (int i = 0; i < 2; ++i) { int R, C; stage_rc(tid * 16 + i * 8192, R, C); const int Rb = (R & ~31) + perm32(R & 31);
        voffA[i] = (unsigned)(R * lda + C) * 2u; voffB[i] = (unsigned)(Rb * ldb + C) * 2u; }
    const size_t kstep = (size_t)(BK * 2);
    const size_t hstepA = (size_t)HALF * lda * 2, hstepB = (size_t)HALF * ldb * 2;
    const unsigned ldsw = (unsigned)wid * 1024u;
    const int aoff = lds_byte(wr * 64 + fr, fq * 8), boff = lds_byte(wc * 32 + fr, fq * 8);
#define PG8_SA(b, h) (((b) * 2 + (h)) * HTB)
#define PG8_SB(b, h) ((4 + (b) * 2 + (h)) * HTB)
#define PG8_STAGE(bufoff, gbase, voff) do { _Pragma("unroll") for (int _i = 0; _i < 2; ++_i) \
        __builtin_amdgcn_global_load_lds((const unsigned*)((const char*)(gbase) + (voff)[_i]), (LAS unsigned*)(lds + (bufoff) + ldsw + _i * 8192), 16, 0, 0); } while (0)
#define PG8_LDA(dst, b, h) do { _Pragma("unroll") for (int m = 0; m < 4; ++m) _Pragma("unroll") for (int k = 0; k < 2; ++k) dst[m][k] = *(const LAS bf16x8*)(lds + PG8_SA(b, h) + aoff + m * 2048 + k * 1024); } while (0)
#define PG8_LDB(dst, b, h) do { _Pragma("unroll") for (int n = 0; n < 2; ++n) _Pragma("unroll") for (int k = 0; k < 2; ++k) dst[n][k] = *(const LAS bf16x8*)(lds + PG8_SB(b, h) + boff + n * 2048 + k * 1024); } while (0)
#define PG8_MMA(ai, bj, At, Bt) do { __builtin_amdgcn_s_setprio(1); _Pragma("unroll") for (int m = 0; m < 4; ++m) _Pragma("unroll") for (int n = 0; n < 2; ++n) _Pragma("unroll") for (int k = 0; k < 2; ++k) \
        acc[ai][bj][m][n] = __builtin_amdgcn_mfma_f32_16x16x32_bf16(Bt[n][k], At[m][k], acc[ai][bj][m][n], 0, 0, 0); __builtin_amdgcn_s_setprio(0); } while (0)
#define PG8_WAIT_V(n) asm volatile("s_waitcnt vmcnt(" #n ")" ::: "memory")
#define PG8_WAIT_L(n) asm volatile("s_waitcnt lgkmcnt(" #n ")" ::: "memory")
#define PG8_BAR __builtin_amdgcn_s_barrier()
#define PG8_SCHED __builtin_amdgcn_sched_barrier(0)
    Unit cur, nxt; int ui = 0;
    if (!S.next(0, cur)) return;
    f32x4 acc[2][2][4][2];
#pragma unroll
    for (int a = 0; a < 2; ++a)
#pragma unroll
        for (int b = 0; b < 2; ++b)
#pragma unroll
            for (int m = 0; m < 4; ++m)
#pragma unroll
                for (int n = 0; n < 2; ++n) acc[a][b][m][n] = (f32x4){0.f, 0.f, 0.f, 0.f};
    bf16x8 At[4][2], B0[2][2], B1[2][2];
    const char* cA = cur.A; const char* cB = cur.B;
    PG8_STAGE(PG8_SB(0, 0), cB, voffB); PG8_STAGE(PG8_SA(0, 0), cA, voffA); PG8_STAGE(PG8_SB(0, 1), cB + hstepB, voffB); PG8_STAGE(PG8_SA(0, 1), cA + hstepA, voffA);
    if (wr == 1) PG8_BAR;
    PG8_WAIT_V(4); PG8_BAR;
    PG8_STAGE(PG8_SB(1, 0), cB + kstep, voffB); PG8_STAGE(PG8_SA(1, 0), cA + kstep, voffA); PG8_STAGE(PG8_SB(1, 1), cB + hstepB + kstep, voffB);
    PG8_WAIT_V(6); PG8_BAR;
    for (;;) {
        const bool has_next = S.next(ui + 1, nxt);
        const char* nA = has_next ? nxt.A : cA; const char* nB = has_next ? nxt.B : cB;
        const int nt = cur.nt;
        for (int t = 0; t < nt; t += 2) {
            const bool last = (t == nt - 2);
            const char* a1 = cA + (size_t)(t + 1) * kstep;
            const char* a2 = last ? nA : cA + (size_t)(t + 2) * kstep; const char* b2 = last ? nB : cB + (size_t)(t + 2) * kstep;
            const char* a3 = a2 + kstep; const char* b3 = b2 + kstep;
            PG8_LDB(B0, 0, 0); PG8_SCHED; PG8_LDA(At, 0, 0); PG8_STAGE(PG8_SA(1, 1), a1 + hstepA, voffA);
            PG8_WAIT_L(8); PG8_BAR; PG8_WAIT_L(0); PG8_MMA(0, 0, At, B0); PG8_BAR; PG8_SCHED;
            PG8_LDB(B1, 0, 1); PG8_STAGE(PG8_SB(0, 0), b2, voffB);
            PG8_BAR; PG8_WAIT_L(0); PG8_MMA(0, 1, At, B1); PG8_BAR;
            PG8_LDA(At, 0, 1); PG8_STAGE(PG8_SA(0, 0), a2, voffA);
            PG8_BAR; PG8_WAIT_L(0); PG8_MMA(1, 0, At, B0); PG8_BAR; PG8_SCHED;
            PG8_STAGE(PG8_SB(0, 1), b2 + hstepB, voffB);
            PG8_WAIT_V(6); PG8_BAR; PG8_MMA(1, 1, At, B1); PG8_BAR;
            PG8_LDB(B0, 1, 0); PG8_SCHED; PG8_LDA(At, 1, 0); PG8_STAGE(PG8_SA(0, 1), a2 + hstepA, voffA);
            PG8_WAIT_L(8); PG8_BAR; PG8_WAIT_L(0); PG8_MMA(0, 0, At, B0); PG8_BAR; PG8_SCHED;
            PG8_LDB(B1, 1, 1); PG8_STAGE(PG8_SB(1, 0), b3, voffB);
            PG8_BAR; PG8_WAIT_L(0); PG8_MMA(0, 1, At, B1); PG8_BAR;
            PG8_LDA(At, 1, 1); PG8_STAGE(PG8_SA(1, 0), a3, voffA);
            PG8_BAR; PG8_WAIT_L(0); PG8_MMA(1, 0, At, B0); PG8_BAR; PG8_SCHED;
            PG8_STAGE(PG8_SB(1, 1), b3 + hstepB, voffB);
            PG8_WAIT_V(6); PG8_BAR; PG8_MMA(1, 1, At, B1); PG8_BAR;
        }
        E(acc, cur, wr, wc, fr, fq);
        if (!has_next) break;
#pragma unroll
        for (int a = 0; a < 2; ++a)
#pragma unroll
            for (int b = 0; b < 2; ++b)
#pragma unroll
                for (int m = 0; m < 4; ++m)
#pragma unroll
                    for (int n = 0; n < 2; ++n) acc[a][b][m][n] = (f32x4){0.f, 0.f, 0.f, 0.f};
        cur = nxt; cA = nA; cB = nB; ++ui;
    }
    PG8_WAIT_V(0);
    if (wr == 0) PG8_BAR;
    PG8_BAR;
#undef PG8_SA
#undef PG8_SB
#undef PG8_STAGE
#undef PG8_LDA
#undef PG8_LDB
#undef PG8_MMA
#undef PG8_WAIT_V
#undef PG8_WAIT_L
#undef PG8_BAR
#undef PG8_SCHED
}

template <int MODE>
struct EpiGated {
    bf16_t* O; int ldc; const float* bias; float* part;
    __device__ __forceinline__ void operator()(const f32x4 (&acc)[2][2][4][2], const Unit& u, int wr, int wc, int fr, int fq) const {
        const int row0 = u.pm * BM + wr * 64 + fr, col0 = u.pn * 128 + wc * 32 + 8 * fq;
        if (MODE == 1 && u.ks >= 0) {
#pragma unroll
            for (int bj = 0; bj < 2; ++bj)
#pragma unroll
                for (int ai = 0; ai < 2; ++ai)
#pragma unroll
                    for (int m = 0; m < 4; ++m) { float* p = part + ((size_t)u.ks * MS + (row0 + ai * HALF + m * 16 - MP)) * (2 * ldc) + u.pn * BM + bj * HALF + wc * 32 + 8 * fq;
                        *(f32x4*)p = acc[ai][bj][m][0]; *(f32x4*)(p + 4) = acc[ai][bj][m][1]; }
            return;
        }
        f32x4 b0[2], b1[2];
#pragma unroll
        for (int n = 0; n < 2; ++n) { b0[n] = (f32x4){0.f, 0.f, 0.f, 0.f}; b1[n] = b0[n];
            if (MODE == 1) { b0[n] = *(const f32x4*)(bias + col0 + 4 * n); b1[n] = *(const f32x4*)(bias + ldc + col0 + 4 * n); } }
#pragma unroll
        for (int ai = 0; ai < 2; ++ai)
#pragma unroll
            for (int m = 0; m < 4; ++m) {
                float v[8]; const float rs = 1.0f;
#pragma unroll
                for (int n = 0; n < 2; ++n)
#pragma unroll
                    for (int j = 0; j < 4; ++j) { const float a = acc[ai][0][m][n][j] * rs + b0[n][j], b = acc[ai][1][m][n][j] * rs + b1[n][j];
                        v[4 * n + j] = (MODE == 0) ? (a * b) * __builtin_amdgcn_rcpf(1.0f + __builtin_amdgcn_exp2f(-a))
                                                   : a * sigmoidf_(b); }
                u32x4 w; w.x = cvt_pk_bf16(v[0], v[1]); w.y = cvt_pk_bf16(v[2], v[3]); w.z = cvt_pk_bf16(v[4], v[5]); w.w = cvt_pk_bf16(v[6], v[7]);
                *(u32x4*)(O + (size_t)(row0 + ai * HALF + m * 16) * ldc + col0) = w;
            }
    }
};
template <int GLA>
struct EpiPlain {
    bf16_t* O; int ldc; const float* bg; float* part; const float* r2;
    __device__ __forceinline__ void operator()(const f32x4 (&acc)[2][2][4][2], const Unit& u, int wr, int wc, int fr, int fq) const {
        const int row0 = u.pm * BM + wr * 64 + fr, col0 = u.pn * BM + wc * 32 + 8 * fq;
        if (!GLA && u.ks >= 0) {
#pragma unroll
            for (int bj = 0; bj < 2; ++bj)
#pragma unroll
                for (int ai = 0; ai < 2; ++ai)
#pragma unroll
                    for (int m = 0; m < 4; ++m) { float* p = part + ((size_t)u.ks * MS + (row0 + ai * HALF + m * 16 - MP)) * D + col0 + bj * HALF;
                        *(f32x4*)p = acc[ai][bj][m][0]; *(f32x4*)(p + 4) = acc[ai][bj][m][1]; }
            return;
        }
        const bool lf = false;
#pragma unroll
        for (int bj = 0; bj < 2; ++bj) {
            f32x4 bb[2];
#pragma unroll
            for (int n = 0; n < 2; ++n) bb[n] = lf ? *(const f32x4*)(bg + (col0 - 3072) + bj * HALF + 4 * n) : (f32x4){0.f, 0.f, 0.f, 0.f};
#pragma unroll
            for (int ai = 0; ai < 2; ++ai)
#pragma unroll
                for (int m = 0; m < 4; ++m) {
                    float v[8]; const float rs = 1.0f;
#pragma unroll
                    for (int n = 0; n < 2; ++n)
#pragma unroll
                        for (int j = 0; j < 4; ++j) { float a = acc[ai][bj][m][n][j] * rs;
                            if (lf) a += bb[n][j];
                            v[4 * n + j] = a; }
                    u32x4 w; w.x = cvt_pk_bf16(v[0], v[1]); w.y = cvt_pk_bf16(v[2], v[3]); w.z = cvt_pk_bf16(v[4], v[5]); w.w = cvt_pk_bf16(v[6], v[7]);
                    *(u32x4*)(O + (size_t)(row0 + ai * HALF + m * 16) * ldc + col0 + bj * HALF) = w;
                }
        }
    }
};
struct EpiS5A {
    bf16_t* HL;
    __device__ __forceinline__ void operator()(const f32x4 (&acc)[2][2][4][2], const Unit& u, int wr, int wc, int fr, int fq) const {
        const int row0 = u.pm * BM + wr * 64 + fr, col0 = wc * 32 + 8 * fq;
#pragma unroll
        for (int ai = 0; ai < 2; ++ai)
#pragma unroll
            for (int m = 0; m < 4; ++m) { const f32x4 a0 = acc[ai][0][m][0], a1 = acc[ai][0][m][1];
                u32x4 w; w.x = cvt_pk_bf16(a0[0], a0[1]); w.y = cvt_pk_bf16(a0[2], a0[3]); w.z = cvt_pk_bf16(a1[0], a1[1]); w.w = cvt_pk_bf16(a1[2], a1[3]);
                *(u32x4*)(HL + ((size_t)u.pn * 1024 + row0 + ai * HALF + m * 16) * 128 + col0) = w; }
    }
};
struct EpiS5B {
    unsigned char* ws; const float* dsk;
    __device__ __forceinline__ void operator()(const f32x4 (&acc)[2][2][4][2], const Unit& u, int wr, int wc, int fr, int fq) const {
        bf16_t* Z = (bf16_t*)(ws + WS_Z); const bf16_t* HS5 = (const bf16_t*)(ws + WS_HS5);
        asm volatile("" : "+v"(fq));
        const int g = u.pn, c0 = (8 * fq) & 15;
        const f32x4 d0 = *(const f32x4*)(dsk + g * 16 + c0), d1 = *(const f32x4*)(dsk + g * 16 + c0 + 4);
#pragma unroll
        for (int bj = 0; bj < 2; ++bj) { const int t = 8 * bj + 2 * wc + (fq >> 1);
#pragma unroll
            for (int ai = 0; ai < 2; ++ai)
#pragma unroll
                for (int m = 0; m < 4; ++m) { const int colr = u.pm * BM + ai * HALF + wr * 64 + m * 16 + fr; const size_t off = (size_t)(colr * 16 + t) * D + g * 16 + c0;
                    const u32x4 uu = *(const u32x4*)(HS5 + ((size_t)g * 1024 + colr) * 384 + t * 16 + c0); const f32x4 a0 = acc[ai][bj][m][0], a1 = acc[ai][bj][m][1];
                    u32x4 w; w.x = cvt_pk_bf16(a0[0] + d0[0] * bflo(uu.x), a0[1] + d0[1] * bfhi(uu.x)); w.y = cvt_pk_bf16(a0[2] + d0[2] * bflo(uu.y), a0[3] + d0[3] * bfhi(uu.y));
                    w.z = cvt_pk_bf16(a1[0] + d1[0] * bflo(uu.z), a1[1] + d1[1] * bfhi(uu.z)); w.w = cvt_pk_bf16(a1[2] + d1[2] * bflo(uu.w), a1[3] + d1[3] * bfhi(uu.w));
                    *(u32x4*)(Z + off) = w; }
        }
    }
};

struct Params { const float* in[23]; float* out; unsigned char* ws; int ph_lo, ph_hi; };

__device__ __forceinline__ int rp_row(int kidx, int gw, int NGW) {
    if (NGW % MS == 0) { const int stride = NGW / MS, kp = (MP + NGW - 1) / NGW;
        if (kidx == 0) return (gw % stride == 0) ? MP + gw / stride : -1;
        if (kidx > kp) return -1;
        const int m = gw + (kidx - 1) * NGW; return m < MP ? m : -1; }
    const int KMAX = (M + NGW - 1) / NGW; if (kidx >= KMAX) return -1;
    const int kk = (kidx + KMAX - 1) % KMAX, m = gw + kk * NGW; return m < M ? m : -1;
}
template <int R, int NKS>
__device__ __forceinline__ void row_pass(const float* xf_p, const float* xf_s, bf16_t* XB, float* R2, const bf16_t* Y, const float* g_post, float scale,
                                         const float* part, float* outf, const float* g_pre, bf16_t* HS5, bf16_t* HSMP, const float* glu_bias = nullptr) {
    const int tid = otid(); const int lane = tid & 63, gw = blockIdx.x * 8 + (tid >> 6), NGW = gridDim.x * 8;
#define CJ(j) (512 * ((j) >> 1) + 8 * lane + 4 * ((j) & 1))
    const int KMAX = (NGW % MS == 0) ? (MP + NGW - 1) / NGW + 1 : (M + NGW - 1) / NGW;
    f32x4 gpo[4];
#pragma unroll
    for (int j = 0; j < 4; ++j) gpo[j] = Y ? *(const f32x4*)(g_post + CJ(j)) : (f32x4){0.f, 0.f, 0.f, 0.f};
    for (int k0 = 0; k0 < KMAX; k0 += R) {
        f32x4 v[R][4], yv[R][4];
#pragma unroll
        for (int r = 0; r < R; ++r) { const int mi = rp_row(k0 + r, gw, NGW), m = mi >= 0 ? mi : gw;
            if (xf_p) { const float* xr = (m < MP) ? xf_p + (size_t)m * D : xf_s + (size_t)(m - MP) * D;
#pragma unroll
                for (int j = 0; j < 4; ++j) v[r][j] = *(const f32x4*)(xr + CJ(j));
            } else {
                const float ir = 1.0f / R2[m];
#pragma unroll
                for (int jj = 0; jj < 2; ++jj) { const u32x4 w = *(const u32x4*)(XB + (size_t)m * D + 512 * jj + 8 * lane);
                    v[r][2 * jj] = (f32x4){bflo(w.x), bfhi(w.x), bflo(w.y), bfhi(w.y)} * ir; v[r][2 * jj + 1] = (f32x4){bflo(w.z), bfhi(w.z), bflo(w.w), bfhi(w.w)} * ir; }
            }
            if (Y) {
                if (glu_bias && m >= MP) {
#pragma unroll
                    for (int j = 0; j < 4; ++j) { const int nc = 256 * (4 * (j >> 1) + (lane >> 4)) + 8 * (lane & 15) + 4 * (j & 1);
                        f32x4 sv = *(const f32x4*)(glu_bias + CJ(j)), sg = *(const f32x4*)(glu_bias + D + CJ(j));
                        f32x4 tv[NKS], tg[NKS];
#pragma unroll
                        for (int ks = 0; ks < NKS; ++ks) { const float* pp = part + ((size_t)ks * MS + (m - MP)) * (2 * D) + nc; tv[ks] = *(const f32x4*)pp; tg[ks] = *(const f32x4*)(pp + 128); }
#pragma unroll
                        for (int ks = 0; ks < NKS; ++ks) { sv += tv[ks]; sg += tg[ks]; }
                        yv[r][j] = (f32x4){sv.x * sigmoidf_(sg.x), sv.y * sigmoidf_(sg.y), sv.z * sigmoidf_(sg.z), sv.w * sigmoidf_(sg.w)}; }
                } else if (part && m >= MP) {
#pragma unroll
                    for (int j = 0; j < 4; ++j) { f32x4 t[NKS];
#pragma unroll
                        for (int ks = 0; ks < NKS; ++ks) t[ks] = *(const f32x4*)(part + ((size_t)ks * MS + (m - MP)) * D + CJ(j));
                        f32x4 s = t[0];
#pragma unroll
                        for (int ks = 1; ks < NKS; ++ks) s += t[ks];
                        yv[r][j] = s; }
                } else {
#pragma unroll
                    for (int jj = 0; jj < 2; ++jj) { const u32x4 w = *(const u32x4*)(Y + (size_t)m * D + 512 * jj + 8 * lane);
                        yv[r][2 * jj] = (f32x4){bflo(w.x), bfhi(w.x), bflo(w.y), bfhi(w.y)}; yv[r][2 * jj + 1] = (f32x4){bflo(w.z), bfhi(w.z), bflo(w.w), bfhi(w.w)}; }
                }
            }
        }
#pragma unroll
        for (int r = 0; r < R; ++r) { const int m = rp_row(k0 + r, gw, NGW); if (m < 0) continue;
            if (Y) {
                float ss = 0.f;
#pragma unroll
                for (int j = 0; j < 4; ++j) ss += (yv[r][j].x * yv[r][j].x + yv[r][j].y * yv[r][j].y) + (yv[r][j].z * yv[r][j].z + yv[r][j].w * yv[r][j].w);
                const float rr = rsqrtf(wave_sum(ss) * (1.0f / D) + EPS) * scale;
#pragma unroll
                for (int j = 0; j < 4; ++j) v[r][j] = v[r][j] + yv[r][j] * gpo[j] * rr;
            }
            if (outf) {
#pragma unroll
                for (int j = 0; j < 4; ++j) *(f32x4*)(outf + (size_t)m * D + CJ(j)) = v[r][j];
            } else {
                float ss = 0.f;
#pragma unroll
                for (int j = 0; j < 4; ++j) ss += (v[r][j].x * v[r][j].x + v[r][j].y * v[r][j].y) + (v[r][j].z * v[r][j].z + v[r][j].w * v[r][j].w);
                const float rr = rsqrtf(wave_sum(ss) * (1.0f / D) + EPS);
#pragma unroll
                for (int jj = 0; jj < 2; ++jj) { const f32x4 a = v[r][2 * jj] * rr, b = v[r][2 * jj + 1] * rr;
                    u32x4 w; w.x = cvt_pk_bf16(a.x, a.y); w.y = cvt_pk_bf16(a.z, a.w); w.z = cvt_pk_bf16(b.x, b.y); w.w = cvt_pk_bf16(b.z, b.w);
                    *(u32x4*)(XB + (size_t)m * D + 512 * jj + 8 * lane) = w; }
                if (lane == 0) R2[m] = rr;
                if (g_pre) {
#pragma unroll
                    for (int jj = 0; jj < 2; ++jj) { const f32x4 ga = *(const f32x4*)(g_pre + CJ(2 * jj)), gb = *(const f32x4*)(g_pre + CJ(2 * jj + 1));
                        const f32x4 ha = v[r][2 * jj] * ga * rr, hb = v[r][2 * jj + 1] * gb * rr;
                        u32x4 w; w.x = cvt_pk_bf16(ha.x, ha.y); w.y = cvt_pk_bf16(ha.z, ha.w); w.z = cvt_pk_bf16(hb.x, hb.y); w.w = cvt_pk_bf16(hb.z, hb.w);
                        if (m < MP) { const int gi = 32 * jj + (lane >> 1), c = (lane & 1) * 8;
                            *(u32x4*)(HS5 + ((size_t)gi * 1024 + (m >> 4)) * 384 + (m & 15) * 16 + c) = w; }
                        else *(u32x4*)(HSMP + (size_t)(m - MP) * D + 512 * jj + 8 * lane) = w; }
                }
            }
        }
    }
}
#undef CJ

__device__ __forceinline__ void transpose_item(const float* W, int ldw, int K, int scol0, bf16_t* Bt, int drow0, int k0, float scale, const float* gk, LAS bf16_t* scr, int lane) {
    const float* src = W + (size_t)(k0 + (lane >> 5)) * ldw + scol0 + 4 * (lane & 31);
#pragma unroll 16
    for (int i = 0; i < 32; ++i) { const f32x4 w = __builtin_nontemporal_load((const f32x4*)(src + (size_t)(2 * i) * ldw));
        const float sc = gk ? gk[k0 + 2 * i + (lane >> 5)] * scale : scale;
        u32x2 o; o.x = cvt_pk_bf16(w.x * sc, w.y * sc); o.y = cvt_pk_bf16(w.z * sc, w.w * sc);
        *(LAS u32x2*)(scr + (2 * i + (lane >> 5)) * 136 + 4 * (lane & 31)) = o; }
    asm volatile("s_waitcnt lgkmcnt(0)" ::: "memory");
#pragma unroll 4
    for (int t = 0; t < 16; ++t) { const int task = t * 64 + lane, n = task >> 3, kc = task & 7; const LAS bf16_t* s = scr + (kc * 8) * 136 + n;
        u32x4 o; o.x = (unsigned)s[0] | ((unsigned)s[136] << 16); o.y = (unsigned)s[272] | ((unsigned)s[408] << 16);
        o.z = (unsigned)s[544] | ((unsigned)s[680] << 16); o.w = (unsigned)s[816] | ((unsigned)s[952] << 16);
        *(u32x4*)(Bt + (size_t)(drow0 + n) * K + k0 + 8 * kc) = o; }
    asm volatile("s_waitcnt lgkmcnt(0)" ::: "memory");
}

__device__ __forceinline__ void s5_prep_group(const Params& P, LAS unsigned char* lds, int g, int qt) {
    LAS float* apr = (LAS float*)lds;
    LAS float* api = apr + 17 * 64;
    LAS float* bbr = api + 17 * 64;
    LAS float* bbi = bbr + 1024;
    LAS float* cre = bbi + 1024;
    LAS float* cim = cre + 1024;
    LAS float* fre = cim + 1024;
    LAS float* fim = fre + 64;
    LAS float* kmat = fim + 64;
    const int tid = otid();
    float* sm = (float*)(P.ws + WS_SMALL);
    bf16_t* Wm = (bf16_t*)(P.ws + WS_S5M + (size_t)g * S5M_G);
    bf16_t* TE = Wm + 128 * 256;
    if (tid < 64) {
        const int p = tid; const float lr = P.in[13][g * 64 + p], li = P.in[14][g * 64 + p]; const float dt = expf(P.in[15][g]);
        float a1r = 0.f, a1i = 0.f;
        for (int tau = 0; tau <= 16; ++tau) {
            const float mag = expf(lr * dt * (float)tau);
            double rev = (double)li * (double)dt * (double)tau * 0.15915494309189535; rev -= __builtin_rint(rev);
            const float rr = (float)rev; const float s = __builtin_amdgcn_sinf(rr), c = __builtin_amdgcn_cosf(rr);
            apr[tau * 64 + p] = mag * c; api[tau * 64 + p] = mag * s;
            if (tau == 1) { a1r = mag * c; a1i = mag * s; }
            if (tau == 16 && qt == 0) { sm[SM_A16R + g * 64 + p] = mag * c; sm[SM_A16I + g * 64 + p] = mag * s; }
        }
        const float nr = a1r - 1.0f, ni = a1i, den = lr * lr + li * li;
        const float fr_ = (nr * lr + ni * li) / den, fi_ = (ni * lr - nr * li) / den;
        fre[p] = fr_; fim[p] = fi_;
        if (qt == 0) { sm[SM_ARE + g * 64 + p] = a1r; sm[SM_AIM + g * 64 + p] = a1i; sm[SM_FRE + g * 64 + p] = fr_; sm[SM_FIM + g * 64 + p] = fi_; }
    }
    __syncthreads();
    for (int idx = tid; idx < 1024; idx += 512) { const int p = idx >> 4; const float br = P.in[16][g * 1024 + idx], bi = P.in[17][g * 1024 + idx];
        bbr[idx] = fre[p] * br - fim[p] * bi; bbi[idx] = fre[p] * bi + fim[p] * br;
        cre[idx] = P.in[18][g * 1024 + idx]; cim[idx] = P.in[19][g * 1024 + idx]; }
    __syncthreads();
    for (int idx = qt * 8192 + tid; idx < (qt + 1) * 8192; idx += 512) { const int row = idx >> 8, col = idx & 255, s = col >> 4, c = col & 15, p = row & 63, im = row >> 6;
        const float ar = apr[(15 - s) * 64 + p], ai = api[(15 - s) * 64 + p], br = bbr[p * 16 + c], bi = bbi[p * 16 + c];
        Wm[idx] = f2bf(im ? (ar * bi + ai * br) : (ar * br - ai * bi)); }
    for (int i2 = tid; i2 < 1024; i2 += 512) { const int tau = i2 >> 6, cp = 4 * qt + ((i2 >> 4) & 3), c = i2 & 15, idx = (tau << 8) + (cp << 4) + c; float sum = 0.f;
        for (int p = 0; p < 64; ++p) { const float cr = cre[cp * 64 + p], ci = cim[cp * 64 + p], ar = apr[tau * 64 + p], ai = api[tau * 64 + p];
            const float car = cr * ar - ci * ai, cai = cr * ai + ci * ar; sum += car * bbr[p * 16 + c] - cai * bbi[p * 16 + c]; }
        kmat[idx] = sum; }
    __syncthreads();
    for (int i2 = tid; i2 < 64 * 384; i2 += 512) { const int r2 = i2 / 384, col = i2 - r2 * 384, t = r2 >> 2, cp = 4 * qt + (r2 & 3), row = t * 16 + cp, idx = row * 384 + col; float v;
        if (col < 256) { const int s = col >> 4, c = col & 15; v = (s <= t) ? kmat[((t - s) << 8) + (cp << 4) + c] : 0.f; }
        else { const int pp = col - 256, p = pp & 63, im = pp >> 6; const float cr = cre[cp * 64 + p], ci = cim[cp * 64 + p], ar = apr[(t + 1) * 64 + p], ai = api[(t + 1) * 64 + p];
            v = im ? -(cr * ai + ci * ar) : (cr * ar - ci * ai); }
        TE[idx] = f2bf(v); }
    __syncthreads();
}

__device__ __forceinline__ void s5_idle_prep(const Params& P, LAS unsigned char* lds, int slot) {
    const int G = gridDim.x, nfull = ((M / BM) * (NGU / BM)) % G, cb = blockIdx.x;
    if (nfull == 0 || cb < nfull) return;
    const int wi = slot * (G - nfull) + (cb - nfull);
    if (wi < 256) s5_prep_group(P, lds, wi >> 2, wi & 3);
}
__device__ __forceinline__ void s5_idle_prep_inproj(const Params& P, LAS unsigned char* lds) {
    const int G = gridDim.x, nf1 = ((M / BM) * (NGU / BM)) % G, nf2 = ((M / BM) * (NIN / BM)) % G, cb = blockIdx.x;
    if (nf1 == 0 || nf2 == 0 || cb < nf2) return;
    const int wi = 3 * (G - nf1) + (cb - nf2);
    if (wi < 256) s5_prep_group(P, lds, wi >> 2, wi & 3);
}
__device__ __forceinline__ void phase0(const Params& P, LAS unsigned char* lds) {
    const int tid = otid(), lane = tid & 63, wave = tid >> 6;
    const int gw = blockIdx.x * 8 + wave, NGW = gridDim.x * 8;
    LAS bf16_t* scr = (LAS bf16_t*)(lds + wave * 17408);
    bf16_t* WGU = (bf16_t*)(P.ws + WS_WGU); bf16_t* WDN = (bf16_t*)(P.ws + WS_WDN); bf16_t* WIN = (bf16_t*)(P.ws + WS_WIN);
    bf16_t* WOUT = (bf16_t*)(P.ws + WS_WOUT); bf16_t* WGLU = (bf16_t*)(P.ws + WS_WGLU);
    constexpr int I_GU = 4 * 16 * 44, I_DN = 4 * 44 * 8, I_IN = 16 * 24, I_OUT = 16 * 8, I_GLU = 16 * 16;
#pragma unroll 1
    for (int step = 0; step < 2; ++step) {
    if (((blockIdx.x & 1) != 0) == (step == 0)) {
        { const int G_ = gridDim.x, nf1_ = ((M / BM) * (NGU / BM)) % G_, nf2_ = ((M / BM) * (NIN / BM)) % G_;
          const int first_ = (nf1_ && nf2_) ? 3 * (G_ - nf1_) + (G_ - nf2_) : (nf1_ ? 3 * (G_ - nf1_) : 0);
          for (int wi = first_ + blockIdx.x; wi < 256; wi += gridDim.x) s5_prep_group(P, lds, wi >> 2, wi & 3); }
    } else {
    for (int it = blockIdx.x + gridDim.x * wave; it < I_GU + I_DN + I_IN + I_OUT + I_GLU; it += NGW) {
        int r = it;
        if (r < I_GU) { const int lf = r / 704, rr = r % 704, kb = rr / 44, nb = rr % 44, n0 = nb * 128, pn = n0 >> 8, bj = (n0 >> 7) & 1;
            transpose_item(P.in[6] + (size_t)lf * D * NGU, NGU, D, bj * FF + pn * 128, WGU + (size_t)lf * NGU * D, n0, kb * 64, bj ? 0.6931471805599453f : 1.4426950408889634f, P.in[5] + (size_t)((lf >> 1) * 6 + (lf & 1) * 4) * D, scr, lane); continue; }
        r -= I_GU;
        if (r < I_DN) { const int lf = r / 352, rr = r % 352, kb = rr / 8, nb = rr % 8;
            transpose_item(P.in[7] + (size_t)lf * FF * D, D, FF, nb * 128, WDN + (size_t)lf * D * FF, nb * 128, kb * 64, 1.0f, nullptr, scr, lane); continue; }
        r -= I_DN;
        if (r < I_IN) { const int kb = r / 24, nb = r % 24, n0 = nb * 128;
            transpose_item(P.in[8], LDIN, D, n0, WIN, n0, kb * 64, n0 < 512 ? 0.08838834764831845f : 1.0f, P.in[5] + 2 * D, scr, lane); continue; }
        r -= I_IN;
        if (r < I_OUT) { const int kb = r / 8, nb = r % 8; transpose_item(P.in[12], D, D, nb * 128, WOUT, nb * 128, kb * 64, 1.0f, nullptr, scr, lane); continue; }
        r -= I_OUT;
        { const int kb = r / 16, nb = r % 16, n0 = nb * 128, pn = n0 >> 8, bj = (n0 >> 7) & 1;
            transpose_item(P.in[21], 2 * D, D, bj * D + pn * 128, WGLU, n0, kb * 64, 1.0f, nullptr, scr, lane); }
    }
    for (int idx = blockIdx.x * 512 + tid; idx < 64 * 1024; idx += gridDim.x * 512) { const int jb = idx >> 10, k = idx & 1023;
        const float* wr = P.in[8] + (size_t)k * LDIN + 3072; const f32x4 a0 = *(const f32x4*)wr, a1 = *(const f32x4*)(wr + 4), a2 = *(const f32x4*)(wr + 8), a3 = *(const f32x4*)(wr + 12);
        const float a[16] = {a0.x, a0.y, a0.z, a0.w, a1.x, a1.y, a1.z, a1.w, a2.x, a2.y, a2.z, a2.w, a3.x, a3.y, a3.z, a3.w}; const float gk = P.in[5][2 * D + k];
#pragma unroll
        for (int jj = 0; jj < 8; ++jj) { const int j = jb * 8 + jj; float s = 0.f;
#pragma unroll
            for (int r = 0; r < 16; ++r) s += a[r] * P.in[9][r * 512 + j];
            WIN[(size_t)(3072 + j) * D + k] = f2bf(s * gk); } }
    }
    __syncthreads();
    }
    row_pass<3, 1>(P.in[0], P.in[1], (bf16_t*)(P.ws + WS_H), (float*)(P.ws + WS_SMALL) + SM_R2, nullptr, nullptr, 0.f, nullptr, nullptr, nullptr, nullptr, nullptr);
}

__device__ __forceinline__ void gla_cumsum(LAS float* BC, LAS float* TOT, const u32x4 (&lw)[2], const f32x4 (&bgv)[2], int tid) {
#pragma unroll
    for (int i = 0; i < 2; ++i) { const int e = tid + 512 * i, t = e >> 4, d0 = (e & 15) * 8; const u32x4 w = lw[i];
        LAS float* b = BC + t * 128 + d0; b[0] = logf_gate(bflo(w.x) + bgv[0].x); b[1] = logf_gate(bfhi(w.x) + bgv[0].y); b[2] = logf_gate(bflo(w.y) + bgv[0].z); b[3] = logf_gate(bfhi(w.y) + bgv[0].w);
        b[4] = logf_gate(bflo(w.z) + bgv[1].x); b[5] = logf_gate(bfhi(w.z) + bgv[1].y); b[6] = logf_gate(bflo(w.w) + bgv[1].z); b[7] = logf_gate(bfhi(w.w) + bgv[1].w); }
    __syncthreads();
    const int dk = tid & 127, seg = tid >> 7; float run = 0.f;
#pragma unroll
    for (int i = 0; i < 16; ++i) { const int t = seg * 16 + i; run += BC[t * 128 + dk]; BC[t * 128 + dk] = run; }
    TOT[seg * 128 + dk] = run;
    __syncthreads();
    float off = 0.f;
    for (int s = 0; s < seg; ++s) off += TOT[s * 128 + dk];
#pragma unroll
    for (int i = 0; i < 16; ++i) BC[(seg * 16 + i) * 128 + dk] += off;
    __syncthreads();
}
__device__ __forceinline__ void gla_load_vt(LAS bf16_t* VT, const u32x4 (&vw)[4], int tid) {
#pragma unroll
    for (int i = 0; i < 4; ++i) { const int e = tid + 512 * i, t = e >> 5, d0 = (e & 31) * 8; const u32x4 w = vw[i];
        LAS bf16_t* p = VT + d0 * 72 + ((((t >> 3) ^ ((d0 >> 3) & 7)) << 3) | (t & 7));
        p[0] = (bf16_t)(w.x & 0xffff); p[72] = (bf16_t)(w.x >> 16); p[144] = (bf16_t)(w.y & 0xffff); p[216] = (bf16_t)(w.y >> 16);
        p[288] = (bf16_t)(w.z & 0xffff); p[360] = (bf16_t)(w.z >> 16); p[432] = (bf16_t)(w.w & 0xffff); p[504] = (bf16_t)(w.w >> 16); }
}

__device__ __forceinline__ void gla_phase_a(const Params& P, LAS unsigned char* lds) {
    const int tid = otid(), lane = tid & 63, w = tid >> 6, l16 = lane & 15, q = lane >> 4;
    LAS float* BC = (LAS float*)lds; LAS float* TOT = (LAS float*)(lds + 32768);
    LAS bf16_t* KT = (LAS bf16_t*)(lds + 34816); LAS bf16_t* VT = (LAS bf16_t*)(lds + 53248);
    const bf16_t* QKV = (const bf16_t*)(P.ws + WS_QKV); bf16_t* KC = (bf16_t*)(P.ws + WS_KC); float* BEND = (float*)(P.ws + WS_BEND);
    for (int item = blockIdx.x; item < 1024; item += gridDim.x) {
        const int b = item >> 7, h = (item >> 5) & 3, c = item & 31; const size_t tok0 = (size_t)b * 2048 + c * 64;
        const bf16_t* base = QKV + tok0 * NIN;
        u32x4 lw[2], kw[2], vw[4]; f32x4 bgv[2]; bgv[0] = *(const f32x4*)(P.in[10] + h * 128 + (tid & 15) * 8); bgv[1] = *(const f32x4*)(P.in[10] + h * 128 + (tid & 15) * 8 + 4);
#pragma unroll
        for (int i = 0; i < 2; ++i) { const int e = tid + 512 * i, t = e >> 4, d0 = (e & 15) * 8; lw[i] = *(const u32x4*)(base + (size_t)t * NIN + 3072 + h * 128 + d0); kw[i] = *(const u32x4*)(base + (size_t)t * NIN + 512 + h * 128 + d0); }
#pragma unroll
        for (int i = 0; i < 4; ++i) { const int e = tid + 512 * i, t = e >> 5, d0 = (e & 31) * 8; vw[i] = *(const u32x4*)(base + (size_t)t * NIN + 1024 + h * 256 + d0); }
        gla_cumsum(BC, TOT, lw, bgv, tid);
        if (tid < 128) BEND[item * 128 + tid] = BC[63 * 128 + tid];
#pragma unroll
        for (int i = 0; i < 2; ++i) { const int e = tid + 512 * i, t = e >> 4, d0 = (e & 15) * 8; const u32x4 wv = kw[i];
            float kv[8] = {bflo(wv.x), bfhi(wv.x), bflo(wv.y), bfhi(wv.y), bflo(wv.z), bfhi(wv.z), bflo(wv.w), bfhi(wv.w)};
#pragma unroll
            for (int j = 0; j < 8; ++j) KT[(d0 + j) * 72 + ((((t >> 3) ^ ((d0 >> 3) & 7)) << 3) | (t & 7))] = f2bf(kv[j] * __expf(BC[63 * 128 + d0 + j] - BC[t * 128 + d0 + j])); }
        gla_load_vt(VT, vw, tid);
        __syncthreads();
        f32x4 acc[8][2];
#pragma unroll
        for (int a = 0; a < 8; ++a) { acc[a][0] = (f32x4){0.f, 0.f, 0.f, 0.f}; acc[a][1] = acc[a][0]; }
#pragma unroll
        for (int kk = 0; kk < 2; ++kk) {
            bf16x8 vb[2];
#pragma unroll
            for (int d = 0; d < 2; ++d) vb[d] = *(const LAS bf16x8*)(VT + (16 * (2 * w + d) + l16) * 72 + (((kk * 4 + q) ^ ((2 * (2 * w + d) + (l16 >> 3)) & 7)) << 3));
#pragma unroll
            for (int a = 0; a < 8; ++a) { const bf16x8 ka = *(const LAS bf16x8*)(KT + (16 * a + l16) * 72 + (((kk * 4 + q) ^ ((2 * a + (l16 >> 3)) & 7)) << 3));
#pragma unroll
                for (int d = 0; d < 2; ++d) acc[a][d] = __builtin_amdgcn_mfma_f32_16x16x32_bf16(ka, vb[d], acc[a][d], 0, 0, 0); }
        }
#pragma unroll
        for (int a = 0; a < 8; ++a)
#pragma unroll
            for (int d = 0; d < 2; ++d) { u32x2 o; o.x = cvt_pk_bf16(acc[a][d][0], acc[a][d][1]); o.y = cvt_pk_bf16(acc[a][d][2], acc[a][d][3]);
                *(u32x2*)(KC + ((size_t)item * 256 + 16 * (2 * w + d) + l16) * 128 + 16 * a + 4 * q) = o; }
        __syncthreads();
    }
}
__device__ __forceinline__ void gla_phase_b(const Params& P) {
    bf16_t* KC = (bf16_t*)(P.ws + WS_KC); const float* BEND = (const float*)(P.ws + WS_BEND);
    const int tidb = otid();
    for (int idx = blockIdx.x * 512 + tidb; idx < 32 * 4096; idx += gridDim.x * 512) {
        const int bh = idx >> 12, e = idx & 4095, dv = e >> 4, dk0 = (e & 15) * 8;
        float S[8];
#pragma unroll
        for (int j = 0; j < 8; ++j) S[j] = 0.f;
#pragma unroll 8
        for (int c = 0; c < 32; ++c) { const int item = bh * 32 + c;
            u32x4* p = (u32x4*)(KC + ((size_t)item * 256 + dv) * 128 + dk0); const u32x4 kc = *p;
            const f32x4 e0 = *(const f32x4*)(BEND + item * 128 + dk0), e1 = *(const f32x4*)(BEND + item * 128 + dk0 + 4);
            u32x4 o; o.x = cvt_pk_bf16(S[0], S[1]); o.y = cvt_pk_bf16(S[2], S[3]); o.z = cvt_pk_bf16(S[4], S[5]); o.w = cvt_pk_bf16(S[6], S[7]); *p = o;
            S[0] = __expf(e0.x) * S[0] + bflo(kc.x); S[1] = __expf(e0.y) * S[1] + bfhi(kc.x); S[2] = __expf(e0.z) * S[2] + bflo(kc.y); S[3] = __expf(e0.w) * S[3] + bfhi(kc.y);
            S[4] = __expf(e1.x) * S[4] + bflo(kc.z); S[5] = __expf(e1.y) * S[5] + bfhi(kc.z); S[6] = __expf(e1.z) * S[6] + bflo(kc.w); S[7] = __expf(e1.w) * S[7] + bfhi(kc.w); }
        float* o = P.out + O_GP + (size_t)bh * 32768;
#pragma unroll
        for (int j = 0; j < 8; ++j) o[(dk0 + j) * 256 + dv] = S[j];
    }
}
__device__ __forceinline__ void gla_phase_c(const Params& P, LAS unsigned char* lds) {
    const int tid = otid(), lane = tid & 63, w = tid >> 6, l16 = lane & 15, q = lane >> 4;
    LAS float* BC = (LAS float*)lds; LAS float* TOT = (LAS float*)(lds + 32768); LAS float* PART = (LAS float*)(lds + 34816);
    LAS bf16_t* QT = (LAS bf16_t*)(lds + 36864); LAS bf16_t* KT = (LAS bf16_t*)(lds + 54272);
    LAS bf16_t* VT = (LAS bf16_t*)(lds + 71680); LAS bf16_t* ATT = (LAS bf16_t*)(lds + 108544);
    const bf16_t* QKV = (const bf16_t*)(P.ws + WS_QKV); const bf16_t* KC = (const bf16_t*)(P.ws + WS_KC); bf16_t* Oo = (bf16_t*)(P.ws + WS_O);
    const float* gon = P.in[11];
    for (int item = blockIdx.x; item < 1024; item += gridDim.x) {
        const int b = item >> 7, h = (item >> 5) & 3, c = item & 31; const size_t tok0 = (size_t)b * 2048 + c * 64;
        const bf16_t* base = QKV + tok0 * NIN;
        u32x4 lw[2], qw[2], kw[2], vw[4]; bf16x8 sfr[4][2]; u32x2 rw[4][2]; f32x4 bgv[2]; bgv[0] = *(const f32x4*)(P.in[10] + h * 128 + (tid & 15) * 8); bgv[1] = *(const f32x4*)(P.in[10] + h * 128 + (tid & 15) * 8 + 4);
#pragma unroll
        for (int i = 0; i < 2; ++i) { const int e = tid + 512 * i, t = e >> 4, d0 = (e & 15) * 8; lw[i] = *(const u32x4*)(base + (size_t)t * NIN + 3072 + h * 128 + d0);
            qw[i] = *(const u32x4*)(base + (size_t)t * NIN + h * 128 + d0); kw[i] = *(const u32x4*)(base + (size_t)t * NIN + 512 + h * 128 + d0); }
#pragma unroll
        for (int i = 0; i < 4; ++i) { const int e = tid + 512 * i, t = e >> 5, d0 = (e & 31) * 8; vw[i] = *(const u32x4*)(base + (size_t)t * NIN + 1024 + h * 256 + d0); }
#pragma unroll
        for (int kk = 0; kk < 4; ++kk)
#pragma unroll
            for (int d = 0; d < 2; ++d) sfr[kk][d] = *(const bf16x8*)(KC + ((size_t)item * 256 + 16 * (2 * w + d) + l16) * 128 + kk * 32 + q * 8);
#pragma unroll
        for (int tm = 0; tm < 4; ++tm)
#pragma unroll
            for (int d = 0; d < 2; ++d) rw[tm][d] = *(const u32x2*)(QKV + (tok0 + 16 * tm + l16) * NIN + 2048 + h * 256 + 16 * (2 * w + d) + 4 * q);
        gla_cumsum(BC, TOT, lw, bgv, tid);
#pragma unroll
        for (int i = 0; i < 2; ++i) { const int e = tid + 512 * i, t = e >> 4, d0 = (e & 15) * 8;
            const u32x4 wq = qw[i], wk = kw[i];
            float qv[8] = {bflo(wq.x), bfhi(wq.x), bflo(wq.y), bfhi(wq.y), bflo(wq.z), bfhi(wq.z), bflo(wq.w), bfhi(wq.w)};
            float kv[8] = {bflo(wk.x), bfhi(wk.x), bflo(wk.y), bfhi(wk.y), bflo(wk.z), bfhi(wk.z), bflo(wk.w), bfhi(wk.w)};
            float eb[8];
#pragma unroll
            for (int j = 0; j < 8; ++j) { eb[j] = BC[t * 128 + d0 + j]; qv[j] *= __expf(eb[j]); kv[j] *= __expf(-eb[j]); }
            u32x4 oq, ok; oq.x = cvt_pk_bf16(qv[0], qv[1]); oq.y = cvt_pk_bf16(qv[2], qv[3]); oq.z = cvt_pk_bf16(qv[4], qv[5]); oq.w = cvt_pk_bf16(qv[6], qv[7]);
            ok.x = cvt_pk_bf16(kv[0], kv[1]); ok.y = cvt_pk_bf16(kv[2], kv[3]); ok.z = cvt_pk_bf16(kv[4], kv[5]); ok.w = cvt_pk_bf16(kv[6], kv[7]);
            *(LAS u32x4*)(QT + t * 136 + d0) = oq; *(LAS u32x4*)(KT + t * 136 + d0) = ok; }
        gla_load_vt(VT, vw, tid);
        __syncthreads();
        {
            const int tm = w >> 1;
#pragma unroll
            for (int d = 0; d < 2; ++d) { const int sn = 2 * (w & 1) + d; f32x4 a = (f32x4){0.f, 0.f, 0.f, 0.f};
                if (sn <= tm) {
#pragma unroll
                    for (int kk = 0; kk < 4; ++kk) { const bf16x8 kf = *(const LAS bf16x8*)(KT + (16 * sn + l16) * 136 + kk * 32 + q * 8);
                        const bf16x8 qf = *(const LAS bf16x8*)(QT + (16 * tm + l16) * 136 + kk * 32 + q * 8);
                        a = __builtin_amdgcn_mfma_f32_16x16x32_bf16(kf, qf, a, 0, 0, 0); }
                }
                const int t = 16 * tm + l16, s0 = 16 * sn + 4 * q;
#pragma unroll
                for (int i = 0; i < 4; ++i) if (s0 + i > t) a[i] = 0.f;
                u32x2 o; o.x = cvt_pk_bf16(a[0], a[1]); o.y = cvt_pk_bf16(a[2], a[3]);
                *(LAS u32x2*)(ATT + t * 72 + s0) = o; }
        }
        __syncthreads();
        f32x4 acc[2][4];
#pragma unroll
        for (int d = 0; d < 2; ++d)
#pragma unroll
            for (int tm = 0; tm < 4; ++tm) acc[d][tm] = (f32x4){0.f, 0.f, 0.f, 0.f};
#pragma unroll
        for (int kk = 0; kk < 2; ++kk) {
            bf16x8 vf[2], af[4];
#pragma unroll
            for (int d = 0; d < 2; ++d) vf[d] = *(const LAS bf16x8*)(VT + (16 * (2 * w + d) + l16) * 72 + (((kk * 4 + q) ^ ((2 * (2 * w + d) + (l16 >> 3)) & 7)) << 3));
#pragma unroll
            for (int tm = 0; tm < 4; ++tm) af[tm] = *(const LAS bf16x8*)(ATT + (16 * tm + l16) * 72 + kk * 32 + q * 8);
#pragma unroll
            for (int d = 0; d < 2; ++d)
#pragma unroll
                for (int tm = 0; tm < 4; ++tm) acc[d][tm] = __builtin_amdgcn_mfma_f32_16x16x32_bf16(vf[d], af[tm], acc[d][tm], 0, 0, 0);
        }
#pragma unroll
        for (int kk = 0; kk < 4; ++kk) {
            bf16x8 sf[2], qf[4];
#pragma unroll
            for (int d = 0; d < 2; ++d) sf[d] = sfr[kk][d];
#pragma unroll
            for (int tm = 0; tm < 4; ++tm) qf[tm] = *(const LAS bf16x8*)(QT + (16 * tm + l16) * 136 + kk * 32 + q * 8);
#pragma unroll
            for (int d = 0; d < 2; ++d)
#pragma unroll
                for (int tm = 0; tm < 4; ++tm) acc[d][tm] = __builtin_amdgcn_mfma_f32_16x16x32_bf16(sf[d], qf[tm], acc[d][tm], 0, 0, 0);
        }
#pragma unroll
        for (int tm = 0; tm < 4; ++tm) { float ss = 0.f;
#pragma unroll
            for (int d = 0; d < 2; ++d) ss += (acc[d][tm][0] * acc[d][tm][0] + acc[d][tm][1] * acc[d][tm][1]) + (acc[d][tm][2] * acc[d][tm][2] + acc[d][tm][3] * acc[d][tm][3]);
            ss += __shfl_xor(ss, 16); ss += __shfl_xor(ss, 32);
            if (q == 0) PART[w * 64 + 16 * tm + l16] = ss; }
        __syncthreads();
#pragma unroll
        for (int tm = 0; tm < 4; ++tm) { float tot = 0.f;
#pragma unroll
            for (int ww = 0; ww < 8; ++ww) tot += PART[ww * 64 + 16 * tm + l16];
            const float rs = rsqrtf(tot * (1.0f / 256.0f) + EPS); const size_t tok = tok0 + 16 * tm + l16;
#pragma unroll
            for (int d = 0; d < 2; ++d) { const int dv0 = 16 * (2 * w + d) + 4 * q; const f32x4 g = *(const f32x4*)(gon + dv0);
                const u32x2 rr = rw[tm][d];
                u32x2 o; o.x = cvt_pk_bf16(acc[d][tm][0] * rs * g.x * siluf_(bflo(rr.x)), acc[d][tm][1] * rs * g.y * siluf_(bfhi(rr.x)));
                o.y = cvt_pk_bf16(acc[d][tm][2] * rs * g.z * siluf_(bflo(rr.y)), acc[d][tm][3] * rs * g.w * siluf_(bfhi(rr.y)));
                *(u32x2*)(Oo + tok * D + h * 256 + dv0) = o; } }
        __syncthreads();
    }
    LAS float* SQ = (LAS float*)lds; LAS float* SK = SQ + 512; LAS float* SE = SK + 512; LAS float* OS = SE + 512;   LAS float* WP = OS + 2048;
    for (int item = blockIdx.x; item < 512; item += gridDim.x) {
        const int b = item >> 2, h = item & 3; const size_t row0 = (size_t)MP + b * 4;
        { const int t = tid >> 7, dk = tid & 127; const bf16_t* r = QKV + (row0 + t) * NIN;
            SQ[tid] = bf2f(r[h * 128 + dk]); SK[tid] = bf2f(r[512 + h * 128 + dk]); SE[tid] = __expf(logf_gate(bf2f(r[3072 + h * 128 + dk]) + P.in[10][h * 128 + dk])); }
        __syncthreads();
        const int dv = tid & 255, half = tid >> 8;
        const float* s0 = P.in[2] + ((size_t)item * 128 + half * 64) * 256 + dv;
        float S[64];
#pragma unroll
        for (int i = 0; i < 64; ++i) S[i] = s0[i * 256];
        float vv[4];
#pragma unroll
        for (int t = 0; t < 4; ++t) vv[t] = bf2f(QKV[(row0 + t) * NIN + 1024 + h * 256 + dv]);
#pragma unroll
        for (int t = 0; t < 4; ++t) { float op = 0.f;
#pragma unroll
            for (int i = 0; i < 64; ++i) { const int dk = half * 64 + i; S[i] = SE[t * 128 + dk] * S[i] + SK[t * 128 + dk] * vv[t]; op += SQ[t * 128 + dk] * S[i]; }
            OS[(half * 4 + t) * 256 + dv] = op; }
        float* so = P.out + O_GS + ((size_t)item * 128 + half * 64) * 256 + dv;
#pragma unroll
        for (int i = 0; i < 64; ++i) so[i * 256] = S[i];
        __syncthreads();
        float o4[4];
#pragma unroll
        for (int t = 0; t < 4; ++t) { o4[t] = OS[t * 256 + dv] + OS[(4 + t) * 256 + dv]; const float s = wave_sum(o4[t] * o4[t]); if (tid < 256 && lane == 0) WP[w * 4 + t] = s; }
        __syncthreads();
        if (tid < 256) {
#pragma unroll
            for (int t = 0; t < 4; ++t) { const float tot = WP[t] + WP[4 + t] + WP[8 + t] + WP[12 + t]; const float rs = rsqrtf(tot * (1.0f / 256.0f) + EPS);
                const float r = bf2f(QKV[(row0 + t) * NIN + 2048 + h * 256 + dv]);
                Oo[(row0 + t) * D + h * 256 + dv] = f2bf(o4[t] * rs * gon[dv] * siluf_(r)); }
        }
        __syncthreads();
    }
}

__device__ __forceinline__ void s5_prefix_and_sample(const Params& P, LAS unsigned char* lds) {
    const int tid = otid(); const int lane = tid & 63, w = tid >> 6, gw = blockIdx.x * 8 + w, NGW = gridDim.x * 8;
    const float* sm = (const float*)(P.ws + WS_SMALL); const bf16_t* HL = (const bf16_t*)(P.ws + WS_HLOC); bf16_t* HS5 = (bf16_t*)(P.ws + WS_HS5);
    LAS float* TOT = (LAS float*)lds;
    for (int L = blockIdx.x; L < 256; L += gridDim.x) {
        int g, mt; { const int xcd = L & 7, idx = L >> 3, combo = xcd * 8 + (idx >> 2); g = (combo >> 2) * 4 + (idx & 3); mt = combo & 3; }
        const char* Aop = (const char*)(P.ws + WS_HS5) + (size_t)g * (1024 * 384 * 2) + (size_t)mt * (BM * 384 * 2);
        { OneUnit S1{{Aop, (const char*)(P.ws + WS_S5M) + (size_t)g * 262144, mt, g, 4, -1}}; EpiS5A E1{(bf16_t*)(P.ws + WS_HLOC)}; gemm_phase(lds, 384, 256, S1, E1); }
        asm volatile("s_waitcnt vmcnt(0)" ::: "memory"); __syncthreads();
        {
        const int seg = w & 3, b = 2 * mt + (w >> 2);
        const float ar = sm[SM_A16R + g * 64 + lane], ai = sm[SM_A16I + g * 64 + lane];
        const size_t col0 = (size_t)g * 1024 + b * 128 + seg * 32;
        float lr[32], li[32];
#pragma unroll
        for (int c = 0; c < 32; ++c) { lr[c] = bf2f(HL[(col0 + c) * 128 + lane]); li[c] = bf2f(HL[(col0 + c) * 128 + 64 + lane]); }
        float hr = 0.f, hi = 0.f;
#pragma unroll
        for (int c = 0; c < 32; ++c) { const float tr = lr[c], ti = li[c]; lr[c] = hr; li[c] = hi; const float nr = ar * hr - ai * hi + tr, ni = ar * hi + ai * hr + ti; hr = nr; hi = ni; }
        TOT[(w * 2 + 0) * 64 + lane] = hr; TOT[(w * 2 + 1) * 64 + lane] = hi;
        __syncthreads();
        float a32r = ar, a32i = ai;
#pragma unroll
        for (int k = 0; k < 5; ++k) { const float nr = a32r * a32r - a32i * a32i, ni = 2.f * a32r * a32i; a32r = nr; a32i = ni; }
        float cr = 0.f, ci = 0.f;
        for (int s = 0; s < seg; ++s) { const int ws_ = (w & 4) + s; const float tr = TOT[(ws_ * 2 + 0) * 64 + lane], ti = TOT[(ws_ * 2 + 1) * 64 + lane];
            const float nr = a32r * cr - a32i * ci + tr, ni = a32r * ci + a32i * cr + ti; cr = nr; ci = ni; }
        float pr_ = cr, pi_ = ci;
#pragma unroll
        for (int c = 0; c < 32; ++c) { HS5[(col0 + c) * 384 + 256 + lane] = f2bf(lr[c] + pr_); HS5[(col0 + c) * 384 + 320 + lane] = f2bf(li[c] + pi_);
            const float nr = ar * pr_ - ai * pi_, ni = ar * pi_ + ai * pr_; pr_ = nr; pi_ = ni; }
        if (seg == 3) { P.out[O_RP + (size_t)b * 4096 + g * 64 + lane] = hr + pr_; P.out[O_IP + (size_t)b * 4096 + g * 64 + lane] = hi + pi_; }
        }
        asm volatile("s_waitcnt vmcnt(0)" ::: "memory"); __syncthreads();
        { OneUnit S2{{Aop, (const char*)(P.ws + WS_S5M + 65536) + (size_t)g * 262144, mt, g, 6, -1}}; EpiS5B E2{P.ws, P.in[20]}; gemm_phase(lds, 384, 384, S2, E2); }
        __syncthreads();
    }
    const bf16_t* HSMP = (const bf16_t*)(P.ws + WS_HSMP); bf16_t* Z = (bf16_t*)(P.ws + WS_Z);
    LAS float* cb_ = (LAS float*)(lds + 4096 + w * 10752);
    LAS float* hb = cb_ + 2 * 16 * 68;
    for (int wv = gw; wv < 64 * 32; wv += NGW) {
        const int g = wv & 63, b0 = (wv >> 6) * 4, p = lane;
        const float ar = sm[SM_ARE + g * 64 + p], ai = sm[SM_AIM + g * 64 + p], fr = sm[SM_FRE + g * 64 + p], fi = sm[SM_FIM + g * 64 + p];
        f32x4 brv[4], biv[4], crv[4], civ[4];
#pragma unroll
        for (int c4 = 0; c4 < 4; ++c4) { brv[c4] = *(const f32x4*)(P.in[16] + ((size_t)g * 64 + p) * 16 + 4 * c4); biv[c4] = *(const f32x4*)(P.in[17] + ((size_t)g * 64 + p) * 16 + 4 * c4);
            crv[c4] = *(const f32x4*)(P.in[18] + (size_t)g * 1024 + (lane + 64 * c4) * 4); civ[c4] = *(const f32x4*)(P.in[19] + (size_t)g * 1024 + (lane + 64 * c4) * 4); }
        const int t = lane >> 4, cp = lane & 15; const float dsk = P.in[20][g * 16 + cp];
        float bbr[16], bbi[16];
#pragma unroll
        for (int c4 = 0; c4 < 4; ++c4) {
#pragma unroll
            for (int j = 0; j < 4; ++j) { bbr[4 * c4 + j] = fr * brv[c4][j] - fi * biv[c4][j]; bbi[4 * c4 + j] = fr * biv[c4][j] + fi * brv[c4][j]; }
            const int f = lane + 64 * c4, row = f >> 4, col = (f & 15) * 4;
            *(LAS f32x4*)(cb_ + row * 68 + col) = crv[c4]; *(LAS f32x4*)(cb_ + 16 * 68 + row * 68 + col) = civ[c4]; }
#pragma unroll 1
        for (int bb = 0; bb < 4; ++bb) { const int b = b0 + bb;
            u32x4 ua[4], ub[4];
#pragma unroll
            for (int tt = 0; tt < 4; ++tt) { ua[tt] = *(const u32x4*)(HSMP + (size_t)(b * 4 + tt) * D + g * 16); ub[tt] = *(const u32x4*)(HSMP + (size_t)(b * 4 + tt) * D + g * 16 + 8); }
            float hr = P.in[3][(size_t)b * 4096 + g * 64 + p], hi = P.in[4][(size_t)b * 4096 + g * 64 + p];
            const size_t row = (size_t)b * 4 + t; const float uu = bf2f(HSMP[row * D + g * 16 + cp]);
#pragma unroll
            for (int tt = 0; tt < 4; ++tt) { const u32x4 u0 = ua[tt], u1 = ub[tt];
                const float u[16] = {bflo(u0.x), bfhi(u0.x), bflo(u0.y), bfhi(u0.y), bflo(u0.z), bfhi(u0.z), bflo(u0.w), bfhi(u0.w),
                                     bflo(u1.x), bfhi(u1.x), bflo(u1.y), bfhi(u1.y), bflo(u1.z), bfhi(u1.z), bflo(u1.w), bfhi(u1.w)};
                float br = 0.f, bi = 0.f;
#pragma unroll
                for (int c = 0; c < 16; ++c) { br += bbr[c] * u[c]; bi += bbi[c] * u[c]; }
                const float nr = ar * hr - ai * hi + br, ni = ar * hi + ai * hr + bi; hr = nr; hi = ni;
                hb[(tt * 2 + 0) * 64 + p] = hr; hb[(tt * 2 + 1) * 64 + p] = hi; }
            P.out[O_RS + (size_t)b * 4096 + g * 64 + p] = hr; P.out[O_IS + (size_t)b * 4096 + g * 64 + p] = hi;
            asm volatile("s_waitcnt lgkmcnt(0)" ::: "memory");
            float y = 0.f;
#pragma unroll
            for (int i = 0; i < 16; ++i) { const f32x4 c4r = *(const LAS f32x4*)(cb_ + cp * 68 + 4 * i), c4i = *(const LAS f32x4*)(cb_ + 16 * 68 + cp * 68 + 4 * i);
                const f32x4 h4r = *(const LAS f32x4*)(hb + (t * 2 + 0) * 64 + 4 * i), h4i = *(const LAS f32x4*)(hb + (t * 2 + 1) * 64 + 4 * i);
                y += (c4r.x * h4r.x - c4i.x * h4i.x) + (c4r.y * h4r.y - c4i.y * h4i.y) + (c4r.z * h4r.z - c4i.z * h4i.z) + (c4r.w * h4r.w - c4i.w * h4i.w); }
            Z[((size_t)MP + row) * D + g * 16 + cp] = f2bf(y + dsk * uu);
            asm volatile("s_waitcnt lgkmcnt(0)" ::: "memory");
        }
    }
}

#define XB_TMO      128
#define XB_XCNT(j)  (256  + 64 * (j))
#define XB_XSUB(j)  (1280 + 64 * (j))
#define XB_XGEN(j)  (2304 + 64 * (j))
#define XB_TOP      3328
#define XB_TOPGEN   3392
#define XCD_BAR_WORDS 3456
#define XB_SPIN_CAP (1u << 22)
__device__ __forceinline__ unsigned xb_ld(unsigned* p)              { return __hip_atomic_load(p, __ATOMIC_RELAXED, __HIP_MEMORY_SCOPE_AGENT); }
__device__ __forceinline__ unsigned xb_add(unsigned* p, unsigned v) { return __hip_atomic_fetch_add(p, v, __ATOMIC_RELAXED, __HIP_MEMORY_SCOPE_AGENT); }
__device__ __forceinline__ unsigned xb_xcc_id() { return (unsigned)__builtin_amdgcn_s_getreg((3 << 11) | 20) & 0xFu; }
#define XB_SPIN(cond, bar) do { unsigned _sp = 0; while (cond) { __builtin_amdgcn_s_sleep(1); \
    if ((++_sp & 255u) == 0u) { if (xb_ld(&(bar)[XB_TMO])) break; if (_sp > XB_SPIN_CAP) { atomicAdd(&(bar)[XB_TMO], 1u); break; } } } } while (0)
struct XcdBarrier { unsigned* bar; unsigned x; volatile LAS unsigned* st; };
__device__ __forceinline__ XcdBarrier xcd_barrier_post(unsigned* bar, volatile LAS unsigned* st) {
    XcdBarrier b; b.bar = bar; b.x = xb_xcc_id(); b.st = st;
    if (threadIdx.x == 0) (void)xb_add(&bar[XB_XCNT(b.x)], 1u);
    return b;
}
__device__ __forceinline__ void xcd_barrier_complete(unsigned* bar, unsigned x, unsigned& nloc, unsigned& nx) {
    const unsigned G = gridDim.x * gridDim.y * gridDim.z;
    unsigned sum, cnt, mine, sp = 0u;
    for (;;) {
        sum = 0u; cnt = 0u; mine = 0u;
#pragma unroll
        for (unsigned j = 0; j < 16; ++j) { const unsigned c = xb_ld(&bar[XB_XCNT(j)]); sum += c; cnt += (c > 0u) ? 1u : 0u; mine = (j == x) ? c : mine; }
        if (sum == G) break;
        __builtin_amdgcn_s_sleep(1);
        if ((++sp & 255u) == 0u) { if (xb_ld(&bar[XB_TMO])) break; if (sp > XB_SPIN_CAP) { atomicAdd(&bar[XB_TMO], 1u); break; } }
    }
    nloc = mine > 0u ? mine : 1u; nx = cnt > 0u ? cnt : 1u;
}
__device__ __forceinline__ void xcd_barrier(const XcdBarrier& b) {
    asm volatile("s_waitcnt vmcnt(0)" ::: "memory");
    __syncthreads();
    if (threadIdx.x == 0) {
        unsigned* bar = b.bar;
        __builtin_amdgcn_s_waitcnt(0);
        unsigned nloc = b.st[0], nx = b.st[1];
        if (nloc == 0u) { xcd_barrier_complete(bar, b.x, nloc, nx); b.st[0] = nloc; b.st[1] = nx; }
        const unsigned old = xb_add(&bar[XB_XSUB(b.x)], 1u);
        const unsigned gen = old / nloc;
        if (old + 1u == (gen + 1u) * nloc) {
            __builtin_amdgcn_fence(__ATOMIC_RELEASE, "agent");
            asm volatile("s_waitcnt vmcnt(0)" ::: "memory");
            const unsigned og = xb_add(&bar[XB_TOP], 1u);
            const unsigned tg = og / nx;
            if (og + 1u == (tg + 1u) * nx) xb_add(&bar[XB_TOPGEN], 1u);
            else XB_SPIN(xb_ld(&bar[XB_TOPGEN]) == tg, bar);
            __builtin_amdgcn_fence(__ATOMIC_ACQUIRE, "agent");
            xb_add(&bar[XB_XGEN(b.x)], 1u);
            asm volatile("s_waitcnt vmcnt(0)" ::: "memory");
        } else {
            XB_SPIN(xb_ld(&bar[XB_XGEN(b.x)]) == gen, bar);
            __builtin_amdgcn_fence(__ATOMIC_ACQUIRE, "agent");
            asm volatile("s_waitcnt vmcnt(0)" ::: "memory");
        }
    }
    __syncthreads();
}

__global__ void __launch_bounds__(512, 2) fwd_kernel(Params P) {
    extern __shared__ __attribute__((aligned(16))) unsigned char lds_raw[];
    LAS unsigned char* lds = (LAS unsigned char*)lds_raw;
    cg::grid_group grid = cg::this_grid();
    const int lo = P.ph_lo, hi = P.ph_hi; int ph = 0;
    const int G = gridDim.x, cb = blockIdx.x;
    unsigned char* ws = P.ws;
    bf16_t* XB = (bf16_t*)(ws + WS_H); bf16_t* ACT = (bf16_t*)(ws + WS_ACT); bf16_t* Y = (bf16_t*)(ws + WS_Y);
    float* R2 = (float*)(ws + WS_SMALL) + SM_R2;
    unsigned long long pr_acc = 0ull, pr_t0 = 0ull;
#define PH_BEGIN if (PROBE_MASK) pr_t0 = __builtin_amdgcn_s_memrealtime(); if (lo <= ph && ph < hi) {
#define PH_END } ++ph; if (lo < ph && ph < hi) xcd_barrier(xbar); \
    if (PROBE_MASK && ((PROBE_MASK >> (ph - 1)) & 1u)) pr_acc += __builtin_amdgcn_s_memrealtime() - pr_t0;
    volatile LAS unsigned* xst = (volatile LAS unsigned*)(lds + LDS_BYTES - 64);
    if (threadIdx.x < 2) xst[threadIdx.x] = 0u;
    __syncthreads();
    if (ws == nullptr) grid.sync();
    XcdBarrier xbar; xbar.bar = (unsigned*)ws; xbar.x = 0; xbar.st = xst;
    if (hi - lo > 1) xbar = xcd_barrier_post((unsigned*)ws, xst);

    PH_BEGIN phase0(P, lds); PH_END

#define MIXER_GLA \
    PH_BEGIN { TileOrder S{M / BM, NIN / BM, (M / BM) * (NIN / BM), G, cb, (const char*)XB, (const char*)(ws + WS_WIN), (size_t)BM * D * 2, (size_t)BM * D * 2, D / BK}; \
        EpiPlain<1> E{(bf16_t*)(ws + WS_QKV), NIN, P.in[10], nullptr, R2}; gemm_phase(lds, D, D, S, E); } s5_idle_prep_inproj(P, lds); PH_END \
    PH_BEGIN gla_phase_a(P, lds); PH_END \
    PH_BEGIN gla_phase_b(P); PH_END \
    PH_BEGIN gla_phase_c(P, lds); PH_END \
    PH_BEGIN { SplitOrder S{{MP / BM, D / BM, (MP / BM) * (D / BM), G, cb, (const char*)(ws + WS_O), (const char*)(ws + WS_WOUT), (size_t)BM * D * 2, (size_t)BM * D * 2, D / BK}, D / 256}; \
        EpiPlain<0> E{Y, D, nullptr, PART, nullptr}; gemm_phase(lds, D, D, S, E); } PH_END
#define MIXER_S5 \
    PH_BEGIN s5_prefix_and_sample(P, lds); PH_END \
    PH_BEGIN { SplitOrder S{{MP / BM, 2 * D / BM, (MP / BM) * (2 * D / BM), G, cb, (const char*)(ws + WS_Z), (const char*)(ws + WS_WGLU), (size_t)BM * D * 2, (size_t)BM * D * 2, D / BK}, D / 256}; \
        EpiGated<1> E{Y, D, P.in[22], (float*)(ws + WS_HLOC)}; gemm_phase(lds, D, D, S, E); } PH_END
#define FFN_GEMMS(l, f, HOOK) \
    PH_BEGIN { TileOrder S{M / BM, NGU / BM, (M / BM) * (NGU / BM), G, cb, (const char*)XB, (const char*)(ws + WS_WGU + (size_t)((l) * 2 + (f)) * NGU * D * 2), (size_t)BM * D * 2, (size_t)BM * D * 2, D / BK}; \
        EpiGated<0> E{ACT, FF, nullptr, nullptr}; gemm_phase(lds, D, D, S, E); } HOOK PH_END \
    PH_BEGIN { SplitOrder S{{MP / BM, D / BM, (MP / BM) * (D / BM), G, cb, (const char*)ACT, (const char*)(ws + WS_WDN + (size_t)((l) * 2 + (f)) * D * FF * 2), (size_t)BM * FF * 2, (size_t)BM * FF * 2, FF / BK}, FF / 256}; \
        EpiPlain<0> E{Y, D, nullptr, PART, nullptr}; gemm_phase(lds, FF, FF, S, E); } PH_END
    const float* ng0 = P.in[5]; const float* ng1 = P.in[5] + 6 * D;
    float* PART = (float*)(ws + WS_PART);
    FFN_GEMMS(0, 0, s5_idle_prep(P, lds, 0);)
    PH_BEGIN row_pass<3, FF / 256>(P.in[0], P.in[1], XB, R2, Y, ng0 + 1 * D, 0.5f, PART, nullptr, nullptr, nullptr, nullptr); PH_END
    MIXER_GLA
    PH_BEGIN row_pass<3, D / 256>(nullptr, nullptr, XB, R2, Y, ng0 + 3 * D, 1.0f, PART, nullptr, nullptr, nullptr, nullptr); PH_END
    FFN_GEMMS(0, 1, s5_idle_prep(P, lds, 1);)
    PH_BEGIN row_pass<3, FF / 256>(nullptr, nullptr, XB, R2, Y, ng0 + 5 * D, 0.5f, PART, nullptr, nullptr, nullptr, nullptr); PH_END
    FFN_GEMMS(1, 0, s5_idle_prep(P, lds, 2);)
    PH_BEGIN row_pass<3, FF / 256>(nullptr, nullptr, XB, R2, Y, ng1 + 1 * D, 0.5f, PART, nullptr, ng1 + 2 * D, (bf16_t*)(ws + WS_HS5), (bf16_t*)(ws + WS_HSMP)); PH_END
    MIXER_S5
    PH_BEGIN row_pass<3, D / 256>(nullptr, nullptr, XB, R2, Y, ng1 + 3 * D, 1.0f, (const float*)(ws + WS_HLOC), nullptr, nullptr, nullptr, nullptr, P.in[22]); PH_END
    FFN_GEMMS(1, 1, )
    PH_BEGIN row_pass<2, FF / 256>(nullptr, nullptr, XB, R2, Y, ng1 + 5 * D, 0.5f, PART, P.out + O_X, nullptr, nullptr, nullptr); PH_END
    if (PROBE_MASK && blockIdx.x == 0 && threadIdx.x == 0) { const unsigned long long t1 = __builtin_amdgcn_s_memrealtime(); while (__builtin_amdgcn_s_memrealtime() - t1 < pr_acc) __builtin_amdgcn_s_sleep(8); }
#undef PH_BEGIN
#undef PH_END
}

__global__ void dbg_checksum(const unsigned* w, size_t nwords, float* out, size_t nout) {
    for (size_t i = (size_t)blockIdx.x * blockDim.x + threadIdx.x; i < nout; i += (size_t)gridDim.x * blockDim.x) {
        unsigned h = 0; for (int j = 0; j < 3; ++j) { const size_t k = 3 * i + j; if (k < nwords) h = h * 0x9E3779B1u + w[k]; }
        out[i] = (float)(h & 0xffffu);
    }
}
extern "C" void kernel_launch(void* const* d_in, const int* in_sizes, int n_in, void* d_out, int out_size, void* d_ws, size_t ws_size, hipStream_t stream) {
    static int grid = 0;
    if (grid == 0) {
        if (n_in != 23 || ws_size < WS_END) { fprintf(stderr, "kernel_launch: unexpected n_in %d or ws_size %zu (< %zu)\n", n_in, ws_size, (size_t)WS_END); grid = -1; return; }
        int dev = 0, cus = 0, per_cu = 0;
        hipGetDevice(&dev); hipDeviceGetAttribute(&cus, hipDeviceAttributeMultiprocessorCount, dev);
        if (hipFuncSetAttribute((const void*)fwd_kernel, hipFuncAttributeMaxDynamicSharedMemorySize, LDS_BYTES) != hipSuccess) { fprintf(stderr, "kernel_launch: hipFuncSetAttribute failed\n"); grid = -1; return; }
        if (hipOccupancyMaxActiveBlocksPerMultiprocessor(&per_cu, (const void*)fwd_kernel, 512, LDS_BYTES) != hipSuccess || per_cu < 1) { fprintf(stderr, "kernel_launch: occupancy query failed (%d)\n", per_cu); grid = -1; return; }
        grid = cus * per_cu;
    }
    if (grid < 0) return;
    if (hipMemsetAsync(d_ws, 0, 16384, stream) != hipSuccess) { fprintf(stderr, "kernel_launch: memset failed\n"); return; }
    Params p{};
    for (int i = 0; i < 23; ++i) p.in[i] = (const float*)d_in[i];
    p.out = (float*)d_out; p.ws = (unsigned char*)d_ws;
#if MULTI_LAUNCH
    for (int k = 0; k < (DBG_NPH ? DBG_NPH : NPH); ++k) { p.ph_lo = k; p.ph_hi = k + 1; hipLaunchKernelGGL(fwd_kernel, dim3(grid), dim3(512), LDS_BYTES, stream, p); }
#if DBG_NPH
    hipLaunchKernelGGL(dbg_checksum, dim3(2048), dim3(256), 0, stream, (const unsigned*)d_ws, (size_t)(WS_END / 4), (float*)d_out, (size_t)out_size);
#endif
#else
    p.ph_lo = 0; p.ph_hi = NPH;
    void* args[] = {&p};
    hipError_t e = hipLaunchCooperativeKernel((const void*)fwd_kernel, dim3(grid), dim3(512), args, LDS_BYTES, stream);
    if (e != hipSuccess) fprintf(stderr, "cooperative launch failed: %s (grid %d)\n", hipGetErrorString(e), grid);
#endif
}
```

```cpp
#include <hip/hip_runtime.h>
#include <hip/hip_cooperative_groups.h>
#include <cstdio>
namespace cg = cooperative_groups;

#ifndef MULTI_LAUNCH
#define MULTI_LAUNCH 0
#endif

#ifndef PROBE_MASK
#define PROBE_MASK 0u
#endif
#ifndef DBG_NPH
#define DBG_NPH 0
#endif
#define LAS __attribute__((address_space(3)))
typedef unsigned short bf16_t;
typedef short bf16x8 __attribute__((ext_vector_type(8)));
typedef float f32x4 __attribute__((ext_vector_type(4)));
typedef unsigned u32x4 __attribute__((ext_vector_type(4)));
typedef unsigned u32x2 __attribute__((ext_vector_type(2)));

constexpr int D = 1024, FF = 2816, NGU = 5632, MP = 16384, MS = 512, M = MP + MS;
constexpr int NIN = 3584;
constexpr int LDIN = 3088;
constexpr float EPS = 1e-6f;
constexpr int NPH = 22;

constexpr size_t O_X = 0, O_GP = 17301504, O_RP = 18350080, O_IP = 18382848, O_GS = 18415616, O_RS = 35192832, O_IS = 35717120;

constexpr size_t MiB = 1u << 20;
constexpr size_t WS_WGU = 1 * MiB;
constexpr size_t WS_WDN = WS_WGU + 44 * MiB;
constexpr size_t WS_WIN = WS_WDN + 22 * MiB;
constexpr size_t WS_WOUT = WS_WIN + 7 * MiB;
constexpr size_t WS_WGLU = WS_WOUT + 2 * MiB;
constexpr size_t WS_S5M = WS_WGLU + 4 * MiB;
constexpr size_t WS_SMALL = WS_S5M + 16 * MiB;
constexpr size_t WS_HSMP = WS_SMALL + 1 * MiB;
constexpr size_t WS_H = WS_SMALL + 2 * MiB;
constexpr size_t WS_BIG = WS_H + 33 * MiB;
constexpr size_t WS_ACT = WS_BIG;
constexpr size_t WS_Y = WS_BIG + 92 * MiB;
constexpr size_t WS_QKV = WS_BIG;
constexpr size_t WS_KC = WS_BIG + 116 * MiB;
constexpr size_t WS_BEND = WS_BIG + 180 * MiB;
constexpr size_t WS_HS5 = WS_BIG;
constexpr size_t WS_HLOC = WS_BIG + 48 * MiB;
constexpr size_t WS_Z = WS_BIG + 128 * MiB;
constexpr size_t WS_PART = WS_BIG + 128 * MiB;
constexpr size_t WS_O = WS_BIG + 181 * MiB;
constexpr size_t WS_END = WS_BIG + 214 * MiB;
constexpr size_t S5M_G = 262144;
constexpr int SM_R2 = 32768;
constexpr int SM_ARE = 0, SM_AIM = 4096, SM_FRE = 8192, SM_FIM = 12288, SM_A16R = 16384, SM_A16I = 20480;

constexpr int LDS_BYTES = 147456;

typedef __bf16 bf16x2_t __attribute__((ext_vector_type(2)));
typedef float f32x2_t __attribute__((ext_vector_type(2)));
__device__ __forceinline__ unsigned cvt_pk_bf16(float lo, float hi) { const f32x2_t v = {lo, hi}; const bf16x2_t b = __builtin_convertvector(v, bf16x2_t); return __builtin_bit_cast(unsigned, b); }
__device__ __forceinline__ float bflo(unsigned w) { return __uint_as_float(w << 16); }
__device__ __forceinline__ float bfhi(unsigned w) { return __uint_as_float(w & 0xffff0000u); }
__device__ __forceinline__ float bf2f(bf16_t b) { return __uint_as_float(((unsigned)b) << 16); }
__device__ __forceinline__ bf16_t f2bf(float f) { return (bf16_t)(cvt_pk_bf16(f, 0.f) & 0xffffu); }
__device__ __forceinline__ float wave_sum(float v) {
#pragma unroll
    for (int o = 1; o < 64; o <<= 1) v += __shfl_xor(v, o);
    return v;
}
__device__ __forceinline__ int otid() { int t = threadIdx.x; asm volatile("" : "+v"(t)); return t; }
__device__ __forceinline__ float sigmoidf_(float a) { return __builtin_amdgcn_rcpf(1.0f + __expf(-a)); }
__device__ __forceinline__ float siluf_(float a) { return a * sigmoidf_(a); }
__device__ __forceinline__ float logf_gate(float z) { return (fminf(z, 0.f) - __logf(1.0f + __expf(-fabsf(z)))) * 0.0625f; }

constexpr int BM = 256, BK = 64, HALF = 128, HTB = HALF * BK * 2;
__device__ __forceinline__ int lds_byte(int r, int c) { const int st = (r >> 4) * 2 + (c >> 5), rr = r & 15, cc = c & 31, ob = rr * 64 + cc * 2; return st * 1024 + (ob ^ (((ob >> 9) & 1) << 5)); }
__device__ __forceinline__ void stage_rc(int b, int& R, int& C) { const int st = b / 1024, sb = b % 1024, swz = sb ^ (((sb >> 9) & 1) << 5); R = (st >> 1) * 16 + swz / 64; C = (st & 1) * 32 + (swz % 64) / 2; }
__device__ __forceinline__ int perm32(int rho) { const int n = rho >> 4, i = rho & 15; return 8 * (i >> 2) + 4 * n + (i & 3); }

struct Unit { const char* A; const char* B; int pm, pn, nt, ks; };

struct TileOrder {
    int nM, nN, nwg, G, c; const char* A0; const char* B0; size_t at, bt; int ntk;
    __device__ __forceinline__ bool next(int i, Unit& u) const {
        const long L = (long)i * G + c; if (L >= nwg) return false;
        u.nt = ntk; u.ks = -1;
        int wgid = (int)L; { const int q = nwg / 8, r = nwg % 8, xcd = wgid % 8, off = wgid / 8; wgid = (xcd < r ? xcd * (q + 1) : r * (q + 1) + (xcd - r) * q) + off; }
        const int nig = 8 * nN, gid = wgid / nig, fm = gid * 8, gsz = (nM - fm) < 8 ? (nM - fm) : 8;
        u.pm = fm + ((wgid % nig) % gsz); u.pn = (wgid % nig) / gsz;
        u.A = A0 + (size_t)u.pm * at; u.B = B0 + (size_t)u.pn * bt; return true;
    }
};
struct SplitOrder {
    TileOrder T; int nks;
    __device__ __forceinline__ bool next(int i, Unit& u) const {
        const int L = i * T.G + T.c;
        if (L < T.nwg) return T.next(i, u);
        const int j = L - T.nwg, ns = 2 * T.nN; if (j >= ns * nks) return false;
        const int st = j % ns, ks = j / ns; u.pm = 64 + st / T.nN; u.pn = st % T.nN; u.nt = 4; u.ks = ks;
        u.A = T.A0 + (size_t)u.pm * T.at + (size_t)ks * 512; u.B = T.B0 + (size_t)u.pn * T.bt + (size_t)ks * 512; return true;
    }
};
struct OneUnit { Unit u; __device__ __forceinline__ bool next(int i, Unit& o) const { if (i) return false; o = u; return true; } };
struct S5Order {
    int G, c; const char* A0; const char* B0; int ntk;
    __device__ __forceinline__ bool next(int i, Unit& u) const {
        const int L = i * G + c; if (L >= 256) return false;
        u.nt = ntk; u.ks = -1;
        { const int xcd = L & 7, idx = L >> 3, combo = xcd * 8 + (idx >> 2); u.pn = (combo >> 2) * 4 + (idx & 3); u.pm = combo & 3; }
        u.A = A0 + (size_t)u.pn * (1024 * 384 * 2) + (size_t)u.pm * (BM * 384 * 2); u.B = B0 + (size_t)u.pn * 262144; return true;
    }
};

template <class Epi, class Sched>
__device__ __forceinline__ void gemm_phase(LAS unsigned char* lds, const int lda, const int ldb, const Sched& S, const Epi& E) {
    int tid_ = threadIdx.x; asm volatile("" : "+v"(tid_));
    const int tid = tid_, wid = __builtin_amdgcn_readfirstlane(tid >> 6), lane = tid & 63, wr = wid >> 2, wc = wid & 3, fr = lane & 15, fq = lane >> 4;
    unsigned voffA[2], voffB[2];
#pragma unroll
    for (int i = 0; i < 2; ++i) { int R, C; stage_rc(tid * 16 + i * 8192, R, C); const int Rb = (R & ~31) + perm32(R & 31);
        voffA[i] = (unsigned)(R * lda + C) * 2u; voffB[i] = (unsigned)(Rb * ldb + C) * 2u; }
    const size_t kstep = (size_t)(BK * 2);
    const size_t hstepA = (size_t)HALF * lda * 2, hstepB = (size_t)HALF * ldb * 2;
    const unsigned ldsw = (unsigned)wid * 1024u;
    const int aoff = lds_byte(wr * 64 + fr, fq * 8), boff = lds_byte(wc * 32 + fr, fq * 8);
#define PG8_SA(b, h) (((b) * 2 + (h)) * HTB)
#define PG8_SB(b, h) ((4 + (b) * 2 + (h)) * HTB)
#define PG8_STAGE(bufoff, gbase, voff) do { _Pragma("unroll") for (int _i = 0; _i < 2; ++_i) \
        __builtin_amdgcn_global_load_lds((const unsigned*)((const char*)(gbase) + (voff)[_i]), (LAS unsigned*)(lds + (bufoff) + ldsw + _i * 8192), 16, 0, 0); } while (0)
#define PG8_LDA(dst, b, h) do { _Pragma("unroll") for (int m = 0; m < 4; ++m) _Pragma("unroll") for (int k = 0; k < 2; ++k) dst[m][k] = *(const LAS bf16x8*)(lds + PG8_SA(b, h) + aoff + m * 2048 + k * 1024); } while (0)
#define PG8_LDB(dst, b, h) do { _Pragma("unroll") for (int n = 0; n < 2; ++n) _Pragma("unroll") for (int k = 0; k < 2; ++k) dst[n][k] = *(const LAS bf16x8*)(lds + PG8_SB(b, h) + boff + n * 2048 + k * 1024); } while (0)
#define PG8_MMA(ai, bj, At, Bt) do { __builtin_amdgcn_s_setprio(1); _Pragma("unroll") for (int m = 0; m < 4; ++m) _Pragma("unroll") for (int n = 0; n < 2; ++n) _Pragma("unroll") for (int k = 0; k < 2; ++k) \
        acc[ai][bj][m][n] = __builtin_amdgcn_mfma_f32_16x16x32_bf16(Bt[n][k], At[m][k], acc[ai][bj][m][n], 0, 0, 0); __builtin_amdgcn_s_setprio(0); } while (0)
#define PG8_WAIT_V(n) asm volatile("s_waitcnt vmcnt(" #n ")" ::: "memory")
#define PG8_WAIT_L(n) asm volatile("s_waitcnt lgkmcnt(" #n ")" ::: "memory")
#define PG8_BAR __builtin_amdgcn_s_barrier()
#define PG8_SCHED __builtin_amdgcn_sched_barrier(0)
    Unit cur, nxt; int ui = 0;
    if (!S.next(0, cur)) return;
    f32x4 acc[2][2][4][2];
#pragma unroll
    for (int a = 0; a < 2; ++a)
#pragma unroll
        for (int b = 0; b < 2; ++b)
#pragma unroll
            for (int m = 0; m < 4; ++m)
#pragma unroll
                for (int n = 0; n < 2; ++n) acc[a][b][m][n] = (f32x4){0.f, 0.f, 0.f, 0.f};
    bf16x8 At[4][2], B0[2][2], B1[2][2];
    const char* cA = cur.A; const char* cB = cur.B;
    PG8_STAGE(PG8_SB(0, 0), cB, voffB); PG8_STAGE(PG8_SA(0, 0), cA, voffA); PG8_STAGE(PG8_SB(0, 1), cB + hstepB, voffB); PG8_STAGE(PG8_SA(0, 1), cA + hstepA, voffA);
    if (wr == 1) PG8_BAR;
    PG8_WAIT_V(4); PG8_BAR;
    PG8_STAGE(PG8_SB(1, 0), cB + kstep, voffB); PG8_STAGE(PG8_SA(1, 0), cA + kstep, voffA); PG8_STAGE(PG8_SB(1, 1), cB + hstepB + kstep, voffB);
    PG8_WAIT_V(6); PG8_BAR;
    for (;;) {
        const bool has_next = S.next(ui + 1, nxt);
        const char* nA = has_next ? nxt.A : cA; const char* nB = has_next ? nxt.B : cB;
        const int nt = cur.nt;
        for (int t = 0; t < nt; t += 2) {
            const bool last = (t == nt - 2);
            const char* a1 = cA + (size_t)(t + 1) * kstep;
            const char* a2 = last ? nA : cA + (size_t)(t + 2) * kstep; const char* b2 = last ? nB : cB + (size_t)(t + 2) * kstep;
            const char* a3 = a2 + kstep; const char* b3 = b2 + kstep;
            PG8_LDB(B0, 0, 0); PG8_SCHED; PG8_LDA(At, 0, 0); PG8_STAGE(PG8_SA(1, 1), a1 + hstepA, voffA);
            PG8_WAIT_L(8); PG8_BAR; PG8_WAIT_L(0); PG8_MMA(0, 0, At, B0); PG8_BAR; PG8_SCHED;
            PG8_LDB(B1, 0, 1); PG8_STAGE(PG8_SB(0, 0), b2, voffB);
            PG8_BAR; PG8_WAIT_L(0); PG8_MMA(0, 1, At, B1); PG8_BAR;
            PG8_LDA(At, 0, 1); PG8_STAGE(PG8_SA(0, 0), a2, voffA);
            PG8_BAR; PG8_WAIT_L(0); PG8_MMA(1, 0, At, B0); PG8_BAR; PG8_SCHED;
            PG8_STAGE(PG8_SB(0, 1), b2 + hstepB, voffB);
            PG8_WAIT_V(6); PG8_BAR; PG8_MMA(1, 1, At, B1); PG8_BAR;
            PG8_LDB(B0, 1, 0); PG8_SCHED; PG8_LDA(At, 1, 0); PG8_STAGE(PG8_SA(0, 1), a2 + hstepA, voffA);
            PG8_WAIT_L(8); PG8_BAR; PG8_WAIT_L(0); PG8_MMA(0, 0, At, B0); PG8_BAR; PG8_SCHED;
            PG8_LDB(B1, 1, 1); PG8_STAGE(PG8_SB(1, 0), b3, voffB);
            PG8_BAR; PG8_WAIT_L(0); PG8_MMA(0, 1, At, B1); PG8_BAR;
            PG8_LDA(At, 1, 1); PG8_STAGE(PG8_SA(1, 0), a3, voffA);
            PG8_BAR; PG8_WAIT_L(0); PG8_MMA(1, 0, At, B0); PG8_BAR; PG8_SCHED;
            PG8_STAGE(PG8_SB(1, 1), b3 + hstepB, voffB);
            PG8_WAIT_V(6); PG8_BAR; PG8_MMA(1, 1, At, B1); PG8_BAR;
        }
        E(acc, cur, wr, wc, fr, fq);
        if (!has_next) break;
#pragma unroll
        for (int a = 0; a < 2; ++a)
#pragma unroll
            for (int b = 0; b < 2; ++b)
#pragma unroll
                for (int m = 0; m < 4; ++m)
#pragma unroll
                    for (int n = 0; n < 2; ++n) acc[a][b][m][n] = (f32x4){0.f, 0.f, 0.f, 0.f};
        cur = nxt; cA = nA; cB = nB; ++ui;
    }
    PG8_WAIT_V(0);
    if (wr == 0) PG8_BAR;
    PG8_BAR;
#undef PG8_SA
#undef PG8_SB
#undef PG8_STAGE
#undef PG8_LDA
#undef PG8_LDB
#undef PG8_MMA
#undef PG8_WAIT_V
#undef PG8_WAIT_L
#undef PG8_BAR
#undef PG8_SCHED
}

template <int MODE>
struct EpiGated {
    bf16_t* O; int ldc; const float* bias; float* part;
    __device__ __forceinline__ void operator()(const f32x4 (&acc)[2][2][4][2], const Unit& u, int wr, int wc, int fr, int fq) const {
        const int row0 = u.pm * BM + wr * 64 + fr, col0 = u.pn * 128 + wc * 32 + 8 * fq;
        if (MODE == 1 && u.ks >= 0) {
#pragma unroll
            for (int bj = 0; bj < 2; ++bj)
#pragma unroll
                for (int ai = 0; ai < 2; ++ai)
#pragma unroll
                    for (int m = 0; m < 4; ++m) { float* p = part + ((size_t)u.ks * MS + (row0 + ai * HALF + m * 16 - MP)) * (2 * ldc) + u.pn * BM + bj * HALF + wc * 32 + 8 * fq;
                        *(f32x4*)p = acc[ai][bj][m][0]; *(f32x4*)(p + 4) = acc[ai][bj][m][1]; }
            return;
        }
        f32x4 b0[2], b1[2];
#pragma unroll
        for (int n = 0; n < 2; ++n) { b0[n] = (f32x4){0.f, 0.f, 0.f, 0.f}; b1[n] = b0[n];
            if (MODE == 1) { b0[n] = *(const f32x4*)(bias + col0 + 4 * n); b1[n] = *(const f32x4*)(bias + ldc + col0 + 4 * n); } }
#pragma unroll
        for (int ai = 0; ai < 2; ++ai)
#pragma unroll
            for (int m = 0; m < 4; ++m) {
                float v[8]; const float rs = 1.0f;
#pragma unroll
                for (int n = 0; n < 2; ++n)
#pragma unroll
                    for (int j = 0; j < 4; ++j) { const float a = acc[ai][0][m][n][j] * rs + b0[n][j], b = acc[ai][1][m][n][j] * rs + b1[n][j];
                        v[4 * n + j] = (MODE == 0) ? (a * b) * __builtin_amdgcn_rcpf(1.0f + __builtin_amdgcn_exp2f(-a))
                                                   : a * sigmoidf_(b); }
                u32x4 w; w.x = cvt_pk_bf16(v[0], v[1]); w.y = cvt_pk_bf16(v[2], v[3]); w.z = cvt_pk_bf16(v[4], v[5]); w.w = cvt_pk_bf16(v[6], v[7]);
                *(u32x4*)(O + (size_t)(row0 + ai * HALF + m * 16) * ldc + col0) = w;
            }
    }
};
template <int GLA>
struct EpiPlain {
    bf16_t* O; int ldc; const float* bg; float* part; const float* r2;
    __device__ __forceinline__ void operator()(const f32x4 (&acc)[2][2][4][2], const Unit& u, int wr, int wc, int fr, int fq) const {
        const int row0 = u.pm * BM + wr * 64 + fr, col0 = u.pn * BM + wc * 32 + 8 * fq;
        if (!GLA && u.ks >= 0) {
#pragma unroll
            for (int bj = 0; bj < 2; ++bj)
#pragma unroll
                for (int ai = 0; ai < 2; ++ai)
#pragma unroll
                    for (int m = 0; m < 4; ++m) { float* p = part + ((size_t)u.ks * MS + (row0 + ai * HALF + m * 16 - MP)) * D + col0 + bj * HALF;
                        *(f32x4*)p = acc[ai][bj][m][0]; *(f32x4*)(p + 4) = acc[ai][bj][m][1]; }
            return;
        }
        const bool lf = false;
#pragma unroll
        for (int bj = 0; bj < 2; ++bj) {
            f32x4 bb[2];
#pragma unroll
            for (int n = 0; n < 2; ++n) bb[n] = lf ? *(const f32x4*)(bg + (col0 - 3072) + bj * HALF + 4 * n) : (f32x4){0.f, 0.f, 0.f, 0.f};
#pragma unroll
            for (int ai = 0; ai < 2; ++ai)
#pragma unroll
                for (int m = 0; m < 4; ++m) {
                    float v[8]; const float rs = 1.0f;
#pragma unroll
                    for (int n = 0; n < 2; ++n)
#pragma unroll
                        for (int j = 0; j < 4; ++j) { float a = acc[ai][bj][m][n][j] * rs;
                            if (lf) a += bb[n][j];
                            v[4 * n + j] = a; }
                    u32x4 w; w.x = cvt_pk_bf16(v[0], v[1]); w.y = cvt_pk_bf16(v[2], v[3]); w.z = cvt_pk_bf16(v[4], v[5]); w.w = cvt_pk_bf16(v[6], v[7]);
                    *(u32x4*)(O + (size_t)(row0 + ai * HALF + m * 16) * ldc + col0 + bj * HALF) = w;
                }
        }
    }
};
struct EpiS5A {
    bf16_t* HL;
    __device__ __forceinline__ void operator()(const f32x4 (&acc)[2][2][4][2], const Unit& u, int wr, int wc, int fr, int fq) const {
        const int row0 = u.pm * BM + wr * 64 + fr, col0 = wc * 32 + 8 * fq;
#pragma unroll
        for (int ai = 0; ai < 2; ++ai)
#pragma unroll
            for (int m = 0; m < 4; ++m) { const f32x4 a0 = acc[ai][0][m][0], a1 = acc[ai][0][m][1];
                u32x4 w; w.x = cvt_pk_bf16(a0[0], a0[1]); w.y = cvt_pk_bf16(a0[2], a0[3]); w.z = cvt_pk_bf16(a1[0], a1[1]); w.w = cvt_pk_bf16(a1[2], a1[3]);
                *(u32x4*)(HL + ((size_t)u.pn * 1024 + row0 + ai * HALF + m * 16) * 128 + col0) = w; }
    }
};
struct EpiS5B {
    unsigned char* ws; const float* dsk;
    __device__ __forceinline__ void operator()(const f32x4 (&acc)[2][2][4][2], const Unit& u, int wr, int wc, int fr, int fq) const {
        bf16_t* Z = (bf16_t*)(ws + WS_Z); const bf16_t* HS5 = (const bf16_t*)(ws + WS_HS5);
        asm volatile("" : "+v"(fq));
        const int g = u.pn, c0 = (8 * fq) & 15;
        const f32x4 d0 = *(const f32x4*)(dsk + g * 16 + c0), d1 = *(const f32x4*)(dsk + g * 16 + c0 + 4);
#pragma unroll
        for (int bj = 0; bj < 2; ++bj) { const int t = 8 * bj + 2 * wc + (fq >> 1);
#pragma unroll
            for (int ai = 0; ai < 2; ++ai)
#pragma unroll
                for (int m = 0; m < 4; ++m) { const int colr = u.pm * BM + ai * HALF + wr * 64 + m * 16 + fr; const size_t off = (size_t)(colr * 16 + t) * D + g * 16 + c0;
                    const u32x4 uu = *(const u32x4*)(HS5 + ((size_t)g * 1024 + colr) * 384 + t * 16 + c0); const f32x4 a0 = acc[ai][bj][m][0], a1 = acc[ai][bj][m][1];
                    u32x4 w; w.x = cvt_pk_bf16(a0[0] + d0[0] * bflo(uu.x), a0[1] + d0[1] * bfhi(uu.x)); w.y = cvt_pk_bf16(a0[2] + d0[2] * bflo(uu.y), a0[3] + d0[3] * bfhi(uu.y));
                    w.z = cvt_pk_bf16(a1[0] + d1[0] * bflo(uu.z), a1[1] + d1[1] * bfhi(uu.z)); w.w = cvt_pk_bf16(a1[2] + d1[2] * bflo(uu.w), a1[3] + d1[3] * bfhi(uu.w));
                    *(u32x4*)(Z + off) = w; }
        }
    }
};

struct Params { const float* in[23]; float* out; unsigned char* ws; int ph_lo, ph_hi; };

__device__ __forceinline__ int rp_row(int kidx, int gw, int NGW) {
    if (NGW % MS == 0) { const int stride = NGW / MS, kp = (MP + NGW - 1) / NGW;
        if (kidx == 0) return (gw % stride == 0) ? MP + gw / stride : -1;
        if (kidx > kp) return -1;
        const int m = gw + (kidx - 1) * NGW; return m < MP ? m : -1; }
    const int KMAX = (M + NGW - 1) / NGW; if (kidx >= KMAX) return -1;
    const int kk = (kidx + KMAX - 1) % KMAX, m = gw + kk * NGW; return m < M ? m : -1;
}
template <int R, int NKS>
__device__ __forceinline__ void row_pass(const float* xf_p, const float* xf_s, bf16_t* XB, float* R2, const bf16_t* Y, const float* g_post, float scale,
                                         const float* part, float* outf, const float* g_pre, bf16_t* HS5, bf16_t* HSMP, const float* glu_bias = nullptr) {
    const int tid = otid(); const int lane = tid & 63, gw = blockIdx.x * 8 + (tid >> 6), NGW = gridDim.x * 8;
#define CJ(j) (512 * ((j) >> 1) + 8 * lane + 4 * ((j) & 1))
    const int KMAX = (NGW % MS == 0) ? (MP + NGW - 1) / NGW + 1 : (M + NGW - 1) / NGW;
    f32x4 gpo[4];
#pragma unroll
    for (int j = 0; j < 4; ++j) gpo[j] = Y ? *(const f32x4*)(g_post + CJ(j)) : (f32x4){0.f, 0.f, 0.f, 0.f};
    for (int k0 = 0; k0 < KMAX; k0 += R) {
        f32x4 v[R][4], yv[R][4];
#pragma unroll
        for (int r = 0; r < R; ++r) { const int mi = rp_row(k0 + r, gw, NGW), m = mi >= 0 ? mi : gw;
            if (xf_p) { const float* xr = (m < MP) ? xf_p + (size_t)m * D : xf_s + (size_t)(m - MP) * D;
#pragma unroll
                for (int j = 0; j < 4; ++j) v[r][j] = *(const f32x4*)(xr + CJ(j));
            } else {
                const float ir = 1.0f / R2[m];
#pragma unroll
                for (int jj = 0; jj < 2; ++jj) { const u32x4 w = *(const u32x4*)(XB + (size_t)m * D + 512 * jj + 8 * lane);
                    v[r][2 * jj] = (f32x4){bflo(w.x), bfhi(w.x), bflo(w.y), bfhi(w.y)} * ir; v[r][2 * jj + 1] = (f32x4){bflo(w.z), bfhi(w.z), bflo(w.w), bfhi(w.w)} * ir; }
            }
            if (Y) {
                if (glu_bias && m >= MP) {
#pragma unroll
                    for (int j = 0; j < 4; ++j) { const int nc = 256 * (4 * (j >> 1) + (lane >> 4)) + 8 * (lane & 15) + 4 * (j & 1);
                        f32x4 sv = *(const f32x4*)(glu_bias + CJ(j)), sg = *(const f32x4*)(glu_bias + D + CJ(j));
                        f32x4 tv[NKS], tg[NKS];
#pragma unroll
                        for (int ks = 0; ks < NKS; ++ks) { const float* pp = part + ((size_t)ks * MS + (m - MP)) * (2 * D) + nc; tv[ks] = *(const f32x4*)pp; tg[ks] = *(const f32x4*)(pp + 128); }
#pragma unroll
                        for (int ks = 0; ks < NKS; ++ks) { sv += tv[ks]; sg += tg[ks]; }
                        yv[r][j] = (f32x4){sv.x * sigmoidf_(sg.x), sv.y * sigmoidf_(sg.y), sv.z * sigmoidf_(sg.z), sv.w * sigmoidf_(sg.w)}; }
                } else if (part && m >= MP) {
#pragma unroll
                    for (int j = 0; j < 4; ++j) { f32x4 t[NKS];
#pragma unroll
                        for (int ks = 0; ks < NKS; ++ks) t[ks] = *(const f32x4*)(part + ((size_t)ks * MS + (m - MP)) * D + CJ(j));
                        f32x4 s = t[0];
#pragma unroll
                        for (int ks = 1; ks < NKS; ++ks) s += t[ks];
                        yv[r][j] = s; }
                } else {
#pragma unroll
                    for (int jj = 0; jj < 2; ++jj) { const u32x4 w = *(const u32x4*)(Y + (size_t)m * D + 512 * jj + 8 * lane);
                        yv[r][2 * jj] = (f32x4){bflo(w.x), bfhi(w.x), bflo(w.y), bfhi(w.y)}; yv[r][2 * jj + 1] = (f32x4){bflo(w.z), bfhi(w.z), bflo(w.w), bfhi(w.w)}; }
                }
            }
        }
        float rry[R], rrx[R];
        if (Y) {
            float sy[R];
#pragma unroll
            for (int r = 0; r < R; ++r) { float ss = 0.f;
#pragma unroll
                for (int j = 0; j < 4; ++j) ss += (yv[r][j].x * yv[r][j].x + yv[r][j].y * yv[r][j].y) + (yv[r][j].z * yv[r][j].z + yv[r][j].w * yv[r][j].w);
                sy[r] = ss; }
#pragma unroll
            for (int o = 1; o < 64; o <<= 1) {
#pragma unroll
                for (int r = 0; r < R; ++r) sy[r] += __shfl_xor(sy[r], o); }
#pragma unroll
            for (int r = 0; r < R; ++r) { rry[r] = rsqrtf(sy[r] * (1.0f / D) + EPS) * scale;
#pragma unroll
                for (int j = 0; j < 4; ++j) v[r][j] = v[r][j] + yv[r][j] * gpo[j] * rry[r]; }
        }
        if (!outf) {
            float sx[R];
#pragma unroll
            for (int r = 0; r < R; ++r) { float ss = 0.f;
#pragma unroll
                for (int j = 0; j < 4; ++j) ss += (v[r][j].x * v[r][j].x + v[r][j].y * v[r][j].y) + (v[r][j].z * v[r][j].z + v[r][j].w * v[r][j].w);
                sx[r] = ss; }
#pragma unroll
            for (int o = 1; o < 64; o <<= 1) {
#pragma unroll
                for (int r = 0; r < R; ++r) sx[r] += __shfl_xor(sx[r], o); }
#pragma unroll
            for (int r = 0; r < R; ++r) rrx[r] = rsqrtf(sx[r] * (1.0f / D) + EPS);
        }
#pragma unroll
        for (int r = 0; r < R; ++r) { const int m = rp_row(k0 + r, gw, NGW); if (m < 0) continue;
            if (outf) {
#pragma unroll
                for (int j = 0; j < 4; ++j) *(f32x4*)(outf + (size_t)m * D + CJ(j)) = v[r][j];
            } else {
                const float rr = rrx[r];
#pragma unroll
                for (int jj = 0; jj < 2; ++jj) { const f32x4 a = v[r][2 * jj] * rr, b = v[r][2 * jj + 1] * rr;
                    u32x4 w; w.x = cvt_pk_bf16(a.x, a.y); w.y = cvt_pk_bf16(a.z, a.w); w.z = cvt_pk_bf16(b.x, b.y); w.w = cvt_pk_bf16(b.z, b.w);
                    *(u32x4*)(XB + (size_t)m * D + 512 * jj + 8 * lane) = w; }
                if (lane == 0) R2[m] = rr;
                if (g_pre) {
#pragma unroll
                    for (int jj = 0; jj < 2; ++jj) { const f32x4 ga = *(const f32x4*)(g_pre + CJ(2 * jj)), gb = *(const f32x4*)(g_pre + CJ(2 * jj + 1));
                        const f32x4 ha = v[r][2 * jj] * ga * rr, hb = v[r][2 * jj + 1] * gb * rr;
                        u32x4 w; w.x = cvt_pk_bf16(ha.x, ha.y); w.y = cvt_pk_bf16(ha.z, ha.w); w.z = cvt_pk_bf16(hb.x, hb.y); w.w = cvt_pk_bf16(hb.z, hb.w);
                        if (m < MP) { const int gi = 32 * jj + (lane >> 1), c = (lane & 1) * 8;
                            *(u32x4*)(HS5 + ((size_t)gi * 1024 + (m >> 4)) * 384 + (m & 15) * 16 + c) = w; }
                        else *(u32x4*)(HSMP + (size_t)(m - MP) * D + 512 * jj + 8 * lane) = w; }
                }
            }
        }
    }
}
#undef CJ

__device__ __forceinline__ void transpose_item(const float* W, int ldw, int K, int scol0, bf16_t* Bt, int drow0, int k0, float scale, const float* gk, LAS bf16_t* scr, int lane) {
    const float* src = W + (size_t)(k0 + (lane >> 5)) * ldw + scol0 + 4 * (lane & 31);
#pragma unroll 16
    for (int i = 0; i < 32; ++i) { const f32x4 w = __builtin_nontemporal_load((const f32x4*)(src + (size_t)(2 * i) * ldw));
        const float sc = gk ? gk[k0 + 2 * i + (lane >> 5)] * scale : scale;
        u32x2 o; o.x = cvt_pk_bf16(w.x * sc, w.y * sc); o.y = cvt_pk_bf16(w.z * sc, w.w * sc);
        *(LAS u32x2*)(scr + (2 * i + (lane >> 5)) * 136 + 4 * (lane & 31)) = o; }
    asm volatile("s_waitcnt lgkmcnt(0)" ::: "memory");
#pragma unroll 4
    for (int t = 0; t < 16; ++t) { const int task = t * 64 + lane, n = task >> 3, kc = task & 7; const LAS bf16_t* s = scr + (kc * 8) * 136 + n;
        u32x4 o; o.x = (unsigned)s[0] | ((unsigned)s[136] << 16); o.y = (unsigned)s[272] | ((unsigned)s[408] << 16);
        o.z = (unsigned)s[544] | ((unsigned)s[680] << 16); o.w = (unsigned)s[816] | ((unsigned)s[952] << 16);
        *(u32x4*)(Bt + (size_t)(drow0 + n) * K + k0 + 8 * kc) = o; }
    asm volatile("s_waitcnt lgkmcnt(0)" ::: "memory");
}

__device__ __forceinline__ void s5_prep_group(const Params& P, LAS unsigned char* lds, int g, int qt) {
    LAS float* apr = (LAS float*)lds;
    LAS float* api = apr + 17 * 64;
    LAS float* bbr = api + 17 * 64;
    LAS float* bbi = bbr + 1024;
    LAS float* cre = bbi + 1024;
    LAS float* cim = cre + 1024;
    LAS float* fre = cim + 1024;
    LAS float* fim = fre + 64;
    LAS float* kmat = fim + 64;
    const int tid = otid();
    float* sm = (float*)(P.ws + WS_SMALL);
    bf16_t* Wm = (bf16_t*)(P.ws + WS_S5M + (size_t)g * S5M_G);
    bf16_t* TE = Wm + 128 * 256;
    if (tid < 64) {
        const int p = tid; const float lr = P.in[13][g * 64 + p], li = P.in[14][g * 64 + p]; const float dt = expf(P.in[15][g]);
        float a1r = 0.f, a1i = 0.f;
        for (int tau = 0; tau <= 16; ++tau) {
            const float mag = expf(lr * dt * (float)tau);
            double rev = (double)li * (double)dt * (double)tau * 0.15915494309189535; rev -= __builtin_rint(rev);
            const float rr = (float)rev; const float s = __builtin_amdgcn_sinf(rr), c = __builtin_amdgcn_cosf(rr);
            apr[tau * 64 + p] = mag * c; api[tau * 64 + p] = mag * s;
            if (tau == 1) { a1r = mag * c; a1i = mag * s; }
            if (tau == 16 && qt == 0) { sm[SM_A16R + g * 64 + p] = mag * c; sm[SM_A16I + g * 64 + p] = mag * s; }
        }
        const float nr = a1r - 1.0f, ni = a1i, den = lr * lr + li * li;
        const float fr_ = (nr * lr + ni * li) / den, fi_ = (ni * lr - nr * li) / den;
        fre[p] = fr_; fim[p] = fi_;
        if (qt == 0) { sm[SM_ARE + g * 64 + p] = a1r; sm[SM_AIM + g * 64 + p] = a1i; sm[SM_FRE + g * 64 + p] = fr_; sm[SM_FIM + g * 64 + p] = fi_; }
    }
    __syncthreads();
    for (int idx = tid; idx < 1024; idx += 512) { const int p = idx >> 4; const float br = P.in[16][g * 1024 + idx], bi = P.in[17][g * 1024 + idx];
        bbr[idx] = fre[p] * br - fim[p] * bi; bbi[idx] = fre[p] * bi + fim[p] * br;
        cre[idx] = P.in[18][g * 1024 + idx]; cim[idx] = P.in[19][g * 1024 + idx]; }
    __syncthreads();
    for (int idx = qt * 8192 + tid; idx < (qt + 1) * 8192; idx += 512) { const int row = idx >> 8, col = idx & 255, s = col >> 4, c = col & 15, p = row & 63, im = row >> 6;
        const float ar = apr[(15 - s) * 64 + p], ai = api[(15 - s) * 64 + p], br = bbr[p * 16 + c], bi = bbi[p * 16 + c];
        Wm[idx] = f2bf(im ? (ar * bi + ai * br) : (ar * br - ai * bi)); }
    for (int i2 = tid; i2 < 1024; i2 += 512) { const int tau = i2 >> 6, cp = 4 * qt + ((i2 >> 4) & 3), c = i2 & 15, idx = (tau << 8) + (cp << 4) + c; float sum = 0.f;
        for (int p = 0; p < 64; ++p) { const float cr = cre[cp * 64 + p], ci = cim[cp * 64 + p], ar = apr[tau * 64 + p], ai = api[tau * 64 + p];
            const float car = cr * ar - ci * ai, cai = cr * ai + ci * ar; sum += car * bbr[p * 16 + c] - cai * bbi[p * 16 + c]; }
        kmat[idx] = sum; }
    __syncthreads();
    for (int i2 = tid; i2 < 64 * 384; i2 += 512) { const int r2 = i2 / 384, col = i2 - r2 * 384, t = r2 >> 2, cp = 4 * qt + (r2 & 3), row = t * 16 + cp, idx = row * 384 + col; float v;
        if (col < 256) { const int s = col >> 4, c = col & 15; v = (s <= t) ? kmat[((t - s) << 8) + (cp << 4) + c] : 0.f; }
        else { const int pp = col - 256, p = pp & 63, im = pp >> 6; const float cr = cre[cp * 64 + p], ci = cim[cp * 64 + p], ar = apr[(t + 1) * 64 + p], ai = api[(t + 1) * 64 + p];
            v = im ? -(cr * ai + ci * ar) : (cr * ar - ci * ai); }
        TE[idx] = f2bf(v); }
    __syncthreads();
}

__device__ __forceinline__ void s5_idle_prep(const Params& P, LAS unsigned char* lds, int slot) {
    const int G = gridDim.x, nfull = ((M / BM) * (NGU / BM)) % G, cb = blockIdx.x;
    if (nfull == 0 || cb < nfull) return;
    const int wi = slot * (G - nfull) + (cb - nfull);
    if (wi < 256) s5_prep_group(P, lds, wi >> 2, wi & 3);
}
__device__ __forceinline__ void s5_idle_prep_inproj(const Params& P, LAS unsigned char* lds) {
    const int G = gridDim.x, nf1 = ((M / BM) * (NGU / BM)) % G, nf2 = ((M / BM) * (NIN / BM)) % G, cb = blockIdx.x;
    if (nf1 == 0 || nf2 == 0 || cb < nf2) return;
    const int wi = 3 * (G - nf1) + (cb - nf2);
    if (wi < 256) s5_prep_group(P, lds, wi >> 2, wi & 3);
}
__device__ __forceinline__ void phase0(const Params& P, LAS unsigned char* lds) {
    const int tid = otid(), lane = tid & 63, wave = tid >> 6;
    const int gw = blockIdx.x * 8 + wave, NGW = gridDim.x * 8;
    LAS bf16_t* scr = (LAS bf16_t*)(lds + wave * 17408);
    bf16_t* WGU = (bf16_t*)(P.ws + WS_WGU); bf16_t* WDN = (bf16_t*)(P.ws + WS_WDN); bf16_t* WIN = (bf16_t*)(P.ws + WS_WIN);
    bf16_t* WOUT = (bf16_t*)(P.ws + WS_WOUT); bf16_t* WGLU = (bf16_t*)(P.ws + WS_WGLU);
    constexpr int I_GU = 4 * 16 * 44, I_DN = 4 * 44 * 8, I_IN = 16 * 24, I_OUT = 16 * 8, I_GLU = 16 * 16;
#pragma unroll 1
    for (int step = 0; step < 2; ++step) {
    if (((blockIdx.x & 1) != 0) == (step == 0)) {
        { const int G_ = gridDim.x, nf1_ = ((M / BM) * (NGU / BM)) % G_, nf2_ = ((M / BM) * (NIN / BM)) % G_;
          const int first_ = (nf1_ && nf2_) ? 3 * (G_ - nf1_) + (G_ - nf2_) : (nf1_ ? 3 * (G_ - nf1_) : 0);
          for (int wi = first_ + blockIdx.x; wi < 256; wi += gridDim.x) s5_prep_group(P, lds, wi >> 2, wi & 3); }
    } else {
    for (int it = blockIdx.x + gridDim.x * wave; it < I_GU + I_DN + I_IN + I_OUT + I_GLU; it += NGW) {
        int r = it;
        if (r < I_GU) { const int lf = r / 704, rr = r % 704, kb = rr / 44, nb = rr % 44, n0 = nb * 128, pn = n0 >> 8, bj = (n0 >> 7) & 1;
            transpose_item(P.in[6] + (size_t)lf * D * NGU, NGU, D, bj * FF + pn * 128, WGU + (size_t)lf * NGU * D, n0, kb * 64, bj ? 0.6931471805599453f : 1.4426950408889634f, P.in[5] + (size_t)((lf >> 1) * 6 + (lf & 1) * 4) * D, scr, lane); continue; }
        r -= I_GU;
        if (r < I_DN) { const int lf = r / 352, rr = r % 352, kb = rr / 8, nb = rr % 8;
            transpose_item(P.in[7] + (size_t)lf * FF * D, D, FF, nb * 128, WDN + (size_t)lf * D * FF, nb * 128, kb * 64, 1.0f, nullptr, scr, lane); continue; }
        r -= I_DN;
        if (r < I_IN) { const int kb = r / 24, nb = r % 24, n0 = nb * 128;
            transpose_item(P.in[8], LDIN, D, n0, WIN, n0, kb * 64, n0 < 512 ? 0.08838834764831845f : 1.0f, P.in[5] + 2 * D, scr, lane); continue; }
        r -= I_IN;
        if (r < I_OUT) { const int kb = r / 8, nb = r % 8; transpose_item(P.in[12], D, D, nb * 128, WOUT, nb * 128, kb * 64, 1.0f, nullptr, scr, lane); continue; }
        r -= I_OUT;
        { const int kb = r / 16, nb = r % 16, n0 = nb * 128, pn = n0 >> 8, bj = (n0 >> 7) & 1;
            transpose_item(P.in[21], 2 * D, D, bj * D + pn * 128, WGLU, n0, kb * 64, 1.0f, nullptr, scr, lane); }
    }
    for (int idx = blockIdx.x * 512 + tid; idx < 64 * 1024; idx += gridDim.x * 512) { const int jb = idx >> 10, k = idx & 1023;
        const float* wr = P.in[8] + (size_t)k * LDIN + 3072; const f32x4 a0 = *(const f32x4*)wr, a1 = *(const f32x4*)(wr + 4), a2 = *(const f32x4*)(wr + 8), a3 = *(const f32x4*)(wr + 12);
        const float a[16] = {a0.x, a0.y, a0.z, a0.w, a1.x, a1.y, a1.z, a1.w, a2.x, a2.y, a2.z, a2.w, a3.x, a3.y, a3.z, a3.w}; const float gk = P.in[5][2 * D + k];
#pragma unroll
        for (int jj = 0; jj < 8; ++jj) { const int j = jb * 8 + jj; float s = 0.f;
#pragma unroll
            for (int r = 0; r < 16; ++r) s += a[r] * P.in[9][r * 512 + j];
            WIN[(size_t)(3072 + j) * D + k] = f2bf(s * gk); } }
    }
    __syncthreads();
    }
    row_pass<3, 1>(P.in[0], P.in[1], (bf16_t*)(P.ws + WS_H), (float*)(P.ws + WS_SMALL) + SM_R2, nullptr, nullptr, 0.f, nullptr, nullptr, nullptr, nullptr, nullptr);
}

__device__ __forceinline__ void gla_cumsum(LAS float* BC, LAS float* TOT, const u32x4 (&lw)[2], const f32x4 (&bgv)[2], int tid) {
#pragma unroll
    for (int i = 0; i < 2; ++i) { const int e = tid + 512 * i, t = e >> 4, d0 = (e & 15) * 8; const u32x4 w = lw[i];
        LAS float* b = BC + t * 128 + d0; b[0] = logf_gate(bflo(w.x) + bgv[0].x); b[1] = logf_gate(bfhi(w.x) + bgv[0].y); b[2] = logf_gate(bflo(w.y) + bgv[0].z); b[3] = logf_gate(bfhi(w.y) + bgv[0].w);
        b[4] = logf_gate(bflo(w.z) + bgv[1].x); b[5] = logf_gate(bfhi(w.z) + bgv[1].y); b[6] = logf_gate(bflo(w.w) + bgv[1].z); b[7] = logf_gate(bfhi(w.w) + bgv[1].w); }
    __syncthreads();
    const int dk = tid & 127, seg = tid >> 7; float run = 0.f;
#pragma unroll
    for (int i = 0; i < 16; ++i) { const int t = seg * 16 + i; run += BC[t * 128 + dk]; BC[t * 128 + dk] = run; }
    TOT[seg * 128 + dk] = run;
    __syncthreads();
    float off = 0.f;
    for (int s = 0; s < seg; ++s) off += TOT[s * 128 + dk];
#pragma unroll
    for (int i = 0; i < 16; ++i) BC[(seg * 16 + i) * 128 + dk] += off;
    __syncthreads();
}
__device__ __forceinline__ void gla_load_vt(LAS bf16_t* VT, const u32x4 (&vw)[4], int tid) {
#pragma unroll
    for (int i = 0; i < 4; ++i) { const int e = tid + 512 * i, t = e >> 5, d0 = (e & 31) * 8; const u32x4 w = vw[i];
        LAS bf16_t* p = VT + d0 * 72 + ((((t >> 3) ^ ((d0 >> 3) & 7)) << 3) | (t & 7));
        p[0] = (bf16_t)(w.x & 0xffff); p[72] = (bf16_t)(w.x >> 16); p[144] = (bf16_t)(w.y & 0xffff); p[216] = (bf16_t)(w.y >> 16);
        p[288] = (bf16_t)(w.z & 0xffff); p[360] = (bf16_t)(w.z >> 16); p[432] = (bf16_t)(w.w & 0xffff); p[504] = (bf16_t)(w.w >> 16); }
}

__device__ __forceinline__ void gla_phase_a(const Params& P, LAS unsigned char* lds) {
    const int tid = otid(), lane = tid & 63, w = tid >> 6, l16 = lane & 15, q = lane >> 4;
    LAS float* BC = (LAS float*)lds; LAS float* TOT = (LAS float*)(lds + 32768);
    LAS bf16_t* KT = (LAS bf16_t*)(lds + 34816); LAS bf16_t* VT = (LAS bf16_t*)(lds + 53248);
    const bf16_t* QKV = (const bf16_t*)(P.ws + WS_QKV); bf16_t* KC = (bf16_t*)(P.ws + WS_KC); float* BEND = (float*)(P.ws + WS_BEND);
    for (int item = blockIdx.x; item < 1024; item += gridDim.x) {
        const int b = item >> 7, h = (item >> 5) & 3, c = item & 31; const size_t tok0 = (size_t)b * 2048 + c * 64;
        const bf16_t* base = QKV + tok0 * NIN;
        u32x4 lw[2], kw[2], vw[4]; f32x4 bgv[2]; bgv[0] = *(const f32x4*)(P.in[10] + h * 128 + (tid & 15) * 8); bgv[1] = *(const f32x4*)(P.in[10] + h * 128 + (tid & 15) * 8 + 4);
#pragma unroll
        for (int i = 0; i < 2; ++i) { const int e = tid + 512 * i, t = e >> 4, d0 = (e & 15) * 8; lw[i] = *(const u32x4*)(base + (size_t)t * NIN + 3072 + h * 128 + d0); kw[i] = *(const u32x4*)(base + (size_t)t * NIN + 512 + h * 128 + d0); }
#pragma unroll
        for (int i = 0; i < 4; ++i) { const int e = tid + 512 * i, t = e >> 5, d0 = (e & 31) * 8; vw[i] = *(const u32x4*)(base + (size_t)t * NIN + 1024 + h * 256 + d0); }
        gla_cumsum(BC, TOT, lw, bgv, tid);
        if (tid < 128) BEND[item * 128 + tid] = BC[63 * 128 + tid];
#pragma unroll
        for (int i = 0; i < 2; ++i) { const int e = tid + 512 * i, t = e >> 4, d0 = (e & 15) * 8; const u32x4 wv = kw[i];
            float kv[8] = {bflo(wv.x), bfhi(wv.x), bflo(wv.y), bfhi(wv.y), bflo(wv.z), bfhi(wv.z), bflo(wv.w), bfhi(wv.w)};
#pragma unroll
            for (int j = 0; j < 8; ++j) KT[(d0 + j) * 72 + ((((t >> 3) ^ ((d0 >> 3) & 7)) << 3) | (t & 7))] = f2bf(kv[j] * __expf(BC[63 * 128 + d0 + j] - BC[t * 128 + d0 + j])); }
        gla_load_vt(VT, vw, tid);
        __syncthreads();
        f32x4 acc[8][2];
#pragma unroll
        for (int a = 0; a < 8; ++a) { acc[a][0] = (f32x4){0.f, 0.f, 0.f, 0.f}; acc[a][1] = acc[a][0]; }
#pragma unroll
        for (int kk = 0; kk < 2; ++kk) {
            bf16x8 vb[2];
#pragma unroll
            for (int d = 0; d < 2; ++d) vb[d] = *(const LAS bf16x8*)(VT + (16 * (2 * w + d) + l16) * 72 + (((kk * 4 + q) ^ ((2 * (2 * w + d) + (l16 >> 3)) & 7)) << 3));
#pragma unroll
            for (int a = 0; a < 8; ++a) { const bf16x8 ka = *(const LAS bf16x8*)(KT + (16 * a + l16) * 72 + (((kk * 4 + q) ^ ((2 * a + (l16 >> 3)) & 7)) << 3));
#pragma unroll
                for (int d = 0; d < 2; ++d) acc[a][d] = __builtin_amdgcn_mfma_f32_16x16x32_bf16(ka, vb[d], acc[a][d], 0, 0, 0); }
        }
#pragma unroll
        for (int a = 0; a < 8; ++a)
#pragma unroll
            for (int d = 0; d < 2; ++d) { u32x2 o; o.x = cvt_pk_bf16(acc[a][d][0], acc[a][d][1]); o.y = cvt_pk_bf16(acc[a][d][2], acc[a][d][3]);
                *(u32x2*)(KC + ((size_t)item * 256 + 16 * (2 * w + d) + l16) * 128 + 16 * a + 4 * q) = o; }
        __syncthreads();
    }
}
__device__ __forceinline__ void gla_phase_b(const Params& P) {
    bf16_t* KC = (bf16_t*)(P.ws + WS_KC); const float* BEND = (const float*)(P.ws + WS_BEND);
    const int tidb = otid();
    for (int idx = blockIdx.x * 512 + tidb; idx < 32 * 4096; idx += gridDim.x * 512) {
        const int bh = idx >> 12, e = idx & 4095, dv = e >> 4, dk0 = (e & 15) * 8;
        float S[8];
#pragma unroll
        for (int j = 0; j < 8; ++j) S[j] = 0.f;
#pragma unroll 8
        for (int c = 0; c < 32; ++c) { const int item = bh * 32 + c;
            u32x4* p = (u32x4*)(KC + ((size_t)item * 256 + dv) * 128 + dk0); const u32x4 kc = *p;
            const f32x4 e0 = *(const f32x4*)(BEND + item * 128 + dk0), e1 = *(const f32x4*)(BEND + item * 128 + dk0 + 4);
            u32x4 o; o.x = cvt_pk_bf16(S[0], S[1]); o.y = cvt_pk_bf16(S[2], S[3]); o.z = cvt_pk_bf16(S[4], S[5]); o.w = cvt_pk_bf16(S[6], S[7]); *p = o;
            S[0] = __expf(e0.x) * S[0] + bflo(kc.x); S[1] = __expf(e0.y) * S[1] + bfhi(kc.x); S[2] = __expf(e0.z) * S[2] + bflo(kc.y); S[3] = __expf(e0.w) * S[3] + bfhi(kc.y);
            S[4] = __expf(e1.x) * S[4] + bflo(kc.z); S[5] = __expf(e1.y) * S[5] + bfhi(kc.z); S[6] = __expf(e1.z) * S[6] + bflo(kc.w); S[7] = __expf(e1.w) * S[7] + bfhi(kc.w); }
        float* o = P.out + O_GP + (size_t)bh * 32768;
#pragma unroll
        for (int j = 0; j < 8; ++j) o[(dk0 + j) * 256 + dv] = S[j];
    }
}
__device__ __forceinline__ void gla_phase_c(const Params& P, LAS unsigned char* lds) {
    const int tid = otid(), lane = tid & 63, w = tid >> 6, l16 = lane & 15, q = lane >> 4;
    LAS float* BC = (LAS float*)lds; LAS float* TOT = (LAS float*)(lds + 32768); LAS float* PART = (LAS float*)(lds + 34816);
    LAS bf16_t* QT = (LAS bf16_t*)(lds + 36864); LAS bf16_t* KT = (LAS bf16_t*)(lds + 54272);
    LAS bf16_t* VT = (LAS bf16_t*)(lds + 71680); LAS bf16_t* ATT = (LAS bf16_t*)(lds + 108544);
    const bf16_t* QKV = (const bf16_t*)(P.ws + WS_QKV); const bf16_t* KC = (const bf16_t*)(P.ws + WS_KC); bf16_t* Oo = (bf16_t*)(P.ws + WS_O);
    const float* gon = P.in[11];
    for (int item = blockIdx.x; item < 1024; item += gridDim.x) {
        const int b = item >> 7, h = (item >> 5) & 3, c = item & 31; const size_t tok0 = (size_t)b * 2048 + c * 64;
        const bf16_t* base = QKV + tok0 * NIN;
        u32x4 lw[2], qw[2], kw[2], vw[4]; bf16x8 sfr[4][2]; u32x2 rw[4][2]; f32x4 bgv[2]; bgv[0] = *(const f32x4*)(P.in[10] + h * 128 + (tid & 15) * 8); bgv[1] = *(const f32x4*)(P.in[10] + h * 128 + (tid & 15) * 8 + 4);
#pragma unroll
        for (int i = 0; i < 2; ++i) { const int e = tid + 512 * i, t = e >> 4, d0 = (e & 15) * 8; lw[i] = *(const u32x4*)(base + (size_t)t * NIN + 3072 + h * 128 + d0);
            qw[i] = *(const u32x4*)(base + (size_t)t * NIN + h * 128 + d0); kw[i] = *(const u32x4*)(base + (size_t)t * NIN + 512 + h * 128 + d0); }
#pragma unroll
        for (int i = 0; i < 4; ++i) { const int e = tid + 512 * i, t = e >> 5, d0 = (e & 31) * 8; vw[i] = *(const u32x4*)(base + (size_t)t * NIN + 1024 + h * 256 + d0); }
#pragma unroll
        for (int kk = 0; kk < 4; ++kk)
#pragma unroll
            for (int d = 0; d < 2; ++d) sfr[kk][d] = *(const bf16x8*)(KC + ((size_t)item * 256 + 16 * (2 * w + d) + l16) * 128 + kk * 32 + q * 8);
#pragma unroll
        for (int tm = 0; tm < 4; ++tm)
#pragma unroll
            for (int d = 0; d < 2; ++d) rw[tm][d] = *(const u32x2*)(QKV + (tok0 + 16 * tm + l16) * NIN + 2048 + h * 256 + 16 * (2 * w + d) + 4 * q);
        gla_cumsum(BC, TOT, lw, bgv, tid);
#pragma unroll
        for (int i = 0; i < 2; ++i) { const int e = tid + 512 * i, t = e >> 4, d0 = (e & 15) * 8;
            const u32x4 wq = qw[i], wk = kw[i];
            float qv[8] = {bflo(wq.x), bfhi(wq.x), bflo(wq.y), bfhi(wq.y), bflo(wq.z), bfhi(wq.z), bflo(wq.w), bfhi(wq.w)};
            float kv[8] = {bflo(wk.x), bfhi(wk.x), bflo(wk.y), bfhi(wk.y), bflo(wk.z), bfhi(wk.z), bflo(wk.w), bfhi(wk.w)};
            float eb[8];
#pragma unroll
            for (int j = 0; j < 8; ++j) { eb[j] = BC[t * 128 + d0 + j]; qv[j] *= __expf(eb[j]); kv[j] *= __expf(-eb[j]); }
            u32x4 oq, ok; oq.x = cvt_pk_bf16(qv[0], qv[1]); oq.y = cvt_pk_bf16(qv[2], qv[3]); oq.z = cvt_pk_bf16(qv[4], qv[5]); oq.w = cvt_pk_bf16(qv[6], qv[7]);
            ok.x = cvt_pk_bf16(kv[0], kv[1]); ok.y = cvt_pk_bf16(kv[2], kv[3]); ok.z = cvt_pk_bf16(kv[4], kv[5]); ok.w = cvt_pk_bf16(kv[6], kv[7]);
            *(LAS u32x4*)(QT + t * 136 + d0) = oq; *(LAS u32x4*)(KT + t * 136 + d0) = ok; }
        gla_load_vt(VT, vw, tid);
        __syncthreads();
        {
            const int tm = w >> 1;
#pragma unroll
            for (int d = 0; d < 2; ++d) { const int sn = 2 * (w & 1) + d; f32x4 a = (f32x4){0.f, 0.f, 0.f, 0.f};
                if (sn <= tm) {
#pragma unroll
                    for (int kk = 0; kk < 4; ++kk) { const bf16x8 kf = *(const LAS bf16x8*)(KT + (16 * sn + l16) * 136 + kk * 32 + q * 8);
                        const bf16x8 qf = *(const LAS bf16x8*)(QT + (16 * tm + l16) * 136 + kk * 32 + q * 8);
                        a = __builtin_amdgcn_mfma_f32_16x16x32_bf16(kf, qf, a, 0, 0, 0); }
                }
                const int t = 16 * tm + l16, s0 = 16 * sn + 4 * q;
#pragma unroll
                for (int i = 0; i < 4; ++i) if (s0 + i > t) a[i] = 0.f;
                u32x2 o; o.x = cvt_pk_bf16(a[0], a[1]); o.y = cvt_pk_bf16(a[2], a[3]);
                *(LAS u32x2*)(ATT + t * 72 + s0) = o; }
        }
        __syncthreads();
        f32x4 acc[2][4];
#pragma unroll
        for (int d = 0; d < 2; ++d)
#pragma unroll
            for (int tm = 0; tm < 4; ++tm) acc[d][tm] = (f32x4){0.f, 0.f, 0.f, 0.f};
#pragma unroll
        for (int kk = 0; kk < 2; ++kk) {
            bf16x8 vf[2], af[4];
#pragma unroll
            for (int d = 0; d < 2; ++d) vf[d] = *(const LAS bf16x8*)(VT + (16 * (2 * w + d) + l16) * 72 + (((kk * 4 + q) ^ ((2 * (2 * w + d) + (l16 >> 3)) & 7)) << 3));
#pragma unroll
            for (int tm = 0; tm < 4; ++tm) af[tm] = *(const LAS bf16x8*)(ATT + (16 * tm + l16) * 72 + kk * 32 + q * 8);
#pragma unroll
            for (int d = 0; d < 2; ++d)
#pragma unroll
                for (int tm = 0; tm < 4; ++tm) acc[d][tm] = __builtin_amdgcn_mfma_f32_16x16x32_bf16(vf[d], af[tm], acc[d][tm], 0, 0, 0);
        }
#pragma unroll
        for (int kk = 0; kk < 4; ++kk) {
            bf16x8 sf[2], qf[4];
#pragma unroll
            for (int d = 0; d < 2; ++d) sf[d] = sfr[kk][d];
#pragma unroll
            for (int tm = 0; tm < 4; ++tm) qf[tm] = *(const LAS bf16x8*)(QT + (16 * tm + l16) * 136 + kk * 32 + q * 8);
#pragma unroll
            for (int d = 0; d < 2; ++d)
#pragma unroll
                for (int tm = 0; tm < 4; ++tm) acc[d][tm] = __builtin_amdgcn_mfma_f32_16x16x32_bf16(sf[d], qf[tm], acc[d][tm], 0, 0, 0);
        }
#pragma unroll
        for (int tm = 0; tm < 4; ++tm) { float ss = 0.f;
#pragma unroll
            for (int d = 0; d < 2; ++d) ss += (acc[d][tm][0] * acc[d][tm][0] + acc[d][tm][1] * acc[d][tm][1]) + (acc[d][tm][2] * acc[d][tm][2] + acc[d][tm][3] * acc[d][tm][3]);
            ss += __shfl_xor(ss, 16); ss += __shfl_xor(ss, 32);
            if (q == 0) PART[w * 64 + 16 * tm + l16] = ss; }
        __syncthreads();
#pragma unroll
        for (int tm = 0; tm < 4; ++tm) { float tot = 0.f;
#pragma unroll
            for (int ww = 0; ww < 8; ++ww) tot += PART[ww * 64 + 16 * tm + l16];
            const float rs = rsqrtf(tot * (1.0f / 256.0f) + EPS); const size_t tok = tok0 + 16 * tm + l16;
#pragma unroll
            for (int d = 0; d < 2; ++d) { const int dv0 = 16 * (2 * w + d) + 4 * q; const f32x4 g = *(const f32x4*)(gon + dv0);
                const u32x2 rr = rw[tm][d];
                u32x2 o; o.x = cvt_pk_bf16(acc[d][tm][0] * rs * g.x * siluf_(bflo(rr.x)), acc[d][tm][1] * rs * g.y * siluf_(bfhi(rr.x)));
                o.y = cvt_pk_bf16(acc[d][tm][2] * rs * g.z * siluf_(bflo(rr.y)), acc[d][tm][3] * rs * g.w * siluf_(bfhi(rr.y)));
                *(u32x2*)(Oo + tok * D + h * 256 + dv0) = o; } }
        __syncthreads();
    }
    LAS float* SQ = (LAS float*)lds; LAS float* SK = SQ + 512; LAS float* SE = SK + 512; LAS float* OS = SE + 512;   LAS float* WP = OS + 2048;
    for (int item = blockIdx.x; item < 512; item += gridDim.x) {
        const int b = item >> 2, h = item & 3; const size_t row0 = (size_t)MP + b * 4;
        { const int t = tid >> 7, dk = tid & 127; const bf16_t* r = QKV + (row0 + t) * NIN;
            SQ[tid] = bf2f(r[h * 128 + dk]); SK[tid] = bf2f(r[512 + h * 128 + dk]); SE[tid] = __expf(logf_gate(bf2f(r[3072 + h * 128 + dk]) + P.in[10][h * 128 + dk])); }
        __syncthreads();
        const int dv = tid & 255, half = tid >> 8;
        const float* s0 = P.in[2] + ((size_t)item * 128 + half * 64) * 256 + dv;
        float S[64];
#pragma unroll
        for (int i = 0; i < 64; ++i) S[i] = s0[i * 256];
        float vv[4];
#pragma unroll
        for (int t = 0; t < 4; ++t) vv[t] = bf2f(QKV[(row0 + t) * NIN + 1024 + h * 256 + dv]);
#pragma unroll
        for (int t = 0; t < 4; ++t) { float op = 0.f;
#pragma unroll
            for (int i = 0; i < 64; ++i) { const int dk = half * 64 + i; S[i] = SE[t * 128 + dk] * S[i] + SK[t * 128 + dk] * vv[t]; op += SQ[t * 128 + dk] * S[i]; }
            OS[(half * 4 + t) * 256 + dv] = op; }
        float* so = P.out + O_GS + ((size_t)item * 128 + half * 64) * 256 + dv;
#pragma unroll
        for (int i = 0; i < 64; ++i) so[i * 256] = S[i];
        __syncthreads();
        float o4[4];
#pragma unroll
        for (int t = 0; t < 4; ++t) { o4[t] = OS[t * 256 + dv] + OS[(4 + t) * 256 + dv]; const float s = wave_sum(o4[t] * o4[t]); if (tid < 256 && lane == 0) WP[w * 4 + t] = s; }
        __syncthreads();
        if (tid < 256) {
#pragma unroll
            for (int t = 0; t < 4; ++t) { const float tot = WP[t] + WP[4 + t] + WP[8 + t] + WP[12 + t]; const float rs = rsqrtf(tot * (1.0f / 256.0f) + EPS);
                const float r = bf2f(QKV[(row0 + t) * NIN + 2048 + h * 256 + dv]);
                Oo[(row0 + t) * D + h * 256 + dv] = f2bf(o4[t] * rs * gon[dv] * siluf_(r)); }
        }
        __syncthreads();
    }
}

__device__ __forceinline__ void s5_prefix_and_sample(const Params& P, LAS unsigned char* lds) {
    const int tid = otid(); const int lane = tid & 63, w = tid >> 6, gw = blockIdx.x * 8 + w, NGW = gridDim.x * 8;
    const float* sm = (const float*)(P.ws + WS_SMALL); const bf16_t* HL = (const bf16_t*)(P.ws + WS_HLOC); bf16_t* HS5 = (bf16_t*)(P.ws + WS_HS5);
    LAS float* TOT = (LAS float*)lds;
    for (int L = blockIdx.x; L < 256; L += gridDim.x) {
        int g, mt; { const int xcd = L & 7, idx = L >> 3, combo = xcd * 8 + (idx >> 2); g = (combo >> 2) * 4 + (idx & 3); mt = combo & 3; }
        const char* Aop = (const char*)(P.ws + WS_HS5) + (size_t)g * (1024 * 384 * 2) + (size_t)mt * (BM * 384 * 2);
        { OneUnit S1{{Aop, (const char*)(P.ws + WS_S5M) + (size_t)g * 262144, mt, g, 4, -1}}; EpiS5A E1{(bf16_t*)(P.ws + WS_HLOC)}; gemm_phase(lds, 384, 256, S1, E1); }
        asm volatile("s_waitcnt vmcnt(0)" ::: "memory"); __syncthreads();
        {
        const int seg = w & 3, b = 2 * mt + (w >> 2);
        const float ar = sm[SM_A16R + g * 64 + lane], ai = sm[SM_A16I + g * 64 + lane];
        const size_t col0 = (size_t)g * 1024 + b * 128 + seg * 32;
        float lr[32], li[32];
#pragma unroll
        for (int c = 0; c < 32; ++c) { lr[c] = bf2f(HL[(col0 + c) * 128 + lane]); li[c] = bf2f(HL[(col0 + c) * 128 + 64 + lane]); }
        float hr = 0.f, hi = 0.f;
#pragma unroll
        for (int c = 0; c < 32; ++c) { const float tr = lr[c], ti = li[c]; lr[c] = hr; li[c] = hi; const float nr = ar * hr - ai * hi + tr, ni = ar * hi + ai * hr + ti; hr = nr; hi = ni; }
        TOT[(w * 2 + 0) * 64 + lane] = hr; TOT[(w * 2 + 1) * 64 + lane] = hi;
        __syncthreads();
        float a32r = ar, a32i = ai;
#pragma unroll
        for (int k = 0; k < 5; ++k) { const float nr = a32r * a32r - a32i * a32i, ni = 2.f * a32r * a32i; a32r = nr; a32i = ni; }
        float cr = 0.f, ci = 0.f;
        for (int s = 0; s < seg; ++s) { const int ws_ = (w & 4) + s; const float tr = TOT[(ws_ * 2 + 0) * 64 + lane], ti = TOT[(ws_ * 2 + 1) * 64 + lane];
            const float nr = a32r * cr - a32i * ci + tr, ni = a32r * ci + a32i * cr + ti; cr = nr; ci = ni; }
        float pr_ = cr, pi_ = ci;
#pragma unroll
        for (int c = 0; c < 32; ++c) { HS5[(col0 + c) * 384 + 256 + lane] = f2bf(lr[c] + pr_); HS5[(col0 + c) * 384 + 320 + lane] = f2bf(li[c] + pi_);
            const float nr = ar * pr_ - ai * pi_, ni = ar * pi_ + ai * pr_; pr_ = nr; pi_ = ni; }
        if (seg == 3) { P.out[O_RP + (size_t)b * 4096 + g * 64 + lane] = hr + pr_; P.out[O_IP + (size_t)b * 4096 + g * 64 + lane] = hi + pi_; }
        }
        asm volatile("s_waitcnt vmcnt(0)" ::: "memory"); __syncthreads();
        { OneUnit S2{{Aop, (const char*)(P.ws + WS_S5M + 65536) + (size_t)g * 262144, mt, g, 6, -1}}; EpiS5B E2{P.ws, P.in[20]}; gemm_phase(lds, 384, 384, S2, E2); }
        __syncthreads();
    }
    const bf16_t* HSMP = (const bf16_t*)(P.ws + WS_HSMP); bf16_t* Z = (bf16_t*)(P.ws + WS_Z);
    LAS float* cb_ = (LAS float*)(lds + 4096 + w * 10752);
    LAS float* hb = cb_ + 2 * 16 * 68;
    for (int wv = gw; wv < 64 * 32; wv += NGW) {
        const int g = wv & 63, b0 = (wv >> 6) * 4, p = lane;
        const float ar = sm[SM_ARE + g * 64 + p], ai = sm[SM_AIM + g * 64 + p], fr = sm[SM_FRE + g * 64 + p], fi = sm[SM_FIM + g * 64 + p];
        f32x4 brv[4], biv[4], crv[4], civ[4];
#pragma unroll
        for (int c4 = 0; c4 < 4; ++c4) { brv[c4] = *(const f32x4*)(P.in[16] + ((size_t)g * 64 + p) * 16 + 4 * c4); biv[c4] = *(const f32x4*)(P.in[17] + ((size_t)g * 64 + p) * 16 + 4 * c4);
            crv[c4] = *(const f32x4*)(P.in[18] + (size_t)g * 1024 + (lane + 64 * c4) * 4); civ[c4] = *(const f32x4*)(P.in[19] + (size_t)g * 1024 + (lane + 64 * c4) * 4); }
        const int t = lane >> 4, cp = lane & 15; const float dsk = P.in[20][g * 16 + cp];
        float bbr[16], bbi[16];
#pragma unroll
        for (int c4 = 0; c4 < 4; ++c4) {
#pragma unroll
            for (int j = 0; j < 4; ++j) { bbr[4 * c4 + j] = fr * brv[c4][j] - fi * biv[c4][j]; bbi[4 * c4 + j] = fr * biv[c4][j] + fi * brv[c4][j]; }
            const int f = lane + 64 * c4, row = f >> 4, col = (f & 15) * 4;
            *(LAS f32x4*)(cb_ + row * 68 + col) = crv[c4]; *(LAS f32x4*)(cb_ + 16 * 68 + row * 68 + col) = civ[c4]; }
#pragma unroll 1
        for (int bb = 0; bb < 4; ++bb) { const int b = b0 + bb;
            u32x4 ua[4], ub[4];
#pragma unroll
            for (int tt = 0; tt < 4; ++tt) { ua[tt] = *(const u32x4*)(HSMP + (size_t)(b * 4 + tt) * D + g * 16); ub[tt] = *(const u32x4*)(HSMP + (size_t)(b * 4 + tt) * D + g * 16 + 8); }
            float hr = P.in[3][(size_t)b * 4096 + g * 64 + p], hi = P.in[4][(size_t)b * 4096 + g * 64 + p];
            const size_t row = (size_t)b * 4 + t; const float uu = bf2f(HSMP[row * D + g * 16 + cp]);
#pragma unroll
            for (int tt = 0; tt < 4; ++tt) { const u32x4 u0 = ua[tt], u1 = ub[tt];
                const float u[16] = {bflo(u0.x), bfhi(u0.x), bflo(u0.y), bfhi(u0.y), bflo(u0.z), bfhi(u0.z), bflo(u0.w), bfhi(u0.w),
                                     bflo(u1.x), bfhi(u1.x), bflo(u1.y), bfhi(u1.y), bflo(u1.z), bfhi(u1.z), bflo(u1.w), bfhi(u1.w)};
                float br = 0.f, bi = 0.f;
#pragma unroll
                for (int c = 0; c < 16; ++c) { br += bbr[c] * u[c]; bi += bbi[c] * u[c]; }
                const float nr = ar * hr - ai * hi + br, ni = ar * hi + ai * hr + bi; hr = nr; hi = ni;
                hb[(tt * 2 + 0) * 64 + p] = hr; hb[(tt * 2 + 1) * 64 + p] = hi; }
            P.out[O_RS + (size_t)b * 4096 + g * 64 + p] = hr; P.out[O_IS + (size_t)b * 4096 + g * 64 + p] = hi;
            asm volatile("s_waitcnt lgkmcnt(0)" ::: "memory");
            float y = 0.f;
#pragma unroll
            for (int i = 0; i < 16; ++i) { const f32x4 c4r = *(const LAS f32x4*)(cb_ + cp * 68 + 4 * i), c4i = *(const LAS f32x4*)(cb_ + 16 * 68 + cp * 68 + 4 * i);
                const f32x4 h4r = *(const LAS f32x4*)(hb + (t * 2 + 0) * 64 + 4 * i), h4i = *(const LAS f32x4*)(hb + (t * 2 + 1) * 64 + 4 * i);
                y += (c4r.x * h4r.x - c4i.x * h4i.x) + (c4r.y * h4r.y - c4i.y * h4i.y) + (c4r.z * h4r.z - c4i.z * h4i.z) + (c4r.w * h4r.w - c4i.w * h4i.w); }
            Z[((size_t)MP + row) * D + g * 16 + cp] = f2bf(y + dsk * uu);
            asm volatile("s_waitcnt lgkmcnt(0)" ::: "memory");
        }
    }
}

#define XB_TMO      128
#define XB_XCNT(j)  (256  + 64 * (j))
#define XB_XSUB(j)  (1280 + 64 * (j))
#define XB_XGEN(j)  (2304 + 64 * (j))
#define XB_TOP      3328
#define XB_TOPGEN   3392
#define XCD_BAR_WORDS 3456
#define XB_SPIN_CAP (1u << 22)
__device__ __forceinline__ unsigned xb_ld(unsigned* p)              { return __hip_atomic_load(p, __ATOMIC_RELAXED, __HIP_MEMORY_SCOPE_AGENT); }
__device__ __forceinline__ unsigned xb_add(unsigned* p, unsigned v) { return __hip_atomic_fetch_add(p, v, __ATOMIC_RELAXED, __HIP_MEMORY_SCOPE_AGENT); }
__device__ __forceinline__ unsigned xb_xcc_id() { return (unsigned)__builtin_amdgcn_s_getreg((3 << 11) | 20) & 0xFu; }
#define XB_SPIN(cond, bar) do { unsigned _sp = 0; while (cond) { __builtin_amdgcn_s_sleep(1); \
    if ((++_sp & 255u) == 0u) { if (xb_ld(&(bar)[XB_TMO])) break; if (_sp > XB_SPIN_CAP) { atomicAdd(&(bar)[XB_TMO], 1u); break; } } } } while (0)
struct XcdBarrier { unsigned* bar; unsigned x; volatile LAS unsigned* st; };
__device__ __forceinline__ XcdBarrier xcd_barrier_post(unsigned* bar, volatile LAS unsigned* st) {
    XcdBarrier b; b.bar = bar; b.x = xb_xcc_id(); b.st = st;
    if (threadIdx.x == 0) (void)xb_add(&bar[XB_XCNT(b.x)], 1u);
    return b;
}
__device__ __forceinline__ void xcd_barrier_complete(unsigned* bar, unsigned x, unsigned& nloc, unsigned& nx) {
    const unsigned G = gridDim.x * gridDim.y * gridDim.z;
    unsigned sum, cnt, mine, sp = 0u;
    for (;;) {
        sum = 0u; cnt = 0u; mine = 0u;
#pragma unroll
        for (unsigned j = 0; j < 16; ++j) { const unsigned c = xb_ld(&bar[XB_XCNT(j)]); sum += c; cnt += (c > 0u) ? 1u : 0u; mine = (j == x) ? c : mine; }
        if (sum == G) break;
        __builtin_amdgcn_s_sleep(1);
        if ((++sp & 255u) == 0u) { if (xb_ld(&bar[XB_TMO])) break; if (sp > XB_SPIN_CAP) { atomicAdd(&bar[XB_TMO], 1u); break; } }
    }
    nloc = mine > 0u ? mine : 1u; nx = cnt > 0u ? cnt : 1u;
}
__device__ __forceinline__ void xcd_barrier(const XcdBarrier& b) {
    asm volatile("s_waitcnt vmcnt(0)" ::: "memory");
    __syncthreads();
    if (threadIdx.x == 0) {
        unsigned* bar = b.bar;
        __builtin_amdgcn_s_waitcnt(0);
        unsigned nloc = b.st[0], nx = b.st[1];
        if (nloc == 0u) { xcd_barrier_complete(bar, b.x, nloc, nx); b.st[0] = nloc; b.st[1] = nx; }
        const unsigned old = xb_add(&bar[XB_XSUB(b.x)], 1u);
        const unsigned gen = old / nloc;
        if (old + 1u == (gen + 1u) * nloc) {
            __builtin_amdgcn_fence(__ATOMIC_RELEASE, "agent");
            asm volatile("s_waitcnt vmcnt(0)" ::: "memory");
            const unsigned og = xb_add(&bar[XB_TOP], 1u);
            const unsigned tg = og / nx;
            if (og + 1u == (tg + 1u) * nx) xb_add(&bar[XB_TOPGEN], 1u);
            else XB_SPIN(xb_ld(&bar[XB_TOPGEN]) == tg, bar);
            __builtin_amdgcn_fence(__ATOMIC_ACQUIRE, "agent");
            xb_add(&bar[XB_XGEN(b.x)], 1u);
            asm volatile("s_waitcnt vmcnt(0)" ::: "memory");
        } else {
            XB_SPIN(xb_ld(&bar[XB_XGEN(b.x)]) == gen, bar);
            __builtin_amdgcn_fence(__ATOMIC_ACQUIRE, "agent");
            asm volatile("s_waitcnt vmcnt(0)" ::: "memory");
        }
    }
    __syncthreads();
}

__global__ void __launch_bounds__(512, 2) fwd_kernel(Params P) {
    extern __shared__ __attribute__((aligned(16))) unsigned char lds_raw[];
    LAS unsigned char* lds = (LAS unsigned char*)lds_raw;
    cg::grid_group grid = cg::this_grid();
    const int lo = P.ph_lo, hi = P.ph_hi; int ph = 0;
    const int G = gridDim.x, cb = blockIdx.x;
    unsigned char* ws = P.ws;
    bf16_t* XB = (bf16_t*)(ws + WS_H); bf16_t* ACT = (bf16_t*)(ws + WS_ACT); bf16_t* Y = (bf16_t*)(ws + WS_Y);
    float* R2 = (float*)(ws + WS_SMALL) + SM_R2;
    unsigned long long pr_acc = 0ull, pr_t0 = 0ull;
#define PH_BEGIN if (PROBE_MASK) pr_t0 = __builtin_amdgcn_s_memrealtime(); if (lo <= ph && ph < hi) {
#define PH_END } ++ph; if (lo < ph && ph < hi) xcd_barrier(xbar); \
    if (PROBE_MASK && ((PROBE_MASK >> (ph - 1)) & 1u)) pr_acc += __builtin_amdgcn_s_memrealtime() - pr_t0;
    volatile LAS unsigned* xst = (volatile LAS unsigned*)(lds + LDS_BYTES - 64);
    if (threadIdx.x < 2) xst[threadIdx.x] = 0u;
    __syncthreads();
    if (ws == nullptr) grid.sync();
    XcdBarrier xbar; xbar.bar = (unsigned*)ws; xbar.x = 0; xbar.st = xst;
    if (hi - lo > 1) xbar = xcd_barrier_post((unsigned*)ws, xst);

    PH_BEGIN phase0(P, lds); PH_END

#define MIXER_GLA \
    PH_BEGIN { TileOrder S{M / BM, NIN / BM, (M / BM) * (NIN / BM), G, cb, (const char*)XB, (const char*)(ws + WS_WIN), (size_t)BM * D * 2, (size_t)BM * D * 2, D / BK}; \
        EpiPlain<1> E{(bf16_t*)(ws + WS_QKV), NIN, P.in[10], nullptr, R2}; gemm_phase(lds, D, D, S, E); } s5_idle_prep_inproj(P, lds); PH_END \
    PH_BEGIN gla_phase_a(P, lds); PH_END \
    PH_BEGIN gla_phase_b(P); PH_END \
    PH_BEGIN gla_phase_c(P, lds); PH_END \
    PH_BEGIN { SplitOrder S{{MP / BM, D / BM, (MP / BM) * (D / BM), G, cb, (const char*)(ws + WS_O), (const char*)(ws + WS_WOUT), (size_t)BM * D * 2, (size_t)BM * D * 2, D / BK}, D / 256}; \
        EpiPlain<0> E{Y, D, nullptr, PART, nullptr}; gemm_phase(lds, D, D, S, E); } PH_END
#define MIXER_S5 \
    PH_BEGIN s5_prefix_and_sample(P, lds); PH_END \
    PH_BEGIN { SplitOrder S{{MP / BM, 2 * D / BM, (MP / BM) * (2 * D / BM), G, cb, (const char*)(ws + WS_Z), (const char*)(ws + WS_WGLU), (size_t)BM * D * 2, (size_t)BM * D * 2, D / BK}, D / 256}; \
        EpiGated<1> E{Y, D, P.in[22], (float*)(ws + WS_HLOC)}; gemm_phase(lds, D, D, S, E); } PH_END
#define FFN_GEMMS(l, f, HOOK) \
    PH_BEGIN { TileOrder S{M / BM, NGU / BM, (M / BM) * (NGU / BM), G, cb, (const char*)XB, (const char*)(ws + WS_WGU + (size_t)((l) * 2 + (f)) * NGU * D * 2), (size_t)BM * D * 2, (size_t)BM * D * 2, D / BK}; \
        EpiGated<0> E{ACT, FF, nullptr, nullptr}; gemm_phase(lds, D, D, S, E); } HOOK PH_END \
    PH_BEGIN { SplitOrder S{{MP / BM, D / BM, (MP / BM) * (D / BM), G, cb, (const char*)ACT, (const char*)(ws + WS_WDN + (size_t)((l) * 2 + (f)) * D * FF * 2), (size_t)BM * FF * 2, (size_t)BM * FF * 2, FF / BK}, FF / 256}; \
        EpiPlain<0> E{Y, D, nullptr, PART, nullptr}; gemm_phase(lds, FF, FF, S, E); } PH_END
    const float* ng0 = P.in[5]; const float* ng1 = P.in[5] + 6 * D;
    float* PART = (float*)(ws + WS_PART);
    FFN_GEMMS(0, 0, s5_idle_prep(P, lds, 0);)
    PH_BEGIN row_pass<3, FF / 256>(P.in[0], P.in[1], XB, R2, Y, ng0 + 1 * D, 0.5f, PART, nullptr, nullptr, nullptr, nullptr); PH_END
    MIXER_GLA
    PH_BEGIN row_pass<3, D / 256>(nullptr, nullptr, XB, R2, Y, ng0 + 3 * D, 1.0f, PART, nullptr, nullptr, nullptr, nullptr); PH_END
    FFN_GEMMS(0, 1, s5_idle_prep(P, lds, 1);)
    PH_BEGIN row_pass<3, FF / 256>(nullptr, nullptr, XB, R2, Y, ng0 + 5 * D, 0.5f, PART, nullptr, nullptr, nullptr, nullptr); PH_END
    FFN_GEMMS(1, 0, s5_idle_prep(P, lds, 2);)
    PH_BEGIN row_pass<3, FF / 256>(nullptr, nullptr, XB, R2, Y, ng1 + 1 * D, 0.5f, PART, nullptr, ng1 + 2 * D, (bf16_t*)(ws + WS_HS5), (bf16_t*)(ws + WS_HSMP)); PH_END
    MIXER_S5
    PH_BEGIN row_pass<3, D / 256>(nullptr, nullptr, XB, R2, Y, ng1 + 3 * D, 1.0f, (const float*)(ws + WS_HLOC), nullptr, nullptr, nullptr, nullptr, P.in[22]); PH_END
    FFN_GEMMS(1, 1, )
    PH_BEGIN row_pass<2, FF / 256>(nullptr, nullptr, XB, R2, Y, ng1 + 5 * D, 0.5f, PART, P.out + O_X, nullptr, nullptr, nullptr); PH_END
    if (PROBE_MASK && blockIdx.x == 0 && threadIdx.x == 0) { const unsigned long long t1 = __builtin_amdgcn_s_memrealtime(); while (__builtin_amdgcn_s_memrealtime() - t1 < pr_acc) __builtin_amdgcn_s_sleep(8); }
#undef PH_BEGIN
#undef PH_END
}

__global__ void dbg_checksum(const unsigned* w, size_t nwords, float* out, size_t nout) {
    for (size_t i = (size_t)blockIdx.x * blockDim.x + threadIdx.x; i < nout; i += (size_t)gridDim.x * blockDim.x) {
        unsigned h = 0; for (int j = 0; j < 3; ++j) { const size_t k = 3 * i + j; if (k < nwords) h = h * 0x9E3779B1u + w[k]; }
        out[i] = (float)(h & 0xffffu);
    }
}
extern "C" void kernel_launch(void* const* d_in, const int* in_sizes, int n_in, void* d_out, int out_size, void* d_ws, size_t ws_size, hipStream_t stream) {
    static int grid = 0;
    if (grid == 0) {
        if (n_in != 23 || ws_size < WS_END) { fprintf(stderr, "kernel_launch: unexpected n_in %d or ws_size %zu (< %zu)\n", n_in, ws_size, (size_t)WS_END); grid = -1; return; }
        int dev = 0, cus = 0, per_cu = 0;
        hipGetDevice(&dev); hipDeviceGetAttribute(&cus, hipDeviceAttributeMultiprocessorCount, dev);
        if (hipFuncSetAttribute((const void*)fwd_kernel, hipFuncAttributeMaxDynamicSharedMemorySize, LDS_BYTES) != hipSuccess) { fprintf(stderr, "kernel_launch: hipFuncSetAttribute failed\n"); grid = -1; return; }
        if (hipOccupancyMaxActiveBlocksPerMultiprocessor(&per_cu, (const void*)fwd_kernel, 512, LDS_BYTES) != hipSuccess || per_cu < 1) { fprintf(stderr, "kernel_launch: occupancy query failed (%d)\n", per_cu); grid = -1; return; }
        grid = cus * per_cu;
    }
    if (grid < 0) return;
    if (hipMemsetAsync(d_ws, 0, 16384, stream) != hipSuccess) { fprintf(stderr, "kernel_launch: memset failed\n"); return; }
    Params p{};
    for (int i = 0; i < 23; ++i) p.in[i] = (const float*)d_in[i];
    p.out = (float*)d_out; p.ws = (unsigned char*)d_ws;
#if MULTI_LAUNCH
    for (int k = 0; k < (DBG_NPH ? DBG_NPH : NPH); ++k) { p.ph_lo = k; p.ph_hi = k + 1; hipLaunchKernelGGL(fwd_kernel, dim3(grid), dim3(512), LDS_BYTES, stream, p); }
#if DBG_NPH
    hipLaunchKernelGGL(dbg_checksum, dim3(2048), dim3(256), 0, stream, (const unsigned*)d_ws, (size_t)(WS_END / 4), (float*)d_out, (size_t)out_size);
#endif
#else
    p.ph_lo = 0; p.ph_hi = NPH;
    void* args[] = {&p};
    hipError_t e = hipLaunchCooperativeKernel((const void*)fwd_kernel, dim3(grid), dim3(512), args, LDS_BYTES, stream);
    if (e != hipSuccess) fprintf(stderr, "cooperative launch failed: %s (grid %d)\n", hipGetErrorString(e), grid);
#endif
}
```
